# Optimizing an MI355X kernel written in HIP

```python
import math, functools
import jax, jax.numpy as jnp
from jax import lax
import numpy as np

D_MODEL = 2048
BATCH = 16
SEQ = 256
DEPTH = 2
DEC_BATCH = 8
DEC_SEQ = 1024
PAST_LEN = 512

GRID_W = 64
N_EVEN = (DEPTH + 1) // 2
N_ODD = DEPTH // 2
HEAD_DIM = 128
HA = 8
NOPE_DIM = 128
ROPE_DIM = 64
V_DIM = 128
QK_DIM = NOPE_DIM + ROPE_DIM
Q_LORA = 512
KV_LORA = 512
HB = 8
NA_KH = 8
NA_KW = 16
HC = 16
KVH_C = 4
GROUPS_C = HC // KVH_C
WINDOW = 128
WINDOW_BLOCK = 128
D_FF = 5632
N_MOD = 9
IN_EVEN = Q_LORA + KV_LORA + ROPE_DIM + 3 * HB * HEAD_DIM
MIX_EVEN = HA * V_DIM + HB * HEAD_DIM
IN_ODD = HC * HEAD_DIM + 2 * KVH_C * HEAD_DIM
MIX_ODD = HC * HEAD_DIM
ROPE_THETA = 10000.0
EPS = 1e-6
NEG_INF = -1e30
QBLOCK = 128

kernel_name = "hybrid_dit_mla_natten_swa_step"


def rms_norm(x, g):
    xf = x.astype(jnp.float32)
    xf = xf * lax.rsqrt(jnp.mean(xf * xf, axis=-1, keepdims=True) + EPS)
    return (xf * g.astype(jnp.float32)).astype(x.dtype)


def modulate(x, g, shift, scale):
    return rms_norm(x, g) * (1 + scale) + shift


def modulation(cond, ada_w, ada_b):
    m = jax.nn.silu(cond) @ ada_w + ada_b
    return jnp.split(m[:, None, :], N_MOD, axis=-1)


def swiglu(h, w_in, w_out):
    gate, up = jnp.split(h @ w_in, 2, axis=-1)
    return (jax.nn.silu(gate) * up) @ w_out


def axial_rope(x):
    S, R = x.shape[1], x.shape[-1]
    half = R // 2
    nf = half // 2
    t = jnp.arange(S)
    inv_freq = ROPE_THETA ** (-jnp.arange(nf, dtype=jnp.float32) / nf)

    def rot(xa, pos):
        ang = pos.astype(jnp.float32)[:, None] * inv_freq[None, :]
        cos = jnp.cos(ang)[None, :, None, :]
        sin = jnp.sin(ang)[None, :, None, :]
        xa = xa.astype(jnp.float32)
        x1, x2 = xa[..., :nf], xa[..., nf:]
        return jnp.concatenate([x1 * cos - x2 * sin, x1 * sin + x2 * cos], axis=-1)

    out = jnp.concatenate([rot(x[..., :half], t // GRID_W), rot(x[..., half:], t % GRID_W)], axis=-1)
    return out.astype(x.dtype)


def rope_tail(x, n_rot):
    return jnp.concatenate([x[..., :-n_rot], axial_rope(x[..., -n_rot:])], axis=-1)


def blocked_attention(q, k, v, scale, sink=None):
    B, S = q.shape[:2]
    nq = S // QBLOCK
    qb = q.reshape(B, nq, QBLOCK, *q.shape[2:]).swapaxes(0, 1)

    def one(qblk):
        s = jnp.einsum('bqhgd,bthd->bhgqt', qblk, k).astype(jnp.float32) * scale
        if sink is not None:
            s_sink = jnp.broadcast_to(sink[None, :, :, None, None].astype(jnp.float32), s.shape[:-1] + (1,))
            s = jnp.concatenate([s, s_sink], axis=-1)
        p = jax.nn.softmax(s, axis=-1)
        if sink is not None:
            p = p[..., :-1]
        return jnp.einsum('bhgqt,bthd->bqhgd', p.astype(v.dtype), v)

    out = lax.map(one, qb)
    return out.swapaxes(0, 1).reshape(B, S, *out.shape[3:])


def neighborhood_attention(q, k, v, k_ctx, v_ctx, rpb):
    B, S, H, Dh = q.shape
    rows = S // GRID_W
    kh = min(NA_KH, rows)
    kw = NA_KW
    ncb = GRID_W // kw
    cbw = 2 * kw
    scale = 1.0 / math.sqrt(Dh)
    qg = q.reshape(B, rows, GRID_W, H, Dh)
    kg = k.reshape(B, rows, GRID_W, H, Dh)
    vg = v.reshape(B, rows, GRID_W, H, Dh)
    band_start = np.clip(np.arange(ncb) * kw - kw // 2, 0, GRID_W - cbw)
    key_col = band_start[:, None] + np.arange(cbw)[None, :]
    q_col = np.arange(ncb)[:, None] * kw + np.arange(kw)[None, :]
    win_start = np.clip(q_col - kw // 2, 0, GRID_W - kw)
    kc = key_col[:, None, :]
    col_valid = jnp.asarray((kc >= win_start[..., None]) & (kc < win_start[..., None] + kw))
    col_off = np.clip(kc - q_col[..., None], -(NA_KW - 1), NA_KW - 1) + (NA_KW - 1)
    col_bias = rpb[:, :, col_off]

    def one_row(r):
        rs = jnp.clip(r - kh // 2, 0, rows - kh)
        k_band = lax.dynamic_slice_in_dim(kg, rs, kh, axis=1)[:, :, key_col]
        v_band = lax.dynamic_slice_in_dim(vg, rs, kh, axis=1)[:, :, key_col]
        q_r = lax.dynamic_index_in_dim(qg, r, axis=1, keepdims=False).reshape(B, ncb, kw, H, Dh)
        s_loc = jnp.einsum('bjqhd,bajchd->bjqhac', q_r, k_band).astype(jnp.float32) * scale
        row_off = rs + jnp.arange(kh) - r + (NA_KH - 1)
        bias = col_bias[:, row_off].transpose(2, 3, 0, 1, 4).astype(jnp.float32)
        s_loc = jnp.where(col_valid[:, :, None, None, :], s_loc + bias, NEG_INF)
        s_loc = s_loc.reshape(B, ncb, kw, H, kh * cbw)
        s_ctx = jnp.einsum('bjqhd,blhd->bjqhl', q_r, k_ctx).astype(jnp.float32) * scale
        p = jax.nn.softmax(jnp.concatenate([s_loc, s_ctx], axis=-1), axis=-1).astype(v.dtype)
        p_loc = p[..., :kh * cbw].reshape(B, ncb, kw, H, kh, cbw)
        p_ctx = p[..., kh * cbw:]
        out = (jnp.einsum('bjqhac,bajchd->bjqhd', p_loc, v_band)
               + jnp.einsum('bjqhl,blhd->bjqhd', p_ctx, v_ctx))
        return out.reshape(B, GRID_W, H, Dh)

    out = lax.map(one_row, jnp.arange(rows))
    return out.transpose(1, 0, 2, 3, 4).reshape(B, S, H, Dh)


def windowed_attention(q, k, v, k_ctx, v_ctx, sink):
    B, S, KVH, G, Dh = q.shape
    wb = WINDOW_BLOCK
    nb = S // wb
    scale = 1.0 / math.sqrt(Dh)
    pad = ((0, 0), (wb, wb), (0, 0), (0, 0))
    kp = jnp.pad(k, pad).reshape(B, nb + 2, wb, KVH, Dh)
    vp = jnp.pad(v, pad).reshape(B, nb + 2, wb, KVH, Dh)
    k_band = jnp.concatenate([kp[:, :-2], kp[:, 1:-1], kp[:, 2:]], axis=2)
    v_band = jnp.concatenate([vp[:, :-2], vp[:, 1:-1], vp[:, 2:]], axis=2)
    qb = q.reshape(B, nb, wb, KVH, G, Dh)

    def one_block(args):
        qblk, kblk, vblk, n = args
        s_loc = jnp.einsum('bqhgd,bthd->bhgqt', qblk, kblk).astype(jnp.float32) * scale
        kabs = n * wb - wb + jnp.arange(3 * wb)
        qabs = n * wb + jnp.arange(wb)
        valid = (jnp.abs(qabs[:, None] - kabs[None, :]) <= WINDOW) & (kabs[None, :] >= 0) & (kabs[None, :] < S)
        s_loc = jnp.where(valid, s_loc, NEG_INF)
        s_ctx = jnp.einsum('bqhgd,blhd->bhgql', qblk, k_ctx).astype(jnp.float32) * scale
        s_sink = jnp.broadcast_to(sink[None, :, :, None, None].astype(jnp.float32), (B, KVH, G, wb, 1))
        p = jax.nn.softmax(jnp.concatenate([s_loc, s_ctx, s_sink], axis=-1), axis=-1).astype(v.dtype)
        return (jnp.einsum('bhgqt,bthd->bqhgd', p[..., :3 * wb], vblk)
                + jnp.einsum('bhgql,blhd->bqhgd', p[..., 3 * wb:-1], v_ctx))

    out = lax.map(one_block, (qb.swapaxes(0, 1), k_band.swapaxes(0, 1), v_band.swapaxes(0, 1), jnp.arange(nb)))
    return out.swapaxes(0, 1).reshape(B, S, KVH, G, Dh)


def even_projections(h, w_in, q_norm, w_q_up, kv_norm, mla_qk_norm, na_qk_norm):
    B, T, _ = h.shape
    i0 = Q_LORA
    i1 = i0 + KV_LORA
    i2 = i1 + ROPE_DIM
    i3 = i2 + HB * HEAD_DIM
    i4 = i3 + HB * HEAD_DIM
    cq, ckv, k_rope, qn, kn, vn = jnp.split(h @ w_in, [i0, i1, i2, i3, i4], axis=-1)
    q_mla = (rms_norm(cq, q_norm) @ w_q_up).reshape(B, T, HA, QK_DIM)
    q_mla = rms_norm(q_mla, mla_qk_norm[0])
    ckv = rms_norm(ckv, kv_norm)
    q_na = rms_norm(qn.reshape(B, T, HB, HEAD_DIM), na_qk_norm[0])
    k_na = rms_norm(kn.reshape(B, T, HB, HEAD_DIM), na_qk_norm[1])
    v_na = vn.reshape(B, T, HB, HEAD_DIM)
    return q_mla, ckv, k_rope, q_na, k_na, v_na


def mla_keys_values(ckv, k_rope, w_kv_up, k_norm):
    B, T, _ = ckv.shape
    kv = (ckv @ w_kv_up).reshape(B, T, HA, NOPE_DIM + V_DIM)
    k = jnp.concatenate([kv[..., :NOPE_DIM], jnp.broadcast_to(k_rope[:, :, None, :], (B, T, HA, ROPE_DIM))], axis=-1)
    return rms_norm(k, k_norm), kv[..., NOPE_DIM:]


def even_mixer_context(w_in, w_out, q_norm, w_q_up, kv_norm, w_kv_up, mla_qk_norm, na_qk_norm, h):
    B, T, _ = h.shape
    q_mla, ckv, k_rope, q_na, k_na, v_na = even_projections(h, w_in, q_norm, w_q_up, kv_norm, mla_qk_norm, na_qk_norm)
    k_mla, v_mla = mla_keys_values(ckv, k_rope, w_kv_up, mla_qk_norm[1])
    o_mla = blocked_attention(q_mla[:, :, :, None], k_mla, v_mla, 1.0 / math.sqrt(QK_DIM))
    o_na = blocked_attention(q_na[:, :, :, None], k_na, v_na, 1.0 / math.sqrt(HEAD_DIM))
    y = jnp.concatenate([o_mla.reshape(B, T, HA * V_DIM), o_na.reshape(B, T, HB * HEAD_DIM)], axis=-1) @ w_out
    return y, (ckv, k_rope, k_na, v_na)


def even_mixer_latent(cache_ckv, cache_krope, cache_k, cache_v, rpb, w_in, w_out, q_norm, w_q_up, kv_norm, w_kv_up,
                      mla_qk_norm, na_qk_norm, h):
    B, S, _ = h.shape
    q_mla, ckv, k_rope, q_na, k_na, v_na = even_projections(h, w_in, q_norm, w_q_up, kv_norm, mla_qk_norm, na_qk_norm)
    k_lat, v_lat = mla_keys_values(ckv, k_rope, w_kv_up, mla_qk_norm[1])
    q_mla = rope_tail(q_mla, ROPE_DIM)
    k_lat = rope_tail(k_lat, ROPE_DIM)
    k_ctx, v_ctx = mla_keys_values(cache_ckv, cache_krope, w_kv_up, mla_qk_norm[1])
    o_mla = blocked_attention(q_mla[:, :, :, None], jnp.concatenate([k_lat, k_ctx], axis=1),
                              jnp.concatenate([v_lat, v_ctx], axis=1), 1.0 / math.sqrt(QK_DIM))
    o_na = neighborhood_attention(q_na, k_na, v_na, cache_k, cache_v, rpb)
    y = jnp.concatenate([o_mla.reshape(B, S, HA * V_DIM), o_na.reshape(B, S, HB * HEAD_DIM)], axis=-1) @ w_out
    return y, ()


def odd_projections(h, w_in, qk_norm):
    B, T, _ = h.shape
    q, k, v = jnp.split(h @ w_in, [HC * HEAD_DIM, (HC + KVH_C) * HEAD_DIM], axis=-1)
    q = rms_norm(q.reshape(B, T, HC, HEAD_DIM), qk_norm[0])
    k = rms_norm(k.reshape(B, T, KVH_C, HEAD_DIM), qk_norm[1])
    return q, k, v.reshape(B, T, KVH_C, HEAD_DIM)


def odd_mixer_context(w_in, w_out, qk_norm, sink, h):
    B, T, _ = h.shape
    q, k, v = odd_projections(h, w_in, qk_norm)
    o = blocked_attention(q.reshape(B, T, KVH_C, GROUPS_C, HEAD_DIM), k, v, 1.0 / math.sqrt(HEAD_DIM),
                          sink=sink.reshape(KVH_C, GROUPS_C))
    return o.reshape(B, T, MIX_ODD) @ w_out, (k, v)


def odd_mixer_latent(cache_k, cache_v, w_in, w_out, qk_norm, sink, h):
    B, S, _ = h.shape
    q, k, v = odd_projections(h, w_in, qk_norm)
    q = axial_rope(q)
    k = axial_rope(k)
    o = windowed_attention(q.reshape(B, S, KVH_C, GROUPS_C, HEAD_DIM), k, v, cache_k, cache_v,
                           sink.reshape(KVH_C, GROUPS_C))
    return o.reshape(B, S, MIX_ODD) @ w_out, ()


def macaron_layer(x, mods, norm_g, ffn_w_in, ffn_w_out, mixer):
    sh1, sc1, g1, sh2, sc2, g2, sh3, sc3, g3 = mods
    x = x + 0.5 * g1 * swiglu(modulate(x, norm_g[0], sh1, sc1), ffn_w_in[0], ffn_w_out[0])
    y, extras = mixer(modulate(x, norm_g[1], sh2, sc2))
    x = x + g2 * y
    x = x + 0.5 * g3 * swiglu(modulate(x, norm_g[2], sh3, sc3), ffn_w_in[1], ffn_w_out[1])
    return x, extras


def setup_inputs(seed: int = 0) -> dict:
    key = jax.random.key(seed)
    ks = iter(jax.random.split(key, 32))

    def normal(shape, scale=1.0):
        return jax.random.normal(next(ks), shape, jnp.float32) * scale

    def gain(shape):
        return 1.0 + normal(shape, 0.02)

    D = D_MODEL
    return {
        "x_prompt": normal((BATCH, SEQ, D)),
        "x_sample": normal((DEC_BATCH, DEC_SEQ, D)),
        "cache_mla_ckv": normal((DEC_BATCH, N_EVEN, PAST_LEN, KV_LORA)),
        "cache_mla_krope": normal((DEC_BATCH, N_EVEN, PAST_LEN, ROPE_DIM)),
        "cache_na_k": normal((DEC_BATCH, N_EVEN, PAST_LEN, HB, HEAD_DIM)),
        "cache_na_v": normal((DEC_BATCH, N_EVEN, PAST_LEN, HB, HEAD_DIM)),
        "cache_gqa_k": normal((DEC_BATCH, N_ODD, PAST_LEN, KVH_C, HEAD_DIM)),
        "cache_gqa_v": normal((DEC_BATCH, N_ODD, PAST_LEN, KVH_C, HEAD_DIM)),
        "c": normal((DEC_BATCH, D)),
        "c_ctx": normal((D,)),
        "ada_w": normal((DEPTH, D, N_MOD * D), 0.5 * D ** -0.5),
        "ada_b": normal((DEPTH, N_MOD * D), 0.02),
        "norm_g": gain((DEPTH, 3, D)),
        "ffn_w_in": normal((DEPTH, 2, D, 2 * D_FF), D ** -0.5),
        "ffn_w_out": normal((DEPTH, 2, D_FF, D), D_FF ** -0.5),
        "even_w_in": normal((N_EVEN, D, IN_EVEN), D ** -0.5),
        "even_w_out": normal((N_EVEN, MIX_EVEN, D), MIX_EVEN ** -0.5),
        "mla_q_norm": gain((N_EVEN, Q_LORA)),
        "mla_w_q_up": normal((N_EVEN, Q_LORA, HA * QK_DIM), Q_LORA ** -0.5),
        "mla_kv_norm": gain((N_EVEN, KV_LORA)),
        "mla_w_kv_up": normal((N_EVEN, KV_LORA, HA * (NOPE_DIM + V_DIM)), KV_LORA ** -0.5),
        "mla_qk_norm": gain((N_EVEN, 2, QK_DIM)),
        "na_qk_norm": gain((N_EVEN, 2, HEAD_DIM)),
        "na_rpb": normal((N_EVEN, HB, 2 * NA_KH - 1, 2 * NA_KW - 1), 0.1),
        "odd_w_in": normal((N_ODD, D, IN_ODD), D ** -0.5),
        "odd_w_out": normal((N_ODD, MIX_ODD, D), MIX_ODD ** -0.5),
        "gqa_qk_norm": gain((N_ODD, 2, HEAD_DIM)),
        "gqa_sink": normal((N_ODD, HC), 0.5),
    }


def reference(x_prompt, x_sample, cache_mla_ckv, cache_mla_krope, cache_na_k, cache_na_v, cache_gqa_k, cache_gqa_v,
              c, c_ctx, ada_w, ada_b, norm_g, ffn_w_in, ffn_w_out, even_w_in, even_w_out, mla_q_norm, mla_w_q_up,
              mla_kv_norm, mla_w_kv_up, mla_qk_norm, na_qk_norm, na_rpb, odd_w_in, odd_w_out, gqa_qk_norm, gqa_sink):
    xp, xs = x_prompt, x_sample
    ctx_cond = c_ctx[None, :]
    ckv_l, kr_l, nak_l, nav_l, gk_l, gv_l = [], [], [], [], [], []
    for layer in range(DEPTH):
        mods_ctx = modulation(ctx_cond, ada_w[layer], ada_b[layer])
        mods_lat = modulation(c, ada_w[layer], ada_b[layer])
        common = (norm_g[layer], ffn_w_in[layer], ffn_w_out[layer])
        e = layer // 2
        if layer % 2 == 0:
            mix_w = (even_w_in[e], even_w_out[e], mla_q_norm[e], mla_w_q_up[e], mla_kv_norm[e], mla_w_kv_up[e],
                     mla_qk_norm[e], na_qk_norm[e])
            xp, (ckv, kr, nak, nav) = macaron_layer(xp, mods_ctx, *common,
                                                    functools.partial(even_mixer_context, *mix_w))
            xs, _ = macaron_layer(xs, mods_lat, *common,
                                  functools.partial(even_mixer_latent, cache_mla_ckv[:, e], cache_mla_krope[:, e],
                                                    cache_na_k[:, e], cache_na_v[:, e], na_rpb[e], *mix_w))
            ckv_l.append(ckv)
            kr_l.append(kr)
            nak_l.append(nak)
            nav_l.append(nav)
        else:
            mix_w = (odd_w_in[e], odd_w_out[e], gqa_qk_norm[e], gqa_sink[e])
            xp, (gk, gv) = macaron_layer(xp, mods_ctx, *common, functools.partial(odd_mixer_context, *mix_w))
            xs, _ = macaron_layer(xs, mods_lat, *common,
                                  functools.partial(odd_mixer_latent, cache_gqa_k[:, e], cache_gqa_v[:, e], *mix_w))
            gk_l.append(gk)
            gv_l.append(gv)
    return (xp, xs, jnp.stack(ckv_l, axis=1), jnp.stack(kr_l, axis=1), jnp.stack(nak_l, axis=1),
            jnp.stack(nav_l, axis=1), jnp.stack(gk_l, axis=1), jnp.stack(gv_l, axis=1))
```

```cpp
#include <hip/hip_runtime.h>
#include <cstdio>
#include <cstdint>

#ifndef MK_ONE_LAUNCH
#define MK_ONE_LAUNCH 1
#endif

#define COMMA ,
#define GAS __attribute__((address_space(1)))
#define LAS __attribute__((address_space(3)))
typedef unsigned short bf16_t;
typedef short bf16x8 __attribute__((ext_vector_type(8)));
typedef float f32x4 __attribute__((ext_vector_type(4)));
typedef float f32x16 __attribute__((ext_vector_type(16)));
typedef unsigned u32x4 __attribute__((ext_vector_type(4)));
typedef unsigned u32x2 __attribute__((ext_vector_type(2)));

namespace pg8 {
constexpr int BM = 256, BK = 64, HALF = 128, HTB = HALF * BK * 2, STAGE_BYTES = 8 * HTB, NXCD = 8, WGM = 8;
__host__ __device__ __forceinline__ int lds_byte(int r, int c) { const int st = (r >> 4) * 2 + (c >> 5), rr = r & 15, cc = c & 31, ob = rr * 64 + cc * 2; return st * 1024 + (ob ^ (((ob >> 9) & 1) << 5)); }
__host__ __device__ __forceinline__ void stage_rc(int b, int& R, int& C) { const int st = b / 1024, sb = b % 1024, swz = sb ^ (((sb >> 9) & 1) << 5); R = (st >> 1) * 16 + swz / 64; C = (st & 1) * 32 + (swz % 64) / 2; }
__host__ __device__ __forceinline__ int perm32(int rho) { const int n = rho >> 4, i = rho & 15; return 8 * (i >> 2) + 4 * n + (i & 3); }
struct Unit { int pm, pn, kt0, nkt, part; };
struct Gemm { const bf16_t* A; const bf16_t* Bt; int M, N, K; };
constexpr int GRID = 256;
template <int M, int N, int K, bool SPLIT>
struct SplitOrder {
    static constexpr int nM = M / BM, nN = N / BM, nwg = nM * nN, G = GRID, nt = K / BK, nfull = (nwg / G) * G, rem = nwg - nfull, NR = nfull / G;
    static constexpr int S0 = (SPLIT && rem > 0 && G % rem == 0) ? G / rem : 1;
    static constexpr int S = ((S0 == 2 || S0 == 4) && nt % (2 * S0) == 0) ? S0 : 1;
    int c;
    __host__ __device__ void init(int c_) { c = c_; }
    __host__ __device__ static Unit unit_of(int L, int kt0, int nkt, int part) {
        int wgid = L; { constexpr int q = nwg / NXCD, r = nwg % NXCD; const int xcd = wgid % NXCD, off = wgid / NXCD; wgid = (xcd < r ? xcd * (q + 1) : r * (q + 1) + (xcd - r) * q) + off; }
        constexpr int nig = WGM * nN; const int gid = wgid / nig, fm = gid * WGM, gsz = (nM - fm) < WGM ? (nM - fm) : WGM;
        Unit u; u.pm = fm + ((wgid % nig) % gsz); u.pn = (wgid % nig) / gsz; u.kt0 = kt0; u.nkt = nkt; u.part = part; return u;
    }
    __host__ __device__ bool next(int i, Unit& u) const {
        int L = i * G + c, kt0 = 0, nkt = nt, part = -1; bool ok = L < nwg;
        if (S > 1 && i >= NR) { constexpr int R1 = rem > 0 ? rem : 1; L = nfull + (c % R1); nkt = nt / S; kt0 = (c / R1) * (nt / S); part = c; ok = (i == NR); }
        if (!ok) return false;
        u = unit_of(L, kt0, nkt, part); return true;
    }
};
typedef float f32x2_t __attribute__((ext_vector_type(2)));
typedef __bf16 bf16x2_t __attribute__((ext_vector_type(2)));
__device__ __forceinline__ unsigned cvt_pk_bf16(float lo, float hi) { const f32x2_t v = {lo, hi}; return __builtin_bit_cast(unsigned, __builtin_convertvector(v, bf16x2_t)); }

template <class Epi, class Sched, bool ALIGN_EPI = false, bool SP2 = false>
__device__ __forceinline__ void gemm_phase(LAS unsigned char* lds, const Gemm g, const Sched& S, const Epi& E, float* slab) {
    const int tid = threadIdx.x, wid = __builtin_amdgcn_readfirstlane(tid >> 6), lane = tid & 63, wr = wid >> 2, wc = wid & 3, fr = lane & 15, fq = lane >> 4;
    const int K = g.K;
    unsigned voffA[2], voffB[2];
#pragma unroll
    for (int i = 0; i < 2; ++i) { int R, C; stage_rc(tid * 16 + i * 8192, R, C); const int Rb = Epi::PERM ? ((R & ~31) + perm32(R & 31)) : R;
        voffA[i] = (unsigned)(R * K + C) * 2u; voffB[i] = (unsigned)(Rb * K + C) * 2u; }
    const size_t kstep = (size_t)(BK * 2);
    const size_t hstep = (size_t)HALF * K * 2;
    const size_t tstep = 2 * hstep;
    const unsigned ldsw = (unsigned)wid * 1024u;
    const int aoff = lds_byte(wr * 64 + fr, fq * 8), boff = lds_byte(wc * 32 + fr, fq * 8);
#define PG8_SA(b, h) (((b) * 2 + (h)) * HTB)
#define PG8_SB(b, h) ((4 + (b) * 2 + (h)) * HTB)
#define PG8_STAGE(bufoff, gbase, voff) do { _Pragma("unroll") for (int _i = 0; _i < 2; ++_i) \
        __builtin_amdgcn_global_load_lds((const unsigned*)((const char*)(gbase) + (voff)[_i]), (LAS unsigned*)(lds + (bufoff) + ldsw + _i * 8192), 16, 0, 0); } while (0)
#define PG8_LDA(dst, b, h) do { _Pragma("unroll") for (int m = 0; m < 4; ++m) _Pragma("unroll") for (int k = 0; k < 2; ++k) dst[m][k] = *(const LAS bf16x8*)(lds + PG8_SA(b, h) + aoff + m * 2048 + k * 1024); } while (0)
#define PG8_LDB(dst, b, h) do { _Pragma("unroll") for (int n = 0; n < 2; ++n) _Pragma("unroll") for (int k = 0; k < 2; ++k) dst[n][k] = *(const LAS bf16x8*)(lds + PG8_SB(b, h) + boff + n * 2048 + k * 1024); } while (0)
#define PG8_MMA(ai, bj, At, Bt) do { __builtin_amdgcn_s_setprio(1); _Pragma("unroll") for (int m = 0; m < 4; ++m) _Pragma("unroll") for (int n = 0; n < 2; ++n) _Pragma("unroll") for (int k = 0; k < 2; ++k) \
        acc[ai][bj][m][n] = __builtin_amdgcn_mfma_f32_16x16x32_bf16(Bt[n][k], At[m][k], acc[ai][bj][m][n], 0, 0, 0); __builtin_amdgcn_s_setprio(0); } while (0)
#define PG8_WAIT_V(n) asm volatile("s_waitcnt vmcnt(" #n ")" ::: "memory")
#define PG8_WAIT_L(n) asm volatile("s_waitcnt lgkmcnt(" #n ")" ::: "memory")
#define PG8_BAR __builtin_amdgcn_s_barrier()
#define PG8_SCHED __builtin_amdgcn_sched_barrier(0)
    Unit cur, nxt; int ui = 0;
    if (!S.next(0, cur)) return;
    f32x4 acc[2][2][4][2];
#pragma unroll
    for (int a = 0; a < 2; ++a)
#pragma unroll
        for (int b = 0; b < 2; ++b)
#pragma unroll
            for (int m = 0; m < 4; ++m)
#pragma unroll
                for (int n = 0; n < 2; ++n) acc[a][b][m][n] = (f32x4){0.f, 0.f, 0.f, 0.f};
    bf16x8 At[4][2], B0[2][2], B1[2][2];
    const char* cA = (const char*)g.A + (size_t)cur.pm * tstep + (size_t)cur.kt0 * kstep; const char* cB = (const char*)g.Bt + (size_t)cur.pn * tstep + (size_t)cur.kt0 * kstep;
    if constexpr (SP2) {
        PG8_STAGE(PG8_SB(0, 0), cB, voffB); PG8_STAGE(PG8_SB(0, 1), cB + hstep, voffB); PG8_STAGE(PG8_SA(0, 0), cA, voffA); PG8_STAGE(PG8_SA(0, 1), cA + hstep, voffA);
        if (wr == 1) PG8_BAR;
        PG8_WAIT_V(2); PG8_BAR;
        PG8_STAGE(PG8_SB(1, 0), cB + kstep, voffB); PG8_STAGE(PG8_SA(1, 0), cA + kstep, voffA); PG8_STAGE(PG8_SB(1, 1), cB + hstep + kstep, voffB);
        PG8_WAIT_V(6); PG8_BAR;
    } else {
        PG8_STAGE(PG8_SB(0, 0), cB, voffB); PG8_STAGE(PG8_SA(0, 0), cA, voffA); PG8_STAGE(PG8_SB(0, 1), cB + hstep, voffB); PG8_STAGE(PG8_SA(0, 1), cA + hstep, voffA);
        if (wr == 1) PG8_BAR;
        PG8_WAIT_V(4); PG8_BAR;
        PG8_STAGE(PG8_SB(1, 0), cB + kstep, voffB); PG8_STAGE(PG8_SA(1, 0), cA + kstep, voffA); PG8_STAGE(PG8_SB(1, 1), cB + hstep + kstep, voffB);
        PG8_WAIT_V(6); PG8_BAR;
    }
    for (;;) {
        const bool has_next = S.next(ui + 1, nxt);
        const char* nA = has_next ? (const char*)g.A + (size_t)nxt.pm * tstep + (size_t)nxt.kt0 * kstep : cA; const char* nB = has_next ? (const char*)g.Bt + (size_t)nxt.pn * tstep + (size_t)nxt.kt0 * kstep : cB;
        const int nt = cur.nkt;
        for (int t = 0; t < nt; t += 2) {
            const bool last = (t == nt - 2);
            const char* a1 = cA + (size_t)(t + 1) * kstep;
            const char* a2 = last ? nA : cA + (size_t)(t + 2) * kstep; const char* b2 = last ? nB : cB + (size_t)(t + 2) * kstep;
            const char* a3 = a2 + kstep; const char* b3 = b2 + kstep;
            if constexpr (SP2) {
            PG8_LDB(B0, 0, 0); PG8_LDB(B1, 0, 1); PG8_SCHED; PG8_LDA(At, 0, 0); PG8_STAGE(PG8_SA(1, 1), a1 + hstep, voffA);
            PG8_WAIT_V(8); PG8_WAIT_L(0); PG8_BAR; PG8_MMA(0, 0, At, B0); PG8_MMA(0, 1, At, B1); PG8_BAR; PG8_SCHED;
            PG8_LDA(At, 0, 1); PG8_STAGE(PG8_SB(0, 0), b2, voffB); PG8_STAGE(PG8_SB(0, 1), b2 + hstep, voffB); PG8_STAGE(PG8_SA(0, 0), a2, voffA);
            PG8_WAIT_V(8); PG8_WAIT_L(0); PG8_BAR; PG8_MMA(1, 0, At, B0); PG8_MMA(1, 1, At, B1); PG8_BAR; PG8_SCHED;
            PG8_LDB(B0, 1, 0); PG8_LDB(B1, 1, 1); PG8_SCHED; PG8_LDA(At, 1, 0); PG8_STAGE(PG8_SA(0, 1), a2 + hstep, voffA);
            PG8_WAIT_V(8); PG8_WAIT_L(0); PG8_BAR; PG8_MMA(0, 0, At, B0); PG8_MMA(0, 1, At, B1); PG8_BAR; PG8_SCHED;
            PG8_LDA(At, 1, 1); PG8_STAGE(PG8_SB(1, 0), b3, voffB); PG8_STAGE(PG8_SB(1, 1), b3 + hstep, voffB); PG8_STAGE(PG8_SA(1, 0), a3, voffA);
            PG8_WAIT_V(8); PG8_WAIT_L(0); PG8_BAR; PG8_MMA(1, 0, At, B0); PG8_MMA(1, 1, At, B1); PG8_BAR; PG8_SCHED;
            } else {
            PG8_LDB(B0, 0, 0); PG8_SCHED; PG8_LDA(At, 0, 0); PG8_STAGE(PG8_SA(1, 1), a1 + hstep, voffA);
            PG8_WAIT_L(8); PG8_BAR; PG8_WAIT_L(0); PG8_MMA(0, 0, At, B0); PG8_BAR; PG8_SCHED;
            PG8_LDB(B1, 0, 1); PG8_STAGE(PG8_SB(0, 0), b2, voffB);
            PG8_BAR; PG8_WAIT_L(0); PG8_MMA(0, 1, At, B1); PG8_BAR;
            PG8_LDA(At, 0, 1); PG8_STAGE(PG8_SA(0, 0), a2, voffA);
            PG8_BAR; PG8_WAIT_L(0); PG8_MMA(1, 0, At, B0); PG8_BAR; PG8_SCHED;
            PG8_STAGE(PG8_SB(0, 1), b2 + hstep, voffB);
            PG8_WAIT_V(6); PG8_BAR; PG8_MMA(1, 1, At, B1); PG8_BAR;
            PG8_LDB(B0, 1, 0); PG8_SCHED; PG8_LDA(At, 1, 0); PG8_STAGE(PG8_SA(0, 1), a2 + hstep, voffA);
            PG8_WAIT_L(8); PG8_BAR; PG8_WAIT_L(0); PG8_MMA(0, 0, At, B0); PG8_BAR; PG8_SCHED;
            PG8_LDB(B1, 1, 1); PG8_STAGE(PG8_SB(1, 0), b3, voffB);
            PG8_BAR; PG8_WAIT_L(0); PG8_MMA(0, 1, At, B1); PG8_BAR;
            PG8_LDA(At, 1, 1); PG8_STAGE(PG8_SA(1, 0), a3, voffA);
            PG8_BAR; PG8_WAIT_L(0); PG8_MMA(1, 0, At, B0); PG8_BAR; PG8_SCHED;
            PG8_STAGE(PG8_SB(1, 1), b3 + hstep, voffB);
            PG8_WAIT_V(6); PG8_BAR; PG8_MMA(1, 1, At, B1); PG8_BAR;
            }
        }
        if constexpr (ALIGN_EPI) { if (wr == 0) PG8_BAR; }
        if (cur.part < 0) {
            const auto cx = E.begin(cur, wr, wc, fr, fq);
#pragma unroll
            for (int ai = 0; ai < 2; ++ai)
#pragma unroll
                for (int m = 0; m < 4; ++m) { const f32x4 v[2][2] = {{acc[ai][0][m][0], acc[ai][0][m][1]}, {acc[ai][1][m][0], acc[ai][1][m][1]}}; E.rows(cx, v, cur, ai, m, wr, wc, fr, fq); }
        } else {
            bf16_t* sp = (bf16_t*)slab + (size_t)cur.part * 65536 + (size_t)tid * 8;
#pragma unroll
            for (int ai = 0; ai < 2; ++ai)
#pragma unroll
                for (int bj = 0; bj < 2; ++bj)
#pragma unroll
                    for (int m = 0; m < 4; ++m) { const f32x4 a = acc[ai][bj][m][0], b = acc[ai][bj][m][1];
                        u32x4 w; w.x = cvt_pk_bf16(a[0], a[1]); w.y = cvt_pk_bf16(a[2], a[3]); w.z = cvt_pk_bf16(b[0], b[1]); w.w = cvt_pk_bf16(b[2], b[3]);
                        *(u32x4*)(sp + (size_t)(((ai * 2 + bj) * 4 + m) * 4096)) = w; }
        }
        if (!has_next) break;
#pragma unroll
        for (int a = 0; a < 2; ++a)
#pragma unroll
            for (int b = 0; b < 2; ++b)
#pragma unroll
                for (int m = 0; m < 4; ++m)
#pragma unroll
                    for (int n = 0; n < 2; ++n) acc[a][b][m][n] = (f32x4){0.f, 0.f, 0.f, 0.f};
        cur = nxt; cA = nA; cB = nB; ++ui;
        if constexpr (ALIGN_EPI) { if (wr == 1) PG8_BAR; }
    }
    PG8_WAIT_V(0);
    if constexpr (!ALIGN_EPI) { if (wr == 0) PG8_BAR; }
    PG8_BAR;
#undef PG8_SA
#undef PG8_SB
#undef PG8_STAGE
#undef PG8_LDA
#undef PG8_LDB
#undef PG8_MMA
#undef PG8_WAIT_V
#undef PG8_WAIT_L
#undef PG8_BAR
#undef PG8_SCHED
}
template <class Epi, class Sched>
__device__ __forceinline__ void gemm_fixup(const Epi& E, const float* slab) {
    if constexpr (Sched::S > 1) {
    constexpr int NG = 8 / Sched::S;
    const int tid = threadIdx.x, wid = __builtin_amdgcn_readfirstlane(tid >> 6), lane = tid & 63, wr = wid >> 2, wc = wid & 3, fr = lane & 15, fq = lane >> 4;
    for (int b = blockIdx.x; b < Sched::rem * Sched::S; b += Sched::G) {
        const int r = b % Sched::rem, q = b / Sched::rem;
        const Unit u = Sched::unit_of(Sched::nfull + r, 0, Sched::nt, -1);
        f32x4 v[NG][2][2];
#pragma unroll
        for (int gi = 0; gi < NG; ++gi)
#pragma unroll
            for (int bj = 0; bj < 2; ++bj)
#pragma unroll
                for (int n = 0; n < 2; ++n) v[gi][bj][n] = (f32x4){0.f, 0.f, 0.f, 0.f};
#pragma unroll
        for (int gi = 0; gi < NG; ++gi) { const int g = q * NG + gi, ai = g >> 2, m = g & 3;
#pragma unroll
            for (int p = 0; p < Sched::S; ++p) {
                const bf16_t* sp = (const bf16_t*)slab + (size_t)(r + p * Sched::rem) * 65536 + (size_t)tid * 8;
#pragma unroll
                for (int bj = 0; bj < 2; ++bj) { const u32x4 w = *(const u32x4*)(sp + (size_t)(((ai * 2 + bj) * 4 + m) * 4096));
                    v[gi][bj][0] += (f32x4){__builtin_bit_cast(float, w.x << 16), __builtin_bit_cast(float, w.x & 0xffff0000u), __builtin_bit_cast(float, w.y << 16), __builtin_bit_cast(float, w.y & 0xffff0000u)};
                    v[gi][bj][1] += (f32x4){__builtin_bit_cast(float, w.z << 16), __builtin_bit_cast(float, w.z & 0xffff0000u), __builtin_bit_cast(float, w.w << 16), __builtin_bit_cast(float, w.w & 0xffff0000u)}; } } }
        const auto cx = E.begin(u, wr, wc, fr, fq);
#pragma unroll
        for (int gi = 0; gi < NG; ++gi) { const int g = q * NG + gi; E.rows(cx, v[gi], u, g >> 2, g & 3, wr, wc, fr, fq); }
    }
    }
}
}

constexpr int DM = 2048, NTOK = 12288, NCTX = 4096, DFF = 5632, NFF2 = 11264;
constexpr int IN_EVEN = 4160, IN_EVEN_P = 4096, IN_ODD = 3072;
constexpr int NMOD = 18432;
constexpr float EPS = 1e-6f;
constexpr float LOG2E = 1.4426950408889634f;

constexpr size_t O_X = 0, O_CKV = 25165824, O_KROPE = 27262976, O_NAK = 27525120, O_NAV = 31719424, O_GK = 35913728, O_GV = 38010880, O_END = 40108032;

constexpr size_t MiB = 1u << 20;
constexpr size_t WS_CTL = 0;
constexpr size_t WS_MODS = 2 * MiB;
constexpr size_t CTL_ZERO_BYTES = 4 * MiB;
constexpr size_t WS_WFI = 4 * MiB;
constexpr size_t WS_WFO = WS_WFI + 176 * MiB;
constexpr size_t WS_WEI = WS_WFO + 88 * MiB;
constexpr size_t WS_WQU = WS_WEI + 17 * MiB;
constexpr size_t WS_WKU = WS_WQU + 2 * MiB;
constexpr size_t WS_WEO = WS_WKU + 2 * MiB;
constexpr size_t WS_WOI = WS_WEO + 8 * MiB;
constexpr size_t WS_WOO = WS_WOI + 12 * MiB;
constexpr size_t WS_H = WS_WOO + 8 * MiB;
constexpr size_t WS_ACT = WS_H + 48 * MiB;
constexpr size_t WS_P = WS_ACT + 132 * MiB;
constexpr size_t WS_QM = WS_P + 204 * MiB;
constexpr size_t WS_CQN = WS_QM + 72 * MiB;
constexpr size_t WS_CKVA = WS_CQN + 12 * MiB;
constexpr size_t WS_QA = WS_CKVA + 16 * MiB;
constexpr size_t WS_QNA = WS_QA + 48 * MiB;
constexpr size_t WS_KM_CTX = WS_QNA + 24 * MiB;
constexpr size_t WS_KM_LAT = WS_KM_CTX + 12 * MiB;
constexpr size_t WS_KM_CAC = WS_KM_LAT + 24 * MiB;
constexpr size_t WS_VM_CTX = WS_KM_CAC + 12 * MiB;
constexpr size_t WS_VM_LAT = WS_VM_CTX + 8 * MiB;
constexpr size_t WS_VM_CAC = WS_VM_LAT + 16 * MiB;
constexpr size_t WS_KN_CTX = WS_VM_CAC + 8 * MiB;
constexpr size_t WS_KN_LAT = WS_KN_CTX + 8 * MiB;
constexpr size_t WS_KN_CAC = WS_KN_LAT + 16 * MiB;
constexpr size_t WS_VN_CTX = WS_KN_CAC + 8 * MiB;
constexpr size_t WS_VN_LAT = WS_VN_CTX + 8 * MiB;
constexpr size_t WS_VN_CAC = WS_VN_LAT + 16 * MiB;
constexpr size_t WS_KG_CTX = WS_VN_CAC + 8 * MiB;
constexpr size_t WS_KG_LAT = WS_KG_CTX + 4 * MiB;
constexpr size_t WS_KG_CAC = WS_KG_LAT + 8 * MiB;
constexpr size_t WS_VG_CTX = WS_KG_CAC + 4 * MiB;
constexpr size_t WS_VG_LAT = WS_VG_CTX + 4 * MiB;
constexpr size_t WS_VG_CAC = WS_VG_LAT + 8 * MiB;
constexpr size_t WS_O = WS_VG_CAC + 4 * MiB;
constexpr size_t WS_KROPE = WS_O + 48 * MiB;
constexpr size_t WS_END = WS_KROPE + 4 * MiB;
constexpr int CW_BAR = 4096;

constexpr int RING_BYTES = 131072;
constexpr int LDSCTL_OFF = RING_BYTES;
constexpr int LDS_BYTES = 147456;

__device__ __forceinline__ unsigned f2bf(float f) { unsigned u = __builtin_bit_cast(unsigned, f); return (u + 0x7fffu + ((u >> 16) & 1u)) >> 16; }
__device__ __forceinline__ unsigned pk2(float lo, float hi) { return pg8::cvt_pk_bf16(lo, hi); }
__device__ __forceinline__ float wave_sum(float v) {
#pragma unroll
    for (int o = 1; o < 64; o <<= 1) v += __shfl_xor(v, o);
    return v;
}
__device__ __forceinline__ float fast_exp2(float x) { return __builtin_amdgcn_exp2f(x); }
__device__ __forceinline__ float fast_rcp(float x) { return __builtin_amdgcn_rcpf(x); }
__device__ __forceinline__ float silu_f(float g) { return g * fast_rcp(1.0f + fast_exp2(-g * LOG2E)); }
__device__ __forceinline__ float sin_rev(float rev) { return __builtin_amdgcn_sinf(rev); }
__device__ __forceinline__ float cos_rev(float rev) { return __builtin_amdgcn_cosf(rev); }

#define XB_TMO      128
#define XB_XCNT(j)  (256  + 64 * (j))
#define XB_XSUB(j)  (1280 + 64 * (j))
#define XB_XGEN(j)  (2304 + 64 * (j))
#define XB_TOP      3328
#define XB_TOPGEN   3392
#define XCD_BAR_WORDS 3456
#define XB_SPIN_CAP (1u << 18)
__device__ __forceinline__ unsigned xb_ld(unsigned* p)              { return __hip_atomic_load(p, __ATOMIC_RELAXED, __HIP_MEMORY_SCOPE_AGENT); }
__device__ __forceinline__ unsigned xb_add(unsigned* p, unsigned v) { return __hip_atomic_fetch_add(p, v, __ATOMIC_RELAXED, __HIP_MEMORY_SCOPE_AGENT); }
__device__ __forceinline__ unsigned xb_xcc_id() { return (unsigned)__builtin_amdgcn_s_getreg((3 << 11) | 20) & 0xFu; }
#define XB_SPIN(cond, bar) do { unsigned _sp = 0; while (cond) { __builtin_amdgcn_s_sleep(1); \
    if ((++_sp & 255u) == 0u) { if (xb_ld(&(bar)[XB_TMO])) break; if (_sp > XB_SPIN_CAP) { atomicAdd(&(bar)[XB_TMO], 1u); break; } } } } while (0)
struct XcdBarrier { unsigned* bar; unsigned x; volatile LAS unsigned* st; };
__device__ __forceinline__ XcdBarrier xcd_barrier_post(unsigned* bar, volatile LAS unsigned* st) {
    XcdBarrier b; b.bar = bar; b.x = xb_xcc_id(); b.st = st;
    if (threadIdx.x == 0) (void)xb_add(&bar[XB_XCNT(b.x)], 1u);
    return b;
}
__device__ __forceinline__ void xcd_barrier_complete(unsigned* bar, unsigned x, unsigned& nloc, unsigned& nx) {
    const unsigned G = gridDim.x * gridDim.y * gridDim.z;
    unsigned sum, cnt, mine, sp = 0u;
    for (;;) {
        sum = 0u; cnt = 0u; mine = 0u;
#pragma unroll
        for (unsigned j = 0; j < 16; ++j) { const unsigned c = xb_ld(&bar[XB_XCNT(j)]); sum += c; cnt += (c > 0u) ? 1u : 0u; mine = (j == x) ? c : mine; }
        if (sum == G) break;
        __builtin_amdgcn_s_sleep(1);
        if ((++sp & 255u) == 0u) { if (xb_ld(&bar[XB_TMO])) break; if (sp > XB_SPIN_CAP) { atomicAdd(&bar[XB_TMO], 1u); break; } }
    }
    nloc = mine > 0u ? mine : 1u; nx = cnt > 0u ? cnt : 1u;
}
__device__ __forceinline__ void xcd_barrier(const XcdBarrier& b) {
    asm volatile("s_waitcnt vmcnt(0)" ::: "memory");
    __syncthreads();
    if (threadIdx.x == 0) {
        unsigned* bar = b.bar;
        __builtin_amdgcn_s_waitcnt(0);
        unsigned nloc = b.st[0], nx = b.st[1];
        if (nloc == 0u) { xcd_barrier_complete(bar, b.x, nloc, nx); b.st[0] = nloc; b.st[1] = nx; }
        const unsigned old = xb_add(&bar[XB_XSUB(b.x)], 1u);
        const unsigned gen = old / nloc;
        if (old + 1u == (gen + 1u) * nloc) {
            __builtin_amdgcn_fence(__ATOMIC_RELEASE, "agent");
            asm volatile("s_waitcnt vmcnt(0)" ::: "memory");
            const unsigned og = xb_add(&bar[XB_TOP], 1u);
            const unsigned tg = og / nx;
            if (og + 1u == (tg + 1u) * nx) xb_add(&bar[XB_TOPGEN], 1u);
            else XB_SPIN(xb_ld(&bar[XB_TOPGEN]) == tg, bar);
            __builtin_amdgcn_fence(__ATOMIC_ACQUIRE, "agent");
            xb_add(&bar[XB_XGEN(b.x)], 1u);
            asm volatile("s_waitcnt vmcnt(0)" ::: "memory");
        } else {
            XB_SPIN(xb_ld(&bar[XB_XGEN(b.x)]) == gen, bar);
            __builtin_amdgcn_fence(__ATOMIC_ACQUIRE, "agent");
            asm volatile("s_waitcnt vmcnt(0)" ::: "memory");
        }
    }
    __syncthreads();
}

struct Args { const float* in[28]; float* out; unsigned char* ws; int ph_lo, ph_hi; };
struct Frame {
    LAS unsigned char* lds;
    int tid, lane, wave, G, gw, NGW;
    const Args* a; float* out; unsigned char* ws;
};
#define IN_XP 0
#define IN_XS 1
#define IN_C_CKV 2
#define IN_C_KROPE 3
#define IN_C_NAK 4
#define IN_C_NAV 5
#define IN_C_GK 6
#define IN_C_GV 7
#define IN_C 8
#define IN_CCTX 9
#define IN_ADAW 10
#define IN_ADAB 11
#define IN_NORMG 12
#define IN_FFI 13
#define IN_FFO 14
#define IN_EWI 15
#define IN_EWO 16
#define IN_QNORM 17
#define IN_WQUP 18
#define IN_KVNORM 19
#define IN_WKVUP 20
#define IN_MLAQK 21
#define IN_NAQK 22
#define IN_RPB 23
#define IN_OWI 24
#define IN_OWO 25
#define IN_GQK 26
#define IN_SINK 27

__device__ __forceinline__ int opaque_v(int x) { asm volatile("" : "+v"(x)); return x; }
__device__ __forceinline__ int tok_mb(int t) { return t < NCTX ? 0 : 1 + ((t - NCTX) >> 10); }

__device__ __forceinline__ size_t k_chunk_off(int DQK, int key, int c8) { return (size_t)(key >> 5) * (DQK * 32) + (size_t)(c8 >> 1) * 512 + (((c8 & 1) * 32 + (key & 31)) << 3); }
__device__ __forceinline__ void vt_tile_write_h(const bf16_t* src0, size_t pitch, bf16_t* dst, int lane) {
#pragma unroll
    for (int it = 0; it < 8; ++it) {
        const int d = (it & 1) * 64 + lane, s = (it >> 1) & 1, hh = it >> 2;
        unsigned v[8];
#pragma unroll
        for (int j = 0; j < 8; ++j) { const int key = 16 * s + 8 * (j >> 2) + 4 * hh + (j & 3); v[j] = src0[(size_t)key * pitch + d]; }
        u32x4 w; w.x = v[0] | (v[1] << 16); w.y = v[2] | (v[3] << 16); w.z = v[4] | (v[5] << 16); w.w = v[6] | (v[7] << 16);
        *(u32x4*)(dst + (size_t)(((s * 4 + (d >> 5)) * 64 + hh * 32 + (d & 31)) << 3)) = w;
    }
}
__device__ __forceinline__ void vt_tile_write(const float* src0, size_t pitch, bf16_t* dst, int lane) {
#pragma unroll
    for (int it = 0; it < 8; ++it) {
        const int d = (it & 1) * 64 + lane, s = (it >> 1) & 1, hh = it >> 2;
        float v[8];
#pragma unroll
        for (int j = 0; j < 8; ++j) { const int key = 16 * s + 8 * (j >> 2) + 4 * hh + (j & 3); v[j] = src0[(size_t)key * pitch + d]; }
        u32x4 w; w.x = pk2(v[0], v[1]); w.y = pk2(v[2], v[3]); w.z = pk2(v[4], v[5]); w.w = pk2(v[6], v[7]);
        *(u32x4*)(dst + (size_t)(((s * 4 + (d >> 5)) * 64 + hh * 32 + (d & 31)) << 3)) = w;
    }
}

__device__ __forceinline__ void p0_transpose_item(const float* W, int K, int N, bf16_t* WT, int mode, LAS float* scr, int item, int lane) {
    const int nblk = N / 32, kb = item / nblk, nb = item % nblk, k0 = 64 * kb, n0 = 32 * nb;
#pragma unroll 8
    for (int i = 0; i < 32; ++i) { const int kk = 2 * i + (lane >> 5); scr[kk * 33 + (lane & 31)] = __builtin_nontemporal_load(W + (size_t)(k0 + kk) * N + n0 + (lane & 31)); }
    asm volatile("s_waitcnt lgkmcnt(0)" ::: "memory");
    int d0 = n0;
    if (mode == 1) { const int j0 = n0 < DFF ? n0 : n0 - DFF; d0 = 256 * (j0 >> 7) + (j0 & 127) + (n0 < DFF ? 0 : 128); }
    if (mode == 2) d0 = n0 < 1024 ? n0 : (n0 < 1088 ? 4096 + (n0 - 1024) : n0 - 64);
    const int c = lane & 7;
#pragma unroll
    for (int j = 0; j < 4; ++j) { const int n = (lane >> 3) + 8 * j; const LAS float* s = scr + (8 * c) * 33 + n;
        u32x4 o; o.x = pk2(s[0 * 33], s[1 * 33]); o.y = pk2(s[2 * 33], s[3 * 33]); o.z = pk2(s[4 * 33], s[5 * 33]); o.w = pk2(s[6 * 33], s[7 * 33]);
        *(u32x4*)(WT + (size_t)(d0 + n) * K + k0 + 8 * c) = o; }
    asm volatile("s_waitcnt lgkmcnt(0)" ::: "memory");
}

__device__ __forceinline__ const float* p0_mods_wptr(Frame& F, int item) {
    const int layer = item / 1152, rem = item % 1152, slab = rem >> 4, ks = rem & 15;
    return F.a->in[IN_ADAW] + (size_t)layer * DM * NMOD + (size_t)(ks * 128 + F.wave * 16) * NMOD + slab * 256 + 4 * F.lane;
}
__device__ __forceinline__ void phase_mods(Frame& F) {
    LAS float* stab = (LAS float*)(F.lds);
    LAS float* part = (LAS float*)(F.lds + 8192);
    const float* c = F.a->in[IN_C]; const float* cctx = F.a->in[IN_CCTX];
    for (int item = blockIdx.x; item < 2304; item += F.G) {
        const int layer = item / 1152, rem = item % 1152, slab = rem >> 4, ks = rem & 15, n0 = slab * 256, k0 = ks * 128;
        f32x4 w[16];
        { const float* W = p0_mods_wptr(F, item);
#pragma unroll
          for (int kk = 0; kk < 16; ++kk) w[kk] = __builtin_nontemporal_load((const f32x4*)(W + (size_t)kk * NMOD)); }
        for (int i = F.tid; i < 9 * 128; i += 512) { const int b = i >> 7, k = i & 127; const float v = (b == 0) ? cctx[k0 + k] : c[(size_t)(b - 1) * DM + k0 + k]; stab[i] = silu_f(v); }
        __syncthreads();
        f32x4 acc[9];
#pragma unroll
        for (int b = 0; b < 9; ++b) acc[b] = (f32x4){0.f, 0.f, 0.f, 0.f};
#pragma unroll
        for (int kk = 0; kk < 16; ++kk) {
#pragma unroll
            for (int b = 0; b < 9; ++b) { const float sv = stab[b * 128 + F.wave * 16 + kk]; acc[b] += w[kk] * sv; }
        }
#pragma unroll
        for (int b = 0; b < 9; ++b) *(LAS f32x4*)(part + (F.wave * 9 + b) * 256 + 4 * F.lane) = acc[b];
        __syncthreads();
        float* mods = (float*)(F.ws + WS_MODS) + (size_t)layer * 9 * NMOD;
        const float* bias = F.a->in[IN_ADAB] + (size_t)layer * NMOD;
        for (int i = F.tid; i < 9 * 256; i += 512) { const int b = i >> 8, col = i & 255; float sm = 0.f;
#pragma unroll
            for (int ww = 0; ww < 8; ++ww) sm += part[(ww * 9 + b) * 256 + col];
            if (ks == 0) sm += bias[n0 + col];
            atomicAdd(mods + (size_t)b * NMOD + n0 + col, sm); }
        __syncthreads();
    }
}

__device__ __forceinline__ void p0_cacheK_item(const float* src, int H, bf16_t* dstbase, int item, int lane) {
    const int t32 = item & 15, bh = item >> 4, b = bh / H, h = bh % H;
    bf16_t* dst = dstbase + (size_t)bh * (512 * 128);
#pragma unroll
    for (int it = 0; it < 8; ++it) { const int idx = it * 64 + lane, kl = idx >> 4, c8 = idx & 15, key = t32 * 32 + kl;
        const float* s = src + ((size_t)(b * 512 + key) * H + h) * 128 + c8 * 8;
        const f32x4 a = *(const f32x4*)s, bb = *(const f32x4*)(s + 4);
        u32x4 w; w.x = pk2(a[0], a[1]); w.y = pk2(a[2], a[3]); w.z = pk2(bb[0], bb[1]); w.w = pk2(bb[2], bb[3]);
        *(u32x4*)(dst + k_chunk_off(128, key, c8)) = w; }
}
__device__ __forceinline__ void p0_cacheV_item(const float* src, int H, bf16_t* dstbase, int item, int lane) {
    const int t32 = item & 15, bh = item >> 4, b = bh / H, h = bh % H;
    vt_tile_write(src + ((size_t)(b * 512 + t32 * 32) * H + h) * 128, (size_t)H * 128, dstbase + (size_t)bh * (512 * 128) + (size_t)t32 * 4096, lane);
}

__device__ __forceinline__ void phase_prologue(Frame& F) {
    phase_mods(F);
    LAS float* scr = (LAS float*)(F.lds + F.wave * 16384);
    constexpr int I_FI = 32 * 352, I_FO = 88 * 64, I_EI = 32 * 130, I_QU = 8 * 48, I_KU = 8 * 64, I_EO = 32 * 64, I_OI = 32 * 96, I_OO = 32 * 64;
    constexpr int I_PAD = 0, I_CKV = 1024, I_NK = 1024, I_NV = 1024, I_GK = 512, I_GV = 512;
    constexpr int NITEMS = 4 * I_FI + 4 * I_FO + I_EI + I_QU + I_KU + I_EO + I_OI + I_OO + I_PAD + I_CKV + I_NK + I_NV + I_GK + I_GV;
    unsigned char* ws = F.ws;
    for (int it = F.gw; it < NITEMS; it += F.NGW) {
        int r = it;
        if (r < 4 * I_FI) { const int m = r / I_FI; p0_transpose_item(F.a->in[IN_FFI] + (size_t)m * DM * NFF2, DM, NFF2, (bf16_t*)(ws + WS_WFI) + (size_t)m * NFF2 * DM, 1, scr, r % I_FI, F.lane); continue; } r -= 4 * I_FI;
        if (r < 4 * I_FO) { const int m = r / I_FO; p0_transpose_item(F.a->in[IN_FFO] + (size_t)m * DFF * DM, DFF, DM, (bf16_t*)(ws + WS_WFO) + (size_t)m * DM * DFF, 0, scr, r % I_FO, F.lane); continue; } r -= 4 * I_FO;
        if (r < I_EI) { p0_transpose_item(F.a->in[IN_EWI], DM, IN_EVEN, (bf16_t*)(ws + WS_WEI), 2, scr, r, F.lane); continue; } r -= I_EI;
        if (r < I_QU) { p0_transpose_item(F.a->in[IN_WQUP], 512, 1536, (bf16_t*)(ws + WS_WQU), 0, scr, r, F.lane); continue; } r -= I_QU;
        if (r < I_KU) { p0_transpose_item(F.a->in[IN_WKVUP], 512, 2048, (bf16_t*)(ws + WS_WKU), 0, scr, r, F.lane); continue; } r -= I_KU;
        if (r < I_EO) { p0_transpose_item(F.a->in[IN_EWO], DM, DM, (bf16_t*)(ws + WS_WEO), 0, scr, r, F.lane); continue; } r -= I_EO;
        if (r < I_OI) { p0_transpose_item(F.a->in[IN_OWI], DM, IN_ODD, (bf16_t*)(ws + WS_WOI), 0, scr, r, F.lane); continue; } r -= I_OI;
        if (r < I_OO) { p0_transpose_item(F.a->in[IN_OWO], DM, DM, (bf16_t*)(ws + WS_WOO), 0, scr, r, F.lane); continue; } r -= I_OO;
        if (r < I_PAD) { u32x4* p = (u32x4*)((bf16_t*)(ws + WS_WEI) + (size_t)(IN_EVEN + r) * DM); const u32x4 z = {0u, 0u, 0u, 0u};
#pragma unroll
            for (int j = 0; j < 4; ++j) p[j * 64 + F.lane] = z; continue; } r -= I_PAD;
        if (r < I_CKV) {
#pragma unroll
            for (int j = 0; j < 4; ++j) { const int row = 4 * r + j; const float* s = F.a->in[IN_C_CKV] + (size_t)row * 512 + 8 * F.lane;
                const f32x4 a = *(const f32x4*)s, b = *(const f32x4*)(s + 4);
                u32x4 w; w.x = pk2(a[0], a[1]); w.y = pk2(a[2], a[3]); w.z = pk2(b[0], b[1]); w.w = pk2(b[2], b[3]);
                *(u32x4*)((bf16_t*)(ws + WS_CKVA) + (size_t)(NTOK + row) * 512 + 8 * F.lane) = w; }
            continue; } r -= I_CKV;
        if (r < I_NK) { p0_cacheK_item(F.a->in[IN_C_NAK], 8, (bf16_t*)(ws + WS_KN_CAC), r, F.lane); continue; } r -= I_NK;
        if (r < I_NV) { p0_cacheV_item(F.a->in[IN_C_NAV], 8, (bf16_t*)(ws + WS_VN_CAC), r, F.lane); continue; } r -= I_NV;
        if (r < I_GK) { p0_cacheK_item(F.a->in[IN_C_GK], 4, (bf16_t*)(ws + WS_KG_CAC), r, F.lane); continue; } r -= I_GK;
        p0_cacheV_item(F.a->in[IN_C_GV], 4, (bf16_t*)(ws + WS_VG_CAC), r, F.lane);
    }
}

__device__ __forceinline__ const float* x_in_row(Frame& F, int t) { return t < NCTX ? F.a->in[IN_XP] + (size_t)t * DM : F.a->in[IN_XS] + (size_t)(t - NCTX) * DM; }
__device__ __forceinline__ void phase_norm(Frame& F, bool from_input, int layer, int sub) {
    const float* g = F.a->in[IN_NORMG] + (size_t)(layer * 3 + sub) * DM;
    bf16_t* H = (bf16_t*)(F.ws + WS_H);
    const int lane = opaque_v(F.lane);
    for (int t = F.gw; t < NTOK; t += F.NGW) {
        const float* xr = from_input ? x_in_row(F, t) : F.out + (size_t)t * DM;
        const float* md = (const float*)(F.ws + WS_MODS) + ((size_t)layer * 9 + tok_mb(t)) * NMOD + (size_t)(3 * sub) * DM;
        f32x4 v[8]; float ss = 0.f;
#pragma unroll
        for (int j = 0; j < 8; ++j) { v[j] = *(const f32x4*)(xr + 256 * j + 4 * lane); ss += (v[j][0] * v[j][0] + v[j][1] * v[j][1]) + (v[j][2] * v[j][2] + v[j][3] * v[j][3]); }
        const float rstd = __builtin_amdgcn_rsqf(wave_sum(ss) * (1.0f / DM) + EPS);
#pragma unroll
        for (int j = 0; j < 8; ++j) { const int c = 256 * j + 4 * lane;
            const f32x4 gg = *(const f32x4*)(g + c), sh = *(const f32x4*)(md + c), sc = *(const f32x4*)(md + DM + c);
            const f32x4 y = (v[j] * rstd * gg) * (sc + 1.0f) + sh;
            u32x2 w; w.x = pk2(y[0], y[1]); w.y = pk2(y[2], y[3]);
            *(u32x2*)(H + (size_t)t * DM + c) = w; }
    }
}

struct EpiSwiGLU {
    static constexpr bool PERM = true;
    bf16_t* O;
    struct Ctx { int row0, col0; };
    __device__ __forceinline__ Ctx begin(const pg8::Unit& u, int wr, int wc, int fr, int fq) const { return Ctx{u.pm * 256 + wr * 64 + fr, u.pn * 128 + wc * 32 + 8 * fq}; }
    __device__ __forceinline__ void rows(const Ctx& c, const f32x4 (&v)[2][2], const pg8::Unit&, int ai, int m, int, int, int, int) const {
        float r[8];
#pragma unroll
        for (int n = 0; n < 2; ++n)
#pragma unroll
            for (int j = 0; j < 4; ++j) r[4 * n + j] = silu_f(v[0][n][j]) * v[1][n][j];
        u32x4 w; w.x = pk2(r[0], r[1]); w.y = pk2(r[2], r[3]); w.z = pk2(r[4], r[5]); w.w = pk2(r[6], r[7]);
        *(u32x4*)(O + (size_t)(c.row0 + ai * 128 + m * 16) * DFF + c.col0) = w;
    }
};
struct EpiResid {
    static constexpr bool PERM = false;
    const float* xp; const float* xs; bool from_input; float* out; const float* gate_base; float coef;
    struct Ctx { const float* xin; f32x4 gv[2][2]; int row0, col0; };
    __device__ __forceinline__ Ctx begin(const pg8::Unit& u, int wr, int wc, int fr, int fq) const {
        Ctx c; const int rowt = u.pm * 256; c.row0 = rowt + wr * 64 + fr; c.col0 = u.pn * 256 + wc * 32 + 4 * fq;
        const float* gt = gate_base + (size_t)tok_mb(rowt) * NMOD;
        c.xin = from_input ? (rowt < NCTX ? xp : xs - (size_t)NCTX * DM) : out;
#pragma unroll
        for (int bj = 0; bj < 2; ++bj)
#pragma unroll
            for (int n = 0; n < 2; ++n) c.gv[bj][n] = *(const f32x4*)(gt + c.col0 + bj * 128 + n * 16) * coef;
        return c;
    }
    __device__ __forceinline__ void rows(const Ctx& c, const f32x4 (&v)[2][2], const pg8::Unit&, int ai, int m, int, int, int, int) const {
        const size_t off = (size_t)(c.row0 + ai * 128 + m * 16) * DM + c.col0;
#pragma unroll
        for (int bj = 0; bj < 2; ++bj)
#pragma unroll
            for (int n = 0; n < 2; ++n) { const f32x4 xv = *(const f32x4*)(c.xin + off + bj * 128 + n * 16);
                *(f32x4*)(out + off + bj * 128 + n * 16) = xv + c.gv[bj][n] * v[bj][n]; }
        asm volatile("" ::: "memory");
    }
};
struct EpiBf16 {
    static constexpr bool PERM = true;
    bf16_t* C; int ldc;
    struct Ctx { int row0, col0; };
    __device__ __forceinline__ Ctx begin(const pg8::Unit& u, int wr, int wc, int fr, int fq) const { return Ctx{u.pm * 256 + wr * 64 + fr, u.pn * 256 + wc * 32 + 8 * fq}; }
    __device__ __forceinline__ void rows(const Ctx& c, const f32x4 (&v)[2][2], const pg8::Unit&, int ai, int m, int, int, int, int) const {
        bf16_t* rowp = C + (size_t)(c.row0 + ai * 128 + m * 16) * ldc + c.col0;
#pragma unroll
        for (int bj = 0; bj < 2; ++bj) { u32x4 w; w.x = pk2(v[bj][0][0], v[bj][0][1]); w.y = pk2(v[bj][0][2], v[bj][0][3]); w.z = pk2(v[bj][1][0], v[bj][1][1]); w.w = pk2(v[bj][1][2], v[bj][1][3]);
            *(u32x4*)(rowp + bj * 128) = w; }
    }
};
struct EpiF32 {
    static constexpr bool PERM = false;
    float* C; int ldc;
    struct Ctx { int row0, col0; };
    __device__ __forceinline__ Ctx begin(const pg8::Unit& u, int wr, int wc, int fr, int fq) const { return Ctx{u.pm * 256 + wr * 64 + fr, u.pn * 256 + wc * 32 + 4 * fq}; }
    __device__ __forceinline__ void rows(const Ctx& c, const f32x4 (&v)[2][2], const pg8::Unit&, int ai, int m, int, int, int, int) const {
        float* rowp = C + (size_t)(c.row0 + ai * 128 + m * 16) * ldc + c.col0;
#pragma unroll
        for (int bj = 0; bj < 2; ++bj)
#pragma unroll
            for (int n = 0; n < 2; ++n) *(f32x4*)(rowp + bj * 128 + n * 16) = v[bj][n];
    }
};

__device__ __forceinline__ void load8(const float* p, float (&v)[8]) { const f32x4 a = *(const f32x4*)p, b = *(const f32x4*)(p + 4); v[0] = a[0]; v[1] = a[1]; v[2] = a[2]; v[3] = a[3]; v[4] = b[0]; v[5] = b[1]; v[6] = b[2]; v[7] = b[3]; }
__device__ __forceinline__ void load8h(const bf16_t* p, float (&v)[8]) { const u32x4 w = *(const u32x4*)p;
    v[0] = __builtin_bit_cast(float, w.x << 16); v[1] = __builtin_bit_cast(float, w.x & 0xffff0000u); v[2] = __builtin_bit_cast(float, w.y << 16); v[3] = __builtin_bit_cast(float, w.y & 0xffff0000u);
    v[4] = __builtin_bit_cast(float, w.z << 16); v[5] = __builtin_bit_cast(float, w.z & 0xffff0000u); v[6] = __builtin_bit_cast(float, w.w << 16); v[7] = __builtin_bit_cast(float, w.w & 0xffff0000u); }
__device__ __forceinline__ u32x4 pack8(const float (&v)[8]) { u32x4 w; w.x = pk2(v[0], v[1]); w.y = pk2(v[2], v[3]); w.z = pk2(v[4], v[5]); w.w = pk2(v[6], v[7]); return w; }
__device__ __forceinline__ void store8f(float* p, const float (&v)[8]) { *(f32x4*)p = (f32x4){v[0], v[1], v[2], v[3]}; *(f32x4*)(p + 4) = (f32x4){v[4], v[5], v[6], v[7]}; }
template <int W> __device__ __forceinline__ float group_sum(float v) {
#pragma unroll
    for (int o = 1; o < W; o <<= 1) v += __shfl_xor(v, o);
    return v;
}

__device__ __forceinline__ void phase_post1_even(Frame& F) {
    const bf16_t* P = (const bf16_t*)(F.ws + WS_P);
    const float* qn_g = F.a->in[IN_QNORM]; const float* kvn_g = F.a->in[IN_KVNORM]; const float* naq_g = F.a->in[IN_NAQK]; const float* nak_g = F.a->in[IN_NAQK] + 128;
    bf16_t* CQN = (bf16_t*)(F.ws + WS_CQN); bf16_t* CKVA = (bf16_t*)(F.ws + WS_CKVA); bf16_t* QNA = (bf16_t*)(F.ws + WS_QNA);
    constexpr int NVT_CTX = 16 * 8 * 8, NVT_LAT = 8 * 8 * 32, NKR = NTOK / 16;
    for (int it = F.gw; it < NKR; it += F.NGW) {
        const int t0 = it * 16, lane = F.lane, lr = lane & 15, lq = lane >> 4;
        const bf16_t* ap = (const bf16_t*)(F.ws + WS_H) + (size_t)(t0 + lr) * DM + 8 * lq;
        const bf16_t* bp = (const bf16_t*)(F.ws + WS_WEI) + (size_t)(4096 + lr) * DM + 8 * lq;
        f32x4 acc[4];
#pragma unroll
        for (int j = 0; j < 4; ++j) acc[j] = (f32x4){0.f, 0.f, 0.f, 0.f};
#pragma unroll 8
        for (int kk = 0; kk < 64; ++kk) {
            const bf16x8 af = *(const bf16x8*)(ap + kk * 32);
#pragma unroll
            for (int j = 0; j < 4; ++j) { const bf16x8 bf = *(const bf16x8*)(bp + (size_t)j * 16 * DM + kk * 32); acc[j] = __builtin_amdgcn_mfma_f32_16x16x32_bf16(af, bf, acc[j], 0, 0, 0); }
        }
        float* kr = (float*)(F.ws + WS_KROPE);
#pragma unroll
        for (int j = 0; j < 4; ++j)
#pragma unroll
            for (int r = 0; r < 4; ++r) { const int t = t0 + 4 * lq + r, c = 16 * j + lr; kr[(size_t)t * 64 + c] = acc[j][r]; if (t < NCTX) F.out[O_KROPE + (size_t)t * 64 + c] = acc[j][r]; }
    }
    for (int it = F.gw; it < NTOK + NVT_CTX + NVT_LAT; it += F.NGW) {
        if (it < NTOK) {
            const int t = it, lane = F.lane; const bf16_t* pr = P + (size_t)t * IN_EVEN_P; const bool ctx = t < NCTX;
            float v[8], g[8];
            load8h(pr + 8 * lane, v); float ss = 0.f;
#pragma unroll
            for (int i = 0; i < 8; ++i) ss += v[i] * v[i];
            float rstd = __builtin_amdgcn_rsqf(wave_sum(ss) * (1.0f / 512) + EPS);
            load8(qn_g + 8 * lane, g);
#pragma unroll
            for (int i = 0; i < 8; ++i) v[i] = v[i] * rstd * g[i];
            *(u32x4*)(CQN + (size_t)t * 512 + 8 * lane) = pack8(v);
            load8h(pr + 512 + 8 * lane, v); ss = 0.f;
#pragma unroll
            for (int i = 0; i < 8; ++i) ss += v[i] * v[i];
            rstd = __builtin_amdgcn_rsqf(wave_sum(ss) * (1.0f / 512) + EPS);
            load8(kvn_g + 8 * lane, g);
#pragma unroll
            for (int i = 0; i < 8; ++i) v[i] = v[i] * rstd * g[i];
            if (ctx) store8f(F.out + O_CKV + (size_t)t * 512 + 8 * lane, v);
            *(u32x4*)(CKVA + (size_t)t * 512 + 8 * lane) = pack8(v);
            const int head = lane >> 3, d0 = (lane & 7) * 16;
            int b, s; if (ctx) { b = t >> 8; s = t & 255; } else { b = (t - NCTX) >> 10; s = (t - NCTX) & 1023; }
#pragma unroll
            for (int which = 0; which < 2; ++which) {
                const bf16_t* src = pr + 1024 + which * 1024 + head * 128 + d0; const float* gg = which ? nak_g : naq_g;
                float a[8], c[8], ga[8], gc[8]; load8h(src, a); load8h(src + 8, c); load8(gg + d0, ga); load8(gg + d0 + 8, gc);
                float q = 0.f;
#pragma unroll
                for (int i = 0; i < 8; ++i) q += a[i] * a[i] + c[i] * c[i];
                const float r2 = __builtin_amdgcn_rsqf(group_sum<8>(q) * (1.0f / 128) + EPS);
#pragma unroll
                for (int i = 0; i < 8; ++i) { a[i] = a[i] * r2 * ga[i]; c[i] = c[i] * r2 * gc[i]; }
                if (which == 0) { bf16_t* qd = QNA + (size_t)t * 1024 + head * 128 + d0; *(u32x4*)qd = pack8(a); *(u32x4*)(qd + 8) = pack8(c); }
                else {
                    if (ctx) { float* od = F.out + O_NAK + (size_t)t * 1024 + head * 128 + d0; store8f(od, a); store8f(od + 8, c); }
                    bf16_t* kb = ctx ? (bf16_t*)(F.ws + WS_KN_CTX) + (size_t)(b * 8 + head) * (256 * 128) : (bf16_t*)(F.ws + WS_KN_LAT) + (size_t)(b * 8 + head) * (1024 * 128);
                    *(u32x4*)(kb + k_chunk_off(128, s, d0 >> 3)) = pack8(a); *(u32x4*)(kb + k_chunk_off(128, s, (d0 >> 3) + 1)) = pack8(c);
                }
            }
            { const bf16_t* src = pr + 3072 + 16 * lane; float a[8], c[8]; load8h(src, a); load8h(src + 8, c); if (ctx) { float* od = F.out + O_NAV + (size_t)t * 1024 + 16 * lane; store8f(od, a); store8f(od + 8, c); } }
        } else {
            int r = it - NTOK;
            if (r < NVT_CTX) { const int t32 = r & 7, bh = r >> 3, b = bh >> 3, h = bh & 7;
                vt_tile_write_h(P + (size_t)(b * 256 + t32 * 32) * IN_EVEN_P + 3072 + h * 128, IN_EVEN_P, (bf16_t*)(F.ws + WS_VN_CTX) + (size_t)bh * (256 * 128) + (size_t)t32 * 4096, F.lane);
            } else { r -= NVT_CTX; const int t32 = r & 31, bh = r >> 5, b = bh >> 3, h = bh & 7;
                vt_tile_write_h(P + (size_t)(NCTX + b * 1024 + t32 * 32) * IN_EVEN_P + 3072 + h * 128, IN_EVEN_P, (bf16_t*)(F.ws + WS_VN_LAT) + (size_t)bh * (1024 * 128) + (size_t)t32 * 4096, F.lane);
            }
        }
    }
}

__device__ __forceinline__ void rope8(float (&v)[8], const float (&vp)[8], bool is_x1, float pos, int f0, float inv_nf) {
#pragma unroll
    for (int i = 0; i < 8; ++i) {
        const float invf = fast_exp2(-(float)(f0 + i) * inv_nf * 13.287712379549449f);
        const float rev = pos * invf * 0.15915494309189535f;
        const float cs = cos_rev(rev), sn = sin_rev(rev);
        v[i] = is_x1 ? (v[i] * cs - vp[i] * sn) : (vp[i] * sn + v[i] * cs);
    }
}

__device__ __forceinline__ void phase_post2_even(Frame& F) {
    const bf16_t* P = (const bf16_t*)(F.ws + WS_P); const bf16_t* QM = (const bf16_t*)(F.ws + WS_QM); const bf16_t* KVM = (const bf16_t*)(F.ws + WS_ACT);
    const float* gq = F.a->in[IN_MLAQK]; const float* gk = F.a->in[IN_MLAQK] + 192;
    bf16_t* QA = (bf16_t*)(F.ws + WS_QA);
    constexpr int NROW = 16384, NVT_CTX = 1024, NVT_LAT = 2048, NVT_CAC = 1024;
    const int lane = F.lane, hsub = lane >> 5, c = lane & 31; const bool act = c < 24;
    for (int it = F.gw; it < NTOK + NROW + NVT_CTX + NVT_LAT + NVT_CAC; it += F.NGW) {
        if (it < NTOK) {
            const int t = it; const bool lat = t >= NCTX; const int s = (t - NCTX) & 1023; const float row = (float)(s >> 6), col = (float)(s & 63);
            const int cc = act ? c : 23, cpq = cc >= 16 ? (cc ^ 2) : cc;
            float g[8], gp[8]; load8(gq + 8 * cc, g); load8(gq + 8 * cpq, gp);
            float v[4][8], vp[4][8];
#pragma unroll
            for (int pass = 0; pass < 4; ++pass) { const bf16_t* src = QM + (size_t)t * 1536 + (2 * pass + hsub) * 192; load8h(src + 8 * cc, v[pass]); load8h(src + 8 * cpq, vp[pass]); }
#pragma unroll
            for (int pass = 0; pass < 4; ++pass) {
                const int head = 2 * pass + hsub;
                float q = 0.f;
#pragma unroll
                for (int i = 0; i < 8; ++i) { v[pass][i] = act ? v[pass][i] : 0.f; q += v[pass][i] * v[pass][i]; }
                const float rstd = __builtin_amdgcn_rsqf(group_sum<32>(q) * (1.0f / 192) + EPS);
#pragma unroll
                for (int i = 0; i < 8; ++i) { v[pass][i] = v[pass][i] * rstd * g[i]; vp[pass][i] = vp[pass][i] * rstd * gp[i]; }
                if (lat && c >= 16 && act) rope8(v[pass], vp[pass], (c & 2) == 0, c < 20 ? row : col, (c & 1) * 8, 1.0f / 16);
                if (act) *(u32x4*)(QA + (size_t)t * 1536 + head * 192 + 8 * c) = pack8(v[pass]);
            }
        } else if (it < NTOK + NROW) {
            const int r = it - NTOK; const bool istok = r < NTOK; const bool lat = istok && r >= NCTX;
            int bsel, s; bf16_t* kb0; int nkeys;
            if (!istok) { bsel = (r - NTOK) >> 9; s = (r - NTOK) & 511; kb0 = (bf16_t*)(F.ws + WS_KM_CAC); nkeys = 512; }
            else if (lat) { bsel = (r - NCTX) >> 10; s = (r - NCTX) & 1023; kb0 = (bf16_t*)(F.ws + WS_KM_LAT); nkeys = 1024; }
            else { bsel = r >> 8; s = r & 255; kb0 = (bf16_t*)(F.ws + WS_KM_CTX); nkeys = 256; }
            const float* krp_f = istok ? (const float*)(F.ws + WS_KROPE) + (size_t)r * 64 : F.a->in[IN_C_KROPE] + (size_t)(r - NTOK) * 64;
            const float row = (float)(s >> 6), col = (float)(s & 63);
            const int cc = act ? c : 23, cpq = cc >= 16 ? (cc ^ 2) : cc, cn = c < 16 ? c : 15, cr = cc >= 16 ? cc - 16 : 0, crp = cc >= 16 ? cpq - 16 : 0;
            float g[8], gp[8], kr[8], krp[8]; load8(gk + 8 * cc, g); load8(gk + 8 * cpq, gp); load8(krp_f + 8 * cr, kr); load8(krp_f + 8 * crp, krp);
            float v[4][8];
#pragma unroll
            for (int pass = 0; pass < 4; ++pass) load8h(KVM + (size_t)r * 2048 + (2 * pass + hsub) * 256 + 8 * cn, v[pass]);
#pragma unroll
            for (int pass = 0; pass < 4; ++pass) {
                const int head = 2 * pass + hsub;
                float vp[8]; float q = 0.f;
#pragma unroll
                for (int i = 0; i < 8; ++i) { v[pass][i] = c < 16 ? v[pass][i] : (act ? kr[i] : 0.f); q += v[pass][i] * v[pass][i]; }
                const float rstd = __builtin_amdgcn_rsqf(group_sum<32>(q) * (1.0f / 192) + EPS);
#pragma unroll
                for (int i = 0; i < 8; ++i) { v[pass][i] = v[pass][i] * rstd * g[i]; vp[i] = krp[i] * rstd * gp[i]; }
                if (lat && c >= 16 && act) rope8(v[pass], vp, (c & 2) == 0, c < 20 ? row : col, (c & 1) * 8, 1.0f / 16);
                if (act) *(u32x4*)(kb0 + (size_t)(bsel * 8 + head) * ((size_t)nkeys * 192) + k_chunk_off(192, s, c)) = pack8(v[pass]);
            }
        } else {
            int r = it - NTOK - NROW;
            if (r < NVT_CTX) { const int t32 = r & 7, bh = r >> 3, b = bh >> 3, h = bh & 7;
                vt_tile_write_h(KVM + (size_t)(b * 256 + t32 * 32) * 2048 + h * 256 + 128, 2048, (bf16_t*)(F.ws + WS_VM_CTX) + (size_t)bh * (256 * 128) + (size_t)t32 * 4096, lane);
            } else if (r < NVT_CTX + NVT_LAT) { r -= NVT_CTX; const int t32 = r & 31, bh = r >> 5, b = bh >> 3, h = bh & 7;
                vt_tile_write_h(KVM + (size_t)(NCTX + b * 1024 + t32 * 32) * 2048 + h * 256 + 128, 2048, (bf16_t*)(F.ws + WS_VM_LAT) + (size_t)bh * (1024 * 128) + (size_t)t32 * 4096, lane);
            } else { r -= NVT_CTX + NVT_LAT; const int t32 = r & 15, bh = r >> 4, b = bh >> 3, h = bh & 7;
                vt_tile_write_h(KVM + (size_t)(NTOK + b * 512 + t32 * 32) * 2048 + h * 256 + 128, 2048, (bf16_t*)(F.ws + WS_VM_CAC) + (size_t)bh * (512 * 128) + (size_t)t32 * 4096, lane);
            }
        }
    }
}

__device__ __forceinline__ void phase_post_odd(Frame& F) {
    const bf16_t* P = (const bf16_t*)(F.ws + WS_P); const float* gq = F.a->in[IN_GQK]; const float* gk = F.a->in[IN_GQK] + 128;
    bf16_t* QA = (bf16_t*)(F.ws + WS_QA);
    constexpr int NVT_CTX = 16 * 4 * 8, NVT_LAT = 8 * 4 * 32;
    const int lane = F.lane, hsub = lane >> 4, c = lane & 15;
    for (int it = F.gw; it < NTOK + NVT_CTX + NVT_LAT; it += F.NGW) {
        if (it < NTOK) {
            const int t = it; const bool ctx = t < NCTX, lat = !ctx; const bf16_t* pr = P + (size_t)t * IN_ODD;
            int b, s; if (ctx) { b = t >> 8; s = t & 255; } else { b = (t - NCTX) >> 10; s = (t - NCTX) & 1023; }
            const float row = (float)(s >> 6), col = (float)(s & 63);
            const int cp = c ^ 4;
            float gqv[8], gqp[8], gkv[8], gkp[8]; load8(gq + 8 * c, gqv); load8(gq + 8 * cp, gqp); load8(gk + 8 * c, gkv); load8(gk + 8 * cp, gkp);
            float v[5][8], vp[5][8];
#pragma unroll
            for (int pass = 0; pass < 5; ++pass) { const bf16_t* src = pr + (pass == 4 ? 2048 + hsub * 128 : (4 * pass + hsub) * 128); load8h(src + 8 * c, v[pass]); load8h(src + 8 * cp, vp[pass]); }
#pragma unroll
            for (int pass = 0; pass < 5; ++pass) {
                const bool isk = pass == 4; const int head = isk ? hsub : 4 * pass + hsub;
                float q = 0.f;
#pragma unroll
                for (int i = 0; i < 8; ++i) q += v[pass][i] * v[pass][i];
                const float rstd = __builtin_amdgcn_rsqf(group_sum<16>(q) * (1.0f / 128) + EPS);
#pragma unroll
                for (int i = 0; i < 8; ++i) { v[pass][i] = v[pass][i] * rstd * (isk ? gkv[i] : gqv[i]); vp[pass][i] = vp[pass][i] * rstd * (isk ? gkp[i] : gqp[i]); }
                if (isk && ctx) store8f(F.out + O_GK + (size_t)t * 512 + head * 128 + 8 * c, v[pass]);
                if (lat) rope8(v[pass], vp[pass], (c & 4) == 0, c < 8 ? row : col, (c & 3) * 8, 1.0f / 32);
                if (!isk) *(u32x4*)(QA + (size_t)t * 2048 + head * 128 + 8 * c) = pack8(v[pass]);
                else { bf16_t* kb = ctx ? (bf16_t*)(F.ws + WS_KG_CTX) + (size_t)(b * 4 + head) * (256 * 128) : (bf16_t*)(F.ws + WS_KG_LAT) + (size_t)(b * 4 + head) * (1024 * 128);
                    *(u32x4*)(kb + k_chunk_off(128, s, c)) = pack8(v[pass]); }
            }
            { float vv[8]; load8h(pr + 2560 + 8 * lane, vv); if (ctx) store8f(F.out + O_GV + (size_t)t * 512 + 8 * lane, vv); }
        } else {
            int r = it - NTOK;
            if (r < NVT_CTX) { const int t32 = r & 7, bh = r >> 3, b = bh >> 2, h = bh & 3;
                vt_tile_write_h(P + (size_t)(b * 256 + t32 * 32) * IN_ODD + 2560 + h * 128, IN_ODD, (bf16_t*)(F.ws + WS_VG_CTX) + (size_t)bh * (256 * 128) + (size_t)t32 * 4096, lane);
            } else { r -= NVT_CTX; const int t32 = r & 31, bh = r >> 5, b = bh >> 2, h = bh & 3;
                vt_tile_write_h(P + (size_t)(NCTX + b * 1024 + t32 * 32) * IN_ODD + 2560 + h * 128, IN_ODD, (bf16_t*)(F.ws + WS_VG_LAT) + (size_t)bh * (1024 * 128) + (size_t)t32 * 4096, lane);
            }
        }
    }
}

struct WgUnit {
    const bf16_t* kc; const bf16_t* vc; int nctx;
    const bf16_t* kl; const bf16_t* vl; int t_lo, t_hi;
};
struct WvUnit {
    const bf16_t* qb; unsigned qoff; int qpitch; bf16_t* ob; unsigned ooff;
    int qpos;
    int qcol0;
    int w_lo, w_hi;
    float sink; int has_sink; float scale;
};
constexpr int ATT_RPB_OFF = RING_BYTES + 512;
constexpr float ATT_THR = 8.0f;
template <int MODE>
__device__ __forceinline__ float attn_mask(float v, int tile32, int r, int hh, int ql, bool masked, const WvUnit& U, const LAS float* rpb) {
    const int kk = (r & 3) + 8 * (r >> 2) + 4 * hh;
    if (MODE == 1) { const int df = U.qpos + ql - (tile32 * 32 + kk); if (masked && (df > 128 || df < -128)) v = -1e30f; }
    if (MODE == 2 && masked) { const int krow = tile32 >> 1, kcol = (tile32 & 1) * 32 + kk, qc = U.qcol0 + ql;
        int ws = qc - 8; ws = ws < 0 ? 0 : (ws > 48 ? 48 : ws);
        const bool valid = (kcol >= ws) && (kcol < ws + 16);
        int co = kcol - qc; co = co < -15 ? -15 : (co > 15 ? 15 : co);
        const float bias = rpb[(krow - U.qpos + 7) * 31 + co + 15];
        v = valid ? v + bias * LOG2E : -1e30f; }
    return v;
}
template <int OFF> __device__ __forceinline__ bf16x8 lds_rd(unsigned addr) { bf16x8 r; asm volatile("ds_read_b128 %0, %1 offset:%2" : "=v"(r) : "v"(addr), "i"(OFF)); return r; }
template <int BASE, int H1> __device__ __forceinline__ void lds_rd8(unsigned addr, bf16x8 (&a)[8]) {
    a[0] = lds_rd<BASE>(addr); a[1] = lds_rd<BASE + 1024>(addr); a[2] = lds_rd<BASE + 2048>(addr); a[3] = lds_rd<BASE + 3072>(addr);
    a[4] = lds_rd<BASE + H1>(addr); a[5] = lds_rd<BASE + H1 + 1024>(addr); a[6] = lds_rd<BASE + H1 + 2048>(addr); a[7] = lds_rd<BASE + H1 + 3072>(addr);
}
#define LDS_WAIT8(n, a) asm volatile("s_waitcnt lgkmcnt(" #n ")" : "+v"(a[0]), "+v"(a[1]), "+v"(a[2]), "+v"(a[3]), "+v"(a[4]), "+v"(a[5]), "+v"(a[6]), "+v"(a[7]))
#define QK_MMA8(a, kb) do { _Pragma("unroll") for (int _j = 0; _j < 4; ++_j) { s0 = __builtin_amdgcn_mfma_f32_32x32x16_bf16(a[_j], qf[(kb) * 4 + _j], s0, 0, 0, 0); s1 = __builtin_amdgcn_mfma_f32_32x32x16_bf16(a[4 + _j], qf[(kb) * 4 + _j], s1, 0, 0, 0); } } while (0)
__device__ __forceinline__ void na_mask16(f32x16& sx, int tile32, int hh, int ql, bool masked, const WvUnit& U, const LAS float* rpb) {
    const int krow = tile32 >> 1, kc0 = (tile32 & 1) * 32 + 4 * hh, qc = U.qcol0 + ql;
    int ws = qc - 8; ws = ws < 0 ? 0 : (ws > 48 ? 48 : ws);
    int ro = krow - U.qpos + 7; ro = ro < 0 ? 0 : (ro > 14 ? 14 : ro);
    const LAS float* rrow = rpb + ro * 31 + 15;
    float bias[16];
#pragma unroll
    for (int r = 0; r < 16; ++r) { int co = kc0 + (r & 3) + 8 * (r >> 2) - qc; co = co < -15 ? -15 : (co > 15 ? 15 : co); bias[r] = rrow[co]; }
#pragma unroll
    for (int r = 0; r < 16; ++r) { const int kcol = kc0 + (r & 3) + 8 * (r >> 2); const float mv = ((unsigned)(kcol - ws) < 16u) ? sx[r] + bias[r] * LOG2E : -1e30f; sx[r] = masked ? mv : sx[r]; }
}
template <int DQK, int MODE>
__device__ __forceinline__ void attn_tile64(const LAS unsigned char* sl, int t64, bool masked, const bf16x8 (&qf)[DQK / 16], f32x16 (&o)[4], float& m, float& l, const WvUnit& U, const LAS float* rpb, int lane, float sl2) {
    constexpr int NKS = DQK / 16, KB = DQK * 128;
    const int ql = lane & 31, hh = lane >> 5;
    const unsigned addr = (unsigned)(unsigned long)sl + (unsigned)lane * 16u;
    f32x16 s0, s1;
#pragma unroll
    for (int r = 0; r < 16; ++r) { s0[r] = 0.f; s1[r] = 0.f; }
    bf16x8 pb[4];
#define ATT_SMA(sx, T32) do { float mt = -1e30f; \
    if (MODE == 2) { _Pragma("unroll") for (int r = 0; r < 16; ++r) sx[r] *= sl2; na_mask16(sx, (T32), hh, ql, masked, U, rpb); } \
    else { _Pragma("unroll") for (int r = 0; r < 16; ++r) sx[r] = attn_mask<MODE>(sx[r] * sl2, (T32), r, hh, ql, masked, U, rpb); } \
    _Pragma("unroll") for (int r = 0; r < 16; ++r) mt = fmaxf(mt, sx[r]); \
    mt = fmaxf(mt, __shfl_xor(mt, 32)); \
    if (!__all(mt - m <= ATT_THR)) { const float mn = fmaxf(m, mt), alpha = fast_exp2(m - mn); m = mn; l *= alpha; \
        _Pragma("unroll") for (int db = 0; db < 4; ++db) _Pragma("unroll") for (int r = 0; r < 16; ++r) o[db][r] *= alpha; } } while (0)
#define ATT_SMB(sx, PBI) do { float ps = 0.f; \
    _Pragma("unroll") for (int r = 0; r < 16; ++r) { sx[r] = fast_exp2(sx[r] - m); ps += sx[r]; } \
    l += ps; \
    _Pragma("unroll") for (int s2 = 0; s2 < 2; ++s2) { \
        u32x4 w; w.x = pk2(sx[8 * s2 + 0], sx[8 * s2 + 1]); w.y = pk2(sx[8 * s2 + 2], sx[8 * s2 + 3]); w.z = pk2(sx[8 * s2 + 4], sx[8 * s2 + 5]); w.w = pk2(sx[8 * s2 + 6], sx[8 * s2 + 7]); pb[(PBI) + s2] = __builtin_bit_cast(bf16x8, w); } } while (0)
#define MFMA32(a_, b_, c_) __builtin_amdgcn_mfma_f32_32x32x16_bf16(a_, b_, c_, 0, 0, 0)
    if constexpr (NKS == 8) {
        bf16x8 ka[8], kb_[8];
        lds_rd8<0, 4096>(addr, ka); lds_rd8<KB / 2, 4096>(addr, kb_);
        LDS_WAIT8(8, ka);
#pragma unroll
        for (int j = 0; j < 8; ++j) s0 = MFMA32(ka[j], qf[j], s0);
        if (MODE != 2) { lds_rd8<KB, 4096>(addr, ka); LDS_WAIT8(8, kb_); } else LDS_WAIT8(0, kb_);
#pragma unroll
        for (int j = 0; j < 4; ++j) s1 = MFMA32(kb_[j], qf[j], s1);
        ATT_SMA(s0, 2 * t64);
        if (MODE == 2) lds_rd8<KB, 4096>(addr, ka);
#pragma unroll
        for (int j = 4; j < 8; ++j) s1 = MFMA32(kb_[j], qf[j], s1);
        ATT_SMB(s0, 0);
        lds_rd8<KB + 8192, 4096>(addr, kb_);
        LDS_WAIT8(8, ka);
#pragma unroll
        for (int db = 0; db < 4; ++db) o[db] = MFMA32(ka[db], pb[0], o[db]);
        ATT_SMA(s1, 2 * t64 + 1);
#pragma unroll
        for (int db = 0; db < 4; ++db) o[db] = MFMA32(ka[4 + db], pb[1], o[db]);
        ATT_SMB(s1, 2);
        LDS_WAIT8(0, kb_);
#pragma unroll
        for (int s2 = 0; s2 < 2; ++s2)
#pragma unroll
            for (int db = 0; db < 4; ++db) o[db] = MFMA32(kb_[s2 * 4 + db], pb[2 + s2], o[db]);
    } else {
        bf16x8 ka[4], kb_[4];
#define RDK4(a, h, b) do { a[0] = lds_rd<(h) * (KB / 2) + (b) * 4096>(addr); a[1] = lds_rd<(h) * (KB / 2) + (b) * 4096 + 1024>(addr); a[2] = lds_rd<(h) * (KB / 2) + (b) * 4096 + 2048>(addr); a[3] = lds_rd<(h) * (KB / 2) + (b) * 4096 + 3072>(addr); } while (0)
#define RDV4(a, q) do { a[0] = lds_rd<KB + (q) * 4096>(addr); a[1] = lds_rd<KB + (q) * 4096 + 1024>(addr); a[2] = lds_rd<KB + (q) * 4096 + 2048>(addr); a[3] = lds_rd<KB + (q) * 4096 + 3072>(addr); } while (0)
#define WAIT4(n, a) asm volatile("s_waitcnt lgkmcnt(" #n ")" : "+v"(a[0]), "+v"(a[1]), "+v"(a[2]), "+v"(a[3]))
#define QK4(a, sx, b) do { _Pragma("unroll") for (int j = 0; j < 4; ++j) sx = MFMA32(a[j], qf[4 * (b) + j], sx); } while (0)
#define PV4(a, q) do { _Pragma("unroll") for (int db = 0; db < 4; ++db) o[db] = MFMA32(a[db], pb[q], o[db]); } while (0)
        RDK4(ka, 0, 0); RDK4(kb_, 0, 1);
        WAIT4(4, ka); QK4(ka, s0, 0); RDK4(ka, 0, 2);
        WAIT4(4, kb_); QK4(kb_, s0, 1); RDK4(kb_, 1, 0);
        WAIT4(4, ka); QK4(ka, s0, 2); RDK4(ka, 1, 1);
        WAIT4(4, kb_); QK4(kb_, s1, 0); RDK4(kb_, 1, 2);
        ATT_SMA(s0, 2 * t64);
        WAIT4(4, ka); QK4(ka, s1, 1); RDV4(ka, 0);
        ATT_SMB(s0, 0);
        WAIT4(4, kb_); QK4(kb_, s1, 2); RDV4(kb_, 1);
        WAIT4(4, ka); PV4(ka, 0); RDV4(ka, 2);
        ATT_SMA(s1, 2 * t64 + 1);
        WAIT4(4, kb_); PV4(kb_, 1); RDV4(kb_, 3);
        ATT_SMB(s1, 2);
        WAIT4(4, ka); PV4(ka, 2);
        WAIT4(0, kb_); PV4(kb_, 3);
#undef RDK4
#undef RDV4
#undef WAIT4
#undef QK4
#undef PV4
    }
#undef ATT_SMA
#undef ATT_SMB
#undef MFMA32
}
template <int DQK, int MODE, int VAR = 0>
__device__ __forceinline__ void attn_wg_unit(LAS unsigned char* ring, const WgUnit& G, const WvUnit& U, const float* rpb_g, int tid, int wave, int lane) {
    constexpr int NKS = DQK / 16, KB = DQK * 128, NLK = KB / 8192;
    constexpr int NS = (DQK == 128) ? 4 : 3, SLOTB = KB + 16384;
    const int ql = lane & 31, hh = lane >> 5;
    const int ntiles = G.nctx + (G.t_hi - G.t_lo);
    const LAS float* rpb = (const LAS float*)(ring + ATT_RPB_OFF);
#define ATT_ISSUE(i, SLOTC) do { const int _i = (i); const bool _c = _i < G.nctx; const int _t = _c ? _i : G.t_lo + (_i - G.nctx); \
        const char* _kg = (const char*)(_c ? G.kc : G.kl) + (size_t)_t * KB + tid * 16; const char* _vg = (const char*)(_c ? G.vc : G.vl) + (size_t)_t * 16384 + tid * 16; \
        LAS unsigned char* _sl = ring + (SLOTC) * SLOTB + wave * 1024; \
        _Pragma("unroll") for (int _p = 0; _p < NLK; ++_p) __builtin_amdgcn_global_load_lds((const unsigned*)(_kg + _p * 8192), (LAS unsigned*)(_sl + _p * 8192), 16, 0, 0); \
        _Pragma("unroll") for (int _p = 0; _p < 2; ++_p) __builtin_amdgcn_global_load_lds((const unsigned*)(_vg + _p * 8192), (LAS unsigned*)(_sl + KB + _p * 8192), 16, 0, 0); } while (0)
    asm volatile("s_waitcnt lgkmcnt(0)" ::: "memory"); __builtin_amdgcn_s_barrier(); asm volatile("" ::: "memory");
    bf16x8 qf[NKS];
#pragma unroll
    for (int ks = 0; ks < NKS; ++ks) qf[ks] = *(const bf16x8*)(U.qb + (size_t)(U.qoff + (unsigned)(ql * U.qpitch + 16 * ks + 8 * hh)));
    if (MODE == 2) { const int i = opaque_v(tid); if (i < 15 * 31) ((LAS float*)(ring + ATT_RPB_OFF))[i] = rpb_g[i]; }
    if (VAR != 2) { ATT_ISSUE(0, 0); if (ntiles > 1) ATT_ISSUE(1, 1); if (NS == 4 && ntiles > 2) ATT_ISSUE(2, 2); }
    f32x16 o[4];
#pragma unroll
    for (int db = 0; db < 4; ++db)
#pragma unroll
        for (int r = 0; r < 16; ++r) o[db][r] = 0.f;
    float m = -1e30f, l = 0.f;
    const float sl2 = U.scale * LOG2E;
#define ATT_STEP(i_, SLOTC) do { const int i = (i_); if (i < ntiles) { \
        if (NS == 4) { if (i + 2 < ntiles) asm volatile("s_waitcnt vmcnt(8)" ::: "memory"); else if (i + 1 < ntiles) asm volatile("s_waitcnt vmcnt(4)" ::: "memory"); else asm volatile("s_waitcnt vmcnt(0)" ::: "memory"); } \
        else { if (i + 1 < ntiles) asm volatile("s_waitcnt vmcnt(5)" ::: "memory"); else asm volatile("s_waitcnt vmcnt(0)" ::: "memory"); } \
        asm volatile("s_waitcnt lgkmcnt(0)" ::: "memory"); __builtin_amdgcn_s_barrier(); asm volatile("" ::: "memory"); \
        if (VAR != 2 && i + NS - 1 < ntiles) ATT_ISSUE(i + NS - 1, ((SLOTC) + NS - 1) % NS); \
        const bool isctx = i < G.nctx; const int t64 = isctx ? 0 : G.t_lo + (i - G.nctx); \
        if (VAR != 1 && (isctx || (t64 >= U.w_lo && t64 < U.w_hi))) attn_tile64<DQK, MODE>(ring + (SLOTC) * SLOTB, t64, !isctx, qf, o, m, l, U, rpb, lane, sl2); } } while (0)
    if constexpr (NS == 4) { for (int i0 = 0; i0 < ntiles; i0 += 4) { ATT_STEP(i0, 0); ATT_STEP(i0 + 1, 1); ATT_STEP(i0 + 2, 2); ATT_STEP(i0 + 3, 3); } }
    else { for (int i0 = 0; i0 < ntiles; i0 += 3) { ATT_STEP(i0, 0); ATT_STEP(i0 + 1, 1); ATT_STEP(i0 + 2, 2); } }
#undef ATT_STEP
#undef ATT_ISSUE
    l += __shfl_xor(l, 32);
    if (U.has_sink) l += fast_exp2(U.sink * LOG2E - m);
    const float inv = 1.0f / l;
    bf16_t* op = U.ob + (size_t)(U.ooff + (unsigned)(opaque_v(ql) * DM));
#pragma unroll
    for (int db = 0; db < 4; ++db)
#pragma unroll
        for (int rg = 0; rg < 4; ++rg) { u32x2 w; w.x = pk2(o[db][4 * rg] * inv, o[db][4 * rg + 1] * inv); w.y = pk2(o[db][4 * rg + 2] * inv, o[db][4 * rg + 3] * inv);
            *(u32x2*)(op + 32 * db + 8 * rg + 4 * hh) = w; }
}

template <int VAR>
__device__ __forceinline__ void phase_attn_even(Frame& F, bf16_t* O) {
 const bf16_t* QA = (const bf16_t*)(F.ws + WS_QA); const bf16_t* QNA = (const bf16_t*)(F.ws + WS_QNA);
    const int wave = F.wave, lane = F.lane, tid = F.tid;
    WgUnit G; WvUnit U; U.sink = 0.f; U.has_sink = 0; U.qpos = 0; U.qcol0 = 0;
    const int vcu = (F.G % 8 == 0) ? ((int)blockIdx.x % 8) * (F.G / 8) + (int)blockIdx.x / 8 : (int)blockIdx.x;
    for (int u = vcu; u < 256; u += F.G) { const int bh = u >> 2, q4 = u & 3, b = bh >> 3, h = bh & 7, t0 = NCTX + b * 1024 + q4 * 256 + 32 * wave;
        U.qb = QA; U.qoff = (unsigned)(t0 * 1536 + h * 192); U.qpitch = 1536; U.scale = 0.07216878364870322f; U.ob = O; U.ooff = (unsigned)(t0 * DM + h * 128);
        G.kc = (const bf16_t*)(F.ws + WS_KM_CAC) + (size_t)bh * (512 * 192); G.vc = (const bf16_t*)(F.ws + WS_VM_CAC) + (size_t)bh * (512 * 128); G.nctx = 8;
        G.kl = (const bf16_t*)(F.ws + WS_KM_LAT) + (size_t)bh * (1024 * 192); G.vl = (const bf16_t*)(F.ws + WS_VM_LAT) + (size_t)bh * (1024 * 128); G.t_lo = 0; G.t_hi = 16; U.w_lo = 0; U.w_hi = 16;
        attn_wg_unit<192, 0, VAR>(F.lds, G, U, nullptr, tid, wave, lane); }
    for (int u = vcu; u < 256; u += F.G) { const int bh = u >> 2, r0 = (u & 3) * 4, b = bh >> 3, h = bh & 7, r = r0 + (wave >> 1), c0 = (wave & 1) * 32, t0 = NCTX + b * 1024 + r * 64 + c0;
        int rs = r - 4; rs = rs < 0 ? 0 : (rs > 8 ? 8 : rs);
        int glo = r0 - 4; glo = glo < 0 ? 0 : (glo > 8 ? 8 : glo); int ghi = r0 - 1; ghi = ghi < 0 ? 0 : (ghi > 8 ? 8 : ghi);
        U.qb = QNA; U.qoff = (unsigned)(t0 * 1024 + h * 128); U.qpitch = 1024; U.scale = 0.08838834764831845f; U.ob = O; U.ooff = (unsigned)(t0 * DM + 1024 + h * 128);
        G.kc = (const bf16_t*)(F.ws + WS_KN_CAC) + (size_t)bh * (512 * 128); G.vc = (const bf16_t*)(F.ws + WS_VN_CAC) + (size_t)bh * (512 * 128); G.nctx = 8;
        G.kl = (const bf16_t*)(F.ws + WS_KN_LAT) + (size_t)bh * (1024 * 128); G.vl = (const bf16_t*)(F.ws + WS_VN_LAT) + (size_t)bh * (1024 * 128); G.t_lo = glo; G.t_hi = ghi + 8; U.w_lo = rs; U.w_hi = rs + 8;
        U.qpos = r; U.qcol0 = c0;
        attn_wg_unit<128, 2, VAR>(F.lds, G, U, F.a->in[IN_RPB] + h * (15 * 31), tid, wave, lane); }
    U.qpos = 0; U.qcol0 = 0; U.w_lo = 0; U.w_hi = 4; G.nctx = 0; G.kc = nullptr; G.vc = nullptr; G.t_lo = 0; G.t_hi = 4;
    for (int u = vcu; u < 256; u += F.G) { const int bh = u & 127, b = bh >> 3, h = bh & 7, t0 = b * 256 + 32 * wave;
        if (u < 128) {
            U.qb = QA; U.qoff = (unsigned)(t0 * 1536 + h * 192); U.qpitch = 1536; U.scale = 0.07216878364870322f; U.ob = O; U.ooff = (unsigned)(t0 * DM + h * 128);
            G.kl = (const bf16_t*)(F.ws + WS_KM_CTX) + (size_t)bh * (256 * 192); G.vl = (const bf16_t*)(F.ws + WS_VM_CTX) + (size_t)bh * (256 * 128);
            attn_wg_unit<192, 0, VAR>(F.lds, G, U, nullptr, tid, wave, lane);
        } else {
            U.qb = QNA; U.qoff = (unsigned)(t0 * 1024 + h * 128); U.qpitch = 1024; U.scale = 0.08838834764831845f; U.ob = O; U.ooff = (unsigned)(t0 * DM + 1024 + h * 128);
            G.kl = (const bf16_t*)(F.ws + WS_KN_CTX) + (size_t)bh * (256 * 128); G.vl = (const bf16_t*)(F.ws + WS_VN_CTX) + (size_t)bh * (256 * 128);
            attn_wg_unit<128, 0, VAR>(F.lds, G, U, nullptr, tid, wave, lane);
        } }
    asm volatile("s_waitcnt vmcnt(0) lgkmcnt(0)" ::: "memory"); __syncthreads();
}
__device__ __forceinline__ void phase_attn_odd(Frame& F) {
    bf16_t* O = (bf16_t*)(F.ws + WS_O); const bf16_t* QA = (const bf16_t*)(F.ws + WS_QA);
    const int wave = F.wave, lane = F.lane, tid = F.tid;
    WgUnit G; WvUnit U; U.has_sink = 1; U.qcol0 = 0; U.qpitch = 2048; U.scale = 0.08838834764831845f;
    const int vcu = (F.G % 8 == 0) ? ((int)blockIdx.x % 8) * (F.G / 8) + (int)blockIdx.x / 8 : (int)blockIdx.x;
    const float* sink = F.a->in[IN_SINK];
    for (int u = vcu; u < 512; u += F.G) { const int bk = u >> 4, q64 = u & 15, b = bk >> 2, kvh = bk & 3, g = wave >> 1, hq = kvh * 4 + g, qs = q64 * 64 + (wave & 1) * 32, t0 = NCTX + b * 1024 + qs;
        U.qb = QA; U.qoff = (unsigned)(t0 * 2048 + hq * 128); U.ob = O; U.ooff = (unsigned)(t0 * DM + hq * 128); U.qpos = qs; U.sink = sink[hq];
        G.kc = (const bf16_t*)(F.ws + WS_KG_CAC) + (size_t)bk * (512 * 128); G.vc = (const bf16_t*)(F.ws + WS_VG_CAC) + (size_t)bk * (512 * 128); G.nctx = 8;
        G.kl = (const bf16_t*)(F.ws + WS_KG_LAT) + (size_t)bk * (1024 * 128); G.vl = (const bf16_t*)(F.ws + WS_VG_LAT) + (size_t)bk * (1024 * 128);
        G.t_lo = q64 - 2 < 0 ? 0 : q64 - 2; G.t_hi = (q64 + 2 > 15 ? 15 : q64 + 2) + 1; U.w_lo = G.t_lo; U.w_hi = G.t_hi;
        attn_wg_unit<128, 1>(F.lds, G, U, nullptr, tid, wave, lane); }
    G.nctx = 0; G.kc = nullptr; G.vc = nullptr; G.t_lo = 0; G.t_hi = 4; U.w_lo = 0; U.w_hi = 4;
    for (int u = vcu; u < 256; u += F.G) { const int bk = u >> 2, q64 = u & 3, b = bk >> 2, kvh = bk & 3, g = wave >> 1, hq = kvh * 4 + g, qs = q64 * 64 + (wave & 1) * 32, t0 = b * 256 + qs;
        U.qb = QA; U.qoff = (unsigned)(t0 * 2048 + hq * 128); U.ob = O; U.ooff = (unsigned)(t0 * DM + hq * 128); U.qpos = 0; U.sink = sink[hq];
        G.kl = (const bf16_t*)(F.ws + WS_KG_CTX) + (size_t)bk * (256 * 128); G.vl = (const bf16_t*)(F.ws + WS_VG_CTX) + (size_t)bk * (256 * 128);
        attn_wg_unit<128, 0>(F.lds, G, U, nullptr, tid, wave, lane); }
    asm volatile("s_waitcnt vmcnt(0) lgkmcnt(0)" ::: "memory"); __syncthreads();
}

constexpr int N_PHASES = 36;
__global__ void __launch_bounds__(512, 2) fwd_kernel(Args args) {
    extern __shared__ __attribute__((aligned(16))) unsigned char lds_raw[];
    Frame F;
    F.lds = (LAS unsigned char*)lds_raw;
    F.tid = threadIdx.x; F.lane = F.tid & 63; F.wave = __builtin_amdgcn_readfirstlane(F.tid >> 6);
    F.G = gridDim.x; F.gw = blockIdx.x * 8 + F.wave; F.NGW = F.G * 8;
    F.a = &args; F.out = args.out; F.ws = args.ws;
    volatile LAS unsigned* MISC = (volatile LAS unsigned*)(F.lds + LDSCTL_OFF);
    for (int u = F.tid; u < (LDS_BYTES - LDSCTL_OFF) / 4; u += 512) ((LAS unsigned*)(F.lds + LDSCTL_OFF))[u] = 0u;
    __syncthreads();
    unsigned* ctl = (unsigned*)(F.ws + WS_CTL);
    const int lo = args.ph_lo, hi = args.ph_hi;
    const bool multi = (hi - lo) > 1;
    XcdBarrier bar; bar.bar = ctl + CW_BAR; bar.x = 0; bar.st = nullptr;
    if (multi) bar = xcd_barrier_post(ctl + CW_BAR, MISC + 8);
#define IN(k) (lo <= (k) && (k) < hi)
    int ph = 0;
#define PHASE(...) do { if (IN(ph)) { __VA_ARGS__ } if (IN(ph) && IN(ph + 1)) xcd_barrier(bar); ++ph; } while (0)
    const float* mods = (const float*)(F.ws + WS_MODS);
    bf16_t* H = (bf16_t*)(F.ws + WS_H); bf16_t* ACT = (bf16_t*)(F.ws + WS_ACT); float* P = (float*)(F.ws + WS_P); bf16_t* OB = (bf16_t*)(F.ws + WS_O);
    LAS unsigned char* ring = F.lds;
    const int cid = (int)blockIdx.x;
#define GEMM2(EPI_T, EDEF, A_, B_, M_, N_, K_, SLAB) \
    PHASE( pg8::Gemm g{(A_), (B_), (M_), (N_), (K_)}; typedef pg8::SplitOrder<(M_), (N_), (K_), true> SO; SO S; S.init(cid); EDEF; pg8::gemm_phase<EPI_T, SO, true, true>(ring, g, S, E, (SLAB)); ); \
    PHASE( typedef pg8::SplitOrder<(M_), (N_), (K_), true> SO; EDEF; pg8::gemm_fixup<EPI_T, SO>(E, (SLAB)); )
#define GEMM1(EPI_T, EDEF, A_, B_, M_, N_, K_) \
    PHASE( pg8::Gemm g{(A_), (B_), (M_), (N_), (K_)}; typedef pg8::SplitOrder<(M_), (N_), (K_), false> SO; SO S; S.init(cid); EDEF; pg8::gemm_phase<EPI_T, SO, true, true>(ring, g, S, E, nullptr); )
#define W_FI(layer, f) ((const bf16_t*)(F.ws + WS_WFI) + (size_t)((layer) * 2 + (f)) * NFF2 * DM)
#define W_FO(layer, f) ((const bf16_t*)(F.ws + WS_WFO) + (size_t)((layer) * 2 + (f)) * DM * DFF)
#define E_SWIGLU EpiSwiGLU E{ACT}
#define E_RESID(layer, gidx, coef, from_in) EpiResid E{F.a->in[IN_XP], F.a->in[IN_XS], (from_in), F.out, mods + (size_t)(layer) * 9 * NMOD + (size_t)(gidx) * DM, (coef)}
#define FFN(layer, f, from_in) \
    GEMM2(EpiSwiGLU, E_SWIGLU, H, W_FI(layer, f), NTOK, NFF2, DM, P); \
    GEMM2(EpiResid, E_RESID(layer, (f) ? 8 : 2, 0.5f, from_in), ACT, W_FO(layer, f), NTOK, DM, DFF, P)

    PHASE( phase_prologue(F); );
    PHASE( phase_norm(F, true, 0, 0); );
    FFN(0, 0, true);
    PHASE( phase_norm(F, false, 0, 1); );
    GEMM1(EpiBf16, EpiBf16 E{(bf16_t*)P COMMA IN_EVEN_P}, H, (const bf16_t*)(F.ws + WS_WEI), NTOK, IN_EVEN_P, DM);
    PHASE( phase_post1_even(F); );
    PHASE( { pg8::Gemm g{(const bf16_t*)(F.ws + WS_CQN), (const bf16_t*)(F.ws + WS_WQU), NTOK, 1536, 512}; typedef pg8::SplitOrder<NTOK, 1536, 512, false> SO; SO S; S.init(cid);
             EpiBf16 E{(bf16_t*)(F.ws + WS_QM), 1536}; pg8::gemm_phase<EpiBf16, SO, true, true>(ring, g, S, E, nullptr); }
           { pg8::Gemm g{(const bf16_t*)(F.ws + WS_CKVA), (const bf16_t*)(F.ws + WS_WKU), 16384, 2048, 512}; typedef pg8::SplitOrder<16384, 2048, 512, false> SO; SO S; S.init(cid);
             EpiBf16 E{(bf16_t*)(F.ws + WS_ACT), 2048}; pg8::gemm_phase<EpiBf16, SO, true, true>(ring, g, S, E, nullptr); } );
    PHASE( phase_post2_even(F); );
    PHASE( phase_attn_even<0>(F, (bf16_t*)(F.ws + WS_O)); );
    GEMM2(EpiResid, E_RESID(0, 5, 1.0f, false), OB, (const bf16_t*)(F.ws + WS_WEO), NTOK, DM, DM, P);
    PHASE( phase_norm(F, false, 0, 2); );
    FFN(0, 1, false);
    PHASE( phase_norm(F, false, 1, 0); );
    FFN(1, 0, false);
    PHASE( phase_norm(F, false, 1, 1); );
    GEMM2(EpiBf16, EpiBf16 E{(bf16_t*)P COMMA IN_ODD}, H, (const bf16_t*)(F.ws + WS_WOI), NTOK, IN_ODD, DM, (float*)(F.ws + WS_ACT));
    PHASE( phase_post_odd(F); );
    PHASE( phase_attn_odd(F); );
    GEMM2(EpiResid, E_RESID(1, 5, 1.0f, false), OB, (const bf16_t*)(F.ws + WS_WOO), NTOK, DM, DM, P);
    PHASE( phase_norm(F, false, 1, 2); );
    FFN(1, 1, false);
#undef IN
}

extern "C" void kernel_launch(void* const* d_in, const int* in_sizes, int n_in, void* d_out, int out_size, void* d_ws, size_t ws_size, hipStream_t stream) {
    static int grid = 0;
    if (grid == 0) {
        if (n_in != 28 || (size_t)out_size != O_END || ws_size < WS_END) { fprintf(stderr, "kernel_launch: unexpected shapes (n_in %d, out %d, ws %zu; need ws >= %zu); nothing launched\n", n_in, out_size, ws_size, (size_t)WS_END); grid = -1; return; }
        int dev = 0, cus = 0, per_cu = 0;
        if (hipGetDevice(&dev) != hipSuccess || hipDeviceGetAttribute(&cus, hipDeviceAttributeMultiprocessorCount, dev) != hipSuccess) { grid = -1; return; }
        if (hipFuncSetAttribute((const void*)fwd_kernel, hipFuncAttributeMaxDynamicSharedMemorySize, LDS_BYTES) != hipSuccess) { fprintf(stderr, "kernel_launch: hipFuncSetAttribute failed\n"); grid = -1; return; }
        if (hipOccupancyMaxActiveBlocksPerMultiprocessor(&per_cu, (const void*)fwd_kernel, 512, LDS_BYTES) != hipSuccess || per_cu < 1) { fprintf(stderr, "kernel_launch: occupancy query says %d blocks per CU\n", per_cu); }
        (void)hipGetLastError();
        if (cus < pg8::GRID) { fprintf(stderr, "kernel_launch: %d CUs < %d workgroups: not resident; nothing launched\n", cus, pg8::GRID); grid = -1; return; }
        grid = pg8::GRID;
    }
    if (grid < 0) return;
    if (hipMemsetAsync((char*)d_ws + WS_CTL, 0, CTL_ZERO_BYTES, stream) != hipSuccess) return;
    Args a{};
    for (int i = 0; i < 28; ++i) a.in[i] = (const float*)d_in[i];
    a.out = (float*)d_out; a.ws = (unsigned char*)d_ws;
#if MK_ONE_LAUNCH
    a.ph_lo = 0; a.ph_hi = N_PHASES;
    hipLaunchKernelGGL(fwd_kernel, dim3(grid), dim3(512), LDS_BYTES, stream, a);
#else
    for (int p = 0; p < N_PHASES; ++p) { a.ph_lo = p; a.ph_hi = p + 1; hipLaunchKernelGGL(fwd_kernel, dim3(grid), dim3(512), LDS_BYTES, stream, a); }
#endif
}
```

```cpp
#include <hip/hip_runtime.h>
#include <cstdio>
#include <cstdint>

#ifndef MK_ONE_LAUNCH
#define MK_ONE_LAUNCH 1
#endif

#define COMMA ,
#define GAS __attribute__((address_space(1)))
#define LAS __attribute__((address_space(3)))
typedef unsigned short bf16_t;
typedef short bf16x8 __attribute__((ext_vector_type(8)));
typedef float f32x4 __attribute__((ext_vector_type(4)));
typedef float f32x16 __attribute__((ext_vector_type(16)));
typedef unsigned u32x4 __attribute__((ext_vector_type(4)));
typedef unsigned u32x2 __attribute__((ext_vector_type(2)));

namespace pg8 {
constexpr int BM = 256, BK = 64, HALF = 128, HTB = HALF * BK * 2, STAGE_BYTES = 8 * HTB, NXCD = 8, WGM = 8;
__host__ __device__ __forceinline__ int lds_byte(int r, int c) { const int st = (r >> 4) * 2 + (c >> 5), rr = r & 15, cc = c & 31, ob = rr * 64 + cc * 2; return st * 1024 + (ob ^ (((ob >> 9) & 1) << 5)); }
__host__ __device__ __forceinline__ void stage_rc(int b, int& R, int& C) { const int st = b / 1024, sb = b % 1024, swz = sb ^ (((sb >> 9) & 1) << 5); R = (st >> 1) * 16 + swz / 64; C = (st & 1) * 32 + (swz % 64) / 2; }
__host__ __device__ __forceinline__ int perm32(int rho) { const int n = rho >> 4, i = rho & 15; return 8 * (i >> 2) + 4 * n + (i & 3); }
struct Unit { int pm, pn, kt0, nkt, part; };
struct Gemm { const bf16_t* A; const bf16_t* Bt; int M, N, K; };
constexpr int GRID = 256;
template <int M, int N, int K, bool SPLIT>
struct SplitOrder {
    static constexpr int nM = M / BM, nN = N / BM, nwg = nM * nN, G = GRID, nt = K / BK, nfull = (nwg / G) * G, rem = nwg - nfull, NR = nfull / G;
    static constexpr int S0 = (SPLIT && rem > 0 && G % rem == 0) ? G / rem : 1;
    static constexpr int S = ((S0 == 2 || S0 == 4) && nt % (2 * S0) == 0) ? S0 : 1;
    int c;
    __host__ __device__ void init(int c_) { c = c_; }
    __host__ __device__ static Unit unit_of(int L, int kt0, int nkt, int part) {
        int wgid = L; { constexpr int q = nwg / NXCD, r = nwg % NXCD; const int xcd = wgid % NXCD, off = wgid / NXCD; wgid = (xcd < r ? xcd * (q + 1) : r * (q + 1) + (xcd - r) * q) + off; }
        constexpr int nig = WGM * nN; const int gid = wgid / nig, fm = gid * WGM, gsz = (nM - fm) < WGM ? (nM - fm) : WGM;
        Unit u; u.pm = fm + ((wgid % nig) % gsz); u.pn = (wgid % nig) / gsz; u.kt0 = kt0; u.nkt = nkt; u.part = part; return u;
    }
    __host__ __device__ bool next(int i, Unit& u) const {
        int L = i * G + c, kt0 = 0, nkt = nt, part = -1; bool ok = L < nwg;
        if (S > 1 && i >= NR) { constexpr int R1 = rem > 0 ? rem : 1; L = nfull + (c % R1); nkt = nt / S; kt0 = (c / R1) * (nt / S); part = c; ok = (i == NR); }
        if (!ok) return false;
        u = unit_of(L, kt0, nkt, part); return true;
    }
};
typedef float f32x2_t __attribute__((ext_vector_type(2)));
typedef __bf16 bf16x2_t __attribute__((ext_vector_type(2)));
__device__ __forceinline__ unsigned cvt_pk_bf16(float lo, float hi) { const f32x2_t v = {lo, hi}; return __builtin_bit_cast(unsigned, __builtin_convertvector(v, bf16x2_t)); }

template <class Epi, class Sched, bool ALIGN_EPI = false, bool SP2 = false>
__device__ __forceinline__ void gemm_phase(LAS unsigned char* lds, const Gemm g, const Sched& S, const Epi& E, float* slab) {
    const int tid = threadIdx.x, wid = __builtin_amdgcn_readfirstlane(tid >> 6), lane = tid & 63, wr = wid >> 2, wc = wid & 3, fr = lane & 15, fq = lane >> 4;
    const int K = g.K;
    unsigned voffA[2], voffB[2];
#pragma unroll
    for (int i = 0; i < 2; ++i) { int R, C; stage_rc(tid * 16 + i * 8192, R, C); const int Rb = Epi::PERM ? ((R & ~31) + perm32(R & 31)) : R;
        voffA[i] = (unsigned)(R * K + C) * 2u; voffB[i] = (unsigned)(Rb * K + C) * 2u; }
    const size_t kstep = (size_t)(BK * 2);
    const size_t hstep = (size_t)HALF * K * 2;
    const size_t tstep = 2 * hstep;
    const unsigned ldsw = (unsigned)wid * 1024u;
    const int aoff = lds_byte(wr * 64 + fr, fq * 8), boff = lds_byte(wc * 32 + fr, fq * 8);
#define PG8_SA(b, h) (((b) * 2 + (h)) * HTB)
#define PG8_SB(b, h) ((4 + (b) * 2 + (h)) * HTB)
#define PG8_STAGE(bufoff, gbase, voff) do { _Pragma("unroll") for (int _i = 0; _i < 2; ++_i) \
        __builtin_amdgcn_global_load_lds((const unsigned*)((const char*)(gbase) + (voff)[_i]), (LAS unsigned*)(lds + (bufoff) + ldsw + _i * 8192), 16, 0, 0); } while (0)
#define PG8_LDA(dst, b, h) do { _Pragma("unroll") for (int m = 0; m < 4; ++m) _Pragma("unroll") for (int k = 0; k < 2; ++k) dst[m][k] = *(const LAS bf16x8*)(lds + PG8_SA(b, h) + aoff + m * 2048 + k * 1024); } while (0)
#define PG8_LDB(dst, b, h) do { _Pragma("unroll") for (int n = 0; n < 2; ++n) _Pragma("unroll") for (int k = 0; k < 2; ++k) dst[n][k] = *(const LAS bf16x8*)(lds + PG8_SB(b, h) + boff + n * 2048 + k * 1024); } while (0)
#define PG8_MMA(ai, bj, At, Bt) do { __builtin_amdgcn_s_setprio(1); _Pragma("unroll") for (int m = 0; m < 4; ++m) _Pragma("unroll") for (int n = 0; n < 2; ++n) _Pragma("unroll") for (int k = 0; k < 2; ++k) \
        acc[ai][bj][m][n] = __builtin_amdgcn_mfma_f32_16x16x32_bf16(Bt[n][k], At[m][k], acc[ai][bj][m][n], 0, 0, 0); __builtin_amdgcn_s_setprio(0); } while (0)
#define PG8_WAIT_V(n) asm volatile("s_waitcnt vmcnt(" #n ")" ::: "memory")
#define PG8_WAIT_L(n) asm volatile("s_waitcnt lgkmcnt(" #n ")" ::: "memory")
#define PG8_BAR __builtin_amdgcn_s_barrier()
#define PG8_SCHED __builtin_amdgcn_sched_barrier(0)
    Unit cur, nxt; int ui = 0;
    if (!S.next(0, cur)) return;
    f32x4 acc[2][2][4][2];
#pragma unroll
    for (int a = 0; a < 2; ++a)
#pragma unroll
        for (int b = 0; b < 2; ++b)
#pragma unroll
            for (int m = 0; m < 4; ++m)
#pragma unroll
                for (int n = 0; n < 2; ++n) acc[a][b][m][n] = (f32x4){0.f, 0.f, 0.f, 0.f};
    bf16x8 At[4][2], B0[2][2], B1[2][2];
    const char* cA = (const char*)g.A + (size_t)cur.pm * tstep + (size_t)cur.kt0 * kstep; const char* cB = (const char*)g.Bt + (size_t)cur.pn * tstep + (size_t)cur.kt0 * kstep;
    if constexpr (SP2) {
        PG8_STAGE(PG8_SB(0, 0), cB, voffB); PG8_STAGE(PG8_SB(0, 1), cB + hstep, voffB); PG8_STAGE(PG8_SA(0, 0), cA, voffA); PG8_STAGE(PG8_SA(0, 1), cA + hstep, voffA);
        if (wr == 1) PG8_BAR;
        PG8_WAIT_V(2); PG8_BAR;
        PG8_STAGE(PG8_SB(1, 0), cB + kstep, voffB); PG8_STAGE(PG8_SA(1, 0), cA + kstep, voffA); PG8_STAGE(PG8_SB(1, 1), cB + hstep + kstep, voffB);
        PG8_WAIT_V(6); PG8_BAR;
    } else {
        PG8_STAGE(PG8_SB(0, 0), cB, voffB); PG8_STAGE(PG8_SA(0, 0), cA, voffA); PG8_STAGE(PG8_SB(0, 1), cB + hstep, voffB); PG8_STAGE(PG8_SA(0, 1), cA + hstep, voffA);
        if (wr == 1) PG8_BAR;
        PG8_WAIT_V(4); PG8_BAR;
        PG8_STAGE(PG8_SB(1, 0), cB + kstep, voffB); PG8_STAGE(PG8_SA(1, 0), cA + kstep, voffA); PG8_STAGE(PG8_SB(1, 1), cB + hstep + kstep, voffB);
        PG8_WAIT_V(6); PG8_BAR;
    }
    for (;;) {
        const bool has_next = S.next(ui + 1, nxt);
        const char* nA = has_next ? (const char*)g.A + (size_t)nxt.pm * tstep + (size_t)nxt.kt0 * kstep : cA; const char* nB = has_next ? (const char*)g.Bt + (size_t)nxt.pn * tstep + (size_t)nxt.kt0 * kstep : cB;
        const int nt = cur.nkt;
        for (int t = 0; t < nt; t += 2) {
            const bool last = (t == nt - 2);
            const char* a1 = cA + (size_t)(t + 1) * kstep;
            const char* a2 = last ? nA : cA + (size_t)(t + 2) * kstep; const char* b2 = last ? nB : cB + (size_t)(t + 2) * kstep;
            const char* a3 = a2 + kstep; const char* b3 = b2 + kstep;
            if constexpr (SP2) {
            PG8_LDB(B0, 0, 0); PG8_LDB(B1, 0, 1); PG8_SCHED; PG8_LDA(At, 0, 0); PG8_STAGE(PG8_SA(1, 1), a1 + hstep, voffA);
            PG8_WAIT_V(8); PG8_WAIT_L(0); PG8_BAR; PG8_MMA(0, 0, At, B0); PG8_MMA(0, 1, At, B1); PG8_BAR; PG8_SCHED;
            PG8_LDA(At, 0, 1); PG8_STAGE(PG8_SB(0, 0), b2, voffB); PG8_STAGE(PG8_SB(0, 1), b2 + hstep, voffB); PG8_STAGE(PG8_SA(0, 0), a2, voffA);
            PG8_WAIT_V(8); PG8_WAIT_L(0); PG8_BAR; PG8_MMA(1, 0, At, B0); PG8_MMA(1, 1, At, B1); PG8_BAR; PG8_SCHED;
            PG8_LDB(B0, 1, 0); PG8_LDB(B1, 1, 1); PG8_SCHED; PG8_LDA(At, 1, 0); PG8_STAGE(PG8_SA(0, 1), a2 + hstep, voffA);
            PG8_WAIT_V(8); PG8_WAIT_L(0); PG8_BAR; PG8_MMA(0, 0, At, B0); PG8_MMA(0, 1, At, B1); PG8_BAR; PG8_SCHED;
            PG8_LDA(At, 1, 1); PG8_STAGE(PG8_SB(1, 0), b3, voffB); PG8_STAGE(PG8_SB(1, 1), b3 + hstep, voffB); PG8_STAGE(PG8_SA(1, 0), a3, voffA);
            PG8_WAIT_V(8); PG8_WAIT_L(0); PG8_BAR; PG8_MMA(1, 0, At, B0); PG8_MMA(1, 1, At, B1); PG8_BAR; PG8_SCHED;
            } else {
            PG8_LDB(B0, 0, 0); PG8_SCHED; PG8_LDA(At, 0, 0); PG8_STAGE(PG8_SA(1, 1), a1 + hstep, voffA);
            PG8_WAIT_L(8); PG8_BAR; PG8_WAIT_L(0); PG8_MMA(0, 0, At, B0); PG8_BAR; PG8_SCHED;
            PG8_LDB(B1, 0, 1); PG8_STAGE(PG8_SB(0, 0), b2, voffB);
            PG8_BAR; PG8_WAIT_L(0); PG8_MMA(0, 1, At, B1); PG8_BAR;
            PG8_LDA(At, 0, 1); PG8_STAGE(PG8_SA(0, 0), a2, voffA);
            PG8_BAR; PG8_WAIT_L(0); PG8_MMA(1, 0, At, B0); PG8_BAR; PG8_SCHED;
            PG8_STAGE(PG8_SB(0, 1), b2 + hstep, voffB);
            PG8_WAIT_V(6); PG8_BAR; PG8_MMA(1, 1, At, B1); PG8_BAR;
            PG8_LDB(B0, 1, 0); PG8_SCHED; PG8_LDA(At, 1, 0); PG8_STAGE(PG8_SA(0, 1), a2 + hstep, voffA);
            PG8_WAIT_L(8); PG8_BAR; PG8_WAIT_L(0); PG8_MMA(0, 0, At, B0); PG8_BAR; PG8_SCHED;
            PG8_LDB(B1, 1, 1); PG8_STAGE(PG8_SB(1, 0), b3, voffB);
            PG8_BAR; PG8_WAIT_L(0); PG8_MMA(0, 1, At, B1); PG8_BAR;
            PG8_LDA(At, 1, 1); PG8_STAGE(PG8_SA(1, 0), a3, voffA);
            PG8_BAR; PG8_WAIT_L(0); PG8_MMA(1, 0, At, B0); PG8_BAR; PG8_SCHED;
            PG8_STAGE(PG8_SB(1, 1), b3 + hstep, voffB);
            PG8_WAIT_V(6); PG8_BAR; PG8_MMA(1, 1, At, B1); PG8_BAR;
            }
        }
        if constexpr (ALIGN_EPI) { if (wr == 0) PG8_BAR; }
        if (cur.part < 0) {
            const auto cx = E.begin(cur, wr, wc, fr, fq);
#pragma unroll
            for (int ai = 0; ai < 2; ++ai)
#pragma unroll
                for (int m = 0; m < 4; ++m) { const f32x4 v[2][2] = {{acc[ai][0][m][0], acc[ai][0][m][1]}, {acc[ai][1][m][0], acc[ai][1][m][1]}}; E.rows(cx, v, cur, ai, m, wr, wc, fr, fq); }
        } else {
            bf16_t* sp = (bf16_t*)slab + (size_t)cur.part * 65536 + (size_t)tid * 8;
#pragma unroll
            for (int ai = 0; ai < 2; ++ai)
#pragma unroll
                for (int bj = 0; bj < 2; ++bj)
#pragma unroll
                    for (int m = 0; m < 4; ++m) { const f32x4 a = acc[ai][bj][m][0], b = acc[ai][bj][m][1];
                        u32x4 w; w.x = cvt_pk_bf16(a[0], a[1]); w.y = cvt_pk_bf16(a[2], a[3]); w.z = cvt_pk_bf16(b[0], b[1]); w.w = cvt_pk_bf16(b[2], b[3]);
                        *(u32x4*)(sp + (size_t)(((ai * 2 + bj) * 4 + m) * 4096)) = w; }
        }
        if (!has_next) break;
#pragma unroll
        for (int a = 0; a < 2; ++a)
#pragma unroll
            for (int b = 0; b < 2; ++b)
#pragma unroll
                for (int m = 0; m < 4; ++m)
#pragma unroll
                    for (int n = 0; n < 2; ++n) acc[a][b][m][n] = (f32x4){0.f, 0.f, 0.f, 0.f};
        cur = nxt; cA = nA; cB = nB; ++ui;
        if constexpr (ALIGN_EPI) { if (wr == 1) PG8_BAR; }
    }
    PG8_WAIT_V(0);
    if constexpr (!ALIGN_EPI) { if (wr == 0) PG8_BAR; }
    PG8_BAR;
#undef PG8_SA
#undef PG8_SB
#undef PG8_STAGE
#undef PG8_LDA
#undef PG8_LDB
#undef PG8_MMA
#undef PG8_WAIT_V
#undef PG8_WAIT_L
#undef PG8_BAR
#undef PG8_SCHED
}
template <class Epi, class Sched>
__device__ __forceinline__ void gemm_fixup(const Epi& E, const float* slab) {
    if constexpr (Sched::S > 1) {
    constexpr int NG = 8 / Sched::S;
    const int tid = threadIdx.x, wid = __builtin_amdgcn_readfirstlane(tid >> 6), lane = tid & 63, wr = wid >> 2, wc = wid & 3, fr = lane & 15, fq = lane >> 4;
    for (int b = blockIdx.x; b < Sched::rem * Sched::S; b += Sched::G) {
        const int r = b % Sched::rem, q = b / Sched::rem;
        const Unit u = Sched::unit_of(Sched::nfull + r, 0, Sched::nt, -1);
        f32x4 v[NG][2][2];
#pragma unroll
        for (int gi = 0; gi < NG; ++gi)
#pragma unroll
            for (int bj = 0; bj < 2; ++bj)
#pragma unroll
                for (int n = 0; n < 2; ++n) v[gi][bj][n] = (f32x4){0.f, 0.f, 0.f, 0.f};
#pragma unroll
        for (int gi = 0; gi < NG; ++gi) { const int g = q * NG + gi, ai = g >> 2, m = g & 3;
#pragma unroll
            for (int p = 0; p < Sched::S; ++p) {
                const bf16_t* sp = (const bf16_t*)slab + (size_t)(r + p * Sched::rem) * 65536 + (size_t)tid * 8;
#pragma unroll
                for (int bj = 0; bj < 2; ++bj) { const u32x4 w = *(const u32x4*)(sp + (size_t)(((ai * 2 + bj) * 4 + m) * 4096));
                    v[gi][bj][0] += (f32x4){__builtin_bit_cast(float, w.x << 16), __builtin_bit_cast(float, w.x & 0xffff0000u), __builtin_bit_cast(float, w.y << 16), __builtin_bit_cast(float, w.y & 0xffff0000u)};
                    v[gi][bj][1] += (f32x4){__builtin_bit_cast(float, w.z << 16), __builtin_bit_cast(float, w.z & 0xffff0000u), __builtin_bit_cast(float, w.w << 16), __builtin_bit_cast(float, w.w & 0xffff0000u)}; } } }
        const auto cx = E.begin(u, wr, wc, fr, fq);
#pragma unroll
        for (int gi = 0; gi < NG; ++gi) { const int g = q * NG + gi; E.rows(cx, v[gi], u, g >> 2, g & 3, wr, wc, fr, fq); }
    }
    }
}
}

constexpr int DM = 2048, NTOK = 12288, NCTX = 4096, DFF = 5632, NFF2 = 11264;
constexpr int IN_EVEN = 4160, IN_EVEN_P = 4096, IN_ODD = 3072;
constexpr int NMOD = 18432;
constexpr float EPS = 1e-6f;
constexpr float LOG2E = 1.4426950408889634f;

constexpr size_t O_X = 0, O_CKV = 25165824, O_KROPE = 27262976, O_NAK = 27525120, O_NAV = 31719424, O_GK = 35913728, O_GV = 38010880, O_END = 40108032;

constexpr size_t MiB = 1u << 20;
constexpr size_t WS_CTL = 0;
constexpr size_t WS_MODS = 2 * MiB;
constexpr size_t CTL_ZERO_BYTES = 4 * MiB;
constexpr size_t WS_WFI = 4 * MiB;
constexpr size_t WS_WFO = WS_WFI + 176 * MiB;
constexpr size_t WS_WEI = WS_WFO + 88 * MiB;
constexpr size_t WS_WQU = WS_WEI + 17 * MiB;
constexpr size_t WS_WKU = WS_WQU + 2 * MiB;
constexpr size_t WS_WEO = WS_WKU + 2 * MiB;
constexpr size_t WS_WOI = WS_WEO + 8 * MiB;
constexpr size_t WS_WOO = WS_WOI + 12 * MiB;
constexpr size_t WS_H = WS_WOO + 8 * MiB;
constexpr size_t WS_ACT = WS_H + 48 * MiB;
constexpr size_t WS_P = WS_ACT + 132 * MiB;
constexpr size_t WS_QM = WS_P + 204 * MiB;
constexpr size_t WS_CQN = WS_QM + 72 * MiB;
constexpr size_t WS_CKVA = WS_CQN + 12 * MiB;
constexpr size_t WS_QA = WS_CKVA + 16 * MiB;
constexpr size_t WS_QNA = WS_QA + 48 * MiB;
constexpr size_t WS_KM_CTX = WS_QNA + 24 * MiB;
constexpr size_t WS_KM_LAT = WS_KM_CTX + 12 * MiB;
constexpr size_t WS_KM_CAC = WS_KM_LAT + 24 * MiB;
constexpr size_t WS_VM_CTX = WS_KM_CAC + 12 * MiB;
constexpr size_t WS_VM_LAT = WS_VM_CTX + 8 * MiB;
constexpr size_t WS_VM_CAC = WS_VM_LAT + 16 * MiB;
constexpr size_t WS_KN_CTX = WS_VM_CAC + 8 * MiB;
constexpr size_t WS_KN_LAT = WS_KN_CTX + 8 * MiB;
constexpr size_t WS_KN_CAC = WS_KN_LAT + 16 * MiB;
constexpr size_t WS_VN_CTX = WS_KN_CAC + 8 * MiB;
constexpr size_t WS_VN_LAT = WS_VN_CTX + 8 * MiB;
constexpr size_t WS_VN_CAC = WS_VN_LAT + 16 * MiB;
constexpr size_t WS_KG_CTX = WS_VN_CAC + 8 * MiB;
constexpr size_t WS_KG_LAT = WS_KG_CTX + 4 * MiB;
constexpr size_t WS_KG_CAC = WS_KG_LAT + 8 * MiB;
constexpr size_t WS_VG_CTX = WS_KG_CAC + 4 * MiB;
constexpr size_t WS_VG_LAT = WS_VG_CTX + 4 * MiB;
constexpr size_t WS_VG_CAC = WS_VG_LAT + 8 * MiB;
constexpr size_t WS_O = WS_VG_CAC + 4 * MiB;
constexpr size_t WS_KROPE = WS_O + 48 * MiB;
constexpr size_t WS_END = WS_KROPE + 4 * MiB;
constexpr int CW_BAR = 4096;

constexpr int RING_BYTES = 131072;
constexpr int LDSCTL_OFF = RING_BYTES;
constexpr int LDS_BYTES = 147456;

__device__ __forceinline__ unsigned f2bf(float f) { unsigned u = __builtin_bit_cast(unsigned, f); return (u + 0x7fffu + ((u >> 16) & 1u)) >> 16; }
__device__ __forceinline__ unsigned pk2(float lo, float hi) { return pg8::cvt_pk_bf16(lo, hi); }
__device__ __forceinline__ float wave_sum(float v) {
#pragma unroll
    for (int o = 1; o < 64; o <<= 1) v += __shfl_xor(v, o);
    return v;
}
__device__ __forceinline__ float fast_exp2(float x) { return __builtin_amdgcn_exp2f(x); }
__device__ __forceinline__ float fast_rcp(float x) { return __builtin_amdgcn_rcpf(x); }
__device__ __forceinline__ float silu_f(float g) { return g * fast_rcp(1.0f + fast_exp2(-g * LOG2E)); }
__device__ __forceinline__ float sin_rev(float rev) { return __builtin_amdgcn_sinf(rev); }
__device__ __forceinline__ float cos_rev(float rev) { return __builtin_amdgcn_cosf(rev); }

#define XB_TMO      128
#define XB_XCNT(j)  (256  + 64 * (j))
#define XB_XSUB(j)  (1280 + 64 * (j))
#define XB_XGEN(j)  (2304 + 64 * (j))
#define XB_TOP      3328
#define XB_TOPGEN   3392
#define XCD_BAR_WORDS 3456
#define XB_SPIN_CAP (1u << 18)
__device__ __forceinline__ unsigned xb_ld(unsigned* p)              { return __hip_atomic_load(p, __ATOMIC_RELAXED, __HIP_MEMORY_SCOPE_AGENT); }
__device__ __forceinline__ unsigned xb_add(unsigned* p, unsigned v) { return __hip_atomic_fetch_add(p, v, __ATOMIC_RELAXED, __HIP_MEMORY_SCOPE_AGENT); }
__device__ __forceinline__ unsigned xb_xcc_id() { return (unsigned)__builtin_amdgcn_s_getreg((3 << 11) | 20) & 0xFu; }
#define XB_SPIN(cond, bar) do { unsigned _sp = 0; while (cond) { __builtin_amdgcn_s_sleep(1); \
    if ((++_sp & 255u) == 0u) { if (xb_ld(&(bar)[XB_TMO])) break; if (_sp > XB_SPIN_CAP) { atomicAdd(&(bar)[XB_TMO], 1u); break; } } } } while (0)
struct XcdBarrier { unsigned* bar; unsigned x; volatile LAS unsigned* st; };
__device__ __forceinline__ XcdBarrier xcd_barrier_post(unsigned* bar, volatile LAS unsigned* st) {
    XcdBarrier b; b.bar = bar; b.x = xb_xcc_id(); b.st = st;
    if (threadIdx.x == 0) (void)xb_add(&bar[XB_XCNT(b.x)], 1u);
    return b;
}
__device__ __forceinline__ void xcd_barrier_complete(unsigned* bar, unsigned x, unsigned& nloc, unsigned& nx) {
    const unsigned G = gridDim.x * gridDim.y * gridDim.z;
    unsigned sum, cnt, mine, sp = 0u;
    for (;;) {
        sum = 0u; cnt = 0u; mine = 0u;
#pragma unroll
        for (unsigned j = 0; j < 16; ++j) { const unsigned c = xb_ld(&bar[XB_XCNT(j)]); sum += c; cnt += (c > 0u) ? 1u : 0u; mine = (j == x) ? c : mine; }
        if (sum == G) break;
        __builtin_amdgcn_s_sleep(1);
        if ((++sp & 255u) == 0u) { if (xb_ld(&bar[XB_TMO])) break; if (sp > XB_SPIN_CAP) { atomicAdd(&bar[XB_TMO], 1u); break; } }
    }
    nloc = mine > 0u ? mine : 1u; nx = cnt > 0u ? cnt : 1u;
}
__device__ __forceinline__ void xcd_barrier(const XcdBarrier& b) {
    asm volatile("s_waitcnt vmcnt(0)" ::: "memory");
    __syncthreads();
    if (threadIdx.x == 0) {
        unsigned* bar = b.bar;
        __builtin_amdgcn_s_waitcnt(0);
        unsigned nloc = b.st[0], nx = b.st[1];
        if (nloc == 0u) { xcd_barrier_complete(bar, b.x, nloc, nx); b.st[0] = nloc; b.st[1] = nx; }
        const unsigned old = xb_add(&bar[XB_XSUB(b.x)], 1u);
        const unsigned gen = old / nloc;
        if (old + 1u == (gen + 1u) * nloc) {
            __builtin_amdgcn_fence(__ATOMIC_RELEASE, "agent");
            asm volatile("s_waitcnt vmcnt(0)" ::: "memory");
            const unsigned og = xb_add(&bar[XB_TOP], 1u);
            const unsigned tg = og / nx;
            if (og + 1u == (tg + 1u) * nx) xb_add(&bar[XB_TOPGEN], 1u);
            else XB_SPIN(xb_ld(&bar[XB_TOPGEN]) == tg, bar);
            __builtin_amdgcn_fence(__ATOMIC_ACQUIRE, "agent");
            xb_add(&bar[XB_XGEN(b.x)], 1u);
            asm volatile("s_waitcnt vmcnt(0)" ::: "memory");
        } else {
            XB_SPIN(xb_ld(&bar[XB_XGEN(b.x)]) == gen, bar);
            __builtin_amdgcn_fence(__ATOMIC_ACQUIRE, "agent");
            asm volatile("s_waitcnt vmcnt(0)" ::: "memory");
        }
    }
    __syncthreads();
}

struct Args { const float* in[28]; float* out; unsigned char* ws; int ph_lo, ph_hi; };
struct Frame {
    LAS unsigned char* lds;
    int tid, lane, wave, G, gw, NGW;
    const Args* a; float* out; unsigned char* ws;
};
#define IN_XP 0
#define IN_XS 1
#define IN_C_CKV 2
#define IN_C_KROPE 3
#define IN_C_NAK 4
#define IN_C_NAV 5
#define IN_C_GK 6
#define IN_C_GV 7
#define IN_C 8
#define IN_CCTX 9
#define IN_ADAW 10
#define IN_ADAB 11
#define IN_NORMG 12
#define IN_FFI 13
#define IN_FFO 14
#define IN_EWI 15
#define IN_EWO 16
#define IN_QNORM 17
#define IN_WQUP 18
#define IN_KVNORM 19
#define IN_WKVUP 20
#define IN_MLAQK 21
#define IN_NAQK 22
#define IN_RPB 23
#define IN_OWI 24
#define IN_OWO 25
#define IN_GQK 26
#define IN_SINK 27

__device__ __forceinline__ int opaque_v(int x) { asm volatile("" : "+v"(x)); return x; }
__device__ __forceinline__ int tok_mb(int t) { return t < NCTX ? 0 : 1 + ((t - NCTX) >> 10); }

__device__ __forceinline__ size_t k_chunk_off(int DQK, int key, int c8) { return (size_t)(key >> 5) * (DQK * 32) + (size_t)(c8 >> 1) * 512 + (((c8 & 1) * 32 + (key & 31)) << 3); }
__device__ __forceinline__ void vt_tile_write_h(const bf16_t* src0, size_t pitch, bf16_t* dst, int lane) {
#pragma unroll
    for (int it = 0; it < 8; ++it) {
        const int d = (it & 1) * 64 + lane, s = (it >> 1) & 1, hh = it >> 2;
        unsigned v[8];
#pragma unroll
        for (int j = 0; j < 8; ++j) { const int key = 16 * s + 8 * (j >> 2) + 4 * hh + (j & 3); v[j] = src0[(size_t)key * pitch + d]; }
        u32x4 w; w.x = v[0] | (v[1] << 16); w.y = v[2] | (v[3] << 16); w.z = v[4] | (v[5] << 16); w.w = v[6] | (v[7] << 16);
        *(u32x4*)(dst + (size_t)(((s * 4 + (d >> 5)) * 64 + hh * 32 + (d & 31)) << 3)) = w;
    }
}
__device__ __forceinline__ void vt_tile_write(const float* src0, size_t pitch, bf16_t* dst, int lane) {
#pragma unroll
    for (int it = 0; it < 8; ++it) {
        const int d = (it & 1) * 64 + lane, s = (it >> 1) & 1, hh = it >> 2;
        float v[8];
#pragma unroll
        for (int j = 0; j < 8; ++j) { const int key = 16 * s + 8 * (j >> 2) + 4 * hh + (j & 3); v[j] = src0[(size_t)key * pitch + d]; }
        u32x4 w; w.x = pk2(v[0], v[1]); w.y = pk2(v[2], v[3]); w.z = pk2(v[4], v[5]); w.w = pk2(v[6], v[7]);
        *(u32x4*)(dst + (size_t)(((s * 4 + (d >> 5)) * 64 + hh * 32 + (d & 31)) << 3)) = w;
    }
}

__device__ __forceinline__ void p0_transpose_item(const float* W, int K, int N, bf16_t* WT, int mode, LAS float* scr, int item, int lane) {
    const int nblk = N / 32, kb = item / nblk, nb = item % nblk, k0 = 64 * kb, n0 = 32 * nb;
#pragma unroll 8
    for (int i = 0; i < 32; ++i) { const int kk = 2 * i + (lane >> 5); scr[kk * 33 + (lane & 31)] = __builtin_nontemporal_load(W + (size_t)(k0 + kk) * N + n0 + (lane & 31)); }
    asm volatile("s_waitcnt lgkmcnt(0)" ::: "memory");
    int d0 = n0;
    if (mode == 1) { const int j0 = n0 < DFF ? n0 : n0 - DFF; d0 = 256 * (j0 >> 7) + (j0 & 127) + (n0 < DFF ? 0 : 128); }
    if (mode == 2) d0 = n0 < 1024 ? n0 : (n0 < 1088 ? 4096 + (n0 - 1024) : n0 - 64);
    const int c = lane & 7;
#pragma unroll
    for (int j = 0; j < 4; ++j) { const int n = (lane >> 3) + 8 * j; const LAS float* s = scr + (8 * c) * 33 + n;
        u32x4 o; o.x = pk2(s[0 * 33], s[1 * 33]); o.y = pk2(s[2 * 33], s[3 * 33]); o.z = pk2(s[4 * 33], s[5 * 33]); o.w = pk2(s[6 * 33], s[7 * 33]);
        *(u32x4*)(WT + (size_t)(d0 + n) * K + k0 + 8 * c) = o; }
    asm volatile("s_waitcnt lgkmcnt(0)" ::: "memory");
}

__device__ __forceinline__ const float* p0_mods_wptr(Frame& F, int item) {
    const int layer = item / 1152, rem = item % 1152, slab = rem >> 4, ks = rem & 15;
    return F.a->in[IN_ADAW] + (size_t)layer * DM * NMOD + (size_t)(ks * 128 + F.wave * 16) * NMOD + slab * 256 + 4 * F.lane;
}
__device__ __forceinline__ void phase_mods(Frame& F) {
    LAS float* stab = (LAS float*)(F.lds);
    LAS float* part = (LAS float*)(F.lds + 8192);
    const float* c = F.a->in[IN_C]; const float* cctx = F.a->in[IN_CCTX];
    for (int item = blockIdx.x; item < 2304; item += F.G) {
        const int layer = item / 1152, rem = item % 1152, slab = rem >> 4, ks = rem & 15, n0 = slab * 256, k0 = ks * 128;
        f32x4 w[16];
        { const float* W = p0_mods_wptr(F, item);
#pragma unroll
          for (int kk = 0; kk < 16; ++kk) w[kk] = __builtin_nontemporal_load((const f32x4*)(W + (size_t)kk * NMOD)); }
        for (int i = F.tid; i < 9 * 128; i += 512) { const int b = i >> 7, k = i & 127; const float v = (b == 0) ? cctx[k0 + k] : c[(size_t)(b - 1) * DM + k0 + k]; stab[i] = silu_f(v); }
        __syncthreads();
        f32x4 acc[9];
#pragma unroll
        for (int b = 0; b < 9; ++b) acc[b] = (f32x4){0.f, 0.f, 0.f, 0.f};
#pragma unroll
        for (int kk = 0; kk < 16; ++kk) {
#pragma unroll
            for (int b = 0; b < 9; ++b) { const float sv = stab[b * 128 + F.wave * 16 + kk]; acc[b] += w[kk] * sv; }
        }
#pragma unroll
        for (int b = 0; b < 9; ++b) *(LAS f32x4*)(part + (F.wave * 9 + b) * 256 + 4 * F.lane) = acc[b];
        __syncthreads();
        float* mods = (float*)(F.ws + WS_MODS) + (size_t)layer * 9 * NMOD;
        const float* bias = F.a->in[IN_ADAB] + (size_t)layer * NMOD;
        for (int i = F.tid; i < 9 * 256; i += 512) { const int b = i >> 8, col = i & 255; float sm = 0.f;
#pragma unroll
            for (int ww = 0; ww < 8; ++ww) sm += part[(ww * 9 + b) * 256 + col];
            if (ks == 0) sm += bias[n0 + col];
            atomicAdd(mods + (size_t)b * NMOD + n0 + col, sm); }
        __syncthreads();
    }
}

__device__ __forceinline__ void p0_cacheK_item(const float* src, int H, bf16_t* dstbase, int item, int lane) {
    const int t32 = item & 15, bh = item >> 4, b = bh / H, h = bh % H;
    bf16_t* dst = dstbase + (size_t)bh * (512 * 128);
#pragma unroll
    for (int it = 0; it < 8; ++it) { const int idx = it * 64 + lane, kl = idx >> 4, c8 = idx & 15, key = t32 * 32 + kl;
        const float* s = src + ((size_t)(b * 512 + key) * H + h) * 128 + c8 * 8;
        const f32x4 a = *(const f32x4*)s, bb = *(const f32x4*)(s + 4);
        u32x4 w; w.x = pk2(a[0], a[1]); w.y = pk2(a[2], a[3]); w.z = pk2(bb[0], bb[1]); w.w = pk2(bb[2], bb[3]);
        *(u32x4*)(dst + k_chunk_off(128, key, c8)) = w; }
}
__device__ __forceinline__ void p0_cacheV_item(const float* src, int H, bf16_t* dstbase, int item, int lane) {
    const int t32 = item & 15, bh = item >> 4, b = bh / H, h = bh % H;
    vt_tile_write(src + ((size_t)(b * 512 + t32 * 32) * H + h) * 128, (size_t)H * 128, dstbase + (size_t)bh * (512 * 128) + (size_t)t32 * 4096, lane);
}

__device__ __forceinline__ void phase_prologue(Frame& F) {
    phase_mods(F);
    LAS float* scr = (LAS float*)(F.lds + F.wave * 16384);
    constexpr int I_FI = 32 * 352, I_FO = 88 * 64, I_EI = 32 * 130, I_QU = 8 * 48, I_KU = 8 * 64, I_EO = 32 * 64, I_OI = 32 * 96, I_OO = 32 * 64;
    constexpr int I_PAD = 0, I_CKV = 1024, I_NK = 1024, I_NV = 1024, I_GK = 512, I_GV = 512;
    constexpr int NITEMS = 4 * I_FI + 4 * I_FO + I_EI + I_QU + I_KU + I_EO + I_OI + I_OO + I_PAD + I_CKV + I_NK + I_NV + I_GK + I_GV;
    unsigned char* ws = F.ws;
    for (int it = F.gw; it < NITEMS; it += F.NGW) {
        int r = it;
        if (r < 4 * I_FI) { const int m = r / I_FI; p0_transpose_item(F.a->in[IN_FFI] + (size_t)m * DM * NFF2, DM, NFF2, (bf16_t*)(ws + WS_WFI) + (size_t)m * NFF2 * DM, 1, scr, r % I_FI, F.lane); continue; } r -= 4 * I_FI;
        if (r < 4 * I_FO) { const int m = r / I_FO; p0_transpose_item(F.a->in[IN_FFO] + (size_t)m * DFF * DM, DFF, DM, (bf16_t*)(ws + WS_WFO) + (size_t)m * DM * DFF, 0, scr, r % I_FO, F.lane); continue; } r -= 4 * I_FO;
        if (r < I_EI) { p0_transpose_item(F.a->in[IN_EWI], DM, IN_EVEN, (bf16_t*)(ws + WS_WEI), 2, scr, r, F.lane); continue; } r -= I_EI;
        if (r < I_QU) { p0_transpose_item(F.a->in[IN_WQUP], 512, 1536, (bf16_t*)(ws + WS_WQU), 0, scr, r, F.lane); continue; } r -= I_QU;
        if (r < I_KU) { p0_transpose_item(F.a->in[IN_WKVUP], 512, 2048, (bf16_t*)(ws + WS_WKU), 0, scr, r, F.lane); continue; } r -= I_KU;
        if (r < I_EO) { p0_transpose_item(F.a->in[IN_EWO], DM, DM, (bf16_t*)(ws + WS_WEO), 0, scr, r, F.lane); continue; } r -= I_EO;
        if (r < I_OI) { p0_transpose_item(F.a->in[IN_OWI], DM, IN_ODD, (bf16_t*)(ws + WS_WOI), 0, scr, r, F.lane); continue; } r -= I_OI;
        if (r < I_OO) { p0_transpose_item(F.a->in[IN_OWO], DM, DM, (bf16_t*)(ws + WS_WOO), 0, scr, r, F.lane); continue; } r -= I_OO;
        if (r < I_PAD) { u32x4* p = (u32x4*)((bf16_t*)(ws + WS_WEI) + (size_t)(IN_EVEN + r) * DM); const u32x4 z = {0u, 0u, 0u, 0u};
#pragma unroll
            for (int j = 0; j < 4; ++j) p[j * 64 + F.lane] = z; continue; } r -= I_PAD;
        if (r < I_CKV) {
#pragma unroll
            for (int j = 0; j < 4; ++j) { const int row = 4 * r + j; const float* s = F.a->in[IN_C_CKV] + (size_t)row * 512 + 8 * F.lane;
                const f32x4 a = *(const f32x4*)s, b = *(const f32x4*)(s + 4);
                u32x4 w; w.x = pk2(a[0], a[1]); w.y = pk2(a[2], a[3]); w.z = pk2(b[0], b[1]); w.w = pk2(b[2], b[3]);
                *(u32x4*)((bf16_t*)(ws + WS_CKVA) + (size_t)(NTOK + row) * 512 + 8 * F.lane) = w; }
            continue; } r -= I_CKV;
        if (r < I_NK) { p0_cacheK_item(F.a->in[IN_C_NAK], 8, (bf16_t*)(ws + WS_KN_CAC), r, F.lane); continue; } r -= I_NK;
        if (r < I_NV) { p0_cacheV_item(F.a->in[IN_C_NAV], 8, (bf16_t*)(ws + WS_VN_CAC), r, F.lane); continue; } r -= I_NV;
        if (r < I_GK) { p0_cacheK_item(F.a->in[IN_C_GK], 4, (bf16_t*)(ws + WS_KG_CAC), r, F.lane); continue; } r -= I_GK;
        p0_cacheV_item(F.a->in[IN_C_GV], 4, (bf16_t*)(ws + WS_VG_CAC), r, F.lane);
    }
}

__device__ __forceinline__ const float* x_in_row(Frame& F, int t) { return t < NCTX ? F.a->in[IN_XP] + (size_t)t * DM : F.a->in[IN_XS] + (size_t)(t - NCTX) * DM; }
__device__ __forceinline__ void phase_norm(Frame& F, bool from_input, int layer, int sub) {
    const float* g = F.a->in[IN_NORMG] + (size_t)(layer * 3 + sub) * DM;
    bf16_t* H = (bf16_t*)(F.ws + WS_H);
    const int lane = opaque_v(F.lane);
    for (int t = F.gw; t < NTOK; t += F.NGW) {
        const float* xr = from_input ? x_in_row(F, t) : F.out + (size_t)t * DM;
        const float* md = (const float*)(F.ws + WS_MODS) + ((size_t)layer * 9 + tok_mb(t)) * NMOD + (size_t)(3 * sub) * DM;
        f32x4 v[8]; float ss = 0.f;
#pragma unroll
        for (int j = 0; j < 8; ++j) { v[j] = *(const f32x4*)(xr + 256 * j + 4 * lane); ss += (v[j][0] * v[j][0] + v[j][1] * v[j][1]) + (v[j][2] * v[j][2] + v[j][3] * v[j][3]); }
        const float rstd = __builtin_amdgcn_rsqf(wave_sum(ss) * (1.0f / DM) + EPS);
#pragma unroll
        for (int j = 0; j < 8; ++j) { const int c = 256 * j + 4 * lane;
            const f32x4 gg = *(const f32x4*)(g + c), sh = *(const f32x4*)(md + c), sc = *(const f32x4*)(md + DM + c);
            const f32x4 y = (v[j] * rstd * gg) * (sc + 1.0f) + sh;
            u32x2 w; w.x = pk2(y[0], y[1]); w.y = pk2(y[2], y[3]);
            *(u32x2*)(H + (size_t)t * DM + c) = w; }
    }
}

struct EpiSwiGLU {
    static constexpr bool PERM = true;
    bf16_t* O;
    struct Ctx { int row0, col0; };
    __device__ __forceinline__ Ctx begin(const pg8::Unit& u, int wr, int wc, int fr, int fq) const { return Ctx{u.pm * 256 + wr * 64 + fr, u.pn * 128 + wc * 32 + 8 * fq}; }
    __device__ __forceinline__ void rows(const Ctx& c, const f32x4 (&v)[2][2], const pg8::Unit&, int ai, int m, int, int, int, int) const {
        float r[8];
#pragma unroll
        for (int n = 0; n < 2; ++n)
#pragma unroll
            for (int j = 0; j < 4; ++j) r[4 * n + j] = silu_f(v[0][n][j]) * v[1][n][j];
        u32x4 w; w.x = pk2(r[0], r[1]); w.y = pk2(r[2], r[3]); w.z = pk2(r[4], r[5]); w.w = pk2(r[6], r[7]);
        *(u32x4*)(O + (size_t)(c.row0 + ai * 128 + m * 16) * DFF + c.col0) = w;
    }
};
struct EpiResid {
    static constexpr bool PERM = false;
    const float* xp; const float* xs; bool from_input; float* out; const float* gate_base; float coef;
    struct Ctx { const float* xin; f32x4 gv[2][2]; int row0, col0; };
    __device__ __forceinline__ Ctx begin(const pg8::Unit& u, int wr, int wc, int fr, int fq) const {
        Ctx c; const int rowt = u.pm * 256; c.row0 = rowt + wr * 64 + fr; c.col0 = u.pn * 256 + wc * 32 + 4 * fq;
        const float* gt = gate_base + (size_t)tok_mb(rowt) * NMOD;
        c.xin = from_input ? (rowt < NCTX ? xp : xs - (size_t)NCTX * DM) : out;
#pragma unroll
        for (int bj = 0; bj < 2; ++bj)
#pragma unroll
            for (int n = 0; n < 2; ++n) c.gv[bj][n] = *(const f32x4*)(gt + c.col0 + bj * 128 + n * 16) * coef;
        return c;
    }
    __device__ __forceinline__ void rows(const Ctx& c, const f32x4 (&v)[2][2], const pg8::Unit&, int ai, int m, int, int, int, int) const {
        const size_t off = (size_t)(c.row0 + ai * 128 + m * 16) * DM + c.col0;
#pragma unroll
        for (int bj = 0; bj < 2; ++bj)
#pragma unroll
            for (int n = 0; n < 2; ++n) { const f32x4 xv = *(const f32x4*)(c.xin + off + bj * 128 + n * 16);
                *(f32x4*)(out + off + bj * 128 + n * 16) = xv + c.gv[bj][n] * v[bj][n]; }
        asm volatile("" ::: "memory");
    }
};
struct EpiBf16 {
    static constexpr bool PERM = true;
    bf16_t* C; int ldc;
    struct Ctx { int row0, col0; };
    __device__ __forceinline__ Ctx begin(const pg8::Unit& u, int wr, int wc, int fr, int fq) const { return Ctx{u.pm * 256 + wr * 64 + fr, u.pn * 256 + wc * 32 + 8 * fq}; }
    __device__ __forceinline__ void rows(const Ctx& c, const f32x4 (&v)[2][2], const pg8::Unit&, int ai, int m, int, int, int, int) const {
        bf16_t* rowp = C + (size_t)(c.row0 + ai * 128 + m * 16) * ldc + c.col0;
#pragma unroll
        for (int bj = 0; bj < 2; ++bj) { u32x4 w; w.x = pk2(v[bj][0][0], v[bj][0][1]); w.y = pk2(v[bj][0][2], v[bj][0][3]); w.z = pk2(v[bj][1][0], v[bj][1][1]); w.w = pk2(v[bj][1][2], v[bj][1][3]);
            *(u32x4*)(rowp + bj * 128) = w; }
    }
};
struct EpiF32 {
    static constexpr bool PERM = false;
    float* C; int ldc;
    struct Ctx { int row0, col0; };
    __device__ __forceinline__ Ctx begin(const pg8::Unit& u, int wr, int wc, int fr, int fq) const { return Ctx{u.pm * 256 + wr * 64 + fr, u.pn * 256 + wc * 32 + 4 * fq}; }
    __device__ __forceinline__ void rows(const Ctx& c, const f32x4 (&v)[2][2], const pg8::Unit&, int ai, int m, int, int, int, int) const {
        float* rowp = C + (size_t)(c.row0 + ai * 128 + m * 16) * ldc + c.col0;
#pragma unroll
        for (int bj = 0; bj < 2; ++bj)
#pragma unroll
            for (int n = 0; n < 2; ++n) *(f32x4*)(rowp + bj * 128 + n * 16) = v[bj][n];
    }
};

__device__ __forceinline__ void load8(const float* p, float (&v)[8]) { const f32x4 a = *(const f32x4*)p, b = *(const f32x4*)(p + 4); v[0] = a[0]; v[1] = a[1]; v[2] = a[2]; v[3] = a[3]; v[4] = b[0]; v[5] = b[1]; v[6] = b[2]; v[7] = b[3]; }
__device__ __forceinline__ void load8h(const bf16_t* p, float (&v)[8]) { const u32x4 w = *(const u32x4*)p;
    v[0] = __builtin_bit_cast(float, w.x << 16); v[1] = __builtin_bit_cast(float, w.x & 0xffff0000u); v[2] = __builtin_bit_cast(float, w.y << 16); v[3] = __builtin_bit_cast(float, w.y & 0xffff0000u);
    v[4] = __builtin_bit_cast(float, w.z << 16); v[5] = __builtin_bit_cast(float, w.z & 0xffff0000u); v[6] = __builtin_bit_cast(float, w.w << 16); v[7] = __builtin_bit_cast(float, w.w & 0xffff0000u); }
__device__ __forceinline__ u32x4 pack8(const float (&v)[8]) { u32x4 w; w.x = pk2(v[0], v[1]); w.y = pk2(v[2], v[3]); w.z = pk2(v[4], v[5]); w.w = pk2(v[6], v[7]); return w; }
__device__ __forceinline__ void store8f(float* p, const float (&v)[8]) { *(f32x4*)p = (f32x4){v[0], v[1], v[2], v[3]}; *(f32x4*)(p + 4) = (f32x4){v[4], v[5], v[6], v[7]}; }
template <int W> __device__ __forceinline__ float group_sum(float v) {
#pragma unroll
    for (int o = 1; o < W; o <<= 1) v += __shfl_xor(v, o);
    return v;
}

__device__ __forceinline__ void phase_post1_even(Frame& F) {
    const bf16_t* P = (const bf16_t*)(F.ws + WS_P);
    const float* qn_g = F.a->in[IN_QNORM]; const float* kvn_g = F.a->in[IN_KVNORM]; const float* naq_g = F.a->in[IN_NAQK]; const float* nak_g = F.a->in[IN_NAQK] + 128;
    bf16_t* CQN = (bf16_t*)(F.ws + WS_CQN); bf16_t* CKVA = (bf16_t*)(F.ws + WS_CKVA); bf16_t* QNA = (bf16_t*)(F.ws + WS_QNA);
    constexpr int NVT_CTX = 16 * 8 * 8, NVT_LAT = 8 * 8 * 32, NKR = NTOK / 16;
    for (int it = F.gw; it < NKR; it += F.NGW) {
        const int t0 = it * 16, lane = F.lane, lr = lane & 15, lq = lane >> 4;
        const bf16_t* ap = (const bf16_t*)(F.ws + WS_H) + (size_t)(t0 + lr) * DM + 8 * lq;
        const bf16_t* bp = (const bf16_t*)(F.ws + WS_WEI) + (size_t)(4096 + lr) * DM + 8 * lq;
        f32x4 acc[4];
#pragma unroll
        for (int j = 0; j < 4; ++j) acc[j] = (f32x4){0.f, 0.f, 0.f, 0.f};
#pragma unroll 8
        for (int kk = 0; kk < 64; ++kk) {
            const bf16x8 af = *(const bf16x8*)(ap + kk * 32);
#pragma unroll
            for (int j = 0; j < 4; ++j) { const bf16x8 bf = *(const bf16x8*)(bp + (size_t)j * 16 * DM + kk * 32); acc[j] = __builtin_amdgcn_mfma_f32_16x16x32_bf16(af, bf, acc[j], 0, 0, 0); }
        }
        float* kr = (float*)(F.ws + WS_KROPE);
#pragma unroll
        for (int j = 0; j < 4; ++j)
#pragma unroll
            for (int r = 0; r < 4; ++r) { const int t = t0 + 4 * lq + r, c = 16 * j + lr; kr[(size_t)t * 64 + c] = acc[j][r]; if (t < NCTX) F.out[O_KROPE + (size_t)t * 64 + c] = acc[j][r]; }
    }
    for (int it = F.gw; it < NTOK + NVT_CTX + NVT_LAT; it += F.NGW) {
        if (it < NTOK) {
            const int t = it, lane = F.lane; const bf16_t* pr = P + (size_t)t * IN_EVEN_P; const bool ctx = t < NCTX;
            float v[8], g[8];
            load8h(pr + 8 * lane, v); float ss = 0.f;
#pragma unroll
            for (int i = 0; i < 8; ++i) ss += v[i] * v[i];
            float rstd = __builtin_amdgcn_rsqf(wave_sum(ss) * (1.0f / 512) + EPS);
            load8(qn_g + 8 * lane, g);
#pragma unroll
            for (int i = 0; i < 8; ++i) v[i] = v[i] * rstd * g[i];
            *(u32x4*)(CQN + (size_t)t * 512 + 8 * lane) = pack8(v);
            load8h(pr + 512 + 8 * lane, v); ss = 0.f;
#pragma unroll
            for (int i = 0; i < 8; ++i) ss += v[i] * v[i];
            rstd = __builtin_amdgcn_rsqf(wave_sum(ss) * (1.0f / 512) + EPS);
            load8(kvn_g + 8 * lane, g);
#pragma unroll
            for (int i = 0; i < 8; ++i) v[i] = v[i] * rstd * g[i];
            if (ctx) store8f(F.out + O_CKV + (size_t)t * 512 + 8 * lane, v);
            *(u32x4*)(CKVA + (size_t)t * 512 + 8 * lane) = pack8(v);
            const int head = lane >> 3, d0 = (lane & 7) * 16;
            int b, s; if (ctx) { b = t >> 8; s = t & 255; } else { b = (t - NCTX) >> 10; s = (t - NCTX) & 1023; }
#pragma unroll
            for (int which = 0; which < 2; ++which) {
                const bf16_t* src = pr + 1024 + which * 1024 + head * 128 + d0; const float* gg = which ? nak_g : naq_g;
                float a[8], c[8], ga[8], gc[8]; load8h(src, a); load8h(src + 8, c); load8(gg + d0, ga); load8(gg + d0 + 8, gc);
                float q = 0.f;
#pragma unroll
                for (int i = 0; i < 8; ++i) q += a[i] * a[i] + c[i] * c[i];
                const float r2 = __builtin_amdgcn_rsqf(group_sum<8>(q) * (1.0f / 128) + EPS);
#pragma unroll
                for (int i = 0; i < 8; ++i) { a[i] = a[i] * r2 * ga[i]; c[i] = c[i] * r2 * gc[i]; }
                if (which == 0) { bf16_t* qd = QNA + (size_t)t * 1024 + head * 128 + d0; *(u32x4*)qd = pack8(a); *(u32x4*)(qd + 8) = pack8(c); }
                else {
                    if (ctx) { float* od = F.out + O_NAK + (size_t)t * 1024 + head * 128 + d0; store8f(od, a); store8f(od + 8, c); }
                    bf16_t* kb = ctx ? (bf16_t*)(F.ws + WS_KN_CTX) + (size_t)(b * 8 + head) * (256 * 128) : (bf16_t*)(F.ws + WS_KN_LAT) + (size_t)(b * 8 + head) * (1024 * 128);
                    *(u32x4*)(kb + k_chunk_off(128, s, d0 >> 3)) = pack8(a); *(u32x4*)(kb + k_chunk_off(128, s, (d0 >> 3) + 1)) = pack8(c);
                }
            }
            { const bf16_t* src = pr + 3072 + 16 * lane; float a[8], c[8]; load8h(src, a); load8h(src + 8, c); if (ctx) { float* od = F.out + O_NAV + (size_t)t * 1024 + 16 * lane; store8f(od, a); store8f(od + 8, c); } }
        } else {
            int r = it - NTOK;
            if (r < NVT_CTX) { const int t32 = r & 7, bh = r >> 3, b = bh >> 3, h = bh & 7;
                vt_tile_write_h(P + (size_t)(b * 256 + t32 * 32) * IN_EVEN_P + 3072 + h * 128, IN_EVEN_P, (bf16_t*)(F.ws + WS_VN_CTX) + (size_t)bh * (256 * 128) + (size_t)t32 * 4096, F.lane);
            } else { r -= NVT_CTX; const int t32 = r & 31, bh = r >> 5, b = bh >> 3, h = bh & 7;
                vt_tile_write_h(P + (size_t)(NCTX + b * 1024 + t32 * 32) * IN_EVEN_P + 3072 + h * 128, IN_EVEN_P, (bf16_t*)(F.ws + WS_VN_LAT) + (size_t)bh * (1024 * 128) + (size_t)t32 * 4096, F.lane);
            }
        }
    }
}

__device__ __forceinline__ void rope8(float (&v)[8], const float (&vp)[8], bool is_x1, float pos, int f0, float inv_nf) {
#pragma unroll
    for (int i = 0; i < 8; ++i) {
        const float invf = fast_exp2(-(float)(f0 + i) * inv_nf * 13.287712379549449f);
        const float rev = pos * invf * 0.15915494309189535f;
        const float cs = cos_rev(rev), sn = sin_rev(rev);
        v[i] = is_x1 ? (v[i] * cs - vp[i] * sn) : (vp[i] * sn + v[i] * cs);
    }
}

__device__ __forceinline__ void phase_post2_even(Frame& F) {
    const bf16_t* P = (const bf16_t*)(F.ws + WS_P); const bf16_t* QM = (const bf16_t*)(F.ws + WS_QM); const bf16_t* KVM = (const bf16_t*)(F.ws + WS_ACT);
    const float* gq = F.a->in[IN_MLAQK]; const float* gk = F.a->in[IN_MLAQK] + 192;
    bf16_t* QA = (bf16_t*)(F.ws + WS_QA);
    constexpr int NROW = 16384, NVT_CTX = 1024, NVT_LAT = 2048, NVT_CAC = 1024;
    const int lane = F.lane, hsub = lane >> 5, c = lane & 31; const bool act = c < 24;
    for (int it = F.gw; it < NTOK + NROW + NVT_CTX + NVT_LAT + NVT_CAC; it += F.NGW) {
        if (it < NTOK) {
            const int t = it; const bool lat = t >= NCTX; const int s = (t - NCTX) & 1023; const float row = (float)(s >> 6), col = (float)(s & 63);
            const int cc = act ? c : 23, cpq = cc >= 16 ? (cc ^ 2) : cc;
            float g[8], gp[8]; load8(gq + 8 * cc, g); load8(gq + 8 * cpq, gp);
            float v[4][8], vp[4][8];
#pragma unroll
            for (int pass = 0; pass < 4; ++pass) { const bf16_t* src = QM + (size_t)t * 1536 + (2 * pass + hsub) * 192; load8h(src + 8 * cc, v[pass]); load8h(src + 8 * cpq, vp[pass]); }
#pragma unroll
            for (int pass = 0; pass < 4; ++pass) {
                const int head = 2 * pass + hsub;
                float q = 0.f;
#pragma unroll
                for (int i = 0; i < 8; ++i) { v[pass][i] = act ? v[pass][i] : 0.f; q += v[pass][i] * v[pass][i]; }
                const float rstd = __builtin_amdgcn_rsqf(group_sum<32>(q) * (1.0f / 192) + EPS);
#pragma unroll
                for (int i = 0; i < 8; ++i) { v[pass][i] = v[pass][i] * rstd * g[i]; vp[pass][i] = vp[pass][i] * rstd * gp[i]; }
                if (lat && c >= 16 && act) rope8(v[pass], vp[pass], (c & 2) == 0, c < 20 ? row : col, (c & 1) * 8, 1.0f / 16);
                if (act) *(u32x4*)(QA + (size_t)t * 1536 + head * 192 + 8 * c) = pack8(v[pass]);
            }
        } else if (it < NTOK + NROW) {
            const int r = it - NTOK; const bool istok = r < NTOK; const bool lat = istok && r >= NCTX;
            int bsel, s; bf16_t* kb0; int nkeys;
            if (!istok) { bsel = (r - NTOK) >> 9; s = (r - NTOK) & 511; kb0 = (bf16_t*)(F.ws + WS_KM_CAC); nkeys = 512; }
            else if (lat) { bsel = (r - NCTX) >> 10; s = (r - NCTX) & 1023; kb0 = (bf16_t*)(F.ws + WS_KM_LAT); nkeys = 1024; }
            else { bsel = r >> 8; s = r & 255; kb0 = (bf16_t*)(F.ws + WS_KM_CTX); nkeys = 256; }
            const float* krp_f = istok ? (const float*)(F.ws + WS_KROPE) + (size_t)r * 64 : F.a->in[IN_C_KROPE] + (size_t)(r - NTOK) * 64;
            const float row = (float)(s >> 6), col = (float)(s & 63);
            const int cc = act ? c : 23, cpq = cc >= 16 ? (cc ^ 2) : cc, cn = c < 16 ? c : 15, cr = cc >= 16 ? cc - 16 : 0, crp = cc >= 16 ? cpq - 16 : 0;
            float g[8], gp[8], kr[8], krp[8]; load8(gk + 8 * cc, g); load8(gk + 8 * cpq, gp); load8(krp_f + 8 * cr, kr); load8(krp_f + 8 * crp, krp);
            float v[4][8];
#pragma unroll
            for (int pass = 0; pass < 4; ++pass) load8h(KVM + (size_t)r * 2048 + (2 * pass + hsub) * 256 + 8 * cn, v[pass]);
#pragma unroll
            for (int pass = 0; pass < 4; ++pass) {
                const int head = 2 * pass + hsub;
                float vp[8]; float q = 0.f;
#pragma unroll
                for (int i = 0; i < 8; ++i) { v[pass][i] = c < 16 ? v[pass][i] : (act ? kr[i] : 0.f); q += v[pass][i] * v[pass][i]; }
                const float rstd = __builtin_amdgcn_rsqf(group_sum<32>(q) * (1.0f / 192) + EPS);
#pragma unroll
                for (int i = 0; i < 8; ++i) { v[pass][i] = v[pass][i] * rstd * g[i]; vp[i] = krp[i] * rstd * gp[i]; }
                if (lat && c >= 16 && act) rope8(v[pass], vp, (c & 2) == 0, c < 20 ? row : col, (c & 1) * 8, 1.0f / 16);
                if (act) *(u32x4*)(kb0 + (size_t)(bsel * 8 + head) * ((size_t)nkeys * 192) + k_chunk_off(192, s, c)) = pack8(v[pass]);
            }
        } else {
            int r = it - NTOK - NROW;
            if (r < NVT_CTX) { const int t32 = r & 7, bh = r >> 3, b = bh >> 3, h = bh & 7;
                vt_tile_write_h(KVM + (size_t)(b * 256 + t32 * 32) * 2048 + h * 256 + 128, 2048, (bf16_t*)(F.ws + WS_VM_CTX) + (size_t)bh * (256 * 128) + (size_t)t32 * 4096, lane);
            } else if (r < NVT_CTX + NVT_LAT) { r -= NVT_CTX; const int t32 = r & 31, bh = r >> 5, b = bh >> 3, h = bh & 7;
                vt_tile_write_h(KVM + (size_t)(NCTX + b * 1024 + t32 * 32) * 2048 + h * 256 + 128, 2048, (bf16_t*)(F.ws + WS_VM_LAT) + (size_t)bh * (1024 * 128) + (size_t)t32 * 4096, lane);
            } else { r -= NVT_CTX + NVT_LAT; const int t32 = r & 15, bh = r >> 4, b = bh >> 3, h = bh & 7;
                vt_tile_write_h(KVM + (size_t)(NTOK + b * 512 + t32 * 32) * 2048 + h * 256 + 128, 2048, (bf16_t*)(F.ws + WS_VM_CAC) + (size_t)bh * (512 * 128) + (size_t)t32 * 4096, lane);
            }
        }
    }
}

__device__ __forceinline__ void phase_post_odd(Frame& F) {
    const bf16_t* P = (const bf16_t*)(F.ws + WS_P); const float* gq = F.a->in[IN_GQK]; const float* gk = F.a->in[IN_GQK] + 128;
    bf16_t* QA = (bf16_t*)(F.ws + WS_QA);
    constexpr int NVT_CTX = 16 * 4 * 8, NVT_LAT = 8 * 4 * 32;
    const int lane = F.lane, hsub = lane >> 4, c = lane & 15;
    for (int it = F.gw; it < NTOK + NVT_CTX + NVT_LAT; it += F.NGW) {
        if (it < NTOK) {
            const int t = it; const bool ctx = t < NCTX, lat = !ctx; const bf16_t* pr = P + (size_t)t * IN_ODD;
            int b, s; if (ctx) { b = t >> 8; s = t & 255; } else { b = (t - NCTX) >> 10; s = (t - NCTX) & 1023; }
            const float row = (float)(s >> 6), col = (float)(s & 63);
            const int cp = c ^ 4;
            float gqv[8], gqp[8], gkv[8], gkp[8]; load8(gq + 8 * c, gqv); load8(gq + 8 * cp, gqp); load8(gk + 8 * c, gkv); load8(gk + 8 * cp, gkp);
            float v[5][8], vp[5][8];
#pragma unroll
            for (int pass = 0; pass < 5; ++pass) { const bf16_t* src = pr + (pass == 4 ? 2048 + hsub * 128 : (4 * pass + hsub) * 128); load8h(src + 8 * c, v[pass]); load8h(src + 8 * cp, vp[pass]); }
#pragma unroll
            for (int pass = 0; pass < 5; ++pass) {
                const bool isk = pass == 4; const int head = isk ? hsub : 4 * pass + hsub;
                float q = 0.f;
#pragma unroll
                for (int i = 0; i < 8; ++i) q += v[pass][i] * v[pass][i];
                const float rstd = __builtin_amdgcn_rsqf(group_sum<16>(q) * (1.0f / 128) + EPS);
#pragma unroll
                for (int i = 0; i < 8; ++i) { v[pass][i] = v[pass][i] * rstd * (isk ? gkv[i] : gqv[i]); vp[pass][i] = vp[pass][i] * rstd * (isk ? gkp[i] : gqp[i]); }
                if (isk && ctx) store8f(F.out + O_GK + (size_t)t * 512 + head * 128 + 8 * c, v[pass]);
                if (lat) rope8(v[pass], vp[pass], (c & 4) == 0, c < 8 ? row : col, (c & 3) * 8, 1.0f / 32);
                if (!isk) *(u32x4*)(QA + (size_t)t * 2048 + head * 128 + 8 * c) = pack8(v[pass]);
                else { bf16_t* kb = ctx ? (bf16_t*)(F.ws + WS_KG_CTX) + (size_t)(b * 4 + head) * (256 * 128) : (bf16_t*)(F.ws + WS_KG_LAT) + (size_t)(b * 4 + head) * (1024 * 128);
                    *(u32x4*)(kb + k_chunk_off(128, s, c)) = pack8(v[pass]); }
            }
            { float vv[8]; load8h(pr + 2560 + 8 * lane, vv); if (ctx) store8f(F.out + O_GV + (size_t)t * 512 + 8 * lane, vv); }
        } else {
            int r = it - NTOK;
            if (r < NVT_CTX) { const int t32 = r & 7, bh = r >> 3, b = bh >> 2, h = bh & 3;
                vt_tile_write_h(P + (size_t)(b * 256 + t32 * 32) * IN_ODD + 2560 + h * 128, IN_ODD, (bf16_t*)(F.ws + WS_VG_CTX) + (size_t)bh * (256 * 128) + (size_t)t32 * 4096, lane);
            } else { r -= NVT_CTX; const int t32 = r & 31, bh = r >> 5, b = bh >> 2, h = bh & 3;
                vt_tile_write_h(P + (size_t)(NCTX + b * 1024 + t32 * 32) * IN_ODD + 2560 + h * 128, IN_ODD, (bf16_t*)(F.ws + WS_VG_LAT) + (size_t)bh * (1024 * 128) + (size_t)t32 * 4096, lane);
            }
        }
    }
}

struct WgUnit {
    const bf16_t* kc; const bf16_t* vc; int nctx;
    const bf16_t* kl; const bf16_t* vl; int t_lo, t_hi;
};
struct WvUnit {
    const bf16_t* qb; unsigned qoff; int qpitch; bf16_t* ob; unsigned ooff;
    int qpos;
    int qcol0;
    int w_lo, w_hi;
    float sink; int has_sink; float scale;
};
constexpr int ATT_RPB_OFF = RING_BYTES + 512;
constexpr float ATT_THR = 8.0f;
template <int MODE>
__device__ __forceinline__ float attn_mask(float v, int tile32, int r, int hh, int ql, bool masked, const WvUnit& U, const LAS float* rpb) {
    const int kk = (r & 3) + 8 * (r >> 2) + 4 * hh;
    if (MODE == 1) { const int df = U.qpos + ql - (tile32 * 32 + kk); if (masked && (df > 128 || df < -128)) v = -1e30f; }
    if (MODE == 2 && masked) { const int krow = tile32 >> 1, kcol = (tile32 & 1) * 32 + kk, qc = U.qcol0 + ql;
        int ws = qc - 8; ws = ws < 0 ? 0 : (ws > 48 ? 48 : ws);
        const bool valid = (kcol >= ws) && (kcol < ws + 16);
        int co = kcol - qc; co = co < -15 ? -15 : (co > 15 ? 15 : co);
        const float bias = rpb[(krow - U.qpos + 7) * 31 + co + 15];
        v = valid ? v + bias * LOG2E : -1e30f; }
    return v;
}
template <int OFF> __device__ __forceinline__ bf16x8 lds_rd(unsigned addr) { bf16x8 r; asm volatile("ds_read_b128 %0, %1 offset:%2" : "=v"(r) : "v"(addr), "i"(OFF)); return r; }
template <int BASE, int H1> __device__ __forceinline__ void lds_rd8(unsigned addr, bf16x8 (&a)[8]) {
    a[0] = lds_rd<BASE>(addr); a[1] = lds_rd<BASE + 1024>(addr); a[2] = lds_rd<BASE + 2048>(addr); a[3] = lds_rd<BASE + 3072>(addr);
    a[4] = lds_rd<BASE + H1>(addr); a[5] = lds_rd<BASE + H1 + 1024>(addr); a[6] = lds_rd<BASE + H1 + 2048>(addr); a[7] = lds_rd<BASE + H1 + 3072>(addr);
}
#define LDS_WAIT8(n, a) asm volatile("s_waitcnt lgkmcnt(" #n ")" : "+v"(a[0]), "+v"(a[1]), "+v"(a[2]), "+v"(a[3]), "+v"(a[4]), "+v"(a[5]), "+v"(a[6]), "+v"(a[7]))
#define QK_MMA8(a, kb) do { _Pragma("unroll") for (int _j = 0; _j < 4; ++_j) { s0 = __builtin_amdgcn_mfma_f32_32x32x16_bf16(a[_j], qf[(kb) * 4 + _j], s0, 0, 0, 0); s1 = __builtin_amdgcn_mfma_f32_32x32x16_bf16(a[4 + _j], qf[(kb) * 4 + _j], s1, 0, 0, 0); } } while (0)
template <int DQK, int MODE>
__device__ __forceinline__ void attn_tile64(const LAS unsigned char* sl, int t64, bool masked, const bf16x8 (&qf)[DQK / 16], f32x16 (&o)[4], float& m, float& l, const WvUnit& U, const LAS float* rpb, int lane, float sl2) {
    constexpr int NKS = DQK / 16, KB = DQK * 128;
    const int ql = lane & 31, hh = lane >> 5;
    const unsigned addr = (unsigned)(unsigned long)sl + (unsigned)lane * 16u;
    f32x16 s0, s1;
#pragma unroll
    for (int r = 0; r < 16; ++r) { s0[r] = 0.f; s1[r] = 0.f; }
    bf16x8 pb[4];
#define ATT_SMA(sx, T32) do { float mt = -1e30f; \
    if (MODE == 1) { _Pragma("unroll") for (int r = 0; r < 16; ++r) sx[r] *= sl2; \
        if (masked) {   _Pragma("unroll") for (int r = 0; r < 16; ++r) sx[r] = attn_mask<MODE>(sx[r], (T32), r, hh, ql, true, U, rpb); } } \
    else { _Pragma("unroll") for (int r = 0; r < 16; ++r) sx[r] = attn_mask<MODE>(sx[r] * sl2, (T32), r, hh, ql, masked, U, rpb); } \
    _Pragma("unroll") for (int r = 0; r < 16; ++r) mt = fmaxf(mt, sx[r]); \
    mt = fmaxf(mt, __shfl_xor(mt, 32)); \
    if (!__all(mt - m <= ATT_THR)) { const float mn = fmaxf(m, mt), alpha = fast_exp2(m - mn); m = mn; l *= alpha; \
        _Pragma("unroll") for (int db = 0; db < 4; ++db) _Pragma("unroll") for (int r = 0; r < 16; ++r) o[db][r] *= alpha; } } while (0)
#define ATT_SMB(sx, PBI) do { float ps = 0.f; \
    _Pragma("unroll") for (int r = 0; r < 16; ++r) { sx[r] = fast_exp2(sx[r] - m); ps += sx[r]; } \
    l += ps; \
    _Pragma("unroll") for (int s2 = 0; s2 < 2; ++s2) { \
        u32x4 w; w.x = pk2(sx[8 * s2 + 0], sx[8 * s2 + 1]); w.y = pk2(sx[8 * s2 + 2], sx[8 * s2 + 3]); w.z = pk2(sx[8 * s2 + 4], sx[8 * s2 + 5]); w.w = pk2(sx[8 * s2 + 6], sx[8 * s2 + 7]); pb[(PBI) + s2] = __builtin_bit_cast(bf16x8, w); } } while (0)
#define MFMA32(a_, b_, c_) __builtin_amdgcn_mfma_f32_32x32x16_bf16(a_, b_, c_, 0, 0, 0)
    if constexpr (NKS == 8) {
        bf16x8 ka[8], kb_[8];
        lds_rd8<0, 4096>(addr, ka); lds_rd8<KB / 2, 4096>(addr, kb_);
        LDS_WAIT8(8, ka);
#pragma unroll
        for (int j = 0; j < 8; ++j) s0 = MFMA32(ka[j], qf[j], s0);
        lds_rd8<KB, 4096>(addr, ka);
        LDS_WAIT8(8, kb_);
#pragma unroll
        for (int j = 0; j < 4; ++j) s1 = MFMA32(kb_[j], qf[j], s1);
        ATT_SMA(s0, 2 * t64);
#pragma unroll
        for (int j = 4; j < 8; ++j) s1 = MFMA32(kb_[j], qf[j], s1);
        ATT_SMB(s0, 0);
        lds_rd8<KB + 8192, 4096>(addr, kb_);
        LDS_WAIT8(8, ka);
#pragma unroll
        for (int db = 0; db < 4; ++db) o[db] = MFMA32(ka[db], pb[0], o[db]);
        ATT_SMA(s1, 2 * t64 + 1);
#pragma unroll
        for (int db = 0; db < 4; ++db) o[db] = MFMA32(ka[4 + db], pb[1], o[db]);
        ATT_SMB(s1, 2);
        LDS_WAIT8(0, kb_);
#pragma unroll
        for (int s2 = 0; s2 < 2; ++s2)
#pragma unroll
            for (int db = 0; db < 4; ++db) o[db] = MFMA32(kb_[s2 * 4 + db], pb[2 + s2], o[db]);
    } else {
        bf16x8 ka[4], kb_[4];
#define RDK4(a, h, b) do { a[0] = lds_rd<(h) * (KB / 2) + (b) * 4096>(addr); a[1] = lds_rd<(h) * (KB / 2) + (b) * 4096 + 1024>(addr); a[2] = lds_rd<(h) * (KB / 2) + (b) * 4096 + 2048>(addr); a[3] = lds_rd<(h) * (KB / 2) + (b) * 4096 + 3072>(addr); } while (0)
#define RDV4(a, q) do { a[0] = lds_rd<KB + (q) * 4096>(addr); a[1] = lds_rd<KB + (q) * 4096 + 1024>(addr); a[2] = lds_rd<KB + (q) * 4096 + 2048>(addr); a[3] = lds_rd<KB + (q) * 4096 + 3072>(addr); } while (0)
#define WAIT4(n, a) asm volatile("s_waitcnt lgkmcnt(" #n ")" : "+v"(a[0]), "+v"(a[1]), "+v"(a[2]), "+v"(a[3]))
#define QK4(a, sx, b) do { _Pragma("unroll") for (int j = 0; j < 4; ++j) sx = MFMA32(a[j], qf[4 * (b) + j], sx); } while (0)
#define PV4(a, q) do { _Pragma("unroll") for (int db = 0; db < 4; ++db) o[db] = MFMA32(a[db], pb[q], o[db]); } while (0)
        RDK4(ka, 0, 0); RDK4(kb_, 0, 1);
        WAIT4(4, ka); QK4(ka, s0, 0); RDK4(ka, 0, 2);
        WAIT4(4, kb_); QK4(kb_, s0, 1); RDK4(kb_, 1, 0);
        WAIT4(4, ka); QK4(ka, s0, 2); RDK4(ka, 1, 1);
        WAIT4(4, kb_); QK4(kb_, s1, 0); RDK4(kb_, 1, 2);
        ATT_SMA(s0, 2 * t64);
        WAIT4(4, ka); QK4(ka, s1, 1); RDV4(ka, 0);
        ATT_SMB(s0, 0);
        WAIT4(4, kb_); QK4(kb_, s1, 2); RDV4(kb_, 1);
        WAIT4(4, ka); PV4(ka, 0); RDV4(ka, 2);
        ATT_SMA(s1, 2 * t64 + 1);
        WAIT4(4, kb_); PV4(kb_, 1); RDV4(kb_, 3);
        ATT_SMB(s1, 2);
        WAIT4(4, ka); PV4(ka, 2);
        WAIT4(0, kb_); PV4(kb_, 3);
#undef RDK4
#undef RDV4
#undef WAIT4
#undef QK4
#undef PV4
    }
#undef ATT_SMA
#undef ATT_SMB
#undef MFMA32
}
template <int DQK, int MODE, int VAR = 0>
__device__ __forceinline__ void attn_wg_unit(LAS unsigned char* ring, const WgUnit& G, const WvUnit& U, const float* rpb_g, int tid, int wave, int lane) {
    constexpr int NKS = DQK / 16, KB = DQK * 128, NLK = KB / 8192;
    constexpr int NS = (DQK == 128) ? 4 : 3, SLOTB = KB + 16384;
    const int ql = lane & 31, hh = lane >> 5;
    const int ntiles = G.nctx + (G.t_hi - G.t_lo);
    const LAS float* rpb = (const LAS float*)(ring + ATT_RPB_OFF);
#define ATT_ISSUE(i, SLOTC) do { const int _i = (i); const bool _c = _i < G.nctx; const int _t = _c ? _i : G.t_lo + (_i - G.nctx); \
        const char* _kg = (const char*)(_c ? G.kc : G.kl) + (size_t)_t * KB + tid * 16; const char* _vg = (const char*)(_c ? G.vc : G.vl) + (size_t)_t * 16384 + tid * 16; \
        LAS unsigned char* _sl = ring + (SLOTC) * SLOTB + wave * 1024; \
        _Pragma("unroll") for (int _p = 0; _p < NLK; ++_p) __builtin_amdgcn_global_load_lds((const unsigned*)(_kg + _p * 8192), (LAS unsigned*)(_sl + _p * 8192), 16, 0, 0); \
        _Pragma("unroll") for (int _p = 0; _p < 2; ++_p) __builtin_amdgcn_global_load_lds((const unsigned*)(_vg + _p * 8192), (LAS unsigned*)(_sl + KB + _p * 8192), 16, 0, 0); } while (0)
    asm volatile("s_waitcnt lgkmcnt(0)" ::: "memory"); __builtin_amdgcn_s_barrier(); asm volatile("" ::: "memory");
    bf16x8 qf[NKS];
#pragma unroll
    for (int ks = 0; ks < NKS; ++ks) qf[ks] = *(const bf16x8*)(U.qb + (size_t)(U.qoff + (unsigned)(ql * U.qpitch + 16 * ks + 8 * hh)));
    if (MODE == 2) { const int i = opaque_v(tid); if (i < 15 * 31) ((LAS float*)(ring + ATT_RPB_OFF))[i] = rpb_g[i]; }
    if (VAR != 2) { ATT_ISSUE(0, 0); if (ntiles > 1) ATT_ISSUE(1, 1); if (NS == 4 && ntiles > 2) ATT_ISSUE(2, 2); }
    f32x16 o[4];
#pragma unroll
    for (int db = 0; db < 4; ++db)
#pragma unroll
        for (int r = 0; r < 16; ++r) o[db][r] = 0.f;
    float m = -1e30f, l = 0.f;
    const float sl2 = U.scale * LOG2E;
#define ATT_STEP(i_, SLOTC) do { const int i = (i_); if (i < ntiles) { \
        if (NS == 4) { if (i + 2 < ntiles) asm volatile("s_waitcnt vmcnt(8)" ::: "memory"); else if (i + 1 < ntiles) asm volatile("s_waitcnt vmcnt(4)" ::: "memory"); else asm volatile("s_waitcnt vmcnt(0)" ::: "memory"); } \
        else { if (i + 1 < ntiles) asm volatile("s_waitcnt vmcnt(5)" ::: "memory"); else asm volatile("s_waitcnt vmcnt(0)" ::: "memory"); } \
        asm volatile("s_waitcnt lgkmcnt(0)" ::: "memory"); __builtin_amdgcn_s_barrier(); asm volatile("" ::: "memory"); \
        if (VAR != 2 && i + NS - 1 < ntiles) ATT_ISSUE(i + NS - 1, ((SLOTC) + NS - 1) % NS); \
        const bool isctx = i < G.nctx; const int t64 = isctx ? 0 : G.t_lo + (i - G.nctx); \
        if (VAR != 1 && (isctx || (t64 >= U.w_lo && t64 < U.w_hi))) attn_tile64<DQK, MODE>(ring + (SLOTC) * SLOTB, t64, !isctx, qf, o, m, l, U, rpb, lane, sl2); } } while (0)
    if constexpr (NS == 4) { for (int i0 = 0; i0 < ntiles; i0 += 4) { ATT_STEP(i0, 0); ATT_STEP(i0 + 1, 1); ATT_STEP(i0 + 2, 2); ATT_STEP(i0 + 3, 3); } }
    else { for (int i0 = 0; i0 < ntiles; i0 += 3) { ATT_STEP(i0, 0); ATT_STEP(i0 + 1, 1); ATT_STEP(i0 + 2, 2); } }
#undef ATT_STEP
#undef ATT_ISSUE
    l += __shfl_xor(l, 32);
    if (U.has_sink) l += fast_exp2(U.sink * LOG2E - m);
    const float inv = 1.0f / l;
    bf16_t* op = U.ob + (size_t)(U.ooff + (unsigned)(opaque_v(ql) * DM));
#pragma unroll
    for (int db = 0; db < 4; ++db)
#pragma unroll
        for (int rg = 0; rg < 4; ++rg) { u32x2 w; w.x = pk2(o[db][4 * rg] * inv, o[db][4 * rg + 1] * inv); w.y = pk2(o[db][4 * rg + 2] * inv, o[db][4 * rg + 3] * inv);
            *(u32x2*)(op + 32 * db + 8 * rg + 4 * hh) = w; }
}

template <int VAR>
__device__ __forceinline__ void phase_attn_even(Frame& F, bf16_t* O) {
 const bf16_t* QA = (const bf16_t*)(F.ws + WS_QA); const bf16_t* QNA = (const bf16_t*)(F.ws + WS_QNA);
    const int wave = F.wave, lane = F.lane, tid = F.tid;
    WgUnit G; WvUnit U; U.sink = 0.f; U.has_sink = 0; U.qpos = 0; U.qcol0 = 0;
    const int vcu = (F.G % 8 == 0) ? ((int)blockIdx.x % 8) * (F.G / 8) + (int)blockIdx.x / 8 : (int)blockIdx.x;
    for (int u = vcu; u < 256; u += F.G) { const int bh = u >> 2, q4 = u & 3, b = bh >> 3, h = bh & 7, t0 = NCTX + b * 1024 + q4 * 256 + 32 * wave;
        U.qb = QA; U.qoff = (unsigned)(t0 * 1536 + h * 192); U.qpitch = 1536; U.scale = 0.07216878364870322f; U.ob = O; U.ooff = (unsigned)(t0 * DM + h * 128);
        G.kc = (const bf16_t*)(F.ws + WS_KM_CAC) + (size_t)bh * (512 * 192); G.vc = (const bf16_t*)(F.ws + WS_VM_CAC) + (size_t)bh * (512 * 128); G.nctx = 8;
        G.kl = (const bf16_t*)(F.ws + WS_KM_LAT) + (size_t)bh * (1024 * 192); G.vl = (const bf16_t*)(F.ws + WS_VM_LAT) + (size_t)bh * (1024 * 128); G.t_lo = 0; G.t_hi = 16; U.w_lo = 0; U.w_hi = 16;
        attn_wg_unit<192, 0, VAR>(F.lds, G, U, nullptr, tid, wave, lane); }
    for (int u = vcu; u < 256; u += F.G) { const int bh = u >> 2, r0 = (u & 3) * 4, b = bh >> 3, h = bh & 7, r = r0 + (wave >> 1), c0 = (wave & 1) * 32, t0 = NCTX + b * 1024 + r * 64 + c0;
        int rs = r - 4; rs = rs < 0 ? 0 : (rs > 8 ? 8 : rs);
        int glo = r0 - 4; glo = glo < 0 ? 0 : (glo > 8 ? 8 : glo); int ghi = r0 - 1; ghi = ghi < 0 ? 0 : (ghi > 8 ? 8 : ghi);
        U.qb = QNA; U.qoff = (unsigned)(t0 * 1024 + h * 128); U.qpitch = 1024; U.scale = 0.08838834764831845f; U.ob = O; U.ooff = (unsigned)(t0 * DM + 1024 + h * 128);
        G.kc = (const bf16_t*)(F.ws + WS_KN_CAC) + (size_t)bh * (512 * 128); G.vc = (const bf16_t*)(F.ws + WS_VN_CAC) + (size_t)bh * (512 * 128); G.nctx = 8;
        G.kl = (const bf16_t*)(F.ws + WS_KN_LAT) + (size_t)bh * (1024 * 128); G.vl = (const bf16_t*)(F.ws + WS_VN_LAT) + (size_t)bh * (1024 * 128); G.t_lo = glo; G.t_hi = ghi + 8; U.w_lo = rs; U.w_hi = rs + 8;
        U.qpos = r; U.qcol0 = c0;
        attn_wg_unit<128, 2, VAR>(F.lds, G, U, F.a->in[IN_RPB] + h * (15 * 31), tid, wave, lane); }
    U.qpos = 0; U.qcol0 = 0; U.w_lo = 0; U.w_hi = 4; G.nctx = 0; G.kc = nullptr; G.vc = nullptr; G.t_lo = 0; G.t_hi = 4;
    for (int u = vcu; u < 256; u += F.G) { const int bh = u & 127, b = bh >> 3, h = bh & 7, t0 = b * 256 + 32 * wave;
        if (u < 128) {
            U.qb = QA; U.qoff = (unsigned)(t0 * 1536 + h * 192); U.qpitch = 1536; U.scale = 0.07216878364870322f; U.ob = O; U.ooff = (unsigned)(t0 * DM + h * 128);
            G.kl = (const bf16_t*)(F.ws + WS_KM_CTX) + (size_t)bh * (256 * 192); G.vl = (const bf16_t*)(F.ws + WS_VM_CTX) + (size_t)bh * (256 * 128);
            attn_wg_unit<192, 0, VAR>(F.lds, G, U, nullptr, tid, wave, lane);
        } else {
            U.qb = QNA; U.qoff = (unsigned)(t0 * 1024 + h * 128); U.qpitch = 1024; U.scale = 0.08838834764831845f; U.ob = O; U.ooff = (unsigned)(t0 * DM + 1024 + h * 128);
            G.kl = (const bf16_t*)(F.ws + WS_KN_CTX) + (size_t)bh * (256 * 128); G.vl = (const bf16_t*)(F.ws + WS_VN_CTX) + (size_t)bh * (256 * 128);
            attn_wg_unit<128, 0, VAR>(F.lds, G, U, nullptr, tid, wave, lane);
        } }
    asm volatile("s_waitcnt vmcnt(0) lgkmcnt(0)" ::: "memory"); __syncthreads();
}
__device__ __forceinline__ void phase_attn_odd(Frame& F) {
    bf16_t* O = (bf16_t*)(F.ws + WS_O); const bf16_t* QA = (const bf16_t*)(F.ws + WS_QA);
    const int wave = F.wave, lane = F.lane, tid = F.tid;
    WgUnit G; WvUnit U; U.has_sink = 1; U.qcol0 = 0; U.qpitch = 2048; U.scale = 0.08838834764831845f;
    const int vcu = (F.G % 8 == 0) ? ((int)blockIdx.x % 8) * (F.G / 8) + (int)blockIdx.x / 8 : (int)blockIdx.x;
    const float* sink = F.a->in[IN_SINK];
    for (int u = vcu; u < 512; u += F.G) { const int bk = u >> 4, q64 = u & 15, b = bk >> 2, kvh = bk & 3, g = wave >> 1, hq = kvh * 4 + g, qs = q64 * 64 + (wave & 1) * 32, t0 = NCTX + b * 1024 + qs;
        U.qb = QA; U.qoff = (unsigned)(t0 * 2048 + hq * 128); U.ob = O; U.ooff = (unsigned)(t0 * DM + hq * 128); U.qpos = qs; U.sink = sink[hq];
        G.kc = (const bf16_t*)(F.ws + WS_KG_CAC) + (size_t)bk * (512 * 128); G.vc = (const bf16_t*)(F.ws + WS_VG_CAC) + (size_t)bk * (512 * 128); G.nctx = 8;
        G.kl = (const bf16_t*)(F.ws + WS_KG_LAT) + (size_t)bk * (1024 * 128); G.vl = (const bf16_t*)(F.ws + WS_VG_LAT) + (size_t)bk * (1024 * 128);
        G.t_lo = q64 - 2 < 0 ? 0 : q64 - 2; G.t_hi = (q64 + 2 > 15 ? 15 : q64 + 2) + 1; U.w_lo = G.t_lo; U.w_hi = G.t_hi;
        attn_wg_unit<128, 1>(F.lds, G, U, nullptr, tid, wave, lane); }
    G.nctx = 0; G.kc = nullptr; G.vc = nullptr; G.t_lo = 0; G.t_hi = 4; U.w_lo = 0; U.w_hi = 4;
    for (int u = vcu; u < 256; u += F.G) { const int bk = u >> 2, q64 = u & 3, b = bk >> 2, kvh = bk & 3, g = wave >> 1, hq = kvh * 4 + g, qs = q64 * 64 + (wave & 1) * 32, t0 = b * 256 + qs;
        U.qb = QA; U.qoff = (unsigned)(t0 * 2048 + hq * 128); U.ob = O; U.ooff = (unsigned)(t0 * DM + hq * 128); U.qpos = 0; U.sink = sink[hq];
        G.kl = (const bf16_t*)(F.ws + WS_KG_CTX) + (size_t)bk * (256 * 128); G.vl = (const bf16_t*)(F.ws + WS_VG_CTX) + (size_t)bk * (256 * 128);
        attn_wg_unit<128, 0>(F.lds, G, U, nullptr, tid, wave, lane); }
    asm volatile("s_waitcnt vmcnt(0) lgkmcnt(0)" ::: "memory"); __syncthreads();
}

constexpr int N_PHASES = 36;
__global__ void __launch_bounds__(512, 2) fwd_kernel(Args args) {
    extern __shared__ __attribute__((aligned(16))) unsigned char lds_raw[];
    Frame F;
    F.lds = (LAS unsigned char*)lds_raw;
    F.tid = threadIdx.x; F.lane = F.tid & 63; F.wave = __builtin_amdgcn_readfirstlane(F.tid >> 6);
    F.G = gridDim.x; F.gw = blockIdx.x * 8 + F.wave; F.NGW = F.G * 8;
    F.a = &args; F.out = args.out; F.ws = args.ws;
    volatile LAS unsigned* MISC = (volatile LAS unsigned*)(F.lds + LDSCTL_OFF);
    for (int u = F.tid; u < (LDS_BYTES - LDSCTL_OFF) / 4; u += 512) ((LAS unsigned*)(F.lds + LDSCTL_OFF))[u] = 0u;
    __syncthreads();
    unsigned* ctl = (unsigned*)(F.ws + WS_CTL);
    const int lo = args.ph_lo, hi = args.ph_hi;
    const bool multi = (hi - lo) > 1;
    XcdBarrier bar; bar.bar = ctl + CW_BAR; bar.x = 0; bar.st = nullptr;
    if (multi) bar = xcd_barrier_post(ctl + CW_BAR, MISC + 8);
#define IN(k) (lo <= (k) && (k) < hi)
    int ph = 0;
#define PHASE(...) do { if (IN(ph)) { __VA_ARGS__ } if (IN(ph) && IN(ph + 1)) xcd_barrier(bar); ++ph; } while (0)
    const float* mods = (const float*)(F.ws + WS_MODS);
    bf16_t* H = (bf16_t*)(F.ws + WS_H); bf16_t* ACT = (bf16_t*)(F.ws + WS_ACT); float* P = (float*)(F.ws + WS_P); bf16_t* OB = (bf16_t*)(F.ws + WS_O);
    LAS unsigned char* ring = F.lds;
    const int cid = (int)blockIdx.x;
#define GEMM2(EPI_T, EDEF, A_, B_, M_, N_, K_, SLAB) \
    PHASE( pg8::Gemm g{(A_), (B_), (M_), (N_), (K_)}; typedef pg8::SplitOrder<(M_), (N_), (K_), true> SO; SO S; S.init(cid); EDEF; pg8::gemm_phase<EPI_T, SO, true, true>(ring, g, S, E, (SLAB)); ); \
    PHASE( typedef pg8::SplitOrder<(M_), (N_), (K_), true> SO; EDEF; pg8::gemm_fixup<EPI_T, SO>(E, (SLAB)); )
#define GEMM1(EPI_T, EDEF, A_, B_, M_, N_, K_) \
    PHASE( pg8::Gemm g{(A_), (B_), (M_), (N_), (K_)}; typedef pg8::SplitOrder<(M_), (N_), (K_), false> SO; SO S; S.init(cid); EDEF; pg8::gemm_phase<EPI_T, SO, true, true>(ring, g, S, E, nullptr); )
#define W_FI(layer, f) ((const bf16_t*)(F.ws + WS_WFI) + (size_t)((layer) * 2 + (f)) * NFF2 * DM)
#define W_FO(layer, f) ((const bf16_t*)(F.ws + WS_WFO) + (size_t)((layer) * 2 + (f)) * DM * DFF)
#define E_SWIGLU EpiSwiGLU E{ACT}
#define E_RESID(layer, gidx, coef, from_in) EpiResid E{F.a->in[IN_XP], F.a->in[IN_XS], (from_in), F.out, mods + (size_t)(layer) * 9 * NMOD + (size_t)(gidx) * DM, (coef)}
#define FFN(layer, f, from_in) \
    GEMM2(EpiSwiGLU, E_SWIGLU, H, W_FI(layer, f), NTOK, NFF2, DM, P); \
    GEMM2(EpiResid, E_RESID(layer, (f) ? 8 : 2, 0.5f, from_in), ACT, W_FO(layer, f), NTOK, DM, DFF, P)

    PHASE( phase_prologue(F); );
    PHASE( phase_norm(F, true, 0, 0); );
    FFN(0, 0, true);
    PHASE( phase_norm(F, false, 0, 1); );
    GEMM1(EpiBf16, EpiBf16 E{(bf16_t*)P COMMA IN_EVEN_P}, H, (const bf16_t*)(F.ws + WS_WEI), NTOK, IN_EVEN_P, DM);
    PHASE( phase_post1_even(F); );
    PHASE( { pg8::Gemm g{(const bf16_t*)(F.ws + WS_CQN), (const bf16_t*)(F.ws + WS_WQU), NTOK, 1536, 512}; typedef pg8::SplitOrder<NTOK, 1536, 512, false> SO; SO S; S.init(cid);
             EpiBf16 E{(bf16_t*)(F.ws + WS_QM), 1536}; pg8::gemm_phase<EpiBf16, SO, true, true>(ring, g, S, E, nullptr); }
           { pg8::Gemm g{(const bf16_t*)(F.ws + WS_CKVA), (const bf16_t*)(F.ws + WS_WKU), 16384, 2048, 512}; typedef pg8::SplitOrder<16384, 2048, 512, false> SO; SO S; S.init(cid);
             EpiBf16 E{(bf16_t*)(F.ws + WS_ACT), 2048}; pg8::gemm_phase<EpiBf16, SO, true, true>(ring, g, S, E, nullptr); } );
    PHASE( phase_post2_even(F); );
    PHASE( phase_attn_even<0>(F, (bf16_t*)(F.ws + WS_O)); );
    GEMM2(EpiResid, E_RESID(0, 5, 1.0f, false), OB, (const bf16_t*)(F.ws + WS_WEO), NTOK, DM, DM, P);
    PHASE( phase_norm(F, false, 0, 2); );
    FFN(0, 1, false);
    PHASE( phase_norm(F, false, 1, 0); );
    FFN(1, 0, false);
    PHASE( phase_norm(F, false, 1, 1); );
    GEMM2(EpiBf16, EpiBf16 E{(bf16_t*)P COMMA IN_ODD}, H, (const bf16_t*)(F.ws + WS_WOI), NTOK, IN_ODD, DM, (float*)(F.ws + WS_ACT));
    PHASE( phase_post_odd(F); );
    PHASE( phase_attn_odd(F); );
    GEMM2(EpiResid, E_RESID(1, 5, 1.0f, false), OB, (const bf16_t*)(F.ws + WS_WOO), NTOK, DM, DM, P);
    PHASE( phase_norm(F, false, 1, 2); );
    FFN(1, 1, false);
#undef IN
}

extern "C" void kernel_launch(void* const* d_in, const int* in_sizes, int n_in, void* d_out, int out_size, void* d_ws, size_t ws_size, hipStream_t stream) {
    static int grid = 0;
    if (grid == 0) {
        if (n_in != 28 || (size_t)out_size != O_END || ws_size < WS_END) { fprintf(stderr, "kernel_launch: unexpected shapes (n_in %d, out %d, ws %zu; need ws >= %zu); nothing launched\n", n_in, out_size, ws_size, (size_t)WS_END); grid = -1; return; }
        int dev = 0, cus = 0, per_cu = 0;
        if (hipGetDevice(&dev) != hipSuccess || hipDeviceGetAttribute(&cus, hipDeviceAttributeMultiprocessorCount, dev) != hipSuccess) { grid = -1; return; }
        if (hipFuncSetAttribute((const void*)fwd_kernel, hipFuncAttributeMaxDynamicSharedMemorySize, LDS_BYTES) != hipSuccess) { fprintf(stderr, "kernel_launch: hipFuncSetAttribute failed\n"); grid = -1; return; }
        if (hipOccupancyMaxActiveBlocksPerMultiprocessor(&per_cu, (const void*)fwd_kernel, 512, LDS_BYTES) != hipSuccess || per_cu < 1) { fprintf(stderr, "kernel_launch: occupancy query says %d blocks per CU\n", per_cu); }
        (void)hipGetLastError();
        if (cus < pg8::GRID) { fprintf(stderr, "kernel_launch: %d CUs < %d workgroups: not resident; nothing launched\n", cus, pg8::GRID); grid = -1; return; }
        grid = pg8::GRID;
    }
    if (grid < 0) return;
    if (hipMemsetAsync((char*)d_ws + WS_CTL, 0, CTL_ZERO_BYTES, stream) != hipSuccess) return;
    Args a{};
    for (int i = 0; i < 28; ++i) a.in[i] = (const float*)d_in[i];
    a.out = (float*)d_out; a.ws = (unsigned char*)d_ws;
#if MK_ONE_LAUNCH
    a.ph_lo = 0; a.ph_hi = N_PHASES;
    hipLaunchKernelGGL(fwd_kernel, dim3(grid), dim3(512), LDS_BYTES, stream, a);
#else
    for (int p = 0; p < N_PHASES; ++p) { a.ph_lo = p; a.ph_hi = p + 1; hipLaunchKernelGGL(fwd_kernel, dim3(grid), dim3(512), LDS_BYTES, stream, a); }
#endif
}
```

```cpp
#include <hip/hip_runtime.h>
#include <cstdio>
#include <cstdint>

#ifndef MK_ONE_LAUNCH
#define MK_ONE_LAUNCH 1
#endif

#define COMMA ,
#define GAS __attribute__((address_space(1)))
#define LAS __attribute__((address_space(3)))
typedef unsigned short bf16_t;
typedef short bf16x8 __attribute__((ext_vector_type(8)));
typedef float f32x4 __attribute__((ext_vector_type(4)));
typedef float f32x16 __attribute__((ext_vector_type(16)));
typedef unsigned u32x4 __attribute__((ext_vector_type(4)));
typedef unsigned u32x2 __attribute__((ext_vector_type(2)));

namespace pg8 {
constexpr int BM = 256, BK = 64, HALF = 128, HTB = HALF * BK * 2, STAGE_BYTES = 8 * HTB, NXCD = 8, WGM = 8;
__host__ __device__ __forceinline__ int lds_byte(int r, int c) { const int st = (r >> 4) * 2 + (c >> 5), rr = r & 15, cc = c & 31, ob = rr * 64 + cc * 2; return st * 1024 + (ob ^ (((ob >> 9) & 1) << 5)); }
__host__ __device__ __forceinline__ void stage_rc(int b, int& R, int& C) { const int st = b / 1024, sb = b % 1024, swz = sb ^ (((sb >> 9) & 1) << 5); R = (st >> 1) * 16 + swz / 64; C = (st & 1) * 32 + (swz % 64) / 2; }
__host__ __device__ __forceinline__ int perm32(int rho) { const int n = rho >> 4, i = rho & 15; return 8 * (i >> 2) + 4 * n + (i & 3); }
struct Unit { int pm, pn, kt0, nkt, part; };
struct Gemm { const bf16_t* A; const bf16_t* Bt; int M, N, K; };
constexpr int GRID = 256;
template <int M, int N, int K, bool SPLIT>
struct SplitOrder {
    static constexpr int nM = M / BM, nN = N / BM, nwg = nM * nN, G = GRID, nt = K / BK, nfull = (nwg / G) * G, rem = nwg - nfull, NR = nfull / G;
    static constexpr int S0 = (SPLIT && rem > 0 && G % rem == 0) ? G / rem : 1;
    static constexpr int S = ((S0 == 2 || S0 == 4) && nt % (2 * S0) == 0) ? S0 : 1;
    int c;
    __host__ __device__ void init(int c_) { c = c_; }
    __host__ __device__ static Unit unit_of(int L, int kt0, int nkt, int part) {
        int wgid = L; { constexpr int q = nwg / NXCD, r = nwg % NXCD; const int xcd = wgid % NXCD, off = wgid / NXCD; wgid = (xcd < r ? xcd * (q + 1) : r * (q + 1) + (xcd - r) * q) + off; }
        constexpr int nig = WGM * nN; const int gid = wgid / nig, fm = gid * WGM, gsz = (nM - fm) < WGM ? (nM - fm) : WGM;
        Unit u; u.pm = fm + ((wgid % nig) % gsz); u.pn = (wgid % nig) / gsz; u.kt0 = kt0; u.nkt = nkt; u.part = part; return u;
    }
    __host__ __device__ bool next(int i, Unit& u) const {
        int L = i * G + c, kt0 = 0, nkt = nt, part = -1; bool ok = L < nwg;
        if (S > 1 && i >= NR) { constexpr int R1 = rem > 0 ? rem : 1; L = nfull + (c % R1); nkt = nt / S; kt0 = (c / R1) * (nt / S); part = c; ok = (i == NR); }
        if (!ok) return false;
        u = unit_of(L, kt0, nkt, part); return true;
    }
};
typedef float f32x2_t __attribute__((ext_vector_type(2)));
typedef __bf16 bf16x2_t __attribute__((ext_vector_type(2)));
__device__ __forceinline__ unsigned cvt_pk_bf16(float lo, float hi) { const f32x2_t v = {lo, hi}; return __builtin_bit_cast(unsigned, __builtin_convertvector(v, bf16x2_t)); }

template <class Epi, class Sched, bool ALIGN_EPI = false, bool SP2 = false>
__device__ __forceinline__ void gemm_phase(LAS unsigned char* lds, const Gemm g, const Sched& S, const Epi& E, float* slab) {
    const int tid = threadIdx.x, wid = __builtin_amdgcn_readfirstlane(tid >> 6), lane = tid & 63, wr = wid >> 2, wc = wid & 3, fr = lane & 15, fq = lane >> 4;
    const int K = g.K;
    unsigned voffA[2], voffB[2];
#pragma unroll
    for (int i = 0; i < 2; ++i) { int R, C; stage_rc(tid * 16 + i * 8192, R, C); const int Rb = Epi::PERM ? ((R & ~31) + perm32(R & 31)) : R;
        voffA[i] = (unsigned)(R * K + C) * 2u; voffB[i] = (unsigned)(Rb * K + C) * 2u; }
    const size_t kstep = (size_t)(BK * 2);
    const size_t hstep = (size_t)HALF * K * 2;
    const size_t tstep = 2 * hstep;
    const unsigned ldsw = (unsigned)wid * 1024u;
    const int aoff = lds_byte(wr * 64 + fr, fq * 8), boff = lds_byte(wc * 32 + fr, fq * 8);
#define PG8_SA(b, h) (((b) * 2 + (h)) * HTB)
#define PG8_SB(b, h) ((4 + (b) * 2 + (h)) * HTB)
#define PG8_STAGE(bufoff, gbase, voff) do { _Pragma("unroll") for (int _i = 0; _i < 2; ++_i) \
        __builtin_amdgcn_global_load_lds((const unsigned*)((const char*)(gbase) + (voff)[_i]), (LAS unsigned*)(lds + (bufoff) + ldsw + _i * 8192), 16, 0, 0); } while (0)
#define PG8_LDA(dst, b, h) do { _Pragma("unroll") for (int m = 0; m < 4; ++m) _Pragma("unroll") for (int k = 0; k < 2; ++k) dst[m][k] = *(const LAS bf16x8*)(lds + PG8_SA(b, h) + aoff + m * 2048 + k * 1024); } while (0)
#define PG8_LDB(dst, b, h) do { _Pragma("unroll") for (int n = 0; n < 2; ++n) _Pragma("unroll") for (int k = 0; k < 2; ++k) dst[n][k] = *(const LAS bf16x8*)(lds + PG8_SB(b, h) + boff + n * 2048 + k * 1024); } while (0)
#define PG8_MMA(ai, bj, At, Bt) do { __builtin_amdgcn_s_setprio(1); _Pragma("unroll") for (int m = 0; m < 4; ++m) _Pragma("unroll") for (int n = 0; n < 2; ++n) _Pragma("unroll") for (int k = 0; k < 2; ++k) \
        acc[ai][bj][m][n] = __builtin_amdgcn_mfma_f32_16x16x32_bf16(Bt[n][k], At[m][k], acc[ai][bj][m][n], 0, 0, 0); __builtin_amdgcn_s_setprio(0); } while (0)
#define PG8_WAIT_V(n) asm volatile("s_waitcnt vmcnt(" #n ")" ::: "memory")
#define PG8_WAIT_L(n) asm volatile("s_waitcnt lgkmcnt(" #n ")" ::: "memory")
#define PG8_BAR __builtin_amdgcn_s_barrier()
#define PG8_SCHED __builtin_amdgcn_sched_barrier(0)
    Unit cur, nxt; int ui = 0;
    if (!S.next(0, cur)) return;
    f32x4 acc[2][2][4][2];
#pragma unroll
    for (int a = 0; a < 2; ++a)
#pragma unroll
        for (int b = 0; b < 2; ++b)
#pragma unroll
            for (int m = 0; m < 4; ++m)
#pragma unroll
                for (int n = 0; n < 2; ++n) acc[a][b][m][n] = (f32x4){0.f, 0.f, 0.f, 0.f};
    bf16x8 At[4][2], B0[2][2], B1[2][2];
    const char* cA = (const char*)g.A + (size_t)cur.pm * tstep + (size_t)cur.kt0 * kstep; const char* cB = (const char*)g.Bt + (size_t)cur.pn * tstep + (size_t)cur.kt0 * kstep;
    if constexpr (SP2) {
        PG8_STAGE(PG8_SB(0, 0), cB, voffB); PG8_STAGE(PG8_SB(0, 1), cB + hstep, voffB); PG8_STAGE(PG8_SA(0, 0), cA, voffA); PG8_STAGE(PG8_SA(0, 1), cA + hstep, voffA);
        if (wr == 1) PG8_BAR;
        PG8_WAIT_V(2); PG8_BAR;
        PG8_STAGE(PG8_SB(1, 0), cB + kstep, voffB); PG8_STAGE(PG8_SA(1, 0), cA + kstep, voffA); PG8_STAGE(PG8_SB(1, 1), cB + hstep + kstep, voffB);
        PG8_WAIT_V(6); PG8_BAR;
    } else {
        PG8_STAGE(PG8_SB(0, 0), cB, voffB); PG8_STAGE(PG8_SA(0, 0), cA, voffA); PG8_STAGE(PG8_SB(0, 1), cB + hstep, voffB); PG8_STAGE(PG8_SA(0, 1), cA + hstep, voffA);
        if (wr == 1) PG8_BAR;
        PG8_WAIT_V(4); PG8_BAR;
        PG8_STAGE(PG8_SB(1, 0), cB + kstep, voffB); PG8_STAGE(PG8_SA(1, 0), cA + kstep, voffA); PG8_STAGE(PG8_SB(1, 1), cB + hstep + kstep, voffB);
        PG8_WAIT_V(6); PG8_BAR;
    }
    for (;;) {
        const bool has_next = S.next(ui + 1, nxt);
        const char* nA = has_next ? (const char*)g.A + (size_t)nxt.pm * tstep + (size_t)nxt.kt0 * kstep : cA; const char* nB = has_next ? (const char*)g.Bt + (size_t)nxt.pn * tstep + (size_t)nxt.kt0 * kstep : cB;
        const int nt = cur.nkt;
        for (int t = 0; t < nt; t += 2) {
            const bool last = (t == nt - 2);
            const char* a1 = cA + (size_t)(t + 1) * kstep;
            const char* a2 = last ? nA : cA + (size_t)(t + 2) * kstep; const char* b2 = last ? nB : cB + (size_t)(t + 2) * kstep;
            const char* a3 = a2 + kstep; const char* b3 = b2 + kstep;
            if constexpr (SP2) {
            PG8_LDB(B0, 0, 0); PG8_LDB(B1, 0, 1); PG8_SCHED; PG8_LDA(At, 0, 0); PG8_STAGE(PG8_SA(1, 1), a1 + hstep, voffA);
            PG8_WAIT_V(8); PG8_WAIT_L(0); PG8_BAR; PG8_MMA(0, 0, At, B0); PG8_MMA(0, 1, At, B1); PG8_BAR; PG8_SCHED;
            PG8_LDA(At, 0, 1); PG8_STAGE(PG8_SB(0, 0), b2, voffB); PG8_STAGE(PG8_SB(0, 1), b2 + hstep, voffB); PG8_STAGE(PG8_SA(0, 0), a2, voffA);
            PG8_WAIT_V(8); PG8_WAIT_L(0); PG8_BAR; PG8_MMA(1, 0, At, B0); PG8_MMA(1, 1, At, B1); PG8_BAR; PG8_SCHED;
            PG8_LDB(B0, 1, 0); PG8_LDB(B1, 1, 1); PG8_SCHED; PG8_LDA(At, 1, 0); PG8_STAGE(PG8_SA(0, 1), a2 + hstep, voffA);
            PG8_WAIT_V(8); PG8_WAIT_L(0); PG8_BAR; PG8_MMA(0, 0, At, B0); PG8_MMA(0, 1, At, B1); PG8_BAR; PG8_SCHED;
            PG8_LDA(At, 1, 1); PG8_STAGE(PG8_SB(1, 0), b3, voffB); PG8_STAGE(PG8_SB(1, 1), b3 + hstep, voffB); PG8_STAGE(PG8_SA(1, 0), a3, voffA);
            PG8_WAIT_V(8); PG8_WAIT_L(0); PG8_BAR; PG8_MMA(1, 0, At, B0); PG8_MMA(1, 1, At, B1); PG8_BAR; PG8_SCHED;
            } else {
            PG8_LDB(B0, 0, 0); PG8_SCHED; PG8_LDA(At, 0, 0); PG8_STAGE(PG8_SA(1, 1), a1 + hstep, voffA);
            PG8_WAIT_L(8); PG8_BAR; PG8_WAIT_L(0); PG8_MMA(0, 0, At, B0); PG8_BAR; PG8_SCHED;
            PG8_LDB(B1, 0, 1); PG8_STAGE(PG8_SB(0, 0), b2, voffB);
            PG8_BAR; PG8_WAIT_L(0); PG8_MMA(0, 1, At, B1); PG8_BAR;
            PG8_LDA(At, 0, 1); PG8_STAGE(PG8_SA(0, 0), a2, voffA);
            PG8_BAR; PG8_WAIT_L(0); PG8_MMA(1, 0, At, B0); PG8_BAR; PG8_SCHED;
            PG8_STAGE(PG8_SB(0, 1), b2 + hstep, voffB);
            PG8_WAIT_V(6); PG8_BAR; PG8_MMA(1, 1, At, B1); PG8_BAR;
            PG8_LDB(B0, 1, 0); PG8_SCHED; PG8_LDA(At, 1, 0); PG8_STAGE(PG8_SA(0, 1), a2 + hstep, voffA);
            PG8_WAIT_L(8); PG8_BAR; PG8_WAIT_L(0); PG8_MMA(0, 0, At, B0); PG8_BAR; PG8_SCHED;
            PG8_LDB(B1, 1, 1); PG8_STAGE(PG8_SB(1, 0), b3, voffB);
            PG8_BAR; PG8_WAIT_L(0); PG8_MMA(0, 1, At, B1); PG8_BAR;
            PG8_LDA(At, 1, 1); PG8_STAGE(PG8_SA(1, 0), a3, voffA);
            PG8_BAR; PG8_WAIT_L(0); PG8_MMA(1, 0, At, B0); PG8_BAR; PG8_SCHED;
            PG8_STAGE(PG8_SB(1, 1), b3 + hstep, voffB);
            PG8_WAIT_V(6); PG8_BAR; PG8_MMA(1, 1, At, B1); PG8_BAR;
            }
        }
        if constexpr (ALIGN_EPI) { if (wr == 0) PG8_BAR; }
        if (cur.part < 0) {
            const auto cx = E.begin(cur, wr, wc, fr, fq);
#pragma unroll
            for (int ai = 0; ai < 2; ++ai)
#pragma unroll
                for (int m = 0; m < 4; ++m) { const f32x4 v[2][2] = {{acc[ai][0][m][0], acc[ai][0][m][1]}, {acc[ai][1][m][0], acc[ai][1][m][1]}}; E.rows(cx, v, cur, ai, m, wr, wc, fr, fq); }
        } else {
            bf16_t* sp = (bf16_t*)slab + (size_t)cur.part * 65536 + (size_t)tid * 8;
#pragma unroll
            for (int ai = 0; ai < 2; ++ai)
#pragma unroll
                for (int bj = 0; bj < 2; ++bj)
#pragma unroll
                    for (int m = 0; m < 4; ++m) { const f32x4 a = acc[ai][bj][m][0], b = acc[ai][bj][m][1];
                        u32x4 w; w.x = cvt_pk_bf16(a[0], a[1]); w.y = cvt_pk_bf16(a[2], a[3]); w.z = cvt_pk_bf16(b[0], b[1]); w.w = cvt_pk_bf16(b[2], b[3]);
                        *(u32x4*)(sp + (size_t)(((ai * 2 + bj) * 4 + m) * 4096)) = w; }
        }
        if (!has_next) break;
#pragma unroll
        for (int a = 0; a < 2; ++a)
#pragma unroll
            for (int b = 0; b < 2; ++b)
#pragma unroll
                for (int m = 0; m < 4; ++m)
#pragma unroll
                    for (int n = 0; n < 2; ++n) acc[a][b][m][n] = (f32x4){0.f, 0.f, 0.f, 0.f};
        cur = nxt; cA = nA; cB = nB; ++ui;
        if constexpr (ALIGN_EPI) { if (wr == 1) PG8_BAR; }
    }
    PG8_WAIT_V(0);
    if constexpr (!ALIGN_EPI) { if (wr == 0) PG8_BAR; }
    PG8_BAR;
#undef PG8_SA
#undef PG8_SB
#undef PG8_STAGE
#undef PG8_LDA
#undef PG8_LDB
#undef PG8_MMA
#undef PG8_WAIT_V
#undef PG8_WAIT_L
#undef PG8_BAR
#undef PG8_SCHED
}
template <class Epi, class Sched>
__device__ __forceinline__ void gemm_fixup(const Epi& E, const float* slab) {
    if constexpr (Sched::S > 1) {
    constexpr int NG = 8 / Sched::S;
    const int tid = threadIdx.x, wid = __builtin_amdgcn_readfirstlane(tid >> 6), lane = tid & 63, wr = wid >> 2, wc = wid & 3, fr = lane & 15, fq = lane >> 4;
    for (int b = blockIdx.x; b < Sched::rem * Sched::S; b += Sched::G) {
        const int r = b % Sched::rem, q = b / Sched::rem;
        const Unit u = Sched::unit_of(Sched::nfull + r, 0, Sched::nt, -1);
        f32x4 v[NG][2][2];
#pragma unroll
        for (int gi = 0; gi < NG; ++gi)
#pragma unroll
            for (int bj = 0; bj < 2; ++bj)
#pragma unroll
                for (int n = 0; n < 2; ++n) v[gi][bj][n] = (f32x4){0.f, 0.f, 0.f, 0.f};
#pragma unroll
        for (int gi = 0; gi < NG; ++gi) { const int g = q * NG + gi, ai = g >> 2, m = g & 3;
#pragma unroll
            for (int p = 0; p < Sched::S; ++p) {
                const bf16_t* sp = (const bf16_t*)slab + (size_t)(r + p * Sched::rem) * 65536 + (size_t)tid * 8;
#pragma unroll
                for (int bj = 0; bj < 2; ++bj) { const u32x4 w = *(const u32x4*)(sp + (size_t)(((ai * 2 + bj) * 4 + m) * 4096));
                    v[gi][bj][0] += (f32x4){__builtin_bit_cast(float, w.x << 16), __builtin_bit_cast(float, w.x & 0xffff0000u), __builtin_bit_cast(float, w.y << 16), __builtin_bit_cast(float, w.y & 0xffff0000u)};
                    v[gi][bj][1] += (f32x4){__builtin_bit_cast(float, w.z << 16), __builtin_bit_cast(float, w.z & 0xffff0000u), __builtin_bit_cast(float, w.w << 16), __builtin_bit_cast(float, w.w & 0xffff0000u)}; } } }
        const auto cx = E.begin(u, wr, wc, fr, fq);
#pragma unroll
        for (int gi = 0; gi < NG; ++gi) { const int g = q * NG + gi; E.rows(cx, v[gi], u, g >> 2, g & 3, wr, wc, fr, fq); }
    }
    }
}
}

constexpr int DM = 2048, NTOK = 12288, NCTX = 4096, DFF = 5632, NFF2 = 11264;
constexpr int IN_EVEN = 4160, IN_EVEN_P = 4096, IN_ODD = 3072;
constexpr int NMOD = 18432;
constexpr float EPS = 1e-6f;
constexpr float LOG2E = 1.4426950408889634f;

constexpr size_t O_X = 0, O_CKV = 25165824, O_KROPE = 27262976, O_NAK = 27525120, O_NAV = 31719424, O_GK = 35913728, O_GV = 38010880, O_END = 40108032;

constexpr size_t MiB = 1u << 20;
constexpr size_t WS_CTL = 0;
constexpr size_t WS_MODS = 2 * MiB;
constexpr size_t CTL_ZERO_BYTES = 4 * MiB;
constexpr size_t WS_WFI = 4 * MiB;
constexpr size_t WS_WFO = WS_WFI + 176 * MiB;
constexpr size_t WS_WEI = WS_WFO + 88 * MiB;
constexpr size_t WS_WQU = WS_WEI + 17 * MiB;
constexpr size_t WS_WKU = WS_WQU + 2 * MiB;
constexpr size_t WS_WEO = WS_WKU + 2 * MiB;
constexpr size_t WS_WOI = WS_WEO + 8 * MiB;
constexpr size_t WS_WOO = WS_WOI + 12 * MiB;
constexpr size_t WS_H = WS_WOO + 8 * MiB;
constexpr size_t WS_ACT = WS_H + 48 * MiB;
constexpr size_t WS_P = WS_ACT + 132 * MiB;
constexpr size_t WS_QM = WS_P + 204 * MiB;
constexpr size_t WS_CQN = WS_QM + 72 * MiB;
constexpr size_t WS_CKVA = WS_CQN + 12 * MiB;
constexpr size_t WS_QA = WS_CKVA + 16 * MiB;
constexpr size_t WS_QNA = WS_QA + 48 * MiB;
constexpr size_t WS_KM_CTX = WS_QNA + 24 * MiB;
constexpr size_t WS_KM_LAT = WS_KM_CTX + 12 * MiB;
constexpr size_t WS_KM_CAC = WS_KM_LAT + 24 * MiB;
constexpr size_t WS_VM_CTX = WS_KM_CAC + 12 * MiB;
constexpr size_t WS_VM_LAT = WS_VM_CTX + 8 * MiB;
constexpr size_t WS_VM_CAC = WS_VM_LAT + 16 * MiB;
constexpr size_t WS_KN_CTX = WS_VM_CAC + 8 * MiB;
constexpr size_t WS_KN_LAT = WS_KN_CTX + 8 * MiB;
constexpr size_t WS_KN_CAC = WS_KN_LAT + 16 * MiB;
constexpr size_t WS_VN_CTX = WS_KN_CAC + 8 * MiB;
constexpr size_t WS_VN_LAT = WS_VN_CTX + 8 * MiB;
constexpr size_t WS_VN_CAC = WS_VN_LAT + 16 * MiB;
constexpr size_t WS_KG_CTX = WS_VN_CAC + 8 * MiB;
constexpr size_t WS_KG_LAT = WS_KG_CTX + 4 * MiB;
constexpr size_t WS_KG_CAC = WS_KG_LAT + 8 * MiB;
constexpr size_t WS_VG_CTX = WS_KG_CAC + 4 * MiB;
constexpr size_t WS_VG_LAT = WS_VG_CTX + 4 * MiB;
constexpr size_t WS_VG_CAC = WS_VG_LAT + 8 * MiB;
constexpr size_t WS_O = WS_VG_CAC + 4 * MiB;
constexpr size_t WS_KROPE = WS_O + 48 * MiB;
constexpr size_t WS_END = WS_KROPE + 4 * MiB;
constexpr int CW_BAR = 4096;

constexpr int RING_BYTES = 131072;
constexpr int LDSCTL_OFF = RING_BYTES;
constexpr int LDS_BYTES = 147456;

__device__ __forceinline__ unsigned f2bf(float f) { unsigned u = __builtin_bit_cast(unsigned, f); return (u + 0x7fffu + ((u >> 16) & 1u)) >> 16; }
__device__ __forceinline__ unsigned pk2(float lo, float hi) { return pg8::cvt_pk_bf16(lo, hi); }
__device__ __forceinline__ float wave_sum(float v) {
#pragma unroll
    for (int o = 1; o < 64; o <<= 1) v += __shfl_xor(v, o);
    return v;
}
__device__ __forceinline__ float fast_exp2(float x) { return __builtin_amdgcn_exp2f(x); }
__device__ __forceinline__ float fast_rcp(float x) { return __builtin_amdgcn_rcpf(x); }
__device__ __forceinline__ float silu_f(float g) { return g * fast_rcp(1.0f + fast_exp2(-g * LOG2E)); }
__device__ __forceinline__ float sin_rev(float rev) { return __builtin_amdgcn_sinf(rev); }
__device__ __forceinline__ float cos_rev(float rev) { return __builtin_amdgcn_cosf(rev); }

#define XB_TMO      128
#define XB_XCNT(j)  (256  + 64 * (j))
#define XB_XSUB(j)  (1280 + 64 * (j))
#define XB_XGEN(j)  (2304 + 64 * (j))
#define XB_TOP      3328
#define XB_TOPGEN   3392
#define XCD_BAR_WORDS 3456
#define XB_SPIN_CAP (1u << 18)
__device__ __forceinline__ unsigned xb_ld(unsigned* p)              { return __hip_atomic_load(p, __ATOMIC_RELAXED, __HIP_MEMORY_SCOPE_AGENT); }
__device__ __forceinline__ unsigned xb_add(unsigned* p, unsigned v) { return __hip_atomic_fetch_add(p, v, __ATOMIC_RELAXED, __HIP_MEMORY_SCOPE_AGENT); }
__device__ __forceinline__ unsigned xb_xcc_id() { return (unsigned)__builtin_amdgcn_s_getreg((3 << 11) | 20) & 0xFu; }
#define XB_SPIN(cond, bar) do { unsigned _sp = 0; while (cond) { __builtin_amdgcn_s_sleep(1); \
    if ((++_sp & 255u) == 0u) { if (xb_ld(&(bar)[XB_TMO])) break; if (_sp > XB_SPIN_CAP) { atomicAdd(&(bar)[XB_TMO], 1u); break; } } } } while (0)
struct XcdBarrier { unsigned* bar; unsigned x; volatile LAS unsigned* st; };
__device__ __forceinline__ XcdBarrier xcd_barrier_post(unsigned* bar, volatile LAS unsigned* st) {
    XcdBarrier b; b.bar = bar; b.x = xb_xcc_id(); b.st = st;
    if (threadIdx.x == 0) (void)xb_add(&bar[XB_XCNT(b.x)], 1u);
    return b;
}
__device__ __forceinline__ void xcd_barrier_complete(unsigned* bar, unsigned x, unsigned& nloc, unsigned& nx) {
    const unsigned G = gridDim.x * gridDim.y * gridDim.z;
    unsigned sum, cnt, mine, sp = 0u;
    for (;;) {
        sum = 0u; cnt = 0u; mine = 0u;
#pragma unroll
        for (unsigned j = 0; j < 16; ++j) { const unsigned c = xb_ld(&bar[XB_XCNT(j)]); sum += c; cnt += (c > 0u) ? 1u : 0u; mine = (j == x) ? c : mine; }
        if (sum == G) break;
        __builtin_amdgcn_s_sleep(1);
        if ((++sp & 255u) == 0u) { if (xb_ld(&bar[XB_TMO])) break; if (sp > XB_SPIN_CAP) { atomicAdd(&bar[XB_TMO], 1u); break; } }
    }
    nloc = mine > 0u ? mine : 1u; nx = cnt > 0u ? cnt : 1u;
}
__device__ __forceinline__ void xcd_barrier(const XcdBarrier& b) {
    asm volatile("s_waitcnt vmcnt(0)" ::: "memory");
    __syncthreads();
    if (threadIdx.x == 0) {
        unsigned* bar = b.bar;
        __builtin_amdgcn_s_waitcnt(0);
        unsigned nloc = b.st[0], nx = b.st[1];
        if (nloc == 0u) { xcd_barrier_complete(bar, b.x, nloc, nx); b.st[0] = nloc; b.st[1] = nx; }
        const unsigned old = xb_add(&bar[XB_XSUB(b.x)], 1u);
        const unsigned gen = old / nloc;
        if (old + 1u == (gen + 1u) * nloc) {
            __builtin_amdgcn_fence(__ATOMIC_RELEASE, "agent");
            asm volatile("s_waitcnt vmcnt(0)" ::: "memory");
            const unsigned og = xb_add(&bar[XB_TOP], 1u);
            const unsigned tg = og / nx;
            if (og + 1u == (tg + 1u) * nx) xb_add(&bar[XB_TOPGEN], 1u);
            else XB_SPIN(xb_ld(&bar[XB_TOPGEN]) == tg, bar);
            __builtin_amdgcn_fence(__ATOMIC_ACQUIRE, "agent");
            xb_add(&bar[XB_XGEN(b.x)], 1u);
            asm volatile("s_waitcnt vmcnt(0)" ::: "memory");
        } else {
            XB_SPIN(xb_ld(&bar[XB_XGEN(b.x)]) == gen, bar);
            __builtin_amdgcn_fence(__ATOMIC_ACQUIRE, "agent");
            asm volatile("s_waitcnt vmcnt(0)" ::: "memory");
        }
    }
    __syncthreads();
}

struct Args { const float* in[28]; float* out; unsigned char* ws; int ph_lo, ph_hi; };
struct Frame {
    LAS unsigned char* lds;
    int tid, lane, wave, G, gw, NGW;
    const Args* a; float* out; unsigned char* ws;
};
#define IN_XP 0
#define IN_XS 1
#define IN_C_CKV 2
#define IN_C_KROPE 3
#define IN_C_NAK 4
#define IN_C_NAV 5
#define IN_C_GK 6
#define IN_C_GV 7
#define IN_C 8
#define IN_CCTX 9
#define IN_ADAW 10
#define IN_ADAB 11
#define IN_NORMG 12
#define IN_FFI 13
#define IN_FFO 14
#define IN_EWI 15
#define IN_EWO 16
#define IN_QNORM 17
#define IN_WQUP 18
#define IN_KVNORM 19
#define IN_WKVUP 20
#define IN_MLAQK 21
#define IN_NAQK 22
#define IN_RPB 23
#define IN_OWI 24
#define IN_OWO 25
#define IN_GQK 26
#define IN_SINK 27

__device__ __forceinline__ int opaque_v(int x) { asm volatile("" : "+v"(x)); return x; }
__device__ __forceinline__ int tok_mb(int t) { return t < NCTX ? 0 : 1 + ((t - NCTX) >> 10); }

__device__ __forceinline__ size_t k_chunk_off(int DQK, int key, int c8) { return (size_t)(key >> 5) * (DQK * 32) + (size_t)(c8 >> 1) * 512 + (((c8 & 1) * 32 + (key & 31)) << 3); }
__device__ __forceinline__ void vt_tile_write_h(const bf16_t* src0, size_t pitch, bf16_t* dst, int lane) {
#pragma unroll
    for (int it = 0; it < 8; ++it) {
        const int d = (it & 1) * 64 + lane, s = (it >> 1) & 1, hh = it >> 2;
        unsigned v[8];
#pragma unroll
        for (int j = 0; j < 8; ++j) { const int key = 16 * s + 8 * (j >> 2) + 4 * hh + (j & 3); v[j] = src0[(size_t)key * pitch + d]; }
        u32x4 w; w.x = v[0] | (v[1] << 16); w.y = v[2] | (v[3] << 16); w.z = v[4] | (v[5] << 16); w.w = v[6] | (v[7] << 16);
        *(u32x4*)(dst + (size_t)(((s * 4 + (d >> 5)) * 64 + hh * 32 + (d & 31)) << 3)) = w;
    }
}
__device__ __forceinline__ void vt_tile_write(const float* src0, size_t pitch, bf16_t* dst, int lane) {
#pragma unroll
    for (int it = 0; it < 8; ++it) {
        const int d = (it & 1) * 64 + lane, s = (it >> 1) & 1, hh = it >> 2;
        float v[8];
#pragma unroll
        for (int j = 0; j < 8; ++j) { const int key = 16 * s + 8 * (j >> 2) + 4 * hh + (j & 3); v[j] = src0[(size_t)key * pitch + d]; }
        u32x4 w; w.x = pk2(v[0], v[1]); w.y = pk2(v[2], v[3]); w.z = pk2(v[4], v[5]); w.w = pk2(v[6], v[7]);
        *(u32x4*)(dst + (size_t)(((s * 4 + (d >> 5)) * 64 + hh * 32 + (d & 31)) << 3)) = w;
    }
}

__device__ __forceinline__ void p0_transpose_item(const float* W, int K, int N, bf16_t* WT, int mode, LAS float* scr, int item, int lane) {
    const int nblk = N / 32, kb = item / nblk, nb = item % nblk, k0 = 64 * kb, n0 = 32 * nb;
#pragma unroll 8
    for (int i = 0; i < 32; ++i) { const int kk = 2 * i + (lane >> 5); scr[kk * 33 + (lane & 31)] = __builtin_nontemporal_load(W + (size_t)(k0 + kk) * N + n0 + (lane & 31)); }
    asm volatile("s_waitcnt lgkmcnt(0)" ::: "memory");
    int d0 = n0;
    if (mode == 1) { const int j0 = n0 < DFF ? n0 : n0 - DFF; d0 = 256 * (j0 >> 7) + (j0 & 127) + (n0 < DFF ? 0 : 128); }
    if (mode == 2) d0 = n0 < 1024 ? n0 : (n0 < 1088 ? 4096 + (n0 - 1024) : n0 - 64);
    const int c = lane & 7;
#pragma unroll
    for (int j = 0; j < 4; ++j) { const int n = (lane >> 3) + 8 * j; const LAS float* s = scr + (8 * c) * 33 + n;
        u32x4 o; o.x = pk2(s[0 * 33], s[1 * 33]); o.y = pk2(s[2 * 33], s[3 * 33]); o.z = pk2(s[4 * 33], s[5 * 33]); o.w = pk2(s[6 * 33], s[7 * 33]);
        *(u32x4*)(WT + (size_t)(d0 + n) * K + k0 + 8 * c) = o; }
    asm volatile("s_waitcnt lgkmcnt(0)" ::: "memory");
}

__device__ __forceinline__ const float* p0_mods_wptr(Frame& F, int item) {
    const int layer = item / 1152, rem = item % 1152, slab = rem >> 4, ks = rem & 15;
    return F.a->in[IN_ADAW] + (size_t)layer * DM * NMOD + (size_t)(ks * 128 + F.wave * 16) * NMOD + slab * 256 + 4 * F.lane;
}
__device__ __forceinline__ void phase_mods(Frame& F) {
    LAS float* stab = (LAS float*)(F.lds);
    LAS float* part = (LAS float*)(F.lds + 8192);
    const float* c = F.a->in[IN_C]; const float* cctx = F.a->in[IN_CCTX];
    for (int item = blockIdx.x; item < 2304; item += F.G) {
        const int layer = item / 1152, rem = item % 1152, slab = rem >> 4, ks = rem & 15, n0 = slab * 256, k0 = ks * 128;
        f32x4 w[16];
        { const float* W = p0_mods_wptr(F, item);
#pragma unroll
          for (int kk = 0; kk < 16; ++kk) w[kk] = __builtin_nontemporal_load((const f32x4*)(W + (size_t)kk * NMOD)); }
        for (int i = F.tid; i < 9 * 128; i += 512) { const int b = i >> 7, k = i & 127; const float v = (b == 0) ? cctx[k0 + k] : c[(size_t)(b - 1) * DM + k0 + k]; stab[i] = silu_f(v); }
        __syncthreads();
        f32x4 acc[9];
#pragma unroll
        for (int b = 0; b < 9; ++b) acc[b] = (f32x4){0.f, 0.f, 0.f, 0.f};
#pragma unroll
        for (int kk = 0; kk < 16; ++kk) {
#pragma unroll
            for (int b = 0; b < 9; ++b) { const float sv = stab[b * 128 + F.wave * 16 + kk]; acc[b] += w[kk] * sv; }
        }
#pragma unroll
        for (int b = 0; b < 9; ++b) *(LAS f32x4*)(part + (F.wave * 9 + b) * 256 + 4 * F.lane) = acc[b];
        __syncthreads();
        float* mods = (float*)(F.ws + WS_MODS) + (size_t)layer * 9 * NMOD;
        const float* bias = F.a->in[IN_ADAB] + (size_t)layer * NMOD;
        for (int i = F.tid; i < 9 * 256; i += 512) { const int b = i >> 8, col = i & 255; float sm = 0.f;
#pragma unroll
            for (int ww = 0; ww < 8; ++ww) sm += part[(ww * 9 + b) * 256 + col];
            if (ks == 0) sm += bias[n0 + col];
            atomicAdd(mods + (size_t)b * NMOD + n0 + col, sm); }
        __syncthreads();
    }
}

__device__ __forceinline__ void p0_cacheK_item(const float* src, int H, bf16_t* dstbase, int item, int lane) {
    const int t32 = item & 15, bh = item >> 4, b = bh / H, h = bh % H;
    bf16_t* dst = dstbase + (size_t)bh * (512 * 128);
#pragma unroll
    for (int it = 0; it < 8; ++it) { const int idx = it * 64 + lane, kl = idx >> 4, c8 = idx & 15, key = t32 * 32 + kl;
        const float* s = src + ((size_t)(b * 512 + key) * H + h) * 128 + c8 * 8;
        const f32x4 a = *(const f32x4*)s, bb = *(const f32x4*)(s + 4);
        u32x4 w; w.x = pk2(a[0], a[1]); w.y = pk2(a[2], a[3]); w.z = pk2(bb[0], bb[1]); w.w = pk2(bb[2], bb[3]);
        *(u32x4*)(dst + k_chunk_off(128, key, c8)) = w; }
}
__device__ __forceinline__ void p0_cacheV_item(const float* src, int H, bf16_t* dstbase, int item, int lane) {
    const int t32 = item & 15, bh = item >> 4, b = bh / H, h = bh % H;
    vt_tile_write(src + ((size_t)(b * 512 + t32 * 32) * H + h) * 128, (size_t)H * 128, dstbase + (size_t)bh * (512 * 128) + (size_t)t32 * 4096, lane);
}

__device__ __forceinline__ void phase_prologue(Frame& F) {
    phase_mods(F);
    LAS float* scr = (LAS float*)(F.lds + F.wave * 16384);
    constexpr int I_FI = 32 * 352, I_FO = 88 * 64, I_EI = 32 * 130, I_QU = 8 * 48, I_KU = 8 * 64, I_EO = 32 * 64, I_OI = 32 * 96, I_OO = 32 * 64;
    constexpr int I_PAD = 0, I_CKV = 1024, I_NK = 1024, I_NV = 1024, I_GK = 512, I_GV = 512;
    constexpr int NITEMS = 4 * I_FI + 4 * I_FO + I_EI + I_QU + I_KU + I_EO + I_OI + I_OO + I_PAD + I_CKV + I_NK + I_NV + I_GK + I_GV;
    unsigned char* ws = F.ws;
    for (int it = F.gw; it < NITEMS; it += F.NGW) {
        int r = it;
        if (r < 4 * I_FI) { const int m = r / I_FI; p0_transpose_item(F.a->in[IN_FFI] + (size_t)m * DM * NFF2, DM, NFF2, (bf16_t*)(ws + WS_WFI) + (size_t)m * NFF2 * DM, 1, scr, r % I_FI, F.lane); continue; } r -= 4 * I_FI;
        if (r < 4 * I_FO) { const int m = r / I_FO; p0_transpose_item(F.a->in[IN_FFO] + (size_t)m * DFF * DM, DFF, DM, (bf16_t*)(ws + WS_WFO) + (size_t)m * DM * DFF, 0, scr, r % I_FO, F.lane); continue; } r -= 4 * I_FO;
        if (r < I_EI) { p0_transpose_item(F.a->in[IN_EWI], DM, IN_EVEN, (bf16_t*)(ws + WS_WEI), 2, scr, r, F.lane); continue; } r -= I_EI;
        if (r < I_QU) { p0_transpose_item(F.a->in[IN_WQUP], 512, 1536, (bf16_t*)(ws + WS_WQU), 0, scr, r, F.lane); continue; } r -= I_QU;
        if (r < I_KU) { p0_transpose_item(F.a->in[IN_WKVUP], 512, 2048, (bf16_t*)(ws + WS_WKU), 0, scr, r, F.lane); continue; } r -= I_KU;
        if (r < I_EO) { p0_transpose_item(F.a->in[IN_EWO], DM, DM, (bf16_t*)(ws + WS_WEO), 0, scr, r, F.lane); continue; } r -= I_EO;
        if (r < I_OI) { p0_transpose_item(F.a->in[IN_OWI], DM, IN_ODD, (bf16_t*)(ws + WS_WOI), 0, scr, r, F.lane); continue; } r -= I_OI;
        if (r < I_OO) { p0_transpose_item(F.a->in[IN_OWO], DM, DM, (bf16_t*)(ws + WS_WOO), 0, scr, r, F.lane); continue; } r -= I_OO;
        if (r < I_PAD) { u32x4* p = (u32x4*)((bf16_t*)(ws + WS_WEI) + (size_t)(IN_EVEN + r) * DM); const u32x4 z = {0u, 0u, 0u, 0u};
#pragma unroll
            for (int j = 0; j < 4; ++j) p[j * 64 + F.lane] = z; continue; } r -= I_PAD;
        if (r < I_CKV) {
#pragma unroll
            for (int j = 0; j < 4; ++j) { const int row = 4 * r + j; const float* s = F.a->in[IN_C_CKV] + (size_t)row * 512 + 8 * F.lane;
                const f32x4 a = *(const f32x4*)s, b = *(const f32x4*)(s + 4);
                u32x4 w; w.x = pk2(a[0], a[1]); w.y = pk2(a[2], a[3]); w.z = pk2(b[0], b[1]); w.w = pk2(b[2], b[3]);
                *(u32x4*)((bf16_t*)(ws + WS_CKVA) + (size_t)(NTOK + row) * 512 + 8 * F.lane) = w; }
            continue; } r -= I_CKV;
        if (r < I_NK) { p0_cacheK_item(F.a->in[IN_C_NAK], 8, (bf16_t*)(ws + WS_KN_CAC), r, F.lane); continue; } r -= I_NK;
        if (r < I_NV) { p0_cacheV_item(F.a->in[IN_C_NAV], 8, (bf16_t*)(ws + WS_VN_CAC), r, F.lane); continue; } r -= I_NV;
        if (r < I_GK) { p0_cacheK_item(F.a->in[IN_C_GK], 4, (bf16_t*)(ws + WS_KG_CAC), r, F.lane); continue; } r -= I_GK;
        p0_cacheV_item(F.a->in[IN_C_GV], 4, (bf16_t*)(ws + WS_VG_CAC), r, F.lane);
    }
}

__device__ __forceinline__ const float* x_in_row(Frame& F, int t) { return t < NCTX ? F.a->in[IN_XP] + (size_t)t * DM : F.a->in[IN_XS] + (size_t)(t - NCTX) * DM; }
__device__ __forceinline__ void phase_norm(Frame& F, bool from_input, int layer, int sub) {
    const float* g = F.a->in[IN_NORMG] + (size_t)(layer * 3 + sub) * DM;
    bf16_t* H = (bf16_t*)(F.ws + WS_H);
    const int lane = opaque_v(F.lane);
    for (int t = F.gw; t < NTOK; t += F.NGW) {
        const float* xr = from_input ? x_in_row(F, t) : F.out + (size_t)t * DM;
        const float* md = (const float*)(F.ws + WS_MODS) + ((size_t)layer * 9 + tok_mb(t)) * NMOD + (size_t)(3 * sub) * DM;
        f32x4 v[8]; float ss = 0.f;
#pragma unroll
        for (int j = 0; j < 8; ++j) { v[j] = *(const f32x4*)(xr + 256 * j + 4 * lane); ss += (v[j][0] * v[j][0] + v[j][1] * v[j][1]) + (v[j][2] * v[j][2] + v[j][3] * v[j][3]); }
        const float rstd = __builtin_amdgcn_rsqf(wave_sum(ss) * (1.0f / DM) + EPS);
#pragma unroll
        for (int j = 0; j < 8; ++j) { const int c = 256 * j + 4 * lane;
            const f32x4 gg = *(const f32x4*)(g + c), sh = *(const f32x4*)(md + c), sc = *(const f32x4*)(md + DM + c);
            const f32x4 y = (v[j] * rstd * gg) * (sc + 1.0f) + sh;
            u32x2 w; w.x = pk2(y[0], y[1]); w.y = pk2(y[2], y[3]);
            *(u32x2*)(H + (size_t)t * DM + c) = w; }
    }
}

struct EpiSwiGLU {
    static constexpr bool PERM = true;
    bf16_t* O;
    struct Ctx { int row0, col0; };
    __device__ __forceinline__ Ctx begin(const pg8::Unit& u, int wr, int wc, int fr, int fq) const { return Ctx{u.pm * 256 + wr * 64 + fr, u.pn * 128 + wc * 32 + 8 * fq}; }
    __device__ __forceinline__ void rows(const Ctx& c, const f32x4 (&v)[2][2], const pg8::Unit&, int ai, int m, int, int, int, int) const {
        float r[8];
#pragma unroll
        for (int n = 0; n < 2; ++n)
#pragma unroll
            for (int j = 0; j < 4; ++j) r[4 * n + j] = silu_f(v[0][n][j]) * v[1][n][j];
        u32x4 w; w.x = pk2(r[0], r[1]); w.y = pk2(r[2], r[3]); w.z = pk2(r[4], r[5]); w.w = pk2(r[6], r[7]);
        *(u32x4*)(O + (size_t)(c.row0 + ai * 128 + m * 16) * DFF + c.col0) = w;
    }
};
struct EpiResid {
    static constexpr bool PERM = false;
    const float* xp; const float* xs; bool from_input; float* out; const float* gate_base; float coef;
    struct Ctx { const float* xin; f32x4 gv[2][2]; int row0, col0; };
    __device__ __forceinline__ Ctx begin(const pg8::Unit& u, int wr, int wc, int fr, int fq) const {
        Ctx c; const int rowt = u.pm * 256; c.row0 = rowt + wr * 64 + fr; c.col0 = u.pn * 256 + wc * 32 + 4 * fq;
        const float* gt = gate_base + (size_t)tok_mb(rowt) * NMOD;
        c.xin = from_input ? (rowt < NCTX ? xp : xs - (size_t)NCTX * DM) : out;
#pragma unroll
        for (int bj = 0; bj < 2; ++bj)
#pragma unroll
            for (int n = 0; n < 2; ++n) c.gv[bj][n] = *(const f32x4*)(gt + c.col0 + bj * 128 + n * 16) * coef;
        return c;
    }
    __device__ __forceinline__ void rows(const Ctx& c, const f32x4 (&v)[2][2], const pg8::Unit&, int ai, int m, int, int, int, int) const {
        const size_t off = (size_t)(c.row0 + ai * 128 + m * 16) * DM + c.col0;
#pragma unroll
        for (int bj = 0; bj < 2; ++bj)
#pragma unroll
            for (int n = 0; n < 2; ++n) { const f32x4 xv = *(const f32x4*)(c.xin + off + bj * 128 + n * 16);
                *(f32x4*)(out + off + bj * 128 + n * 16) = xv + c.gv[bj][n] * v[bj][n]; }
        asm volatile("" ::: "memory");
    }
};
struct EpiBf16 {
    static constexpr bool PERM = true;
    bf16_t* C; int ldc;
    struct Ctx { int row0, col0; };
    __device__ __forceinline__ Ctx begin(const pg8::Unit& u, int wr, int wc, int fr, int fq) const { return Ctx{u.pm * 256 + wr * 64 + fr, u.pn * 256 + wc * 32 + 8 * fq}; }
    __device__ __forceinline__ void rows(const Ctx& c, const f32x4 (&v)[2][2], const pg8::Unit&, int ai, int m, int, int, int, int) const {
        bf16_t* rowp = C + (size_t)(c.row0 + ai * 128 + m * 16) * ldc + c.col0;
#pragma unroll
        for (int bj = 0; bj < 2; ++bj) { u32x4 w; w.x = pk2(v[bj][0][0], v[bj][0][1]); w.y = pk2(v[bj][0][2], v[bj][0][3]); w.z = pk2(v[bj][1][0], v[bj][1][1]); w.w = pk2(v[bj][1][2], v[bj][1][3]);
            *(u32x4*)(rowp + bj * 128) = w; }
    }
};
struct EpiF32 {
    static constexpr bool PERM = false;
    float* C; int ldc;
    struct Ctx { int row0, col0; };
    __device__ __forceinline__ Ctx begin(const pg8::Unit& u, int wr, int wc, int fr, int fq) const { return Ctx{u.pm * 256 + wr * 64 + fr, u.pn * 256 + wc * 32 + 4 * fq}; }
    __device__ __forceinline__ void rows(const Ctx& c, const f32x4 (&v)[2][2], const pg8::Unit&, int ai, int m, int, int, int, int) const {
        float* rowp = C + (size_t)(c.row0 + ai * 128 + m * 16) * ldc + c.col0;
#pragma unroll
        for (int bj = 0; bj < 2; ++bj)
#pragma unroll
            for (int n = 0; n < 2; ++n) *(f32x4*)(rowp + bj * 128 + n * 16) = v[bj][n];
    }
};

__device__ __forceinline__ void load8(const float* p, float (&v)[8]) { const f32x4 a = *(const f32x4*)p, b = *(const f32x4*)(p + 4); v[0] = a[0]; v[1] = a[1]; v[2] = a[2]; v[3] = a[3]; v[4] = b[0]; v[5] = b[1]; v[6] = b[2]; v[7] = b[3]; }
__device__ __forceinline__ void load8h(const bf16_t* p, float (&v)[8]) { const u32x4 w = *(const u32x4*)p;
    v[0] = __builtin_bit_cast(float, w.x << 16); v[1] = __builtin_bit_cast(float, w.x & 0xffff0000u); v[2] = __builtin_bit_cast(float, w.y << 16); v[3] = __builtin_bit_cast(float, w.y & 0xffff0000u);
    v[4] = __builtin_bit_cast(float, w.z << 16); v[5] = __builtin_bit_cast(float, w.z & 0xffff0000u); v[6] = __builtin_bit_cast(float, w.w << 16); v[7] = __builtin_bit_cast(float, w.w & 0xffff0000u); }
__device__ __forceinline__ u32x4 pack8(const float (&v)[8]) { u32x4 w; w.x = pk2(v[0], v[1]); w.y = pk2(v[2], v[3]); w.z = pk2(v[4], v[5]); w.w = pk2(v[6], v[7]); return w; }
__device__ __forceinline__ void store8f(float* p, const float (&v)[8]) { *(f32x4*)p = (f32x4){v[0], v[1], v[2], v[3]}; *(f32x4*)(p + 4) = (f32x4){v[4], v[5], v[6], v[7]}; }
template <int W> __device__ __forceinline__ float group_sum(float v) {
#pragma unroll
    for (int o = 1; o < W; o <<= 1) v += __shfl_xor(v, o);
    return v;
}

__device__ __forceinline__ void phase_post1_even(Frame& F) {
    const bf16_t* P = (const bf16_t*)(F.ws + WS_P);
    const float* qn_g = F.a->in[IN_QNORM]; const float* kvn_g = F.a->in[IN_KVNORM]; const float* naq_g = F.a->in[IN_NAQK]; const float* nak_g = F.a->in[IN_NAQK] + 128;
    bf16_t* CQN = (bf16_t*)(F.ws + WS_CQN); bf16_t* CKVA = (bf16_t*)(F.ws + WS_CKVA); bf16_t* QNA = (bf16_t*)(F.ws + WS_QNA);
    constexpr int NVT_CTX = 16 * 8 * 8, NVT_LAT = 8 * 8 * 32, NKR = NTOK / 16;
    for (int it = F.gw; it < NKR; it += F.NGW) {
        const int t0 = it * 16, lane = F.lane, lr = lane & 15, lq = lane >> 4;
        const bf16_t* ap = (const bf16_t*)(F.ws + WS_H) + (size_t)(t0 + lr) * DM + 8 * lq;
        const bf16_t* bp = (const bf16_t*)(F.ws + WS_WEI) + (size_t)(4096 + lr) * DM + 8 * lq;
        f32x4 acc[4];
#pragma unroll
        for (int j = 0; j < 4; ++j) acc[j] = (f32x4){0.f, 0.f, 0.f, 0.f};
#pragma unroll 8
        for (int kk = 0; kk < 64; ++kk) {
            const bf16x8 af = *(const bf16x8*)(ap + kk * 32);
#pragma unroll
            for (int j = 0; j < 4; ++j) { const bf16x8 bf = *(const bf16x8*)(bp + (size_t)j * 16 * DM + kk * 32); acc[j] = __builtin_amdgcn_mfma_f32_16x16x32_bf16(af, bf, acc[j], 0, 0, 0); }
        }
        float* kr = (float*)(F.ws + WS_KROPE);
#pragma unroll
        for (int j = 0; j < 4; ++j)
#pragma unroll
            for (int r = 0; r < 4; ++r) { const int t = t0 + 4 * lq + r, c = 16 * j + lr; kr[(size_t)t * 64 + c] = acc[j][r]; if (t < NCTX) F.out[O_KROPE + (size_t)t * 64 + c] = acc[j][r]; }
    }
    for (int it = F.gw; it < NTOK + NVT_CTX + NVT_LAT; it += F.NGW) {
        if (it < NTOK) {
            const int t = it, lane = F.lane; const bf16_t* pr = P + (size_t)t * IN_EVEN_P; const bool ctx = t < NCTX;
            float v[8], g[8];
            load8h(pr + 8 * lane, v); float ss = 0.f;
#pragma unroll
            for (int i = 0; i < 8; ++i) ss += v[i] * v[i];
            float rstd = __builtin_amdgcn_rsqf(wave_sum(ss) * (1.0f / 512) + EPS);
            load8(qn_g + 8 * lane, g);
#pragma unroll
            for (int i = 0; i < 8; ++i) v[i] = v[i] * rstd * g[i];
            *(u32x4*)(CQN + (size_t)t * 512 + 8 * lane) = pack8(v);
            load8h(pr + 512 + 8 * lane, v); ss = 0.f;
#pragma unroll
            for (int i = 0; i < 8; ++i) ss += v[i] * v[i];
            rstd = __builtin_amdgcn_rsqf(wave_sum(ss) * (1.0f / 512) + EPS);
            load8(kvn_g + 8 * lane, g);
#pragma unroll
            for (int i = 0; i < 8; ++i) v[i] = v[i] * rstd * g[i];
            if (ctx) store8f(F.out + O_CKV + (size_t)t * 512 + 8 * lane, v);
            *(u32x4*)(CKVA + (size_t)t * 512 + 8 * lane) = pack8(v);
            const int head = lane >> 3, d0 = (lane & 7) * 16;
            int b, s; if (ctx) { b = t >> 8; s = t & 255; } else { b = (t - NCTX) >> 10; s = (t - NCTX) & 1023; }
#pragma unroll
            for (int which = 0; which < 2; ++which) {
                const bf16_t* src = pr + 1024 + which * 1024 + head * 128 + d0; const float* gg = which ? nak_g : naq_g;
                float a[8], c[8], ga[8], gc[8]; load8h(src, a); load8h(src + 8, c); load8(gg + d0, ga); load8(gg + d0 + 8, gc);
                float q = 0.f;
#pragma unroll
                for (int i = 0; i < 8; ++i) q += a[i] * a[i] + c[i] * c[i];
                const float r2 = __builtin_amdgcn_rsqf(group_sum<8>(q) * (1.0f / 128) + EPS);
#pragma unroll
                for (int i = 0; i < 8; ++i) { a[i] = a[i] * r2 * ga[i]; c[i] = c[i] * r2 * gc[i]; }
                if (which == 0) { bf16_t* qd = QNA + (size_t)t * 1024 + head * 128 + d0; *(u32x4*)qd = pack8(a); *(u32x4*)(qd + 8) = pack8(c); }
                else {
                    if (ctx) { float* od = F.out + O_NAK + (size_t)t * 1024 + head * 128 + d0; store8f(od, a); store8f(od + 8, c); }
                    bf16_t* kb = ctx ? (bf16_t*)(F.ws + WS_KN_CTX) + (size_t)(b * 8 + head) * (256 * 128) : (bf16_t*)(F.ws + WS_KN_LAT) + (size_t)(b * 8 + head) * (1024 * 128);
                    *(u32x4*)(kb + k_chunk_off(128, s, d0 >> 3)) = pack8(a); *(u32x4*)(kb + k_chunk_off(128, s, (d0 >> 3) + 1)) = pack8(c);
                }
            }
            { const bf16_t* src = pr + 3072 + 16 * lane; float a[8], c[8]; load8h(src, a); load8h(src + 8, c); if (ctx) { float* od = F.out + O_NAV + (size_t)t * 1024 + 16 * lane; store8f(od, a); store8f(od + 8, c); } }
        } else {
            int r = it - NTOK;
            if (r < NVT_CTX) { const int t32 = r & 7, bh = r >> 3, b = bh >> 3, h = bh & 7;
                vt_tile_write_h(P + (size_t)(b * 256 + t32 * 32) * IN_EVEN_P + 3072 + h * 128, IN_EVEN_P, (bf16_t*)(F.ws + WS_VN_CTX) + (size_t)bh * (256 * 128) + (size_t)t32 * 4096, F.lane);
            } else { r -= NVT_CTX; const int t32 = r & 31, bh = r >> 5, b = bh >> 3, h = bh & 7;
                vt_tile_write_h(P + (size_t)(NCTX + b * 1024 + t32 * 32) * IN_EVEN_P + 3072 + h * 128, IN_EVEN_P, (bf16_t*)(F.ws + WS_VN_LAT) + (size_t)bh * (1024 * 128) + (size_t)t32 * 4096, F.lane);
            }
        }
    }
}

__device__ __forceinline__ void rope8(float (&v)[8], const float (&vp)[8], bool is_x1, float pos, int f0, float inv_nf) {
#pragma unroll
    for (int i = 0; i < 8; ++i) {
        const float invf = fast_exp2(-(float)(f0 + i) * inv_nf * 13.287712379549449f);
        const float rev = pos * invf * 0.15915494309189535f;
        const float cs = cos_rev(rev), sn = sin_rev(rev);
        v[i] = is_x1 ? (v[i] * cs - vp[i] * sn) : (vp[i] * sn + v[i] * cs);
    }
}

__device__ __forceinline__ void phase_post2_even(Frame& F) {
    const bf16_t* P = (const bf16_t*)(F.ws + WS_P); const bf16_t* QM = (const bf16_t*)(F.ws + WS_QM); const bf16_t* KVM = (const bf16_t*)(F.ws + WS_ACT);
    const float* gq = F.a->in[IN_MLAQK]; const float* gk = F.a->in[IN_MLAQK] + 192;
    bf16_t* QA = (bf16_t*)(F.ws + WS_QA);
    constexpr int NROW = 16384, NVT_CTX = 1024, NVT_LAT = 2048, NVT_CAC = 1024;
    const int lane = F.lane, hsub = lane >> 5, c = lane & 31; const bool act = c < 24;
    for (int it = F.gw; it < NTOK + NROW + NVT_CTX + NVT_LAT + NVT_CAC; it += F.NGW) {
        if (it < NTOK) {
            const int t = it; const bool lat = t >= NCTX; const int s = (t - NCTX) & 1023; const float row = (float)(s >> 6), col = (float)(s & 63);
            const int cc = act ? c : 23, cpq = cc >= 16 ? (cc ^ 2) : cc;
            float g[8], gp[8]; load8(gq + 8 * cc, g); load8(gq + 8 * cpq, gp);
            float v[4][8], vp[4][8];
#pragma unroll
            for (int pass = 0; pass < 4; ++pass) { const bf16_t* src = QM + (size_t)t * 1536 + (2 * pass + hsub) * 192; load8h(src + 8 * cc, v[pass]); load8h(src + 8 * cpq, vp[pass]); }
#pragma unroll
            for (int pass = 0; pass < 4; ++pass) {
                const int head = 2 * pass + hsub;
                float q = 0.f;
#pragma unroll
                for (int i = 0; i < 8; ++i) { v[pass][i] = act ? v[pass][i] : 0.f; q += v[pass][i] * v[pass][i]; }
                const float rstd = __builtin_amdgcn_rsqf(group_sum<32>(q) * (1.0f / 192) + EPS);
#pragma unroll
                for (int i = 0; i < 8; ++i) { v[pass][i] = v[pass][i] * rstd * g[i]; vp[pass][i] = vp[pass][i] * rstd * gp[i]; }
                if (lat && c >= 16 && act) rope8(v[pass], vp[pass], (c & 2) == 0, c < 20 ? row : col, (c & 1) * 8, 1.0f / 16);
                if (act) *(u32x4*)(QA + (size_t)t * 1536 + head * 192 + 8 * c) = pack8(v[pass]);
            }
        } else if (it < NTOK + NROW) {
            const int r = it - NTOK; const bool istok = r < NTOK; const bool lat = istok && r >= NCTX;
            int bsel, s; bf16_t* kb0; int nkeys;
            if (!istok) { bsel = (r - NTOK) >> 9; s = (r - NTOK) & 511; kb0 = (bf16_t*)(F.ws + WS_KM_CAC); nkeys = 512; }
            else if (lat) { bsel = (r - NCTX) >> 10; s = (r - NCTX) & 1023; kb0 = (bf16_t*)(F.ws + WS_KM_LAT); nkeys = 1024; }
            else { bsel = r >> 8; s = r & 255; kb0 = (bf16_t*)(F.ws + WS_KM_CTX); nkeys = 256; }
            const float* krp_f = istok ? (const float*)(F.ws + WS_KROPE) + (size_t)r * 64 : F.a->in[IN_C_KROPE] + (size_t)(r - NTOK) * 64;
            const float row = (float)(s >> 6), col = (float)(s & 63);
            const int cc = act ? c : 23, cpq = cc >= 16 ? (cc ^ 2) : cc, cn = c < 16 ? c : 15, cr = cc >= 16 ? cc - 16 : 0, crp = cc >= 16 ? cpq - 16 : 0;
            float g[8], gp[8], kr[8], krp[8]; load8(gk + 8 * cc, g); load8(gk + 8 * cpq, gp); load8(krp_f + 8 * cr, kr); load8(krp_f + 8 * crp, krp);
            float v[4][8];
#pragma unroll
            for (int pass = 0; pass < 4; ++pass) load8h(KVM + (size_t)r * 2048 + (2 * pass + hsub) * 256 + 8 * cn, v[pass]);
#pragma unroll
            for (int pass = 0; pass < 4; ++pass) {
                const int head = 2 * pass + hsub;
                float vp[8]; float q = 0.f;
#pragma unroll
                for (int i = 0; i < 8; ++i) { v[pass][i] = c < 16 ? v[pass][i] : (act ? kr[i] : 0.f); q += v[pass][i] * v[pass][i]; }
                const float rstd = __builtin_amdgcn_rsqf(group_sum<32>(q) * (1.0f / 192) + EPS);
#pragma unroll
                for (int i = 0; i < 8; ++i) { v[pass][i] = v[pass][i] * rstd * g[i]; vp[i] = krp[i] * rstd * gp[i]; }
                if (lat && c >= 16 && act) rope8(v[pass], vp, (c & 2) == 0, c < 20 ? row : col, (c & 1) * 8, 1.0f / 16);
                if (act) *(u32x4*)(kb0 + (size_t)(bsel * 8 + head) * ((size_t)nkeys * 192) + k_chunk_off(192, s, c)) = pack8(v[pass]);
            }
        } else {
            int r = it - NTOK - NROW;
            if (r < NVT_CTX) { const int t32 = r & 7, bh = r >> 3, b = bh >> 3, h = bh & 7;
                vt_tile_write_h(KVM + (size_t)(b * 256 + t32 * 32) * 2048 + h * 256 + 128, 2048, (bf16_t*)(F.ws + WS_VM_CTX) + (size_t)bh * (256 * 128) + (size_t)t32 * 4096, lane);
            } else if (r < NVT_CTX + NVT_LAT) { r -= NVT_CTX; const int t32 = r & 31, bh = r >> 5, b = bh >> 3, h = bh & 7;
                vt_tile_write_h(KVM + (size_t)(NCTX + b * 1024 + t32 * 32) * 2048 + h * 256 + 128, 2048, (bf16_t*)(F.ws + WS_VM_LAT) + (size_t)bh * (1024 * 128) + (size_t)t32 * 4096, lane);
            } else { r -= NVT_CTX + NVT_LAT; const int t32 = r & 15, bh = r >> 4, b = bh >> 3, h = bh & 7;
                vt_tile_write_h(KVM + (size_t)(NTOK + b * 512 + t32 * 32) * 2048 + h * 256 + 128, 2048, (bf16_t*)(F.ws + WS_VM_CAC) + (size_t)bh * (512 * 128) + (size_t)t32 * 4096, lane);
            }
        }
    }
}

__device__ __forceinline__ void phase_post_odd(Frame& F) {
    const bf16_t* P = (const bf16_t*)(F.ws + WS_P); const float* gq = F.a->in[IN_GQK]; const float* gk = F.a->in[IN_GQK] + 128;
    bf16_t* QA = (bf16_t*)(F.ws + WS_QA);
    constexpr int NVT_CTX = 16 * 4 * 8, NVT_LAT = 8 * 4 * 32;
    const int lane = F.lane, hsub = lane >> 4, c = lane & 15;
    for (int it = F.gw; it < NTOK + NVT_CTX + NVT_LAT; it += F.NGW) {
        if (it < NTOK) {
            const int t = it; const bool ctx = t < NCTX, lat = !ctx; const bf16_t* pr = P + (size_t)t * IN_ODD;
            int b, s; if (ctx) { b = t >> 8; s = t & 255; } else { b = (t - NCTX) >> 10; s = (t - NCTX) & 1023; }
            const float row = (float)(s >> 6), col = (float)(s & 63);
            const int cp = c ^ 4;
            float gqv[8], gqp[8], gkv[8], gkp[8]; load8(gq + 8 * c, gqv); load8(gq + 8 * cp, gqp); load8(gk + 8 * c, gkv); load8(gk + 8 * cp, gkp);
            float v[5][8], vp[5][8];
#pragma unroll
            for (int pass = 0; pass < 5; ++pass) { const bf16_t* src = pr + (pass == 4 ? 2048 + hsub * 128 : (4 * pass + hsub) * 128); load8h(src + 8 * c, v[pass]); load8h(src + 8 * cp, vp[pass]); }
#pragma unroll
            for (int pass = 0; pass < 5; ++pass) {
                const bool isk = pass == 4; const int head = isk ? hsub : 4 * pass + hsub;
                float q = 0.f;
#pragma unroll
                for (int i = 0; i < 8; ++i) q += v[pass][i] * v[pass][i];
                const float rstd = __builtin_amdgcn_rsqf(group_sum<16>(q) * (1.0f / 128) + EPS);
#pragma unroll
                for (int i = 0; i < 8; ++i) { v[pass][i] = v[pass][i] * rstd * (isk ? gkv[i] : gqv[i]); vp[pass][i] = vp[pass][i] * rstd * (isk ? gkp[i] : gqp[i]); }
                if (isk && ctx) store8f(F.out + O_GK + (size_t)t * 512 + head * 128 + 8 * c, v[pass]);
                if (lat) rope8(v[pass], vp[pass], (c & 4) == 0, c < 8 ? row : col, (c & 3) * 8, 1.0f / 32);
                if (!isk) *(u32x4*)(QA + (size_t)t * 2048 + head * 128 + 8 * c) = pack8(v[pass]);
                else { bf16_t* kb = ctx ? (bf16_t*)(F.ws + WS_KG_CTX) + (size_t)(b * 4 + head) * (256 * 128) : (bf16_t*)(F.ws + WS_KG_LAT) + (size_t)(b * 4 + head) * (1024 * 128);
                    *(u32x4*)(kb + k_chunk_off(128, s, c)) = pack8(v[pass]); }
            }
            { float vv[8]; load8h(pr + 2560 + 8 * lane, vv); if (ctx) store8f(F.out + O_GV + (size_t)t * 512 + 8 * lane, vv); }
        } else {
            int r = it - NTOK;
            if (r < NVT_CTX) { const int t32 = r & 7, bh = r >> 3, b = bh >> 2, h = bh & 3;
                vt_tile_write_h(P + (size_t)(b * 256 + t32 * 32) * IN_ODD + 2560 + h * 128, IN_ODD, (bf16_t*)(F.ws + WS_VG_CTX) + (size_t)bh * (256 * 128) + (size_t)t32 * 4096, lane);
            } else { r -= NVT_CTX; const int t32 = r & 31, bh = r >> 5, b = bh >> 2, h = bh & 3;
                vt_tile_write_h(P + (size_t)(NCTX + b * 1024 + t32 * 32) * IN_ODD + 2560 + h * 128, IN_ODD, (bf16_t*)(F.ws + WS_VG_LAT) + (size_t)bh * (1024 * 128) + (size_t)t32 * 4096, lane);
            }
        }
    }
}

struct WgUnit {
    const bf16_t* kc; const bf16_t* vc; int nctx;
    const bf16_t* kl; const bf16_t* vl; int t_lo, t_hi;
};
struct WvUnit {
    const bf16_t* qb; unsigned qoff; int qpitch; bf16_t* ob; unsigned ooff;
    int qpos;
    int qcol0;
    int w_lo, w_hi;
    float sink; int has_sink; float scale;
};
constexpr int ATT_RPB_OFF = RING_BYTES + 512;
constexpr float ATT_THR = 8.0f;
template <int MODE>
__device__ __forceinline__ float attn_mask(float v, int tile32, int r, int hh, int ql, bool masked, const WvUnit& U, const LAS float* rpb) {
    const int kk = (r & 3) + 8 * (r >> 2) + 4 * hh;
    if (MODE == 1) { const int df = U.qpos + ql - (tile32 * 32 + kk); if (masked && (df > 128 || df < -128)) v = -1e30f; }
    if (MODE == 2 && masked) { const int krow = tile32 >> 1, kcol = (tile32 & 1) * 32 + kk, qc = U.qcol0 + ql;
        int ws = qc - 8; ws = ws < 0 ? 0 : (ws > 48 ? 48 : ws);
        const bool valid = (kcol >= ws) && (kcol < ws + 16);
        int co = kcol - qc; co = co < -15 ? -15 : (co > 15 ? 15 : co);
        const float bias = rpb[(krow - U.qpos + 7) * 31 + co + 15];
        v = valid ? v + bias * LOG2E : -1e30f; }
    return v;
}
template <int OFF> __device__ __forceinline__ bf16x8 lds_rd(unsigned addr) { bf16x8 r; asm volatile("ds_read_b128 %0, %1 offset:%2" : "=v"(r) : "v"(addr), "i"(OFF)); return r; }
template <int BASE, int H1> __device__ __forceinline__ void lds_rd8(unsigned addr, bf16x8 (&a)[8]) {
    a[0] = lds_rd<BASE>(addr); a[1] = lds_rd<BASE + 1024>(addr); a[2] = lds_rd<BASE + 2048>(addr); a[3] = lds_rd<BASE + 3072>(addr);
    a[4] = lds_rd<BASE + H1>(addr); a[5] = lds_rd<BASE + H1 + 1024>(addr); a[6] = lds_rd<BASE + H1 + 2048>(addr); a[7] = lds_rd<BASE + H1 + 3072>(addr);
}
#define LDS_WAIT8(n, a) asm volatile("s_waitcnt lgkmcnt(" #n ")" : "+v"(a[0]), "+v"(a[1]), "+v"(a[2]), "+v"(a[3]), "+v"(a[4]), "+v"(a[5]), "+v"(a[6]), "+v"(a[7]))
#define QK_MMA8(a, kb) do { _Pragma("unroll") for (int _j = 0; _j < 4; ++_j) { s0 = __builtin_amdgcn_mfma_f32_32x32x16_bf16(a[_j], qf[(kb) * 4 + _j], s0, 0, 0, 0); s1 = __builtin_amdgcn_mfma_f32_32x32x16_bf16(a[4 + _j], qf[(kb) * 4 + _j], s1, 0, 0, 0); } } while (0)
template <int DQK, int MODE>
__device__ __forceinline__ void attn_tile64(const LAS unsigned char* sl, int t64, bool masked, const bf16x8 (&qf)[DQK / 16], f32x16 (&o)[4], float& m, float& l, const WvUnit& U, const LAS float* rpb, int lane, float sl2) {
    constexpr int NKS = DQK / 16, KB = DQK * 128;
    const int ql = lane & 31, hh = lane >> 5;
    const unsigned addr = (unsigned)(unsigned long)sl + (unsigned)lane * 16u;
    f32x16 s0, s1;
#pragma unroll
    for (int r = 0; r < 16; ++r) { s0[r] = 0.f; s1[r] = 0.f; }
    bf16x8 pb[4];
#define ATT_SMA(sx, T32) do { float mt = -1e30f; \
    if (MODE == 1) { if (masked) {   \
            _Pragma("unroll") for (int r = 0; r < 16; ++r) sx[r] = attn_mask<MODE>(sx[r] * sl2, (T32), r, hh, ql, true, U, rpb); } } \
    if (MODE == 2) { _Pragma("unroll") for (int r = 0; r < 16; ++r) sx[r] = attn_mask<MODE>(sx[r] * sl2, (T32), r, hh, ql, masked, U, rpb); } \
    _Pragma("unroll") for (int r = 0; r < 16; ++r) mt = fmaxf(mt, sx[r]); \
    if (MODE == 0 || (MODE == 1 && !masked)) mt *= sl2;     \
    mt = fmaxf(mt, __shfl_xor(mt, 32)); \
    if (!__all(mt - m <= ATT_THR)) { const float mn = fmaxf(m, mt), alpha = fast_exp2(m - mn); m = mn; l *= alpha; \
        _Pragma("unroll") for (int db = 0; db < 4; ++db) _Pragma("unroll") for (int r = 0; r < 16; ++r) o[db][r] *= alpha; } } while (0)
#define ATT_SMB(sx, PBI) do { float ps = 0.f; const float esc = (MODE == 0 || (MODE == 1 && !masked)) ? sl2 : 1.0f; \
    _Pragma("unroll") for (int r = 0; r < 16; ++r) { sx[r] = fast_exp2(fmaf(sx[r], esc, -m)); ps += sx[r]; } \
    l += ps; \
    _Pragma("unroll") for (int s2 = 0; s2 < 2; ++s2) { \
        u32x4 w; w.x = pk2(sx[8 * s2 + 0], sx[8 * s2 + 1]); w.y = pk2(sx[8 * s2 + 2], sx[8 * s2 + 3]); w.z = pk2(sx[8 * s2 + 4], sx[8 * s2 + 5]); w.w = pk2(sx[8 * s2 + 6], sx[8 * s2 + 7]); pb[(PBI) + s2] = __builtin_bit_cast(bf16x8, w); } } while (0)
#define MFMA32(a_, b_, c_) __builtin_amdgcn_mfma_f32_32x32x16_bf16(a_, b_, c_, 0, 0, 0)
    if constexpr (NKS == 8) {
        bf16x8 ka[8], kb_[8];
        lds_rd8<0, 4096>(addr, ka); lds_rd8<KB / 2, 4096>(addr, kb_);
        LDS_WAIT8(8, ka);
#pragma unroll
        for (int j = 0; j < 8; ++j) s0 = MFMA32(ka[j], qf[j], s0);
        lds_rd8<KB, 4096>(addr, ka);
        LDS_WAIT8(8, kb_);
#pragma unroll
        for (int j = 0; j < 4; ++j) s1 = MFMA32(kb_[j], qf[j], s1);
        ATT_SMA(s0, 2 * t64);
#pragma unroll
        for (int j = 4; j < 8; ++j) s1 = MFMA32(kb_[j], qf[j], s1);
        ATT_SMB(s0, 0);
        lds_rd8<KB + 8192, 4096>(addr, kb_);
        LDS_WAIT8(8, ka);
#pragma unroll
        for (int db = 0; db < 4; ++db) o[db] = MFMA32(ka[db], pb[0], o[db]);
        ATT_SMA(s1, 2 * t64 + 1);
#pragma unroll
        for (int db = 0; db < 4; ++db) o[db] = MFMA32(ka[4 + db], pb[1], o[db]);
        ATT_SMB(s1, 2);
        LDS_WAIT8(0, kb_);
#pragma unroll
        for (int s2 = 0; s2 < 2; ++s2)
#pragma unroll
            for (int db = 0; db < 4; ++db) o[db] = MFMA32(kb_[s2 * 4 + db], pb[2 + s2], o[db]);
    } else {
        bf16x8 ka[4], kb_[4];
#define RDK4(a, h, b) do { a[0] = lds_rd<(h) * (KB / 2) + (b) * 4096>(addr); a[1] = lds_rd<(h) * (KB / 2) + (b) * 4096 + 1024>(addr); a[2] = lds_rd<(h) * (KB / 2) + (b) * 4096 + 2048>(addr); a[3] = lds_rd<(h) * (KB / 2) + (b) * 4096 + 3072>(addr); } while (0)
#define RDV4(a, q) do { a[0] = lds_rd<KB + (q) * 4096>(addr); a[1] = lds_rd<KB + (q) * 4096 + 1024>(addr); a[2] = lds_rd<KB + (q) * 4096 + 2048>(addr); a[3] = lds_rd<KB + (q) * 4096 + 3072>(addr); } while (0)
#define WAIT4(n, a) asm volatile("s_waitcnt lgkmcnt(" #n ")" : "+v"(a[0]), "+v"(a[1]), "+v"(a[2]), "+v"(a[3]))
#define QK4(a, sx, b) do { _Pragma("unroll") for (int j = 0; j < 4; ++j) sx = MFMA32(a[j], qf[4 * (b) + j], sx); } while (0)
#define PV4(a, q) do { _Pragma("unroll") for (int db = 0; db < 4; ++db) o[db] = MFMA32(a[db], pb[q], o[db]); } while (0)
        RDK4(ka, 0, 0); RDK4(kb_, 0, 1);
        WAIT4(4, ka); QK4(ka, s0, 0); RDK4(ka, 0, 2);
        WAIT4(4, kb_); QK4(kb_, s0, 1); RDK4(kb_, 1, 0);
        WAIT4(4, ka); QK4(ka, s0, 2); RDK4(ka, 1, 1);
        WAIT4(4, kb_); QK4(kb_, s1, 0); RDK4(kb_, 1, 2);
        ATT_SMA(s0, 2 * t64);
        WAIT4(4, ka); QK4(ka, s1, 1); RDV4(ka, 0);
        ATT_SMB(s0, 0);
        WAIT4(4, kb_); QK4(kb_, s1, 2); RDV4(kb_, 1);
        WAIT4(4, ka); PV4(ka, 0); RDV4(ka, 2);
        ATT_SMA(s1, 2 * t64 + 1);
        WAIT4(4, kb_); PV4(kb_, 1); RDV4(kb_, 3);
        ATT_SMB(s1, 2);
        WAIT4(4, ka); PV4(ka, 2);
        WAIT4(0, kb_); PV4(kb_, 3);
#undef RDK4
#undef RDV4
#undef WAIT4
#undef QK4
#undef PV4
    }
#undef ATT_SMA
#undef ATT_SMB
#undef MFMA32
}
template <int DQK, int MODE, int VAR = 0>
__device__ __forceinline__ void attn_wg_unit(LAS unsigned char* ring, const WgUnit& G, const WvUnit& U, const float* rpb_g, int tid, int wave, int lane) {
    constexpr int NKS = DQK / 16, KB = DQK * 128, NLK = KB / 8192;
    constexpr int NS = (DQK == 128) ? 4 : 3, SLOTB = KB + 16384;
    const int ql = lane & 31, hh = lane >> 5;
    const int ntiles = G.nctx + (G.t_hi - G.t_lo);
    const LAS float* rpb = (const LAS float*)(ring + ATT_RPB_OFF);
#define ATT_ISSUE(i, SLOTC) do { const int _i = (i); const bool _c = _i < G.nctx; const int _t = _c ? _i : G.t_lo + (_i - G.nctx); \
        const char* _kg = (const char*)(_c ? G.kc : G.kl) + (size_t)_t * KB + tid * 16; const char* _vg = (const char*)(_c ? G.vc : G.vl) + (size_t)_t * 16384 + tid * 16; \
        LAS unsigned char* _sl = ring + (SLOTC) * SLOTB + wave * 1024; \
        _Pragma("unroll") for (int _p = 0; _p < NLK; ++_p) __builtin_amdgcn_global_load_lds((const unsigned*)(_kg + _p * 8192), (LAS unsigned*)(_sl + _p * 8192), 16, 0, 0); \
        _Pragma("unroll") for (int _p = 0; _p < 2; ++_p) __builtin_amdgcn_global_load_lds((const unsigned*)(_vg + _p * 8192), (LAS unsigned*)(_sl + KB + _p * 8192), 16, 0, 0); } while (0)
    asm volatile("s_waitcnt lgkmcnt(0)" ::: "memory"); __builtin_amdgcn_s_barrier(); asm volatile("" ::: "memory");
    bf16x8 qf[NKS];
#pragma unroll
    for (int ks = 0; ks < NKS; ++ks) qf[ks] = *(const bf16x8*)(U.qb + (size_t)(U.qoff + (unsigned)(ql * U.qpitch + 16 * ks + 8 * hh)));
    if (MODE == 2) { const int i = opaque_v(tid); if (i < 15 * 31) ((LAS float*)(ring + ATT_RPB_OFF))[i] = rpb_g[i]; }
    if (VAR != 2) { ATT_ISSUE(0, 0); if (ntiles > 1) ATT_ISSUE(1, 1); if (NS == 4 && ntiles > 2) ATT_ISSUE(2, 2); }
    f32x16 o[4];
#pragma unroll
    for (int db = 0; db < 4; ++db)
#pragma unroll
        for (int r = 0; r < 16; ++r) o[db][r] = 0.f;
    float m = -1e30f, l = 0.f;
    const float sl2 = U.scale * LOG2E;
#define ATT_STEP(i_, SLOTC) do { const int i = (i_); if (i < ntiles) { \
        if (NS == 4) { if (i + 2 < ntiles) asm volatile("s_waitcnt vmcnt(8)" ::: "memory"); else if (i + 1 < ntiles) asm volatile("s_waitcnt vmcnt(4)" ::: "memory"); else asm volatile("s_waitcnt vmcnt(0)" ::: "memory"); } \
        else { if (i + 1 < ntiles) asm volatile("s_waitcnt vmcnt(5)" ::: "memory"); else asm volatile("s_waitcnt vmcnt(0)" ::: "memory"); } \
        asm volatile("s_waitcnt lgkmcnt(0)" ::: "memory"); __builtin_amdgcn_s_barrier(); asm volatile("" ::: "memory"); \
        if (VAR != 2 && i + NS - 1 < ntiles) ATT_ISSUE(i + NS - 1, ((SLOTC) + NS - 1) % NS); \
        const bool isctx = i < G.nctx; const int t64 = isctx ? 0 : G.t_lo + (i - G.nctx); \
        if (VAR != 1 && (isctx || (t64 >= U.w_lo && t64 < U.w_hi))) attn_tile64<DQK, MODE>(ring + (SLOTC) * SLOTB, t64, !isctx, qf, o, m, l, U, rpb, lane, sl2); } } while (0)
    if constexpr (NS == 4) { for (int i0 = 0; i0 < ntiles; i0 += 4) { ATT_STEP(i0, 0); ATT_STEP(i0 + 1, 1); ATT_STEP(i0 + 2, 2); ATT_STEP(i0 + 3, 3); } }
    else { for (int i0 = 0; i0 < ntiles; i0 += 3) { ATT_STEP(i0, 0); ATT_STEP(i0 + 1, 1); ATT_STEP(i0 + 2, 2); } }
#undef ATT_STEP
#undef ATT_ISSUE
    l += __shfl_xor(l, 32);
    if (U.has_sink) l += fast_exp2(U.sink * LOG2E - m);
    const float inv = 1.0f / l;
    bf16_t* op = U.ob + (size_t)(U.ooff + (unsigned)(opaque_v(ql) * DM));
#pragma unroll
    for (int db = 0; db < 4; ++db)
#pragma unroll
        for (int rg = 0; rg < 4; ++rg) { u32x2 w; w.x = pk2(o[db][4 * rg] * inv, o[db][4 * rg + 1] * inv); w.y = pk2(o[db][4 * rg + 2] * inv, o[db][4 * rg + 3] * inv);
            *(u32x2*)(op + 32 * db + 8 * rg + 4 * hh) = w; }
}

template <int VAR>
__device__ __forceinline__ void phase_attn_even(Frame& F, bf16_t* O) {
 const bf16_t* QA = (const bf16_t*)(F.ws + WS_QA); const bf16_t* QNA = (const bf16_t*)(F.ws + WS_QNA);
    const int wave = F.wave, lane = F.lane, tid = F.tid;
    WgUnit G; WvUnit U; U.sink = 0.f; U.has_sink = 0; U.qpos = 0; U.qcol0 = 0;
    const int vcu = (F.G % 8 == 0) ? ((int)blockIdx.x % 8) * (F.G / 8) + (int)blockIdx.x / 8 : (int)blockIdx.x;
    for (int u = vcu; u < 256; u += F.G) { const int bh = u >> 2, q4 = u & 3, b = bh >> 3, h = bh & 7, t0 = NCTX + b * 1024 + q4 * 256 + 32 * wave;
        U.qb = QA; U.qoff = (unsigned)(t0 * 1536 + h * 192); U.qpitch = 1536; U.scale = 0.07216878364870322f; U.ob = O; U.ooff = (unsigned)(t0 * DM + h * 128);
        G.kc = (const bf16_t*)(F.ws + WS_KM_CAC) + (size_t)bh * (512 * 192); G.vc = (const bf16_t*)(F.ws + WS_VM_CAC) + (size_t)bh * (512 * 128); G.nctx = 8;
        G.kl = (const bf16_t*)(F.ws + WS_KM_LAT) + (size_t)bh * (1024 * 192); G.vl = (const bf16_t*)(F.ws + WS_VM_LAT) + (size_t)bh * (1024 * 128); G.t_lo = 0; G.t_hi = 16; U.w_lo = 0; U.w_hi = 16;
        attn_wg_unit<192, 0, VAR>(F.lds, G, U, nullptr, tid, wave, lane); }
    for (int u = vcu; u < 256; u += F.G) { const int bh = u >> 2, r0 = (u & 3) * 4, b = bh >> 3, h = bh & 7, r = r0 + (wave >> 1), c0 = (wave & 1) * 32, t0 = NCTX + b * 1024 + r * 64 + c0;
        int rs = r - 4; rs = rs < 0 ? 0 : (rs > 8 ? 8 : rs);
        int glo = r0 - 4; glo = glo < 0 ? 0 : (glo > 8 ? 8 : glo); int ghi = r0 - 1; ghi = ghi < 0 ? 0 : (ghi > 8 ? 8 : ghi);
        U.qb = QNA; U.qoff = (unsigned)(t0 * 1024 + h * 128); U.qpitch = 1024; U.scale = 0.08838834764831845f; U.ob = O; U.ooff = (unsigned)(t0 * DM + 1024 + h * 128);
        G.kc = (const bf16_t*)(F.ws + WS_KN_CAC) + (size_t)bh * (512 * 128); G.vc = (const bf16_t*)(F.ws + WS_VN_CAC) + (size_t)bh * (512 * 128); G.nctx = 8;
        G.kl = (const bf16_t*)(F.ws + WS_KN_LAT) + (size_t)bh * (1024 * 128); G.vl = (const bf16_t*)(F.ws + WS_VN_LAT) + (size_t)bh * (1024 * 128); G.t_lo = glo; G.t_hi = ghi + 8; U.w_lo = rs; U.w_hi = rs + 8;
        U.qpos = r; U.qcol0 = c0;
        attn_wg_unit<128, 2, VAR>(F.lds, G, U, F.a->in[IN_RPB] + h * (15 * 31), tid, wave, lane); }
    U.qpos = 0; U.qcol0 = 0; U.w_lo = 0; U.w_hi = 4; G.nctx = 0; G.kc = nullptr; G.vc = nullptr; G.t_lo = 0; G.t_hi = 4;
    for (int u = vcu; u < 256; u += F.G) { const int bh = u & 127, b = bh >> 3, h = bh & 7, t0 = b * 256 + 32 * wave;
        if (u < 128) {
            U.qb = QA; U.qoff = (unsigned)(t0 * 1536 + h * 192); U.qpitch = 1536; U.scale = 0.07216878364870322f; U.ob = O; U.ooff = (unsigned)(t0 * DM + h * 128);
            G.kl = (const bf16_t*)(F.ws + WS_KM_CTX) + (size_t)bh * (256 * 192); G.vl = (const bf16_t*)(F.ws + WS_VM_CTX) + (size_t)bh * (256 * 128);
            attn_wg_unit<192, 0, VAR>(F.lds, G, U, nullptr, tid, wave, lane);
        } else {
            U.qb = QNA; U.qoff = (unsigned)(t0 * 1024 + h * 128); U.qpitch = 1024; U.scale = 0.08838834764831845f; U.ob = O; U.ooff = (unsigned)(t0 * DM + 1024 + h * 128);
            G.kl = (const bf16_t*)(F.ws + WS_KN_CTX) + (size_t)bh * (256 * 128); G.vl = (const bf16_t*)(F.ws + WS_VN_CTX) + (size_t)bh * (256 * 128);
            attn_wg_unit<128, 0, VAR>(F.lds, G, U, nullptr, tid, wave, lane);
        } }
    asm volatile("s_waitcnt vmcnt(0) lgkmcnt(0)" ::: "memory"); __syncthreads();
}
__device__ __forceinline__ void phase_attn_odd(Frame& F) {
    bf16_t* O = (bf16_t*)(F.ws + WS_O); const bf16_t* QA = (const bf16_t*)(F.ws + WS_QA);
    const int wave = F.wave, lane = F.lane, tid = F.tid;
    WgUnit G; WvUnit U; U.has_sink = 1; U.qcol0 = 0; U.qpitch = 2048; U.scale = 0.08838834764831845f;
    const int vcu = (F.G % 8 == 0) ? ((int)blockIdx.x % 8) * (F.G / 8) + (int)blockIdx.x / 8 : (int)blockIdx.x;
    const float* sink = F.a->in[IN_SINK];
    for (int u = vcu; u < 512; u += F.G) { const int bk = u >> 4, q64 = u & 15, b = bk >> 2, kvh = bk & 3, g = wave >> 1, hq = kvh * 4 + g, qs = q64 * 64 + (wave & 1) * 32, t0 = NCTX + b * 1024 + qs;
        U.qb = QA; U.qoff = (unsigned)(t0 * 2048 + hq * 128); U.ob = O; U.ooff = (unsigned)(t0 * DM + hq * 128); U.qpos = qs; U.sink = sink[hq];
        G.kc = (const bf16_t*)(F.ws + WS_KG_CAC) + (size_t)bk * (512 * 128); G.vc = (const bf16_t*)(F.ws + WS_VG_CAC) + (size_t)bk * (512 * 128); G.nctx = 8;
        G.kl = (const bf16_t*)(F.ws + WS_KG_LAT) + (size_t)bk * (1024 * 128); G.vl = (const bf16_t*)(F.ws + WS_VG_LAT) + (size_t)bk * (1024 * 128);
        G.t_lo = q64 - 2 < 0 ? 0 : q64 - 2; G.t_hi = (q64 + 2 > 15 ? 15 : q64 + 2) + 1; U.w_lo = G.t_lo; U.w_hi = G.t_hi;
        attn_wg_unit<128, 1>(F.lds, G, U, nullptr, tid, wave, lane); }
    G.nctx = 0; G.kc = nullptr; G.vc = nullptr; G.t_lo = 0; G.t_hi = 4; U.w_lo = 0; U.w_hi = 4;
    for (int u = vcu; u < 256; u += F.G) { const int bk = u >> 2, q64 = u & 3, b = bk >> 2, kvh = bk & 3, g = wave >> 1, hq = kvh * 4 + g, qs = q64 * 64 + (wave & 1) * 32, t0 = b * 256 + qs;
        U.qb = QA; U.qoff = (unsigned)(t0 * 2048 + hq * 128); U.ob = O; U.ooff = (unsigned)(t0 * DM + hq * 128); U.qpos = 0; U.sink = sink[hq];
        G.kl = (const bf16_t*)(F.ws + WS_KG_CTX) + (size_t)bk * (256 * 128); G.vl = (const bf16_t*)(F.ws + WS_VG_CTX) + (size_t)bk * (256 * 128);
        attn_wg_unit<128, 0>(F.lds, G, U, nullptr, tid, wave, lane); }
    asm volatile("s_waitcnt vmcnt(0) lgkmcnt(0)" ::: "memory"); __syncthreads();
}

constexpr int N_PHASES = 36;
__global__ void __launch_bounds__(512, 2) fwd_kernel(Args args) {
    extern __shared__ __attribute__((aligned(16))) unsigned char lds_raw[];
    Frame F;
    F.lds = (LAS unsigned char*)lds_raw;
    F.tid = threadIdx.x; F.lane = F.tid & 63; F.wave = __builtin_amdgcn_readfirstlane(F.tid >> 6);
    F.G = gridDim.x; F.gw = blockIdx.x * 8 + F.wave; F.NGW = F.G * 8;
    F.a = &args; F.out = args.out; F.ws = args.ws;
    volatile LAS unsigned* MISC = (volatile LAS unsigned*)(F.lds + LDSCTL_OFF);
    for (int u = F.tid; u < (LDS_BYTES - LDSCTL_OFF) / 4; u += 512) ((LAS unsigned*)(F.lds + LDSCTL_OFF))[u] = 0u;
    __syncthreads();
    unsigned* ctl = (unsigned*)(F.ws + WS_CTL);
    const int lo = args.ph_lo, hi = args.ph_hi;
    const bool multi = (hi - lo) > 1;
    XcdBarrier bar; bar.bar = ctl + CW_BAR; bar.x = 0; bar.st = nullptr;
    if (multi) bar = xcd_barrier_post(ctl + CW_BAR, MISC + 8);
#define IN(k) (lo <= (k) && (k) < hi)
    int ph = 0;
#define PHASE(...) do { if (IN(ph)) { __VA_ARGS__ } if (IN(ph) && IN(ph + 1)) xcd_barrier(bar); ++ph; } while (0)
    const float* mods = (const float*)(F.ws + WS_MODS);
    bf16_t* H = (bf16_t*)(F.ws + WS_H); bf16_t* ACT = (bf16_t*)(F.ws + WS_ACT); float* P = (float*)(F.ws + WS_P); bf16_t* OB = (bf16_t*)(F.ws + WS_O);
    LAS unsigned char* ring = F.lds;
    const int cid = (int)blockIdx.x;
#define GEMM2(EPI_T, EDEF, A_, B_, M_, N_, K_, SLAB) \
    PHASE( pg8::Gemm g{(A_), (B_), (M_), (N_), (K_)}; typedef pg8::SplitOrder<(M_), (N_), (K_), true> SO; SO S; S.init(cid); EDEF; pg8::gemm_phase<EPI_T, SO, true, true>(ring, g, S, E, (SLAB)); ); \
    PHASE( typedef pg8::SplitOrder<(M_), (N_), (K_), true> SO; EDEF; pg8::gemm_fixup<EPI_T, SO>(E, (SLAB)); )
#define GEMM1(EPI_T, EDEF, A_, B_, M_, N_, K_) \
    PHASE( pg8::Gemm g{(A_), (B_), (M_), (N_), (K_)}; typedef pg8::SplitOrder<(M_), (N_), (K_), false> SO; SO S; S.init(cid); EDEF; pg8::gemm_phase<EPI_T, SO, true, true>(ring, g, S, E, nullptr); )
#define W_FI(layer, f) ((const bf16_t*)(F.ws + WS_WFI) + (size_t)((layer) * 2 + (f)) * NFF2 * DM)
#define W_FO(layer, f) ((const bf16_t*)(F.ws + WS_WFO) + (size_t)((layer) * 2 + (f)) * DM * DFF)
#define E_SWIGLU EpiSwiGLU E{ACT}
#define E_RESID(layer, gidx, coef, from_in) EpiResid E{F.a->in[IN_XP], F.a->in[IN_XS], (from_in), F.out, mods + (size_t)(layer) * 9 * NMOD + (size_t)(gidx) * DM, (coef)}
#define FFN(layer, f, from_in) \
    GEMM2(EpiSwiGLU, E_SWIGLU, H, W_FI(layer, f), NTOK, NFF2, DM, P); \
    GEMM2(EpiResid, E_RESID(layer, (f) ? 8 : 2, 0.5f, from_in), ACT, W_FO(layer, f), NTOK, DM, DFF, P)

    PHASE( phase_prologue(F); );
    PHASE( phase_norm(F, true, 0, 0); );
    FFN(0, 0, true);
    PHASE( phase_norm(F, false, 0, 1); );
    GEMM1(EpiBf16, EpiBf16 E{(bf16_t*)P COMMA IN_EVEN_P}, H, (const bf16_t*)(F.ws + WS_WEI), NTOK, IN_EVEN_P, DM);
    PHASE( phase_post1_even(F); );
    PHASE( { pg8::Gemm g{(const bf16_t*)(F.ws + WS_CQN), (const bf16_t*)(F.ws + WS_WQU), NTOK, 1536, 512}; typedef pg8::SplitOrder<NTOK, 1536, 512, false> SO; SO S; S.init(cid);
             EpiBf16 E{(bf16_t*)(F.ws + WS_QM), 1536}; pg8::gemm_phase<EpiBf16, SO, true, true>(ring, g, S, E, nullptr); }
           { pg8::Gemm g{(const bf16_t*)(F.ws + WS_CKVA), (const bf16_t*)(F.ws + WS_WKU), 16384, 2048, 512}; typedef pg8::SplitOrder<16384, 2048, 512, false> SO; SO S; S.init(cid);
             EpiBf16 E{(bf16_t*)(F.ws + WS_ACT), 2048}; pg8::gemm_phase<EpiBf16, SO, true, true>(ring, g, S, E, nullptr); } );
    PHASE( phase_post2_even(F); );
    PHASE( phase_attn_even<0>(F, (bf16_t*)(F.ws + WS_O)); );
    GEMM2(EpiResid, E_RESID(0, 5, 1.0f, false), OB, (const bf16_t*)(F.ws + WS_WEO), NTOK, DM, DM, P);
    PHASE( phase_norm(F, false, 0, 2); );
    FFN(0, 1, false);
    PHASE( phase_norm(F, false, 1, 0); );
    FFN(1, 0, false);
    PHASE( phase_norm(F, false, 1, 1); );
    GEMM2(EpiBf16, EpiBf16 E{(bf16_t*)P COMMA IN_ODD}, H, (const bf16_t*)(F.ws + WS_WOI), NTOK, IN_ODD, DM, (float*)(F.ws + WS_ACT));
    PHASE( phase_post_odd(F); );
    PHASE( phase_attn_odd(F); );
    GEMM2(EpiResid, E_RESID(1, 5, 1.0f, false), OB, (const bf16_t*)(F.ws + WS_WOO), NTOK, DM, DM, P);
    PHASE( phase_norm(F, false, 1, 2); );
    FFN(1, 1, false);
#undef IN
}

extern "C" void kernel_launch(void* const* d_in, const int* in_sizes, int n_in, void* d_out, int out_size, void* d_ws, size_t ws_size, hipStream_t stream) {
    static int grid = 0;
    if (grid == 0) {
        if (n_in != 28 || (size_t)out_size != O_END || ws_size < WS_END) { fprintf(stderr, "kernel_launch: unexpected shapes (n_in %d, out %d, ws %zu; need ws >= %zu); nothing launched\n", n_in, out_size, ws_size, (size_t)WS_END); grid = -1; return; }
        int dev = 0, cus = 0, per_cu = 0;
        if (hipGetDevice(&dev) != hipSuccess || hipDeviceGetAttribute(&cus, hipDeviceAttributeMultiprocessorCount, dev) != hipSuccess) { grid = -1; return; }
        if (hipFuncSetAttribute((const void*)fwd_kernel, hipFuncAttributeMaxDynamicSharedMemorySize, LDS_BYTES) != hipSuccess) { fprintf(stderr, "kernel_launch: hipFuncSetAttribute failed\n"); grid = -1; return; }
        if (hipOccupancyMaxActiveBlocksPerMultiprocessor(&per_cu, (const void*)fwd_kernel, 512, LDS_BYTES) != hipSuccess || per_cu < 1) { fprintf(stderr, "kernel_launch: occupancy query says %d blocks per CU\n", per_cu); }
        (void)hipGetLastError();
        if (cus < pg8::GRID) { fprintf(stderr, "kernel_launch: %d CUs < %d workgroups: not resident; nothing launched\n", cus, pg8::GRID); grid = -1; return; }
        grid = pg8::GRID;
    }
    if (grid < 0) return;
    if (hipMemsetAsync((char*)d_ws + WS_CTL, 0, CTL_ZERO_BYTES, stream) != hipSuccess) return;
    Args a{};
    for (int i = 0; i < 28; ++i) a.in[i] = (const float*)d_in[i];
    a.out = (float*)d_out; a.ws = (unsigned char*)d_ws;
#if MK_ONE_LAUNCH
    a.ph_lo = 0; a.ph_hi = N_PHASES;
    hipLaunchKernelGGL(fwd_kernel, dim3(grid), dim3(512), LDS_BYTES, stream, a);
#else
    for (int p = 0; p < N_PHASES; ++p) { a.ph_lo = p; a.ph_hi = p + 1; hipLaunchKernelGGL(fwd_kernel, dim3(grid), dim3(512), LDS_BYTES, stream, a); }
#endif
}
```

```cpp
#include <hip/hip_runtime.h>
#include <cstdio>
#include <cstdint>

#ifndef MK_ONE_LAUNCH
#define MK_ONE_LAUNCH 1
#endif

#define COMMA ,
#define GAS __attribute__((address_space(1)))
#define LAS __attribute__((address_space(3)))
typedef unsigned short bf16_t;
typedef short bf16x8 __attribute__((ext_vector_type(8)));
typedef float f32x4 __attribute__((ext_vector_type(4)));
typedef float f32x16 __attribute__((ext_vector_type(16)));
typedef unsigned u32x4 __attribute__((ext_vector_type(4)));
typedef unsigned u32x2 __attribute__((ext_vector_type(2)));

namespace pg8 {
constexpr int BM = 256, BK = 64, HALF = 128, HTB = HALF * BK * 2, STAGE_BYTES = 8 * HTB, NXCD = 8, WGM = 8;
__host__ __device__ __forceinline__ int lds_byte(int r, int c) { const int st = (r >> 4) * 2 + (c >> 5), rr = r & 15, cc = c & 31, ob = rr * 64 + cc * 2; return st * 1024 + (ob ^ (((ob >> 9) & 1) << 5)); }
__host__ __device__ __forceinline__ void stage_rc(int b, int& R, int& C) { const int st = b / 1024, sb = b % 1024, swz = sb ^ (((sb >> 9) & 1) << 5); R = (st >> 1) * 16 + swz / 64; C = (st & 1) * 32 + (swz % 64) / 2; }
__host__ __device__ __forceinline__ int perm32(int rho) { const int n = rho >> 4, i = rho & 15; return 8 * (i >> 2) + 4 * n + (i & 3); }
struct Unit { int pm, pn, kt0, nkt, part; };
struct Gemm { const bf16_t* A; const bf16_t* Bt; int M, N, K; };
constexpr int GRID = 256;
template <int M, int N, int K, bool SPLIT>
struct SplitOrder {
    static constexpr int nM = M / BM, nN = N / BM, nwg = nM * nN, G = GRID, nt = K / BK, nfull = (nwg / G) * G, rem = nwg - nfull, NR = nfull / G;
    static constexpr int S0 = (SPLIT && rem > 0 && G % rem == 0) ? G / rem : 1;
    static constexpr int S = ((S0 == 2 || S0 == 4) && nt % (2 * S0) == 0) ? S0 : 1;
    int c;
    __host__ __device__ void init(int c_) { c = c_; }
    __host__ __device__ static Unit unit_of(int L, int kt0, int nkt, int part) {
        int wgid = L; { constexpr int q = nwg / NXCD, r = nwg % NXCD; const int xcd = wgid % NXCD, off = wgid / NXCD; wgid = (xcd < r ? xcd * (q + 1) : r * (q + 1) + (xcd - r) * q) + off; }
        constexpr int nig = WGM * nN; const int gid = wgid / nig, fm = gid * WGM, gsz = (nM - fm) < WGM ? (nM - fm) : WGM;
        Unit u; u.pm = fm + ((wgid % nig) % gsz); u.pn = (wgid % nig) / gsz; u.kt0 = kt0; u.nkt = nkt; u.part = part; return u;
    }
    __host__ __device__ bool next(int i, Unit& u) const {
        int L = i * G + c, kt0 = 0, nkt = nt, part = -1; bool ok = L < nwg;
        if (S > 1 && i >= NR) { constexpr int R1 = rem > 0 ? rem : 1; L = nfull + (c % R1); nkt = nt / S; kt0 = (c / R1) * (nt / S); part = c; ok = (i == NR); }
        if (!ok) return false;
        u = unit_of(L, kt0, nkt, part); return true;
    }
};
typedef float f32x2_t __attribute__((ext_vector_type(2)));
typedef __bf16 bf16x2_t __attribute__((ext_vector_type(2)));
__device__ __forceinline__ unsigned cvt_pk_bf16(float lo, float hi) { const f32x2_t v = {lo, hi}; return __builtin_bit_cast(unsigned, __builtin_convertvector(v, bf16x2_t)); }

template <class Epi, class Sched, bool ALIGN_EPI = false, bool SP2 = false>
__device__ __forceinline__ void gemm_phase(LAS unsigned char* lds, const Gemm g, const Sched& S, const Epi& E, float* slab) {
    const int tid = threadIdx.x, wid = __builtin_amdgcn_readfirstlane(tid >> 6), lane = tid & 63, wr = wid >> 2, wc = wid & 3, fr = lane & 15, fq = lane >> 4;
    const int K = g.K;
    unsigned voffA[2], voffB[2];
#pragma unroll
    for (int i = 0; i < 2; ++i) { int R, C; stage_rc(tid * 16 + i * 8192, R, C); const int Rb = Epi::PERM ? ((R & ~31) + perm32(R & 31)) : R;
        voffA[i] = (unsigned)(R * K + C) * 2u; voffB[i] = (unsigned)(Rb * K + C) * 2u; }
    const size_t kstep = (size_t)(BK * 2);
    const size_t hstep = (size_t)HALF * K * 2;
    const size_t tstep = 2 * hstep;
    const unsigned ldsw = (unsigned)wid * 1024u;
    const int aoff = lds_byte(wr * 64 + fr, fq * 8), boff = lds_byte(wc * 32 + fr, fq * 8);
#define PG8_SA(b, h) (((b) * 2 + (h)) * HTB)
#define PG8_SB(b, h) ((4 + (b) * 2 + (h)) * HTB)
#define PG8_STAGE(bufoff, gbase, voff) do { _Pragma("unroll") for (int _i = 0; _i < 2; ++_i) \
        __builtin_amdgcn_global_load_lds((const unsigned*)((const char*)(gbase) + (voff)[_i]), (LAS unsigned*)(lds + (bufoff) + ldsw + _i * 8192), 16, 0, 0); } while (0)
#define PG8_LDA(dst, b, h) do { _Pragma("unroll") for (int m = 0; m < 4; ++m) _Pragma("unroll") for (int k = 0; k < 2; ++k) dst[m][k] = *(const LAS bf16x8*)(lds + PG8_SA(b, h) + aoff + m * 2048 + k * 1024); } while (0)
#define PG8_LDB(dst, b, h) do { _Pragma("unroll") for (int n = 0; n < 2; ++n) _Pragma("unroll") for (int k = 0; k < 2; ++k) dst[n][k] = *(const LAS bf16x8*)(lds + PG8_SB(b, h) + boff + n * 2048 + k * 1024); } while (0)
#define PG8_MMA(ai, bj, At, Bt) do { __builtin_amdgcn_s_setprio(1); _Pragma("unroll") for (int m = 0; m < 4; ++m) _Pragma("unroll") for (int n = 0; n < 2; ++n) _Pragma("unroll") for (int k = 0; k < 2; ++k) \
        acc[ai][bj][m][n] = __builtin_amdgcn_mfma_f32_16x16x32_bf16(Bt[n][k], At[m][k], acc[ai][bj][m][n], 0, 0, 0); __builtin_amdgcn_s_setprio(0); } while (0)
#define PG8_WAIT_V(n) asm volatile("s_waitcnt vmcnt(" #n ")" ::: "memory")
#define PG8_WAIT_L(n) asm volatile("s_waitcnt lgkmcnt(" #n ")" ::: "memory")
#define PG8_BAR __builtin_amdgcn_s_barrier()
#define PG8_SCHED __builtin_amdgcn_sched_barrier(0)
    Unit cur, nxt; int ui = 0;
    if (!S.next(0, cur)) return;
    f32x4 acc[2][2][4][2];
#pragma unroll
    for (int a = 0; a < 2; ++a)
#pragma unroll
        for (int b = 0; b < 2; ++b)
#pragma unroll
            for (int m = 0; m < 4; ++m)
#pragma unroll
                for (int n = 0; n < 2; ++n) acc[a][b][m][n] = (f32x4){0.f, 0.f, 0.f, 0.f};
    bf16x8 At[4][2], B0[2][2], B1[2][2];
    const char* cA = (const char*)g.A + (size_t)cur.pm * tstep + (size_t)cur.kt0 * kstep; const char* cB = (const char*)g.Bt + (size_t)cur.pn * tstep + (size_t)cur.kt0 * kstep;
    if constexpr (SP2) {
        PG8_STAGE(PG8_SB(0, 0), cB, voffB); PG8_STAGE(PG8_SB(0, 1), cB + hstep, voffB); PG8_STAGE(PG8_SA(0, 0), cA, voffA); PG8_STAGE(PG8_SA(0, 1), cA + hstep, voffA);
        if (wr == 1) PG8_BAR;
        PG8_WAIT_V(2); PG8_BAR;
        PG8_STAGE(PG8_SB(1, 0), cB + kstep, voffB); PG8_STAGE(PG8_SA(1, 0), cA + kstep, voffA); PG8_STAGE(PG8_SB(1, 1), cB + hstep + kstep, voffB);
        PG8_WAIT_V(6); PG8_BAR;
    } else {
        PG8_STAGE(PG8_SB(0, 0), cB, voffB); PG8_STAGE(PG8_SA(0, 0), cA, voffA); PG8_STAGE(PG8_SB(0, 1), cB + hstep, voffB); PG8_STAGE(PG8_SA(0, 1), cA + hstep, voffA);
        if (wr == 1) PG8_BAR;
        PG8_WAIT_V(4); PG8_BAR;
        PG8_STAGE(PG8_SB(1, 0), cB + kstep, voffB); PG8_STAGE(PG8_SA(1, 0), cA + kstep, voffA); PG8_STAGE(PG8_SB(1, 1), cB + hstep + kstep, voffB);
        PG8_WAIT_V(6); PG8_BAR;
    }
    for (;;) {
        const bool has_next = S.next(ui + 1, nxt);
        const char* nA = has_next ? (const char*)g.A + (size_t)nxt.pm * tstep + (size_t)nxt.kt0 * kstep : cA; const char* nB = has_next ? (const char*)g.Bt + (size_t)nxt.pn * tstep + (size_t)nxt.kt0 * kstep : cB;
        const int nt = cur.nkt;
        for (int t = 0; t < nt; t += 2) {
            const bool last = (t == nt - 2);
            const char* a1 = cA + (size_t)(t + 1) * kstep;
            const char* a2 = last ? nA : cA + (size_t)(t + 2) * kstep; const char* b2 = last ? nB : cB + (size_t)(t + 2) * kstep;
            const char* a3 = a2 + kstep; const char* b3 = b2 + kstep;
            if constexpr (SP2) {
            PG8_LDB(B0, 0, 0); PG8_LDB(B1, 0, 1); PG8_SCHED; PG8_LDA(At, 0, 0); PG8_STAGE(PG8_SA(1, 1), a1 + hstep, voffA);
            PG8_WAIT_V(8); PG8_WAIT_L(0); PG8_BAR; PG8_MMA(0, 0, At, B0); PG8_MMA(0, 1, At, B1); PG8_BAR; PG8_SCHED;
            PG8_LDA(At, 0, 1); PG8_STAGE(PG8_SB(0, 0), b2, voffB); PG8_STAGE(PG8_SB(0, 1), b2 + hstep, voffB); PG8_STAGE(PG8_SA(0, 0), a2, voffA);
            PG8_WAIT_V(8); PG8_WAIT_L(0); PG8_BAR; PG8_MMA(1, 0, At, B0); PG8_MMA(1, 1, At, B1); PG8_BAR; PG8_SCHED;
            PG8_LDB(B0, 1, 0); PG8_LDB(B1, 1, 1); PG8_SCHED; PG8_LDA(At, 1, 0); PG8_STAGE(PG8_SA(0, 1), a2 + hstep, voffA);
            PG8_WAIT_V(8); PG8_WAIT_L(0); PG8_BAR; PG8_MMA(0, 0, At, B0); PG8_MMA(0, 1, At, B1); PG8_BAR; PG8_SCHED;
            PG8_LDA(At, 1, 1); PG8_STAGE(PG8_SB(1, 0), b3, voffB); PG8_STAGE(PG8_SB(1, 1), b3 + hstep, voffB); PG8_STAGE(PG8_SA(1, 0), a3, voffA);
            PG8_WAIT_V(8); PG8_WAIT_L(0); PG8_BAR; PG8_MMA(1, 0, At, B0); PG8_MMA(1, 1, At, B1); PG8_BAR; PG8_SCHED;
            } else {
            PG8_LDB(B0, 0, 0); PG8_SCHED; PG8_LDA(At, 0, 0); PG8_STAGE(PG8_SA(1, 1), a1 + hstep, voffA);
            PG8_WAIT_L(8); PG8_BAR; PG8_WAIT_L(0); PG8_MMA(0, 0, At, B0); PG8_BAR; PG8_SCHED;
            PG8_LDB(B1, 0, 1); PG8_STAGE(PG8_SB(0, 0), b2, voffB);
            PG8_BAR; PG8_WAIT_L(0); PG8_MMA(0, 1, At, B1); PG8_BAR;
            PG8_LDA(At, 0, 1); PG8_STAGE(PG8_SA(0, 0), a2, voffA);
            PG8_BAR; PG8_WAIT_L(0); PG8_MMA(1, 0, At, B0); PG8_BAR; PG8_SCHED;
            PG8_STAGE(PG8_SB(0, 1), b2 + hstep, voffB);
            PG8_WAIT_V(6); PG8_BAR; PG8_MMA(1, 1, At, B1); PG8_BAR;
            PG8_LDB(B0, 1, 0); PG8_SCHED; PG8_LDA(At, 1, 0); PG8_STAGE(PG8_SA(0, 1), a2 + hstep, voffA);
            PG8_WAIT_L(8); PG8_BAR; PG8_WAIT_L(0); PG8_MMA(0, 0, At, B0); PG8_BAR; PG8_SCHED;
            PG8_LDB(B1, 1, 1); PG8_STAGE(PG8_SB(1, 0), b3, voffB);
            PG8_BAR; PG8_WAIT_L(0); PG8_MMA(0, 1, At, B1); PG8_BAR;
            PG8_LDA(At, 1, 1); PG8_STAGE(PG8_SA(1, 0), a3, voffA);
            PG8_BAR; PG8_WAIT_L(0); PG8_MMA(1, 0, At, B0); PG8_BAR; PG8_SCHED;
            PG8_STAGE(PG8_SB(1, 1), b3 + hstep, voffB);
            PG8_WAIT_V(6); PG8_BAR; PG8_MMA(1, 1, At, B1); PG8_BAR;
            }
        }
        if constexpr (ALIGN_EPI) { if (wr == 0) PG8_BAR; }
        if (cur.part < 0) {
            const auto cx = E.begin(cur, wr, wc, fr, fq);
#pragma unroll
            for (int ai = 0; ai < 2; ++ai)
#pragma unroll
                for (int m = 0; m < 4; ++m) { const f32x4 v[2][2] = {{acc[ai][0][m][0], acc[ai][0][m][1]}, {acc[ai][1][m][0], acc[ai][1][m][1]}}; E.rows(cx, v, cur, ai, m, wr, wc, fr, fq); }
        } else {
            bf16_t* sp = (bf16_t*)slab + (size_t)cur.part * 65536 + (size_t)tid * 8;
#pragma unroll
            for (int ai = 0; ai < 2; ++ai)
#pragma unroll
                for (int bj = 0; bj < 2; ++bj)
#pragma unroll
                    for (int m = 0; m < 4; ++m) { const f32x4 a = acc[ai][bj][m][0], b = acc[ai][bj][m][1];
                        u32x4 w; w.x = cvt_pk_bf16(a[0], a[1]); w.y = cvt_pk_bf16(a[2], a[3]); w.z = cvt_pk_bf16(b[0], b[1]); w.w = cvt_pk_bf16(b[2], b[3]);
                        *(u32x4*)(sp + (size_t)(((ai * 2 + bj) * 4 + m) * 4096)) = w; }
        }
        if (!has_next) break;
#pragma unroll
        for (int a = 0; a < 2; ++a)
#pragma unroll
            for (int b = 0; b < 2; ++b)
#pragma unroll
                for (int m = 0; m < 4; ++m)
#pragma unroll
                    for (int n = 0; n < 2; ++n) acc[a][b][m][n] = (f32x4){0.f, 0.f, 0.f, 0.f};
        cur = nxt; cA = nA; cB = nB; ++ui;
        if constexpr (ALIGN_EPI) { if (wr == 1) PG8_BAR; }
    }
    PG8_WAIT_V(0);
    if constexpr (!ALIGN_EPI) { if (wr == 0) PG8_BAR; }
    PG8_BAR;
#undef PG8_SA
#undef PG8_SB
#undef PG8_STAGE
#undef PG8_LDA
#undef PG8_LDB
#undef PG8_MMA
#undef PG8_WAIT_V
#undef PG8_WAIT_L
#undef PG8_BAR
#undef PG8_SCHED
}
template <class Epi, class Sched>
__device__ __forceinline__ void gemm_fixup(const Epi& E, const float* slab) {
    if constexpr (Sched::S > 1) {
    constexpr int NG = 8 / Sched::S;
    const int tid = threadIdx.x, wid = __builtin_amdgcn_readfirstlane(tid >> 6), lane = tid & 63, wr = wid >> 2, wc = wid & 3, fr = lane & 15, fq = lane >> 4;
    for (int b = blockIdx.x; b < Sched::rem * Sched::S; b += Sched::G) {
        const int r = b % Sched::rem, q = b / Sched::rem;
        const Unit u = Sched::unit_of(Sched::nfull + r, 0, Sched::nt, -1);
        f32x4 v[NG][2][2];
#pragma unroll
        for (int gi = 0; gi < NG; ++gi)
#pragma unroll
            for (int bj = 0; bj < 2; ++bj)
#pragma unroll
                for (int n = 0; n < 2; ++n) v[gi][bj][n] = (f32x4){0.f, 0.f, 0.f, 0.f};
#pragma unroll
        for (int gi = 0; gi < NG; ++gi) { const int g = q * NG + gi, ai = g >> 2, m = g & 3;
#pragma unroll
            for (int p = 0; p < Sched::S; ++p) {
                const bf16_t* sp = (const bf16_t*)slab + (size_t)(r + p * Sched::rem) * 65536 + (size_t)tid * 8;
#pragma unroll
                for (int bj = 0; bj < 2; ++bj) { const u32x4 w = *(const u32x4*)(sp + (size_t)(((ai * 2 + bj) * 4 + m) * 4096));
                    v[gi][bj][0] += (f32x4){__builtin_bit_cast(float, w.x << 16), __builtin_bit_cast(float, w.x & 0xffff0000u), __builtin_bit_cast(float, w.y << 16), __builtin_bit_cast(float, w.y & 0xffff0000u)};
                    v[gi][bj][1] += (f32x4){__builtin_bit_cast(float, w.z << 16), __builtin_bit_cast(float, w.z & 0xffff0000u), __builtin_bit_cast(float, w.w << 16), __builtin_bit_cast(float, w.w & 0xffff0000u)}; } } }
        const auto cx = E.begin(u, wr, wc, fr, fq);
#pragma unroll
        for (int gi = 0; gi < NG; ++gi) { const int g = q * NG + gi; E.rows(cx, v[gi], u, g >> 2, g & 3, wr, wc, fr, fq); }
    }
    }
}
}

constexpr int DM = 2048, NTOK = 12288, NCTX = 4096, DFF = 5632, NFF2 = 11264;
constexpr int IN_EVEN = 4160, IN_EVEN_P = 4096, IN_ODD = 3072;
constexpr int NMOD = 18432;
constexpr float EPS = 1e-6f;
constexpr float LOG2E = 1.4426950408889634f;

constexpr size_t O_X = 0, O_CKV = 25165824, O_KROPE = 27262976, O_NAK = 27525120, O_NAV = 31719424, O_GK = 35913728, O_GV = 38010880, O_END = 40108032;

constexpr size_t MiB = 1u << 20;
constexpr size_t WS_CTL = 0;
constexpr size_t WS_MODS = 2 * MiB;
constexpr size_t CTL_ZERO_BYTES = 4 * MiB;
constexpr size_t WS_WFI = 4 * MiB;
constexpr size_t WS_WFO = WS_WFI + 176 * MiB;
constexpr size_t WS_WEI = WS_WFO + 88 * MiB;
constexpr size_t WS_WQU = WS_WEI + 17 * MiB;
constexpr size_t WS_WKU = WS_WQU + 2 * MiB;
constexpr size_t WS_WEO = WS_WKU + 2 * MiB;
constexpr size_t WS_WOI = WS_WEO + 8 * MiB;
constexpr size_t WS_WOO = WS_WOI + 12 * MiB;
constexpr size_t WS_H = WS_WOO + 8 * MiB;
constexpr size_t WS_ACT = WS_H + 48 * MiB;
constexpr size_t WS_P = WS_ACT + 132 * MiB;
constexpr size_t WS_QM = WS_P + 204 * MiB;
constexpr size_t WS_CQN = WS_QM + 72 * MiB;
constexpr size_t WS_CKVA = WS_CQN + 12 * MiB;
constexpr size_t WS_QA = WS_CKVA + 16 * MiB;
constexpr size_t WS_QNA = WS_QA + 48 * MiB;
constexpr size_t WS_KM_CTX = WS_QNA + 24 * MiB;
constexpr size_t WS_KM_LAT = WS_KM_CTX + 12 * MiB;
constexpr size_t WS_KM_CAC = WS_KM_LAT + 24 * MiB;
constexpr size_t WS_VM_CTX = WS_KM_CAC + 12 * MiB;
constexpr size_t WS_VM_LAT = WS_VM_CTX + 8 * MiB;
constexpr size_t WS_VM_CAC = WS_VM_LAT + 16 * MiB;
constexpr size_t WS_KN_CTX = WS_VM_CAC + 8 * MiB;
constexpr size_t WS_KN_LAT = WS_KN_CTX + 8 * MiB;
constexpr size_t WS_KN_CAC = WS_KN_LAT + 16 * MiB;
constexpr size_t WS_VN_CTX = WS_KN_CAC + 8 * MiB;
constexpr size_t WS_VN_LAT = WS_VN_CTX + 8 * MiB;
constexpr size_t WS_VN_CAC = WS_VN_LAT + 16 * MiB;
constexpr size_t WS_KG_CTX = WS_VN_CAC + 8 * MiB;
constexpr size_t WS_KG_LAT = WS_KG_CTX + 4 * MiB;
constexpr size_t WS_KG_CAC = WS_KG_LAT + 8 * MiB;
constexpr size_t WS_VG_CTX = WS_KG_CAC + 4 * MiB;
constexpr size_t WS_VG_LAT = WS_VG_CTX + 4 * MiB;
constexpr size_t WS_VG_CAC = WS_VG_LAT + 8 * MiB;
constexpr size_t WS_O = WS_VG_CAC + 4 * MiB;
constexpr size_t WS_KROPE = WS_O + 48 * MiB;
constexpr size_t WS_END = WS_KROPE + 4 * MiB;
constexpr int CW_BAR = 4096;

constexpr int RING_BYTES = 131072;
constexpr int LDSCTL_OFF = RING_BYTES;
constexpr int LDS_BYTES = 147456;

__device__ __forceinline__ unsigned f2bf(float f) { unsigned u = __builtin_bit_cast(unsigned, f); return (u + 0x7fffu + ((u >> 16) & 1u)) >> 16; }
__device__ __forceinline__ unsigned pk2(float lo, float hi) { return pg8::cvt_pk_bf16(lo, hi); }
__device__ __forceinline__ float wave_sum(float v) {
#pragma unroll
    for (int o = 1; o < 64; o <<= 1) v += __shfl_xor(v, o);
    return v;
}
__device__ __forceinline__ float fast_exp2(float x) { return __builtin_amdgcn_exp2f(x); }
__device__ __forceinline__ float fast_rcp(float x) { return __builtin_amdgcn_rcpf(x); }
__device__ __forceinline__ float silu_f(float g) { return g * fast_rcp(1.0f + fast_exp2(-g * LOG2E)); }
__device__ __forceinline__ float sin_rev(float rev) { return __builtin_amdgcn_sinf(rev); }
__device__ __forceinline__ float cos_rev(float rev) { return __builtin_amdgcn_cosf(rev); }

#define XB_TMO      128
#define XB_XCNT(j)  (256  + 64 * (j))
#define XB_XSUB(j)  (1280 + 64 * (j))
#define XB_XGEN(j)  (2304 + 64 * (j))
#define XB_TOP      3328
#define XB_TOPGEN   3392
#define XCD_BAR_WORDS 3456
#define XB_SPIN_CAP (1u << 18)
__device__ __forceinline__ unsigned xb_ld(unsigned* p)              { return __hip_atomic_load(p, __ATOMIC_RELAXED, __HIP_MEMORY_SCOPE_AGENT); }
__device__ __forceinline__ unsigned xb_add(unsigned* p, unsigned v) { return __hip_atomic_fetch_add(p, v, __ATOMIC_RELAXED, __HIP_MEMORY_SCOPE_AGENT); }
__device__ __forceinline__ unsigned xb_xcc_id() { return (unsigned)__builtin_amdgcn_s_getreg((3 << 11) | 20) & 0xFu; }
#define XB_SPIN(cond, bar) do { unsigned _sp = 0; while (cond) { __builtin_amdgcn_s_sleep(1); \
    if ((++_sp & 255u) == 0u) { if (xb_ld(&(bar)[XB_TMO])) break; if (_sp > XB_SPIN_CAP) { atomicAdd(&(bar)[XB_TMO], 1u); break; } } } } while (0)
struct XcdBarrier { unsigned* bar; unsigned x; volatile LAS unsigned* st; };
__device__ __forceinline__ XcdBarrier xcd_barrier_post(unsigned* bar, volatile LAS unsigned* st) {
    XcdBarrier b; b.bar = bar; b.x = xb_xcc_id(); b.st = st;
    if (threadIdx.x == 0) (void)xb_add(&bar[XB_XCNT(b.x)], 1u);
    return b;
}
__device__ __forceinline__ void xcd_barrier_complete(unsigned* bar, unsigned x, unsigned& nloc, unsigned& nx) {
    const unsigned G = gridDim.x * gridDim.y * gridDim.z;
    unsigned sum, cnt, mine, sp = 0u;
    for (;;) {
        sum = 0u; cnt = 0u; mine = 0u;
#pragma unroll
        for (unsigned j = 0; j < 16; ++j) { const unsigned c = xb_ld(&bar[XB_XCNT(j)]); sum += c; cnt += (c > 0u) ? 1u : 0u; mine = (j == x) ? c : mine; }
        if (sum == G) break;
        __builtin_amdgcn_s_sleep(1);
        if ((++sp & 255u) == 0u) { if (xb_ld(&bar[XB_TMO])) break; if (sp > XB_SPIN_CAP) { atomicAdd(&bar[XB_TMO], 1u); break; } }
    }
    nloc = mine > 0u ? mine : 1u; nx = cnt > 0u ? cnt : 1u;
}
__device__ __forceinline__ void xcd_barrier(const XcdBarrier& b) {
    asm volatile("s_waitcnt vmcnt(0)" ::: "memory");
    __syncthreads();
    if (threadIdx.x == 0) {
        unsigned* bar = b.bar;
        __builtin_amdgcn_s_waitcnt(0);
        unsigned nloc = b.st[0], nx = b.st[1];
        if (nloc == 0u) { xcd_barrier_complete(bar, b.x, nloc, nx); b.st[0] = nloc; b.st[1] = nx; }
        const unsigned old = xb_add(&bar[XB_XSUB(b.x)], 1u);
        const unsigned gen = old / nloc;
        if (old + 1u == (gen + 1u) * nloc) {
            __builtin_amdgcn_fence(__ATOMIC_RELEASE, "agent");
            asm volatile("s_waitcnt vmcnt(0)" ::: "memory");
            const unsigned og = xb_add(&bar[XB_TOP], 1u);
            const unsigned tg = og / nx;
            if (og + 1u == (tg + 1u) * nx) xb_add(&bar[XB_TOPGEN], 1u);
            else XB_SPIN(xb_ld(&bar[XB_TOPGEN]) == tg, bar);
            __builtin_amdgcn_fence(__ATOMIC_ACQUIRE, "agent");
            xb_add(&bar[XB_XGEN(b.x)], 1u);
            asm volatile("s_waitcnt vmcnt(0)" ::: "memory");
        } else {
            XB_SPIN(xb_ld(&bar[XB_XGEN(b.x)]) == gen, bar);
            __builtin_amdgcn_fence(__ATOMIC_ACQUIRE, "agent");
            asm volatile("s_waitcnt vmcnt(0)" ::: "memory");
        }
    }
    __syncthreads();
}

struct Args { const float* in[28]; float* out; unsigned char* ws; int ph_lo, ph_hi; };
struct Frame {
    LAS unsigned char* lds;
    int tid, lane, wave, G, gw, NGW;
    const Args* a; float* out; unsigned char* ws;
};
#define IN_XP 0
#define IN_XS 1
#define IN_C_CKV 2
#define IN_C_KROPE 3
#define IN_C_NAK 4
#define IN_C_NAV 5
#define IN_C_GK 6
#define IN_C_GV 7
#define IN_C 8
#define IN_CCTX 9
#define IN_ADAW 10
#define IN_ADAB 11
#define IN_NORMG 12
#define IN_FFI 13
#define IN_FFO 14
#define IN_EWI 15
#define IN_EWO 16
#define IN_QNORM 17
#define IN_WQUP 18
#define IN_KVNORM 19
#define IN_WKVUP 20
#define IN_MLAQK 21
#define IN_NAQK 22
#define IN_RPB 23
#define IN_OWI 24
#define IN_OWO 25
#define IN_GQK 26
#define IN_SINK 27

__device__ __forceinline__ int opaque_v(int x) { asm volatile("" : "+v"(x)); return x; }
__device__ __forceinline__ int tok_mb(int t) { return t < NCTX ? 0 : 1 + ((t - NCTX) >> 10); }

__device__ __forceinline__ size_t k_chunk_off(int DQK, int key, int c8) { return (size_t)(key >> 5) * (DQK * 32) + (size_t)(c8 >> 1) * 512 + (((c8 & 1) * 32 + (key & 31)) << 3); }
__device__ __forceinline__ void vt_tile_write_h(const bf16_t* src0, size_t pitch, bf16_t* dst, int lane) {
#pragma unroll
    for (int it = 0; it < 8; ++it) {
        const int d = (it & 1) * 64 + lane, s = (it >> 1) & 1, hh = it >> 2;
        unsigned v[8];
#pragma unroll
        for (int j = 0; j < 8; ++j) { const int key = 16 * s + 8 * (j >> 2) + 4 * hh + (j & 3); v[j] = src0[(size_t)key * pitch + d]; }
        u32x4 w; w.x = v[0] | (v[1] << 16); w.y = v[2] | (v[3] << 16); w.z = v[4] | (v[5] << 16); w.w = v[6] | (v[7] << 16);
        *(u32x4*)(dst + (size_t)(((s * 4 + (d >> 5)) * 64 + hh * 32 + (d & 31)) << 3)) = w;
    }
}
__device__ __forceinline__ void vt_tile_write(const float* src0, size_t pitch, bf16_t* dst, int lane) {
#pragma unroll
    for (int it = 0; it < 8; ++it) {
        const int d = (it & 1) * 64 + lane, s = (it >> 1) & 1, hh = it >> 2;
        float v[8];
#pragma unroll
        for (int j = 0; j < 8; ++j) { const int key = 16 * s + 8 * (j >> 2) + 4 * hh + (j & 3); v[j] = src0[(size_t)key * pitch + d]; }
        u32x4 w; w.x = pk2(v[0], v[1]); w.y = pk2(v[2], v[3]); w.z = pk2(v[4], v[5]); w.w = pk2(v[6], v[7]);
        *(u32x4*)(dst + (size_t)(((s * 4 + (d >> 5)) * 64 + hh * 32 + (d & 31)) << 3)) = w;
    }
}

__device__ __forceinline__ void p0_transpose_item(const float* W, int K, int N, bf16_t* WT, int mode, LAS float* scr, int item, int lane) {
    const int nblk = N / 32, kb = item / nblk, nb = item % nblk, k0 = 64 * kb, n0 = 32 * nb;
#pragma unroll 8
    for (int i = 0; i < 32; ++i) { const int kk = 2 * i + (lane >> 5); scr[kk * 33 + (lane & 31)] = __builtin_nontemporal_load(W + (size_t)(k0 + kk) * N + n0 + (lane & 31)); }
    asm volatile("s_waitcnt lgkmcnt(0)" ::: "memory");
    int d0 = n0;
    if (mode == 1) { const int j0 = n0 < DFF ? n0 : n0 - DFF; d0 = 256 * (j0 >> 7) + (j0 & 127) + (n0 < DFF ? 0 : 128); }
    if (mode == 2) d0 = n0 < 1024 ? n0 : (n0 < 1088 ? 4096 + (n0 - 1024) : n0 - 64);
    const int c = lane & 7;
#pragma unroll
    for (int j = 0; j < 4; ++j) { const int n = (lane >> 3) + 8 * j; const LAS float* s = scr + (8 * c) * 33 + n;
        u32x4 o; o.x = pk2(s[0 * 33], s[1 * 33]); o.y = pk2(s[2 * 33], s[3 * 33]); o.z = pk2(s[4 * 33], s[5 * 33]); o.w = pk2(s[6 * 33], s[7 * 33]);
        *(u32x4*)(WT + (size_t)(d0 + n) * K + k0 + 8 * c) = o; }
    asm volatile("s_waitcnt lgkmcnt(0)" ::: "memory");
}

__device__ __forceinline__ const float* p0_mods_wptr(Frame& F, int item) {
    const int layer = item / 1152, rem = item % 1152, slab = rem >> 4, ks = rem & 15;
    return F.a->in[IN_ADAW] + (size_t)layer * DM * NMOD + (size_t)(ks * 128 + F.wave * 16) * NMOD + slab * 256 + 4 * F.lane;
}
__device__ __forceinline__ void phase_mods(Frame& F) {
    LAS float* stab = (LAS float*)(F.lds);
    LAS float* part = (LAS float*)(F.lds + 8192);
    const float* c = F.a->in[IN_C]; const float* cctx = F.a->in[IN_CCTX];
    for (int item = blockIdx.x; item < 2304; item += F.G) {
        const int layer = item / 1152, rem = item % 1152, slab = rem >> 4, ks = rem & 15, n0 = slab * 256, k0 = ks * 128;
        f32x4 w[16];
        { const float* W = p0_mods_wptr(F, item);
#pragma unroll
          for (int kk = 0; kk < 16; ++kk) w[kk] = __builtin_nontemporal_load((const f32x4*)(W + (size_t)kk * NMOD)); }
        for (int i = F.tid; i < 9 * 128; i += 512) { const int b = i >> 7, k = i & 127; const float v = (b == 0) ? cctx[k0 + k] : c[(size_t)(b - 1) * DM + k0 + k]; stab[i] = silu_f(v); }
        __syncthreads();
        f32x4 acc[9];
#pragma unroll
        for (int b = 0; b < 9; ++b) acc[b] = (f32x4){0.f, 0.f, 0.f, 0.f};
#pragma unroll
        for (int kk = 0; kk < 16; ++kk) {
#pragma unroll
            for (int b = 0; b < 9; ++b) { const float sv = stab[b * 128 + F.wave * 16 + kk]; acc[b] += w[kk] * sv; }
        }
#pragma unroll
        for (int b = 0; b < 9; ++b) *(LAS f32x4*)(part + (F.wave * 9 + b) * 256 + 4 * F.lane) = acc[b];
        __syncthreads();
        float* mods = (float*)(F.ws + WS_MODS) + (size_t)layer * 9 * NMOD;
        const float* bias = F.a->in[IN_ADAB] + (size_t)layer * NMOD;
        for (int i = F.tid; i < 9 * 256; i += 512) { const int b = i >> 8, col = i & 255; float sm = 0.f;
#pragma unroll
            for (int ww = 0; ww < 8; ++ww) sm += part[(ww * 9 + b) * 256 + col];
            if (ks == 0) sm += bias[n0 + col];
            atomicAdd(mods + (size_t)b * NMOD + n0 + col, sm); }
        __syncthreads();
    }
}

__device__ __forceinline__ void p0_cacheK_item(const float* src, int H, bf16_t* dstbase, int item, int lane) {
    const int t32 = item & 15, bh = item >> 4, b = bh / H, h = bh % H;
    bf16_t* dst = dstbase + (size_t)bh * (512 * 128);
#pragma unroll
    for (int it = 0; it < 8; ++it) { const int idx = it * 64 + lane, kl = idx >> 4, c8 = idx & 15, key = t32 * 32 + kl;
        const float* s = src + ((size_t)(b * 512 + key) * H + h) * 128 + c8 * 8;
        const f32x4 a = *(const f32x4*)s, bb = *(const f32x4*)(s + 4);
        u32x4 w; w.x = pk2(a[0], a[1]); w.y = pk2(a[2], a[3]); w.z = pk2(bb[0], bb[1]); w.w = pk2(bb[2], bb[3]);
        *(u32x4*)(dst + k_chunk_off(128, key, c8)) = w; }
}
__device__ __forceinline__ void p0_cacheV_item(const float* src, int H, bf16_t* dstbase, int item, int lane) {
    const int t32 = item & 15, bh = item >> 4, b = bh / H, h = bh % H;
    vt_tile_write(src + ((size_t)(b * 512 + t32 * 32) * H + h) * 128, (size_t)H * 128, dstbase + (size_t)bh * (512 * 128) + (size_t)t32 * 4096, lane);
}

__device__ __forceinline__ void phase_prologue(Frame& F) {
    phase_mods(F);
    LAS float* scr = (LAS float*)(F.lds + F.wave * 16384);
    constexpr int I_FI = 32 * 352, I_FO = 88 * 64, I_EI = 32 * 130, I_QU = 8 * 48, I_KU = 8 * 64, I_EO = 32 * 64, I_OI = 32 * 96, I_OO = 32 * 64;
    constexpr int I_PAD = 0, I_CKV = 1024, I_NK = 1024, I_NV = 1024, I_GK = 512, I_GV = 512;
    constexpr int NITEMS = 4 * I_FI + 4 * I_FO + I_EI + I_QU + I_KU + I_EO + I_OI + I_OO + I_PAD + I_CKV + I_NK + I_NV + I_GK + I_GV;
    unsigned char* ws = F.ws;
    for (int it = F.gw; it < NITEMS; it += F.NGW) {
        int r = it;
        if (r < 4 * I_FI) { const int m = r / I_FI; p0_transpose_item(F.a->in[IN_FFI] + (size_t)m * DM * NFF2, DM, NFF2, (bf16_t*)(ws + WS_WFI) + (size_t)m * NFF2 * DM, 1, scr, r % I_FI, F.lane); continue; } r -= 4 * I_FI;
        if (r < 4 * I_FO) { const int m = r / I_FO; p0_transpose_item(F.a->in[IN_FFO] + (size_t)m * DFF * DM, DFF, DM, (bf16_t*)(ws + WS_WFO) + (size_t)m * DM * DFF, 0, scr, r % I_FO, F.lane); continue; } r -= 4 * I_FO;
        if (r < I_EI) { p0_transpose_item(F.a->in[IN_EWI], DM, IN_EVEN, (bf16_t*)(ws + WS_WEI), 2, scr, r, F.lane); continue; } r -= I_EI;
        if (r < I_QU) { p0_transpose_item(F.a->in[IN_WQUP], 512, 1536, (bf16_t*)(ws + WS_WQU), 0, scr, r, F.lane); continue; } r -= I_QU;
        if (r < I_KU) { p0_transpose_item(F.a->in[IN_WKVUP], 512, 2048, (bf16_t*)(ws + WS_WKU), 0, scr, r, F.lane); continue; } r -= I_KU;
        if (r < I_EO) { p0_transpose_item(F.a->in[IN_EWO], DM, DM, (bf16_t*)(ws + WS_WEO), 0, scr, r, F.lane); continue; } r -= I_EO;
        if (r < I_OI) { p0_transpose_item(F.a->in[IN_OWI], DM, IN_ODD, (bf16_t*)(ws + WS_WOI), 0, scr, r, F.lane); continue; } r -= I_OI;
        if (r < I_OO) { p0_transpose_item(F.a->in[IN_OWO], DM, DM, (bf16_t*)(ws + WS_WOO), 0, scr, r, F.lane); continue; } r -= I_OO;
        if (r < I_PAD) { u32x4* p = (u32x4*)((bf16_t*)(ws + WS_WEI) + (size_t)(IN_EVEN + r) * DM); const u32x4 z = {0u, 0u, 0u, 0u};
#pragma unroll
            for (int j = 0; j < 4; ++j) p[j * 64 + F.lane] = z; continue; } r -= I_PAD;
        if (r < I_CKV) {
#pragma unroll
            for (int j = 0; j < 4; ++j) { const int row = 4 * r + j; const float* s = F.a->in[IN_C_CKV] + (size_t)row * 512 + 8 * F.lane;
                const f32x4 a = *(const f32x4*)s, b = *(const f32x4*)(s + 4);
                u32x4 w; w.x = pk2(a[0], a[1]); w.y = pk2(a[2], a[3]); w.z = pk2(b[0], b[1]); w.w = pk2(b[2], b[3]);
                *(u32x4*)((bf16_t*)(ws + WS_CKVA) + (size_t)(NTOK + row) * 512 + 8 * F.lane) = w; }
            continue; } r -= I_CKV;
        if (r < I_NK) { p0_cacheK_item(F.a->in[IN_C_NAK], 8, (bf16_t*)(ws + WS_KN_CAC), r, F.lane); continue; } r -= I_NK;
        if (r < I_NV) { p0_cacheV_item(F.a->in[IN_C_NAV], 8, (bf16_t*)(ws + WS_VN_CAC), r, F.lane); continue; } r -= I_NV;
        if (r < I_GK) { p0_cacheK_item(F.a->in[IN_C_GK], 4, (bf16_t*)(ws + WS_KG_CAC), r, F.lane); continue; } r -= I_GK;
        p0_cacheV_item(F.a->in[IN_C_GV], 4, (bf16_t*)(ws + WS_VG_CAC), r, F.lane);
    }
}

__device__ __forceinline__ const float* x_in_row(Frame& F, int t) { return t < NCTX ? F.a->in[IN_XP] + (size_t)t * DM : F.a->in[IN_XS] + (size_t)(t - NCTX) * DM; }
__device__ __forceinline__ void phase_norm(Frame& F, bool from_input, int layer, int sub) {
    const float* g = F.a->in[IN_NORMG] + (size_t)(layer * 3 + sub) * DM;
    bf16_t* H = (bf16_t*)(F.ws + WS_H);
    const int lane = opaque_v(F.lane);
    for (int t = F.gw; t < NTOK; t += F.NGW) {
        const float* xr = from_input ? x_in_row(F, t) : F.out + (size_t)t * DM;
        const float* md = (const float*)(F.ws + WS_MODS) + ((size_t)layer * 9 + tok_mb(t)) * NMOD + (size_t)(3 * sub) * DM;
        f32x4 v[8]; float ss = 0.f;
#pragma unroll
        for (int j = 0; j < 8; ++j) { v[j] = *(const f32x4*)(xr + 256 * j + 4 * lane); ss += (v[j][0] * v[j][0] + v[j][1] * v[j][1]) + (v[j][2] * v[j][2] + v[j][3] * v[j][3]); }
        const float rstd = __builtin_amdgcn_rsqf(wave_sum(ss) * (1.0f / DM) + EPS);
#pragma unroll
        for (int j = 0; j < 8; ++j) { const int c = 256 * j + 4 * lane;
            const f32x4 gg = *(const f32x4*)(g + c), sh = *(const f32x4*)(md + c), sc = *(const f32x4*)(md + DM + c);
            const f32x4 y = (v[j] * rstd * gg) * (sc + 1.0f) + sh;
            u32x2 w; w.x = pk2(y[0], y[1]); w.y = pk2(y[2], y[3]);
            *(u32x2*)(H + (size_t)t * DM + c) = w; }
    }
}

struct EpiSwiGLU {
    static constexpr bool PERM = true;
    bf16_t* O;
    struct Ctx { int row0, col0; };
    __device__ __forceinline__ Ctx begin(const pg8::Unit& u, int wr, int wc, int fr, int fq) const { return Ctx{u.pm * 256 + wr * 64 + fr, u.pn * 128 + wc * 32 + 8 * fq}; }
    __device__ __forceinline__ void rows(const Ctx& c, const f32x4 (&v)[2][2], const pg8::Unit&, int ai, int m, int, int, int, int) const {
        float r[8];
#pragma unroll
        for (int n = 0; n < 2; ++n)
#pragma unroll
            for (int j = 0; j < 4; ++j) r[4 * n + j] = silu_f(v[0][n][j]) * v[1][n][j];
        u32x4 w; w.x = pk2(r[0], r[1]); w.y = pk2(r[2], r[3]); w.z = pk2(r[4], r[5]); w.w = pk2(r[6], r[7]);
        *(u32x4*)(O + (size_t)(c.row0 + ai * 128 + m * 16) * DFF + c.col0) = w;
    }
};
struct EpiResid {
    static constexpr bool PERM = false;
    const float* xp; const float* xs; bool from_input; float* out; const float* gate_base; float coef;
    struct Ctx { const float* xin; f32x4 gv[2][2]; int row0, col0; };
    __device__ __forceinline__ Ctx begin(const pg8::Unit& u, int wr, int wc, int fr, int fq) const {
        Ctx c; const int rowt = u.pm * 256; c.row0 = rowt + wr * 64 + fr; c.col0 = u.pn * 256 + wc * 32 + 4 * fq;
        const float* gt = gate_base + (size_t)tok_mb(rowt) * NMOD;
        c.xin = from_input ? (rowt < NCTX ? xp : xs - (size_t)NCTX * DM) : out;
#pragma unroll
        for (int bj = 0; bj < 2; ++bj)
#pragma unroll
            for (int n = 0; n < 2; ++n) c.gv[bj][n] = *(const f32x4*)(gt + c.col0 + bj * 128 + n * 16) * coef;
        return c;
    }
    __device__ __forceinline__ void rows(const Ctx& c, const f32x4 (&v)[2][2], const pg8::Unit&, int ai, int m, int, int, int, int) const {
        const size_t off = (size_t)(c.row0 + ai * 128 + m * 16) * DM + c.col0;
#pragma unroll
        for (int bj = 0; bj < 2; ++bj)
#pragma unroll
            for (int n = 0; n < 2; ++n) { const f32x4 xv = *(const f32x4*)(c.xin + off + bj * 128 + n * 16);
                *(f32x4*)(out + off + bj * 128 + n * 16) = xv + c.gv[bj][n] * v[bj][n]; }
        asm volatile("" ::: "memory");
    }
};
struct EpiBf16 {
    static constexpr bool PERM = true;
    bf16_t* C; int ldc;
    struct Ctx { int row0, col0; };
    __device__ __forceinline__ Ctx begin(const pg8::Unit& u, int wr, int wc, int fr, int fq) const { return Ctx{u.pm * 256 + wr * 64 + fr, u.pn * 256 + wc * 32 + 8 * fq}; }
    __device__ __forceinline__ void rows(const Ctx& c, const f32x4 (&v)[2][2], const pg8::Unit&, int ai, int m, int, int, int, int) const {
        bf16_t* rowp = C + (size_t)(c.row0 + ai * 128 + m * 16) * ldc + c.col0;
#pragma unroll
        for (int bj = 0; bj < 2; ++bj) { u32x4 w; w.x = pk2(v[bj][0][0], v[bj][0][1]); w.y = pk2(v[bj][0][2], v[bj][0][3]); w.z = pk2(v[bj][1][0], v[bj][1][1]); w.w = pk2(v[bj][1][2], v[bj][1][3]);
            *(u32x4*)(rowp + bj * 128) = w; }
    }
};
struct EpiF32 {
    static constexpr bool PERM = false;
    float* C; int ldc;
    struct Ctx { int row0, col0; };
    __device__ __forceinline__ Ctx begin(const pg8::Unit& u, int wr, int wc, int fr, int fq) const { return Ctx{u.pm * 256 + wr * 64 + fr, u.pn * 256 + wc * 32 + 4 * fq}; }
    __device__ __forceinline__ void rows(const Ctx& c, const f32x4 (&v)[2][2], const pg8::Unit&, int ai, int m, int, int, int, int) const {
        float* rowp = C + (size_t)(c.row0 + ai * 128 + m * 16) * ldc + c.col0;
#pragma unroll
        for (int bj = 0; bj < 2; ++bj)
#pragma unroll
            for (int n = 0; n < 2; ++n) *(f32x4*)(rowp + bj * 128 + n * 16) = v[bj][n];
    }
};

__device__ __forceinline__ void load8(const float* p, float (&v)[8]) { const f32x4 a = *(const f32x4*)p, b = *(const f32x4*)(p + 4); v[0] = a[0]; v[1] = a[1]; v[2] = a[2]; v[3] = a[3]; v[4] = b[0]; v[5] = b[1]; v[6] = b[2]; v[7] = b[3]; }
__device__ __forceinline__ void load8h(const bf16_t* p, float (&v)[8]) { const u32x4 w = *(const u32x4*)p;
    v[0] = __builtin_bit_cast(float, w.x << 16); v[1] = __builtin_bit_cast(float, w.x & 0xffff0000u); v[2] = __builtin_bit_cast(float, w.y << 16); v[3] = __builtin_bit_cast(float, w.y & 0xffff0000u);
    v[4] = __builtin_bit_cast(float, w.z << 16); v[5] = __builtin_bit_cast(float, w.z & 0xffff0000u); v[6] = __builtin_bit_cast(float, w.w << 16); v[7] = __builtin_bit_cast(float, w.w & 0xffff0000u); }
__device__ __forceinline__ u32x4 pack8(const float (&v)[8]) { u32x4 w; w.x = pk2(v[0], v[1]); w.y = pk2(v[2], v[3]); w.z = pk2(v[4], v[5]); w.w = pk2(v[6], v[7]); return w; }
__device__ __forceinline__ void store8f(float* p, const float (&v)[8]) { *(f32x4*)p = (f32x4){v[0], v[1], v[2], v[3]}; *(f32x4*)(p + 4) = (f32x4){v[4], v[5], v[6], v[7]}; }
template <int W> __device__ __forceinline__ float group_sum(float v) {
#pragma unroll
    for (int o = 1; o < W; o <<= 1) v += __shfl_xor(v, o);
    return v;
}

__device__ __forceinline__ void phase_post1_even(Frame& F) {
    const bf16_t* P = (const bf16_t*)(F.ws + WS_P);
    const float* qn_g = F.a->in[IN_QNORM]; const float* kvn_g = F.a->in[IN_KVNORM]; const float* naq_g = F.a->in[IN_NAQK]; const float* nak_g = F.a->in[IN_NAQK] + 128;
    bf16_t* CQN = (bf16_t*)(F.ws + WS_CQN); bf16_t* CKVA = (bf16_t*)(F.ws + WS_CKVA); bf16_t* QNA = (bf16_t*)(F.ws + WS_QNA);
    constexpr int NVT_CTX = 16 * 8 * 8, NVT_LAT = 8 * 8 * 32, NKR = NTOK / 16;
    for (int it = F.gw; it < NKR; it += F.NGW) {
        const int t0 = it * 16, lane = F.lane, lr = lane & 15, lq = lane >> 4;
        const bf16_t* ap = (const bf16_t*)(F.ws + WS_H) + (size_t)(t0 + lr) * DM + 8 * lq;
        const bf16_t* bp = (const bf16_t*)(F.ws + WS_WEI) + (size_t)(4096 + lr) * DM + 8 * lq;
        f32x4 acc[4];
#pragma unroll
        for (int j = 0; j < 4; ++j) acc[j] = (f32x4){0.f, 0.f, 0.f, 0.f};
#pragma unroll 8
        for (int kk = 0; kk < 64; ++kk) {
            const bf16x8 af = *(const bf16x8*)(ap + kk * 32);
#pragma unroll
            for (int j = 0; j < 4; ++j) { const bf16x8 bf = *(const bf16x8*)(bp + (size_t)j * 16 * DM + kk * 32); acc[j] = __builtin_amdgcn_mfma_f32_16x16x32_bf16(af, bf, acc[j], 0, 0, 0); }
        }
        float* kr = (float*)(F.ws + WS_KROPE);
#pragma unroll
        for (int j = 0; j < 4; ++j)
#pragma unroll
            for (int r = 0; r < 4; ++r) { const int t = t0 + 4 * lq + r, c = 16 * j + lr; kr[(size_t)t * 64 + c] = acc[j][r]; if (t < NCTX) F.out[O_KROPE + (size_t)t * 64 + c] = acc[j][r]; }
    }
    for (int it = F.gw; it < NTOK + NVT_CTX + NVT_LAT; it += F.NGW) {
        if (it < NTOK) {
            const int t = it, lane = F.lane; const bf16_t* pr = P + (size_t)t * IN_EVEN_P; const bool ctx = t < NCTX;
            float v[8], g[8];
            load8h(pr + 8 * lane, v); float ss = 0.f;
#pragma unroll
            for (int i = 0; i < 8; ++i) ss += v[i] * v[i];
            float rstd = __builtin_amdgcn_rsqf(wave_sum(ss) * (1.0f / 512) + EPS);
            load8(qn_g + 8 * lane, g);
#pragma unroll
            for (int i = 0; i < 8; ++i) v[i] = v[i] * rstd * g[i];
            *(u32x4*)(CQN + (size_t)t * 512 + 8 * lane) = pack8(v);
            load8h(pr + 512 + 8 * lane, v); ss = 0.f;
#pragma unroll
            for (int i = 0; i < 8; ++i) ss += v[i] * v[i];
            rstd = __builtin_amdgcn_rsqf(wave_sum(ss) * (1.0f / 512) + EPS);
            load8(kvn_g + 8 * lane, g);
#pragma unroll
            for (int i = 0; i < 8; ++i) v[i] = v[i] * rstd * g[i];
            if (ctx) store8f(F.out + O_CKV + (size_t)t * 512 + 8 * lane, v);
            *(u32x4*)(CKVA + (size_t)t * 512 + 8 * lane) = pack8(v);
            const int head = lane >> 3, d0 = (lane & 7) * 16;
            int b, s; if (ctx) { b = t >> 8; s = t & 255; } else { b = (t - NCTX) >> 10; s = (t - NCTX) & 1023; }
#pragma unroll
            for (int which = 0; which < 2; ++which) {
                const bf16_t* src = pr + 1024 + which * 1024 + head * 128 + d0; const float* gg = which ? nak_g : naq_g;
                float a[8], c[8], ga[8], gc[8]; load8h(src, a); load8h(src + 8, c); load8(gg + d0, ga); load8(gg + d0 + 8, gc);
                float q = 0.f;
#pragma unroll
                for (int i = 0; i < 8; ++i) q += a[i] * a[i] + c[i] * c[i];
                const float r2 = __builtin_amdgcn_rsqf(group_sum<8>(q) * (1.0f / 128) + EPS);
#pragma unroll
                for (int i = 0; i < 8; ++i) { a[i] = a[i] * r2 * ga[i]; c[i] = c[i] * r2 * gc[i]; }
                if (which == 0) { bf16_t* qd = QNA + (size_t)t * 1024 + head * 128 + d0; *(u32x4*)qd = pack8(a); *(u32x4*)(qd + 8) = pack8(c); }
                else {
                    if (ctx) { float* od = F.out + O_NAK + (size_t)t * 1024 + head * 128 + d0; store8f(od, a); store8f(od + 8, c); }
                    bf16_t* kb = ctx ? (bf16_t*)(F.ws + WS_KN_CTX) + (size_t)(b * 8 + head) * (256 * 128) : (bf16_t*)(F.ws + WS_KN_LAT) + (size_t)(b * 8 + head) * (1024 * 128);
                    *(u32x4*)(kb + k_chunk_off(128, s, d0 >> 3)) = pack8(a); *(u32x4*)(kb + k_chunk_off(128, s, (d0 >> 3) + 1)) = pack8(c);
                }
            }
            { const bf16_t* src = pr + 3072 + 16 * lane; float a[8], c[8]; load8h(src, a); load8h(src + 8, c); if (ctx) { float* od = F.out + O_NAV + (size_t)t * 1024 + 16 * lane; store8f(od, a); store8f(od + 8, c); } }
        } else {
            int r = it - NTOK;
            if (r < NVT_CTX) { const int t32 = r & 7, bh = r >> 3, b = bh >> 3, h = bh & 7;
                vt_tile_write_h(P + (size_t)(b * 256 + t32 * 32) * IN_EVEN_P + 3072 + h * 128, IN_EVEN_P, (bf16_t*)(F.ws + WS_VN_CTX) + (size_t)bh * (256 * 128) + (size_t)t32 * 4096, F.lane);
            } else { r -= NVT_CTX; const int t32 = r & 31, bh = r >> 5, b = bh >> 3, h = bh & 7;
                vt_tile_write_h(P + (size_t)(NCTX + b * 1024 + t32 * 32) * IN_EVEN_P + 3072 + h * 128, IN_EVEN_P, (bf16_t*)(F.ws + WS_VN_LAT) + (size_t)bh * (1024 * 128) + (size_t)t32 * 4096, F.lane);
            }
        }
    }
}

__device__ __forceinline__ void rope8(float (&v)[8], const float (&vp)[8], bool is_x1, float pos, int f0, float inv_nf) {
#pragma unroll
    for (int i = 0; i < 8; ++i) {
        const float invf = fast_exp2(-(float)(f0 + i) * inv_nf * 13.287712379549449f);
        const float rev = pos * invf * 0.15915494309189535f;
        const float cs = cos_rev(rev), sn = sin_rev(rev);
        v[i] = is_x1 ? (v[i] * cs - vp[i] * sn) : (vp[i] * sn + v[i] * cs);
    }
}

__device__ __forceinline__ void phase_post2_even(Frame& F) {
    const bf16_t* P = (const bf16_t*)(F.ws + WS_P); const bf16_t* QM = (const bf16_t*)(F.ws + WS_QM); const bf16_t* KVM = (const bf16_t*)(F.ws + WS_ACT);
    const float* gq = F.a->in[IN_MLAQK]; const float* gk = F.a->in[IN_MLAQK] + 192;
    bf16_t* QA = (bf16_t*)(F.ws + WS_QA);
    constexpr int NROW = 16384, NVT_CTX = 1024, NVT_LAT = 2048, NVT_CAC = 1024;
    const int lane = F.lane, hsub = lane >> 5, c = lane & 31; const bool act = c < 24;
    for (int it = F.gw; it < NTOK + NROW + NVT_CTX + NVT_LAT + NVT_CAC; it += F.NGW) {
        if (it < NTOK) {
            const int t = it; const bool lat = t >= NCTX; const int s = (t - NCTX) & 1023; const float row = (float)(s >> 6), col = (float)(s & 63);
            const int cc = act ? c : 23, cpq = cc >= 16 ? (cc ^ 2) : cc;
            float g[8], gp[8]; load8(gq + 8 * cc, g); load8(gq + 8 * cpq, gp);
            float v[4][8], vp[4][8];
#pragma unroll
            for (int pass = 0; pass < 4; ++pass) { const bf16_t* src = QM + (size_t)t * 1536 + (2 * pass + hsub) * 192; load8h(src + 8 * cc, v[pass]); load8h(src + 8 * cpq, vp[pass]); }
#pragma unroll
            for (int pass = 0; pass < 4; ++pass) {
                const int head = 2 * pass + hsub;
                float q = 0.f;
#pragma unroll
                for (int i = 0; i < 8; ++i) { v[pass][i] = act ? v[pass][i] : 0.f; q += v[pass][i] * v[pass][i]; }
                const float rstd = __builtin_amdgcn_rsqf(group_sum<32>(q) * (1.0f / 192) + EPS);
#pragma unroll
                for (int i = 0; i < 8; ++i) { v[pass][i] = v[pass][i] * rstd * g[i]; vp[pass][i] = vp[pass][i] * rstd * gp[i]; }
                if (lat && c >= 16 && act) rope8(v[pass], vp[pass], (c & 2) == 0, c < 20 ? row : col, (c & 1) * 8, 1.0f / 16);
                if (act) *(u32x4*)(QA + (size_t)t * 1536 + head * 192 + 8 * c) = pack8(v[pass]);
            }
        } else if (it < NTOK + NROW) {
            const int r = it - NTOK; const bool istok = r < NTOK; const bool lat = istok && r >= NCTX;
            int bsel, s; bf16_t* kb0; int nkeys;
            if (!istok) { bsel = (r - NTOK) >> 9; s = (r - NTOK) & 511; kb0 = (bf16_t*)(F.ws + WS_KM_CAC); nkeys = 512; }
            else if (lat) { bsel = (r - NCTX) >> 10; s = (r - NCTX) & 1023; kb0 = (bf16_t*)(F.ws + WS_KM_LAT); nkeys = 1024; }
            else { bsel = r >> 8; s = r & 255; kb0 = (bf16_t*)(F.ws + WS_KM_CTX); nkeys = 256; }
            const float* krp_f = istok ? (const float*)(F.ws + WS_KROPE) + (size_t)r * 64 : F.a->in[IN_C_KROPE] + (size_t)(r - NTOK) * 64;
            const float row = (float)(s >> 6), col = (float)(s & 63);
            const int cc = act ? c : 23, cpq = cc >= 16 ? (cc ^ 2) : cc, cn = c < 16 ? c : 15, cr = cc >= 16 ? cc - 16 : 0, crp = cc >= 16 ? cpq - 16 : 0;
            float g[8], gp[8], kr[8], krp[8]; load8(gk + 8 * cc, g); load8(gk + 8 * cpq, gp); load8(krp_f + 8 * cr, kr); load8(krp_f + 8 * crp, krp);
            float v[4][8];
#pragma unroll
            for (int pass = 0; pass < 4; ++pass) load8h(KVM + (size_t)r * 2048 + (2 * pass + hsub) * 256 + 8 * cn, v[pass]);
#pragma unroll
            for (int pass = 0; pass < 4; ++pass) {
                const int head = 2 * pass + hsub;
                float vp[8]; float q = 0.f;
#pragma unroll
                for (int i = 0; i < 8; ++i) { v[pass][i] = c < 16 ? v[pass][i] : (act ? kr[i] : 0.f); q += v[pass][i] * v[pass][i]; }
                const float rstd = __builtin_amdgcn_rsqf(group_sum<32>(q) * (1.0f / 192) + EPS);
#pragma unroll
                for (int i = 0; i < 8; ++i) { v[pass][i] = v[pass][i] * rstd * g[i]; vp[i] = krp[i] * rstd * gp[i]; }
                if (lat && c >= 16 && act) rope8(v[pass], vp, (c & 2) == 0, c < 20 ? row : col, (c & 1) * 8, 1.0f / 16);
                if (act) *(u32x4*)(kb0 + (size_t)(bsel * 8 + head) * ((size_t)nkeys * 192) + k_chunk_off(192, s, c)) = pack8(v[pass]);
            }
        } else {
            int r = it - NTOK - NROW;
            if (r < NVT_CTX) { const int t32 = r & 7, bh = r >> 3, b = bh >> 3, h = bh & 7;
                vt_tile_write_h(KVM + (size_t)(b * 256 + t32 * 32) * 2048 + h * 256 + 128, 2048, (bf16_t*)(F.ws + WS_VM_CTX) + (size_t)bh * (256 * 128) + (size_t)t32 * 4096, lane);
            } else if (r < NVT_CTX + NVT_LAT) { r -= NVT_CTX; const int t32 = r & 31, bh = r >> 5, b = bh >> 3, h = bh & 7;
                vt_tile_write_h(KVM + (size_t)(NCTX + b * 1024 + t32 * 32) * 2048 + h * 256 + 128, 2048, (bf16_t*)(F.ws + WS_VM_LAT) + (size_t)bh * (1024 * 128) + (size_t)t32 * 4096, lane);
            } else { r -= NVT_CTX + NVT_LAT; const int t32 = r & 15, bh = r >> 4, b = bh >> 3, h = bh & 7;
                vt_tile_write_h(KVM + (size_t)(NTOK + b * 512 + t32 * 32) * 2048 + h * 256 + 128, 2048, (bf16_t*)(F.ws + WS_VM_CAC) + (size_t)bh * (512 * 128) + (size_t)t32 * 4096, lane);
            }
        }
    }
}

__device__ __forceinline__ void phase_post_odd(Frame& F) {
    const bf16_t* P = (const bf16_t*)(F.ws + WS_P); const float* gq = F.a->in[IN_GQK]; const float* gk = F.a->in[IN_GQK] + 128;
    bf16_t* QA = (bf16_t*)(F.ws + WS_QA);
    constexpr int NVT_CTX = 16 * 4 * 8, NVT_LAT = 8 * 4 * 32;
    const int lane = F.lane, hsub = lane >> 4, c = lane & 15;
    for (int it = F.gw; it < NTOK + NVT_CTX + NVT_LAT; it += F.NGW) {
        if (it < NTOK) {
            const int t = it; const bool ctx = t < NCTX, lat = !ctx; const bf16_t* pr = P + (size_t)t * IN_ODD;
            int b, s; if (ctx) { b = t >> 8; s = t & 255; } else { b = (t - NCTX) >> 10; s = (t - NCTX) & 1023; }
            const float row = (float)(s >> 6), col = (float)(s & 63);
            const int cp = c ^ 4;
            float gqv[8], gqp[8], gkv[8], gkp[8]; load8(gq + 8 * c, gqv); load8(gq + 8 * cp, gqp); load8(gk + 8 * c, gkv); load8(gk + 8 * cp, gkp);
            float v[5][8], vp[5][8];
#pragma unroll
            for (int pass = 0; pass < 5; ++pass) { const bf16_t* src = pr + (pass == 4 ? 2048 + hsub * 128 : (4 * pass + hsub) * 128); load8h(src + 8 * c, v[pass]); load8h(src + 8 * cp, vp[pass]); }
#pragma unroll
            for (int pass = 0; pass < 5; ++pass) {
                const bool isk = pass == 4; const int head = isk ? hsub : 4 * pass + hsub;
                float q = 0.f;
#pragma unroll
                for (int i = 0; i < 8; ++i) q += v[pass][i] * v[pass][i];
                const float rstd = __builtin_amdgcn_rsqf(group_sum<16>(q) * (1.0f / 128) + EPS);
#pragma unroll
                for (int i = 0; i < 8; ++i) { v[pass][i] = v[pass][i] * rstd * (isk ? gkv[i] : gqv[i]); vp[pass][i] = vp[pass][i] * rstd * (isk ? gkp[i] : gqp[i]); }
                if (isk && ctx) store8f(F.out + O_GK + (size_t)t * 512 + head * 128 + 8 * c, v[pass]);
                if (lat) rope8(v[pass], vp[pass], (c & 4) == 0, c < 8 ? row : col, (c & 3) * 8, 1.0f / 32);
                if (!isk) *(u32x4*)(QA + (size_t)t * 2048 + head * 128 + 8 * c) = pack8(v[pass]);
                else { bf16_t* kb = ctx ? (bf16_t*)(F.ws + WS_KG_CTX) + (size_t)(b * 4 + head) * (256 * 128) : (bf16_t*)(F.ws + WS_KG_LAT) + (size_t)(b * 4 + head) * (1024 * 128);
                    *(u32x4*)(kb + k_chunk_off(128, s, c)) = pack8(v[pass]); }
            }
            { float vv[8]; load8h(pr + 2560 + 8 * lane, vv); if (ctx) store8f(F.out + O_GV + (size_t)t * 512 + 8 * lane, vv); }
        } else {
            int r = it - NTOK;
            if (r < NVT_CTX) { const int t32 = r & 7, bh = r >> 3, b = bh >> 2, h = bh & 3;
                vt_tile_write_h(P + (size_t)(b * 256 + t32 * 32) * IN_ODD + 2560 + h * 128, IN_ODD, (bf16_t*)(F.ws + WS_VG_CTX) + (size_t)bh * (256 * 128) + (size_t)t32 * 4096, lane);
            } else { r -= NVT_CTX; const int t32 = r & 31, bh = r >> 5, b = bh >> 2, h = bh & 3;
                vt_tile_write_h(P + (size_t)(NCTX + b * 1024 + t32 * 32) * IN_ODD + 2560 + h * 128, IN_ODD, (bf16_t*)(F.ws + WS_VG_LAT) + (size_t)bh * (1024 * 128) + (size_t)t32 * 4096, lane);
            }
        }
    }
}

struct WgUnit {
    const bf16_t* kc; const bf16_t* vc; int nctx;
    const bf16_t* kl; const bf16_t* vl; int t_lo, t_hi;
};
struct WvUnit {
    const bf16_t* qb; unsigned qoff; int qpitch; bf16_t* ob; unsigned ooff;
    int qpos;
    int qcol0;
    int w_lo, w_hi;
    float sink; int has_sink; float scale;
};
constexpr int ATT_RPB_OFF = RING_BYTES + 512;
constexpr float ATT_THR = 8.0f;
template <int MODE>
__device__ __forceinline__ float attn_mask(float v, int tile32, int r, int hh, int ql, bool masked, const WvUnit& U, const LAS float* rpb) {
    const int kk = (r & 3) + 8 * (r >> 2) + 4 * hh;
    if (MODE == 1) { const int df = U.qpos + ql - (tile32 * 32 + kk); if (masked && (df > 128 || df < -128)) v = -1e30f; }
    if (MODE == 2 && masked) { const int krow = tile32 >> 1, kcol = (tile32 & 1) * 32 + kk, qc = U.qcol0 + ql;
        int ws = qc - 8; ws = ws < 0 ? 0 : (ws > 48 ? 48 : ws);
        const bool valid = (kcol >= ws) && (kcol < ws + 16);
        int co = kcol - qc; co = co < -15 ? -15 : (co > 15 ? 15 : co);
        const float bias = rpb[(krow - U.qpos + 7) * 31 + co + 15];
        v = valid ? v + bias * LOG2E : -1e30f; }
    return v;
}
template <int OFF> __device__ __forceinline__ bf16x8 lds_rd(unsigned addr) { bf16x8 r; asm volatile("ds_read_b128 %0, %1 offset:%2" : "=v"(r) : "v"(addr), "i"(OFF)); return r; }
template <int BASE, int H1> __device__ __forceinline__ void lds_rd8(unsigned addr, bf16x8 (&a)[8]) {
    a[0] = lds_rd<BASE>(addr); a[1] = lds_rd<BASE + 1024>(addr); a[2] = lds_rd<BASE + 2048>(addr); a[3] = lds_rd<BASE + 3072>(addr);
    a[4] = lds_rd<BASE + H1>(addr); a[5] = lds_rd<BASE + H1 + 1024>(addr); a[6] = lds_rd<BASE + H1 + 2048>(addr); a[7] = lds_rd<BASE + H1 + 3072>(addr);
}
#define LDS_WAIT8(n, a) asm volatile("s_waitcnt lgkmcnt(" #n ")" : "+v"(a[0]), "+v"(a[1]), "+v"(a[2]), "+v"(a[3]), "+v"(a[4]), "+v"(a[5]), "+v"(a[6]), "+v"(a[7]))
#define QK_MMA8(a, kb) do { _Pragma("unroll") for (int _j = 0; _j < 4; ++_j) { s0 = __builtin_amdgcn_mfma_f32_32x32x16_bf16(a[_j], qf[(kb) * 4 + _j], s0, 0, 0, 0); s1 = __builtin_amdgcn_mfma_f32_32x32x16_bf16(a[4 + _j], qf[(kb) * 4 + _j], s1, 0, 0, 0); } } while (0)
__device__ __forceinline__ void na_mask16(f32x16& sx, int tile32, int hh, int ql, bool masked, const WvUnit& U, const LAS float* rpb) {
    const int krow = tile32 >> 1, kc0 = (tile32 & 1) * 32 + 4 * hh, qc = U.qcol0 + ql;
    int ws = qc - 8; ws = ws < 0 ? 0 : (ws > 48 ? 48 : ws);
    int ro = krow - U.qpos + 7; ro = ro < 0 ? 0 : (ro > 14 ? 14 : ro);
    const LAS float* rrow = rpb + ro * 31 + 15;
    float bias[16];
#pragma unroll
    for (int r = 0; r < 16; ++r) { int co = kc0 + (r & 3) + 8 * (r >> 2) - qc; co = co < -15 ? -15 : (co > 15 ? 15 : co); bias[r] = rrow[co]; }
#pragma unroll
    for (int r = 0; r < 16; ++r) { const int kcol = kc0 + (r & 3) + 8 * (r >> 2); const float mv = ((unsigned)(kcol - ws) < 16u) ? sx[r] + bias[r] * LOG2E : -1e30f; sx[r] = masked ? mv : sx[r]; }
}
template <int DQK, int MODE>
__device__ __forceinline__ void attn_tile64(const LAS unsigned char* sl, int t64, bool masked, const bf16x8 (&qf)[DQK / 16], f32x16 (&o)[4], float& m, float& l, const WvUnit& U, const LAS float* rpb, int lane, float sl2) {
    constexpr int NKS = DQK / 16, KB = DQK * 128;
    const int ql = lane & 31, hh = lane >> 5;
    const unsigned addr = (unsigned)(unsigned long)sl + (unsigned)lane * 16u;
    f32x16 s0, s1;
#pragma unroll
    for (int r = 0; r < 16; ++r) { s0[r] = 0.f; s1[r] = 0.f; }
    bf16x8 pb[4];
#define ATT_SMA(sx, T32) do { float mt = -1e30f; \
    if (MODE == 1) { if (masked) {   \
            _Pragma("unroll") for (int r = 0; r < 16; ++r) sx[r] = attn_mask<MODE>(sx[r] * sl2, (T32), r, hh, ql, true, U, rpb); } } \
    if (MODE == 2) { _Pragma("unroll") for (int r = 0; r < 16; ++r) sx[r] *= sl2; na_mask16(sx, (T32), hh, ql, masked, U, rpb); } \
    _Pragma("unroll") for (int r = 0; r < 16; ++r) mt = fmaxf(mt, sx[r]); \
    if (MODE == 0 || (MODE == 1 && !masked)) mt *= sl2;     \
    mt = fmaxf(mt, __shfl_xor(mt, 32)); \
    if (!__all(mt - m <= ATT_THR)) { const float mn = fmaxf(m, mt), alpha = fast_exp2(m - mn); m = mn; l *= alpha; \
        _Pragma("unroll") for (int db = 0; db < 4; ++db) _Pragma("unroll") for (int r = 0; r < 16; ++r) o[db][r] *= alpha; } } while (0)
#define ATT_SMB(sx, PBI) do { float ps = 0.f; const float esc = (MODE == 0 || (MODE == 1 && !masked)) ? sl2 : 1.0f; \
    _Pragma("unroll") for (int r = 0; r < 16; ++r) { sx[r] = fast_exp2(fmaf(sx[r], esc, -m)); ps += sx[r]; } \
    l += ps; \
    _Pragma("unroll") for (int s2 = 0; s2 < 2; ++s2) { \
        u32x4 w; w.x = pk2(sx[8 * s2 + 0], sx[8 * s2 + 1]); w.y = pk2(sx[8 * s2 + 2], sx[8 * s2 + 3]); w.z = pk2(sx[8 * s2 + 4], sx[8 * s2 + 5]); w.w = pk2(sx[8 * s2 + 6], sx[8 * s2 + 7]); pb[(PBI) + s2] = __builtin_bit_cast(bf16x8, w); } } while (0)
#define MFMA32(a_, b_, c_) __builtin_amdgcn_mfma_f32_32x32x16_bf16(a_, b_, c_, 0, 0, 0)
    if constexpr (NKS == 8) {
        bf16x8 ka[8], kb_[8];
        lds_rd8<0, 4096>(addr, ka); lds_rd8<KB / 2, 4096>(addr, kb_);
        LDS_WAIT8(8, ka);
#pragma unroll
        for (int j = 0; j < 8; ++j) s0 = MFMA32(ka[j], qf[j], s0);
        if (MODE != 2) { lds_rd8<KB, 4096>(addr, ka); LDS_WAIT8(8, kb_); } else LDS_WAIT8(0, kb_);
#pragma unroll
        for (int j = 0; j < 4; ++j) s1 = MFMA32(kb_[j], qf[j], s1);
        ATT_SMA(s0, 2 * t64);
        if (MODE == 2) lds_rd8<KB, 4096>(addr, ka);
#pragma unroll
        for (int j = 4; j < 8; ++j) s1 = MFMA32(kb_[j], qf[j], s1);
        ATT_SMB(s0, 0);
        lds_rd8<KB + 8192, 4096>(addr, kb_);
        LDS_WAIT8(8, ka);
#pragma unroll
        for (int db = 0; db < 4; ++db) o[db] = MFMA32(ka[db], pb[0], o[db]);
        ATT_SMA(s1, 2 * t64 + 1);
#pragma unroll
        for (int db = 0; db < 4; ++db) o[db] = MFMA32(ka[4 + db], pb[1], o[db]);
        ATT_SMB(s1, 2);
        LDS_WAIT8(0, kb_);
#pragma unroll
        for (int s2 = 0; s2 < 2; ++s2)
#pragma unroll
            for (int db = 0; db < 4; ++db) o[db] = MFMA32(kb_[s2 * 4 + db], pb[2 + s2], o[db]);
    } else {
        bf16x8 ka[4], kb_[4];
#define RDK4(a, h, b) do { a[0] = lds_rd<(h) * (KB / 2) + (b) * 4096>(addr); a[1] = lds_rd<(h) * (KB / 2) + (b) * 4096 + 1024>(addr); a[2] = lds_rd<(h) * (KB / 2) + (b) * 4096 + 2048>(addr); a[3] = lds_rd<(h) * (KB / 2) + (b) * 4096 + 3072>(addr); } while (0)
#define RDV4(a, q) do { a[0] = lds_rd<KB + (q) * 4096>(addr); a[1] = lds_rd<KB + (q) * 4096 + 1024>(addr); a[2] = lds_rd<KB + (q) * 4096 + 2048>(addr); a[3] = lds_rd<KB + (q) * 4096 + 3072>(addr); } while (0)
#define WAIT4(n, a) asm volatile("s_waitcnt lgkmcnt(" #n ")" : "+v"(a[0]), "+v"(a[1]), "+v"(a[2]), "+v"(a[3]))
#define QK4(a, sx, b) do { _Pragma("unroll") for (int j = 0; j < 4; ++j) sx = MFMA32(a[j], qf[4 * (b) + j], sx); } while (0)
#define PV4(a, q) do { _Pragma("unroll") for (int db = 0; db < 4; ++db) o[db] = MFMA32(a[db], pb[q], o[db]); } while (0)
        RDK4(ka, 0, 0); RDK4(kb_, 0, 1);
        WAIT4(4, ka); QK4(ka, s0, 0); RDK4(ka, 0, 2);
        WAIT4(4, kb_); QK4(kb_, s0, 1); RDK4(kb_, 1, 0);
        WAIT4(4, ka); QK4(ka, s0, 2); RDK4(ka, 1, 1);
        WAIT4(4, kb_); QK4(kb_, s1, 0); RDK4(kb_, 1, 2);
        ATT_SMA(s0, 2 * t64);
        WAIT4(4, ka); QK4(ka, s1, 1); RDV4(ka, 0);
        ATT_SMB(s0, 0);
        WAIT4(4, kb_); QK4(kb_, s1, 2); RDV4(kb_, 1);
        WAIT4(4, ka); PV4(ka, 0); RDV4(ka, 2);
        ATT_SMA(s1, 2 * t64 + 1);
        WAIT4(4, kb_); PV4(kb_, 1); RDV4(kb_, 3);
        ATT_SMB(s1, 2);
        WAIT4(4, ka); PV4(ka, 2);
        WAIT4(0, kb_); PV4(kb_, 3);
#undef RDK4
#undef RDV4
#undef WAIT4
#undef QK4
#undef PV4
    }
#undef ATT_SMA
#undef ATT_SMB
#undef MFMA32
}
template <int DQK, int MODE, int VAR = 0>
__device__ __forceinline__ void attn_wg_unit(LAS unsigned char* ring, const WgUnit& G, const WvUnit& U, const float* rpb_g, int tid, int wave, int lane) {
    constexpr int NKS = DQK / 16, KB = DQK * 128, NLK = KB / 8192;
    constexpr int NS = (DQK == 128) ? 4 : 3, SLOTB = KB + 16384;
    const int ql = lane & 31, hh = lane >> 5;
    const int ntiles = G.nctx + (G.t_hi - G.t_lo);
    const LAS float* rpb = (const LAS float*)(ring + ATT_RPB_OFF);
#define ATT_ISSUE(i, SLOTC) do { const int _i = (i); const bool _c = _i < G.nctx; const int _t = _c ? _i : G.t_lo + (_i - G.nctx); \
        const char* _kg = (const char*)(_c ? G.kc : G.kl) + (size_t)_t * KB + tid * 16; const char* _vg = (const char*)(_c ? G.vc : G.vl) + (size_t)_t * 16384 + tid * 16; \
        LAS unsigned char* _sl = ring + (SLOTC) * SLOTB + wave * 1024; \
        _Pragma("unroll") for (int _p = 0; _p < NLK; ++_p) __builtin_amdgcn_global_load_lds((const unsigned*)(_kg + _p * 8192), (LAS unsigned*)(_sl + _p * 8192), 16, 0, 0); \
        _Pragma("unroll") for (int _p = 0; _p < 2; ++_p) __builtin_amdgcn_global_load_lds((const unsigned*)(_vg + _p * 8192), (LAS unsigned*)(_sl + KB + _p * 8192), 16, 0, 0); } while (0)
    asm volatile("s_waitcnt lgkmcnt(0)" ::: "memory"); __builtin_amdgcn_s_barrier(); asm volatile("" ::: "memory");
    bf16x8 qf[NKS];
#pragma unroll
    for (int ks = 0; ks < NKS; ++ks) qf[ks] = *(const bf16x8*)(U.qb + (size_t)(U.qoff + (unsigned)(ql * U.qpitch + 16 * ks + 8 * hh)));
    if (MODE == 2) { const int i = opaque_v(tid); if (i < 15 * 31) ((LAS float*)(ring + ATT_RPB_OFF))[i] = rpb_g[i]; }
    if (VAR != 2) { ATT_ISSUE(0, 0); if (ntiles > 1) ATT_ISSUE(1, 1); if (NS == 4 && ntiles > 2) ATT_ISSUE(2, 2); }
    f32x16 o[4];
#pragma unroll
    for (int db = 0; db < 4; ++db)
#pragma unroll
        for (int r = 0; r < 16; ++r) o[db][r] = 0.f;
    float m = -1e30f, l = 0.f;
    const float sl2 = U.scale * LOG2E;
#define ATT_STEP(i_, SLOTC) do { const int i = (i_); if (i < ntiles) { \
        if (NS == 4) { if (i + 2 < ntiles) asm volatile("s_waitcnt vmcnt(8)" ::: "memory"); else if (i + 1 < ntiles) asm volatile("s_waitcnt vmcnt(4)" ::: "memory"); else asm volatile("s_waitcnt vmcnt(0)" ::: "memory"); } \
        else { if (i + 1 < ntiles) asm volatile("s_waitcnt vmcnt(5)" ::: "memory"); else asm volatile("s_waitcnt vmcnt(0)" ::: "memory"); } \
        asm volatile("s_waitcnt lgkmcnt(0)" ::: "memory"); __builtin_amdgcn_s_barrier(); asm volatile("" ::: "memory"); \
        if (VAR != 2 && i + NS - 1 < ntiles) ATT_ISSUE(i + NS - 1, ((SLOTC) + NS - 1) % NS); \
        const bool isctx = i < G.nctx; const int t64 = isctx ? 0 : G.t_lo + (i - G.nctx); \
        if (VAR != 1 && (isctx || (t64 >= U.w_lo && t64 < U.w_hi))) attn_tile64<DQK, MODE>(ring + (SLOTC) * SLOTB, t64, !isctx, qf, o, m, l, U, rpb, lane, sl2); } } while (0)
    if constexpr (NS == 4) { for (int i0 = 0; i0 < ntiles; i0 += 4) { ATT_STEP(i0, 0); ATT_STEP(i0 + 1, 1); ATT_STEP(i0 + 2, 2); ATT_STEP(i0 + 3, 3); } }
    else { for (int i0 = 0; i0 < ntiles; i0 += 3) { ATT_STEP(i0, 0); ATT_STEP(i0 + 1, 1); ATT_STEP(i0 + 2, 2); } }
#undef ATT_STEP
#undef ATT_ISSUE
    l += __shfl_xor(l, 32);
    if (U.has_sink) l += fast_exp2(U.sink * LOG2E - m);
    const float inv = 1.0f / l;
    bf16_t* op = U.ob + (size_t)(U.ooff + (unsigned)(opaque_v(ql) * DM));
#pragma unroll
    for (int db = 0; db < 4; ++db)
#pragma unroll
        for (int rg = 0; rg < 4; ++rg) { u32x2 w; w.x = pk2(o[db][4 * rg] * inv, o[db][4 * rg + 1] * inv); w.y = pk2(o[db][4 * rg + 2] * inv, o[db][4 * rg + 3] * inv);
            *(u32x2*)(op + 32 * db + 8 * rg + 4 * hh) = w; }
}

template <int VAR>
__device__ __forceinline__ void phase_attn_even(Frame& F, bf16_t* O) {
 const bf16_t* QA = (const bf16_t*)(F.ws + WS_QA); const bf16_t* QNA = (const bf16_t*)(F.ws + WS_QNA);
    const int wave = F.wave, lane = F.lane, tid = F.tid;
    WgUnit G; WvUnit U; U.sink = 0.f; U.has_sink = 0; U.qpos = 0; U.qcol0 = 0;
    const int vcu = (F.G % 8 == 0) ? ((int)blockIdx.x % 8) * (F.G / 8) + (int)blockIdx.x / 8 : (int)blockIdx.x;
    for (int u = vcu; u < 256; u += F.G) { const int bh = u >> 2, q4 = u & 3, b = bh >> 3, h = bh & 7, t0 = NCTX + b * 1024 + q4 * 256 + 32 * wave;
        U.qb = QA; U.qoff = (unsigned)(t0 * 1536 + h * 192); U.qpitch = 1536; U.scale = 0.07216878364870322f; U.ob = O; U.ooff = (unsigned)(t0 * DM + h * 128);
        G.kc = (const bf16_t*)(F.ws + WS_KM_CAC) + (size_t)bh * (512 * 192); G.vc = (const bf16_t*)(F.ws + WS_VM_CAC) + (size_t)bh * (512 * 128); G.nctx = 8;
        G.kl = (const bf16_t*)(F.ws + WS_KM_LAT) + (size_t)bh * (1024 * 192); G.vl = (const bf16_t*)(F.ws + WS_VM_LAT) + (size_t)bh * (1024 * 128); G.t_lo = 0; G.t_hi = 16; U.w_lo = 0; U.w_hi = 16;
        attn_wg_unit<192, 0, VAR>(F.lds, G, U, nullptr, tid, wave, lane); }
    for (int u = vcu; u < 256; u += F.G) { const int bh = u >> 2, r0 = (u & 3) * 4, b = bh >> 3, h = bh & 7, r = r0 + (wave >> 1), c0 = (wave & 1) * 32, t0 = NCTX + b * 1024 + r * 64 + c0;
        int rs = r - 4; rs = rs < 0 ? 0 : (rs > 8 ? 8 : rs);
        int glo = r0 - 4; glo = glo < 0 ? 0 : (glo > 8 ? 8 : glo); int ghi = r0 - 1; ghi = ghi < 0 ? 0 : (ghi > 8 ? 8 : ghi);
        U.qb = QNA; U.qoff = (unsigned)(t0 * 1024 + h * 128); U.qpitch = 1024; U.scale = 0.08838834764831845f; U.ob = O; U.ooff = (unsigned)(t0 * DM + 1024 + h * 128);
        G.kc = (const bf16_t*)(F.ws + WS_KN_CAC) + (size_t)bh * (512 * 128); G.vc = (const bf16_t*)(F.ws + WS_VN_CAC) + (size_t)bh * (512 * 128); G.nctx = 8;
        G.kl = (const bf16_t*)(F.ws + WS_KN_LAT) + (size_t)bh * (1024 * 128); G.vl = (const bf16_t*)(F.ws + WS_VN_LAT) + (size_t)bh * (1024 * 128); G.t_lo = glo; G.t_hi = ghi + 8; U.w_lo = rs; U.w_hi = rs + 8;
        U.qpos = r; U.qcol0 = c0;
        attn_wg_unit<128, 2, VAR>(F.lds, G, U, F.a->in[IN_RPB] + h * (15 * 31), tid, wave, lane); }
    U.qpos = 0; U.qcol0 = 0; U.w_lo = 0; U.w_hi = 4; G.nctx = 0; G.kc = nullptr; G.vc = nullptr; G.t_lo = 0; G.t_hi = 4;
    for (int u = vcu; u < 256; u += F.G) { const int bh = u & 127, b = bh >> 3, h = bh & 7, t0 = b * 256 + 32 * wave;
        if (u < 128) {
            U.qb = QA; U.qoff = (unsigned)(t0 * 1536 + h * 192); U.qpitch = 1536; U.scale = 0.07216878364870322f; U.ob = O; U.ooff = (unsigned)(t0 * DM + h * 128);
            G.kl = (const bf16_t*)(F.ws + WS_KM_CTX) + (size_t)bh * (256 * 192); G.vl = (const bf16_t*)(F.ws + WS_VM_CTX) + (size_t)bh * (256 * 128);
            attn_wg_unit<192, 0, VAR>(F.lds, G, U, nullptr, tid, wave, lane);
        } else {
            U.qb = QNA; U.qoff = (unsigned)(t0 * 1024 + h * 128); U.qpitch = 1024; U.scale = 0.08838834764831845f; U.ob = O; U.ooff = (unsigned)(t0 * DM + 1024 + h * 128);
            G.kl = (const bf16_t*)(F.ws + WS_KN_CTX) + (size_t)bh * (256 * 128); G.vl = (const bf16_t*)(F.ws + WS_VN_CTX) + (size_t)bh * (256 * 128);
            attn_wg_unit<128, 0, VAR>(F.lds, G, U, nullptr, tid, wave, lane);
        } }
    asm volatile("s_waitcnt vmcnt(0) lgkmcnt(0)" ::: "memory"); __syncthreads();
}
__device__ __forceinline__ void phase_attn_odd(Frame& F) {
    bf16_t* O = (bf16_t*)(F.ws + WS_O); const bf16_t* QA = (const bf16_t*)(F.ws + WS_QA);
    const int wave = F.wave, lane = F.lane, tid = F.tid;
    WgUnit G; WvUnit U; U.has_sink = 1; U.qcol0 = 0; U.qpitch = 2048; U.scale = 0.08838834764831845f;
    const int vcu = (F.G % 8 == 0) ? ((int)blockIdx.x % 8) * (F.G / 8) + (int)blockIdx.x / 8 : (int)blockIdx.x;
    const float* sink = F.a->in[IN_SINK];
    for (int u = vcu; u < 512; u += F.G) { const int bk = u >> 4, q64 = u & 15, b = bk >> 2, kvh = bk & 3, g = wave >> 1, hq = kvh * 4 + g, qs = q64 * 64 + (wave & 1) * 32, t0 = NCTX + b * 1024 + qs;
        U.qb = QA; U.qoff = (unsigned)(t0 * 2048 + hq * 128); U.ob = O; U.ooff = (unsigned)(t0 * DM + hq * 128); U.qpos = qs; U.sink = sink[hq];
        G.kc = (const bf16_t*)(F.ws + WS_KG_CAC) + (size_t)bk * (512 * 128); G.vc = (const bf16_t*)(F.ws + WS_VG_CAC) + (size_t)bk * (512 * 128); G.nctx = 8;
        G.kl = (const bf16_t*)(F.ws + WS_KG_LAT) + (size_t)bk * (1024 * 128); G.vl = (const bf16_t*)(F.ws + WS_VG_LAT) + (size_t)bk * (1024 * 128);
        G.t_lo = q64 - 2 < 0 ? 0 : q64 - 2; G.t_hi = (q64 + 2 > 15 ? 15 : q64 + 2) + 1; U.w_lo = G.t_lo; U.w_hi = G.t_hi;
        attn_wg_unit<128, 1>(F.lds, G, U, nullptr, tid, wave, lane); }
    G.nctx = 0; G.kc = nullptr; G.vc = nullptr; G.t_lo = 0; G.t_hi = 4; U.w_lo = 0; U.w_hi = 4;
    for (int u = vcu; u < 256; u += F.G) { const int bk = u >> 2, q64 = u & 3, b = bk >> 2, kvh = bk & 3, g = wave >> 1, hq = kvh * 4 + g, qs = q64 * 64 + (wave & 1) * 32, t0 = b * 256 + qs;
        U.qb = QA; U.qoff = (unsigned)(t0 * 2048 + hq * 128); U.ob = O; U.ooff = (unsigned)(t0 * DM + hq * 128); U.qpos = 0; U.sink = sink[hq];
        G.kl = (const bf16_t*)(F.ws + WS_KG_CTX) + (size_t)bk * (256 * 128); G.vl = (const bf16_t*)(F.ws + WS_VG_CTX) + (size_t)bk * (256 * 128);
        attn_wg_unit<128, 0>(F.lds, G, U, nullptr, tid, wave, lane); }
    asm volatile("s_waitcnt vmcnt(0) lgkmcnt(0)" ::: "memory"); __syncthreads();
}

constexpr int N_PHASES = 36;
__global__ void __launch_bounds__(512, 2) fwd_kernel(Args args) {
    extern __shared__ __attribute__((aligned(16))) unsigned char lds_raw[];
    Frame F;
    F.lds = (LAS unsigned char*)lds_raw;
    F.tid = threadIdx.x; F.lane = F.tid & 63; F.wave = __builtin_amdgcn_readfirstlane(F.tid >> 6);
    F.G = gridDim.x; F.gw = blockIdx.x * 8 + F.wave; F.NGW = F.G * 8;
    F.a = &args; F.out = args.out; F.ws = args.ws;
    volatile LAS unsigned* MISC = (volatile LAS unsigned*)(F.lds + LDSCTL_OFF);
    for (int u = F.tid; u < (LDS_BYTES - LDSCTL_OFF) / 4; u += 512) ((LAS unsigned*)(F.lds + LDSCTL_OFF))[u] = 0u;
    __syncthreads();
    unsigned* ctl = (unsigned*)(F.ws + WS_CTL);
    const int lo = args.ph_lo, hi = args.ph_hi;
    const bool multi = (hi - lo) > 1;
    XcdBarrier bar; bar.bar = ctl + CW_BAR; bar.x = 0; bar.st = nullptr;
    if (multi) bar = xcd_barrier_post(ctl + CW_BAR, MISC + 8);
#define IN(k) (lo <= (k) && (k) < hi)
    int ph = 0;
#define PHASE(...) do { if (IN(ph)) { __VA_ARGS__ } if (IN(ph) && IN(ph + 1)) xcd_barrier(bar); ++ph; } while (0)
    const float* mods = (const float*)(F.ws + WS_MODS);
    bf16_t* H = (bf16_t*)(F.ws + WS_H); bf16_t* ACT = (bf16_t*)(F.ws + WS_ACT); float* P = (float*)(F.ws + WS_P); bf16_t* OB = (bf16_t*)(F.ws + WS_O);
    LAS unsigned char* ring = F.lds;
    const int cid = (int)blockIdx.x;
#define GEMM2(EPI_T, EDEF, A_, B_, M_, N_, K_, SLAB) \
    PHASE( pg8::Gemm g{(A_), (B_), (M_), (N_), (K_)}; typedef pg8::SplitOrder<(M_), (N_), (K_), true> SO; SO S; S.init(cid); EDEF; pg8::gemm_phase<EPI_T, SO, true, true>(ring, g, S, E, (SLAB)); ); \
    PHASE( typedef pg8::SplitOrder<(M_), (N_), (K_), true> SO; EDEF; pg8::gemm_fixup<EPI_T, SO>(E, (SLAB)); )
#define GEMM1(EPI_T, EDEF, A_, B_, M_, N_, K_) \
    PHASE( pg8::Gemm g{(A_), (B_), (M_), (N_), (K_)}; typedef pg8::SplitOrder<(M_), (N_), (K_), false> SO; SO S; S.init(cid); EDEF; pg8::gemm_phase<EPI_T, SO, true, true>(ring, g, S, E, nullptr); )
#define W_FI(layer, f) ((const bf16_t*)(F.ws + WS_WFI) + (size_t)((layer) * 2 + (f)) * NFF2 * DM)
#define W_FO(layer, f) ((const bf16_t*)(F.ws + WS_WFO) + (size_t)((layer) * 2 + (f)) * DM * DFF)
#define E_SWIGLU EpiSwiGLU E{ACT}
#define E_RESID(layer, gidx, coef, from_in) EpiResid E{F.a->in[IN_XP], F.a->in[IN_XS], (from_in), F.out, mods + (size_t)(layer) * 9 * NMOD + (size_t)(gidx) * DM, (coef)}
#define FFN(layer, f, from_in) \
    GEMM2(EpiSwiGLU, E_SWIGLU, H, W_FI(layer, f), NTOK, NFF2, DM, P); \
    GEMM2(EpiResid, E_RESID(layer, (f) ? 8 : 2, 0.5f, from_in), ACT, W_FO(layer, f), NTOK, DM, DFF, P)

    PHASE( phase_prologue(F); );
    PHASE( phase_norm(F, true, 0, 0); );
    FFN(0, 0, true);
    PHASE( phase_norm(F, false, 0, 1); );
    GEMM1(EpiBf16, EpiBf16 E{(bf16_t*)P COMMA IN_EVEN_P}, H, (const bf16_t*)(F.ws + WS_WEI), NTOK, IN_EVEN_P, DM);
    PHASE( phase_post1_even(F); );
    PHASE( { pg8::Gemm g{(const bf16_t*)(F.ws + WS_CQN), (const bf16_t*)(F.ws + WS_WQU), NTOK, 1536, 512}; typedef pg8::SplitOrder<NTOK, 1536, 512, false> SO; SO S; S.init(cid);
             EpiBf16 E{(bf16_t*)(F.ws + WS_QM), 1536}; pg8::gemm_phase<EpiBf16, SO, true, true>(ring, g, S, E, nullptr); }
           { pg8::Gemm g{(const bf16_t*)(F.ws + WS_CKVA), (const bf16_t*)(F.ws + WS_WKU), 16384, 2048, 512}; typedef pg8::SplitOrder<16384, 2048, 512, false> SO; SO S; S.init(cid);
             EpiBf16 E{(bf16_t*)(F.ws + WS_ACT), 2048}; pg8::gemm_phase<EpiBf16, SO, true, true>(ring, g, S, E, nullptr); } );
    PHASE( phase_post2_even(F); );
    PHASE( phase_attn_even<0>(F, (bf16_t*)(F.ws + WS_O)); );
    GEMM2(EpiResid, E_RESID(0, 5, 1.0f, false), OB, (const bf16_t*)(F.ws + WS_WEO), NTOK, DM, DM, P);
    PHASE( phase_norm(F, false, 0, 2); );
    FFN(0, 1, false);
    PHASE( phase_norm(F, false, 1, 0); );
    FFN(1, 0, false);
    PHASE( phase_norm(F, false, 1, 1); );
    GEMM2(EpiBf16, EpiBf16 E{(bf16_t*)P COMMA IN_ODD}, H, (const bf16_t*)(F.ws + WS_WOI), NTOK, IN_ODD, DM, (float*)(F.ws + WS_ACT));
    PHASE( phase_post_odd(F); );
    PHASE( phase_attn_odd(F); );
    GEMM2(EpiResid, E_RESID(1, 5, 1.0f, false), OB, (const bf16_t*)(F.ws + WS_WOO), NTOK, DM, DM, P);
    PHASE( phase_norm(F, false, 1, 2); );
    FFN(1, 1, false);
#undef IN
}

extern "C" void kernel_launch(void* const* d_in, const int* in_sizes, int n_in, void* d_out, int out_size, void* d_ws, size_t ws_size, hipStream_t stream) {
    static int grid = 0;
    if (grid == 0) {
        if (n_in != 28 || (size_t)out_size != O_END || ws_size < WS_END) { fprintf(stderr, "kernel_launch: unexpected shapes (n_in %d, out %d, ws %zu; need ws >= %zu); nothing launched\n", n_in, out_size, ws_size, (size_t)WS_END); grid = -1; return; }
        int dev = 0, cus = 0, per_cu = 0;
        if (hipGetDevice(&dev) != hipSuccess || hipDeviceGetAttribute(&cus, hipDeviceAttributeMultiprocessorCount, dev) != hipSuccess) { grid = -1; return; }
        if (hipFuncSetAttribute((const void*)fwd_kernel, hipFuncAttributeMaxDynamicSharedMemorySize, LDS_BYTES) != hipSuccess) { fprintf(stderr, "kernel_launch: hipFuncSetAttribute failed\n"); grid = -1; return; }
        if (hipOccupancyMaxActiveBlocksPerMultiprocessor(&per_cu, (const void*)fwd_kernel, 512, LDS_BYTES) != hipSuccess || per_cu < 1) { fprintf(stderr, "kernel_launch: occupancy query says %d blocks per CU\n", per_cu); }
        (void)hipGetLastError();
        if (cus < pg8::GRID) { fprintf(stderr, "kernel_launch: %d CUs < %d workgroups: not resident; nothing launched\n", cus, pg8::GRID); grid = -1; return; }
        grid = pg8::GRID;
    }
    if (grid < 0) return;
    if (hipMemsetAsync((char*)d_ws + WS_CTL, 0, CTL_ZERO_BYTES, stream) != hipSuccess) return;
    Args a{};
    for (int i = 0; i < 28; ++i) a.in[i] = (const float*)d_in[i];
    a.out = (float*)d_out; a.ws = (unsigned char*)d_ws;
#if MK_ONE_LAUNCH
    a.ph_lo = 0; a.ph_hi = N_PHASES;
    hipLaunchKernelGGL(fwd_kernel, dim3(grid), dim3(512), LDS_BYTES, stream, a);
#else
    for (int p = 0; p < N_PHASES; ++p) { a.ph_lo = p; a.ph_hi = p + 1; hipLaunchKernelGGL(fwd_kernel, dim3(grid), dim3(512), LDS_BYTES, stream, a); }
#endif
}
```

```cpp
#include <hip/hip_runtime.h>
#include <cstdio>
#include <cstdint>

#ifndef MK_ONE_LAUNCH
#define MK_ONE_LAUNCH 1
#endif

#define COMMA ,
#define GAS __attribute__((address_space(1)))
#define LAS __attribute__((address_space(3)))
typedef unsigned short bf16_t;
typedef short bf16x8 __attribute__((ext_vector_type(8)));
typedef float f32x4 __attribute__((ext_vector_type(4)));
typedef float f32x16 __attribute__((ext_vector_type(16)));
typedef unsigned u32x4 __attribute__((ext_vector_type(4)));
typedef unsigned u32x2 __attribute__((ext_vector_type(2)));

namespace pg8 {
constexpr int BM = 256, BK = 64, HALF = 128, HTB = HALF * BK * 2, STAGE_BYTES = 8 * HTB, NXCD = 8, WGM = 8;
__host__ __device__ __forceinline__ int lds_byte(int r, int c) { const int st = (r >> 4) * 2 + (c >> 5), rr = r & 15, cc = c & 31, ob = rr * 64 + cc * 2; return st * 1024 + (ob ^ (((ob >> 9) & 1) << 5)); }
__host__ __device__ __forceinline__ void stage_rc(int b, int& R, int& C) { const int st = b / 1024, sb = b % 1024, swz = sb ^ (((sb >> 9) & 1) << 5); R = (st >> 1) * 16 + swz / 64; C = (st & 1) * 32 + (swz % 64) / 2; }
__host__ __device__ __forceinline__ int perm32(int rho) { const int n = rho >> 4, i = rho & 15; return 8 * (i >> 2) + 4 * n + (i & 3); }
struct Unit { int pm, pn, kt0, nkt, part; };
struct Gemm { const bf16_t* A; const bf16_t* Bt; int M, N, K; };
constexpr int GRID = 256;
template <int M, int N, int K, bool SPLIT>
struct SplitOrder {
    static constexpr int nM = M / BM, nN = N / BM, nwg = nM * nN, G = GRID, nt = K / BK, nfull = (nwg / G) * G, rem = nwg - nfull, NR = nfull / G;
    static constexpr int S0 = (SPLIT && rem > 0 && G % rem == 0) ? G / rem : 1;
    static constexpr int S = ((S0 == 2 || S0 == 4) && nt % (2 * S0) == 0) ? S0 : 1;
    int c;
    __host__ __device__ void init(int c_) { c = c_; }
    __host__ __device__ static Unit unit_of(int L, int kt0, int nkt, int part) {
        int wgid = L; { constexpr int q = nwg / NXCD, r = nwg % NXCD; const int xcd = wgid % NXCD, off = wgid / NXCD; wgid = (xcd < r ? xcd * (q + 1) : r * (q + 1) + (xcd - r) * q) + off; }
        constexpr int nig = WGM * nN; const int gid = wgid / nig, fm = gid * WGM, gsz = (nM - fm) < WGM ? (nM - fm) : WGM;
        Unit u; u.pm = fm + ((wgid % nig) % gsz); u.pn = (wgid % nig) / gsz; u.kt0 = kt0; u.nkt = nkt; u.part = part; return u;
    }
    __host__ __device__ bool next(int i, Unit& u) const {
        int L = i * G + c, kt0 = 0, nkt = nt, part = -1; bool ok = L < nwg;
        if (S > 1 && i >= NR) { constexpr int R1 = rem > 0 ? rem : 1; L = nfull + (c % R1); nkt = nt / S; kt0 = (c / R1) * (nt / S); part = c; ok = (i == NR); }
        if (!ok) return false;
        u = unit_of(L, kt0, nkt, part); return true;
    }
};
typedef float f32x2_t __attribute__((ext_vector_type(2)));
typedef __bf16 bf16x2_t __attribute__((ext_vector_type(2)));
__device__ __forceinline__ unsigned cvt_pk_bf16(float lo, float hi) { const f32x2_t v = {lo, hi}; return __builtin_bit_cast(unsigned, __builtin_convertvector(v, bf16x2_t)); }

template <class Epi, class Sched, bool ALIGN_EPI = false, bool SP2 = false>
__device__ __forceinline__ void gemm_phase(LAS unsigned char* lds, const Gemm g, const Sched& S, const Epi& E, float* slab) {
    const int tid = threadIdx.x, wid = __builtin_amdgcn_readfirstlane(tid >> 6), lane = tid & 63, wr = wid >> 2, wc = wid & 3, fr = lane & 15, fq = lane >> 4;
    const int K = g.K;
    unsigned voffA[2], voffB[2];
#pragma unroll
    for (int i = 0; i < 2; ++i) { int R, C; stage_rc(tid * 16 + i * 8192, R, C); const int Rb = Epi::PERM ? ((R & ~31) + perm32(R & 31)) : R;
        voffA[i] = (unsigned)(R * K + C) * 2u; voffB[i] = (unsigned)(Rb * K + C) * 2u; }
    const size_t kstep = (size_t)(BK * 2);
    const size_t hstep = (size_t)HALF * K * 2;
    const size_t tstep = 2 * hstep;
    const unsigned ldsw = (unsigned)wid * 1024u;
    const int aoff = lds_byte(wr * 64 + fr, fq * 8), boff = lds_byte(wc * 32 + fr, fq * 8);
#define PG8_SA(b, h) (((b) * 2 + (h)) * HTB)
#define PG8_SB(b, h) ((4 + (b) * 2 + (h)) * HTB)
#define PG8_STAGE(bufoff, gbase, voff) do { _Pragma("unroll") for (int _i = 0; _i < 2; ++_i) \
        __builtin_amdgcn_global_load_lds((const unsigned*)((const char*)(gbase) + (voff)[_i]), (LAS unsigned*)(lds + (bufoff) + ldsw + _i * 8192), 16, 0, 0); } while (0)
#define PG8_LDA(dst, b, h) do { _Pragma("unroll") for (int m = 0; m < 4; ++m) _Pragma("unroll") for (int k = 0; k < 2; ++k) dst[m][k] = *(const LAS bf16x8*)(lds + PG8_SA(b, h) + aoff + m * 2048 + k * 1024); } while (0)
#define PG8_LDB(dst, b, h) do { _Pragma("unroll") for (int n = 0; n < 2; ++n) _Pragma("unroll") for (int k = 0; k < 2; ++k) dst[n][k] = *(const LAS bf16x8*)(lds + PG8_SB(b, h) + boff + n * 2048 + k * 1024); } while (0)
#define PG8_MMA(ai, bj, At, Bt) do { __builtin_amdgcn_s_setprio(1); _Pragma("unroll") for (int m = 0; m < 4; ++m) _Pragma("unroll") for (int n = 0; n < 2; ++n) _Pragma("unroll") for (int k = 0; k < 2; ++k) \
        acc[ai][bj][m][n] = __builtin_amdgcn_mfma_f32_16x16x32_bf16(Bt[n][k], At[m][k], acc[ai][bj][m][n], 0, 0, 0); __builtin_amdgcn_s_setprio(0); } while (0)
#define PG8_WAIT_V(n) asm volatile("s_waitcnt vmcnt(" #n ")" ::: "memory")
#define PG8_WAIT_L(n) asm volatile("s_waitcnt lgkmcnt(" #n ")" ::: "memory")
#define PG8_BAR __builtin_amdgcn_s_barrier()
#define PG8_SCHED __builtin_amdgcn_sched_barrier(0)
    Unit cur, nxt; int ui = 0;
    if (!S.next(0, cur)) return;
    f32x4 acc[2][2][4][2];
#pragma unroll
    for (int a = 0; a < 2; ++a)
#pragma unroll
        for (int b = 0; b < 2; ++b)
#pragma unroll
            for (int m = 0; m < 4; ++m)
#pragma unroll
                for (int n = 0; n < 2; ++n) acc[a][b][m][n] = (f32x4){0.f, 0.f, 0.f, 0.f};
    bf16x8 At[4][2], B0[2][2], B1[2][2];
    const char* cA = (const char*)g.A + (size_t)cur.pm * tstep + (size_t)cur.kt0 * kstep; const char* cB = (const char*)g.Bt + (size_t)cur.pn * tstep + (size_t)cur.kt0 * kstep;
    if constexpr (SP2) {
        PG8_STAGE(PG8_SB(0, 0), cB, voffB); PG8_STAGE(PG8_SB(0, 1), cB + hstep, voffB); PG8_STAGE(PG8_SA(0, 0), cA, voffA); PG8_STAGE(PG8_SA(0, 1), cA + hstep, voffA);
        if (wr == 1) PG8_BAR;
        PG8_WAIT_V(2); PG8_BAR;
        PG8_STAGE(PG8_SB(1, 0), cB + kstep, voffB); PG8_STAGE(PG8_SA(1, 0), cA + kstep, voffA); PG8_STAGE(PG8_SB(1, 1), cB + hstep + kstep, voffB);
        PG8_WAIT_V(6); PG8_BAR;
    } else {
        PG8_STAGE(PG8_SB(0, 0), cB, voffB); PG8_STAGE(PG8_SA(0, 0), cA, voffA); PG8_STAGE(PG8_SB(0, 1), cB + hstep, voffB); PG8_STAGE(PG8_SA(0, 1), cA + hstep, voffA);
        if (wr == 1) PG8_BAR;
        PG8_WAIT_V(4); PG8_BAR;
        PG8_STAGE(PG8_SB(1, 0), cB + kstep, voffB); PG8_STAGE(PG8_SA(1, 0), cA + kstep, voffA); PG8_STAGE(PG8_SB(1, 1), cB + hstep + kstep, voffB);
        PG8_WAIT_V(6); PG8_BAR;
    }
    for (;;) {
        const bool has_next = S.next(ui + 1, nxt);
        const char* nA = has_next ? (const char*)g.A + (size_t)nxt.pm * tstep + (size_t)nxt.kt0 * kstep : cA; const char* nB = has_next ? (const char*)g.Bt + (size_t)nxt.pn * tstep + (size_t)nxt.kt0 * kstep : cB;
        const int nt = cur.nkt;
        for (int t = 0; t < nt; t += 2) {
            const bool last = (t == nt - 2);
            const char* a1 = cA + (size_t)(t + 1) * kstep;
            const char* a2 = last ? nA : cA + (size_t)(t + 2) * kstep; const char* b2 = last ? nB : cB + (size_t)(t + 2) * kstep;
            const char* a3 = a2 + kstep; const char* b3 = b2 + kstep;
            if constexpr (SP2) {
            PG8_LDB(B0, 0, 0); PG8_LDB(B1, 0, 1); PG8_SCHED; PG8_LDA(At, 0, 0); PG8_STAGE(PG8_SA(1, 1), a1 + hstep, voffA);
            PG8_WAIT_V(8); PG8_WAIT_L(0); PG8_BAR; PG8_MMA(0, 0, At, B0); PG8_MMA(0, 1, At, B1); PG8_BAR; PG8_SCHED;
            PG8_LDA(At, 0, 1); PG8_STAGE(PG8_SB(0, 0), b2, voffB); PG8_STAGE(PG8_SB(0, 1), b2 + hstep, voffB); PG8_STAGE(PG8_SA(0, 0), a2, voffA);
            PG8_WAIT_V(8); PG8_WAIT_L(0); PG8_BAR; PG8_MMA(1, 0, At, B0); PG8_MMA(1, 1, At, B1); PG8_BAR; PG8_SCHED;
            PG8_LDB(B0, 1, 0); PG8_LDB(B1, 1, 1); PG8_SCHED; PG8_LDA(At, 1, 0); PG8_STAGE(PG8_SA(0, 1), a2 + hstep, voffA);
            PG8_WAIT_V(8); PG8_WAIT_L(0); PG8_BAR; PG8_MMA(0, 0, At, B0); PG8_MMA(0, 1, At, B1); PG8_BAR; PG8_SCHED;
            PG8_LDA(At, 1, 1); PG8_STAGE(PG8_SB(1, 0), b3, voffB); PG8_STAGE(PG8_SB(1, 1), b3 + hstep, voffB); PG8_STAGE(PG8_SA(1, 0), a3, voffA);
            PG8_WAIT_V(8); PG8_WAIT_L(0); PG8_BAR; PG8_MMA(1, 0, At, B0); PG8_MMA(1, 1, At, B1); PG8_BAR; PG8_SCHED;
            } else {
            PG8_LDB(B0, 0, 0); PG8_SCHED; PG8_LDA(At, 0, 0); PG8_STAGE(PG8_SA(1, 1), a1 + hstep, voffA);
            PG8_WAIT_L(8); PG8_BAR; PG8_WAIT_L(0); PG8_MMA(0, 0, At, B0); PG8_BAR; PG8_SCHED;
            PG8_LDB(B1, 0, 1); PG8_STAGE(PG8_SB(0, 0), b2, voffB);
            PG8_BAR; PG8_WAIT_L(0); PG8_MMA(0, 1, At, B1); PG8_BAR;
            PG8_LDA(At, 0, 1); PG8_STAGE(PG8_SA(0, 0), a2, voffA);
            PG8_BAR; PG8_WAIT_L(0); PG8_MMA(1, 0, At, B0); PG8_BAR; PG8_SCHED;
            PG8_STAGE(PG8_SB(0, 1), b2 + hstep, voffB);
            PG8_WAIT_V(6); PG8_BAR; PG8_MMA(1, 1, At, B1); PG8_BAR;
            PG8_LDB(B0, 1, 0); PG8_SCHED; PG8_LDA(At, 1, 0); PG8_STAGE(PG8_SA(0, 1), a2 + hstep, voffA);
            PG8_WAIT_L(8); PG8_BAR; PG8_WAIT_L(0); PG8_MMA(0, 0, At, B0); PG8_BAR; PG8_SCHED;
            PG8_LDB(B1, 1, 1); PG8_STAGE(PG8_SB(1, 0), b3, voffB);
            PG8_BAR; PG8_WAIT_L(0); PG8_MMA(0, 1, At, B1); PG8_BAR;
            PG8_LDA(At, 1, 1); PG8_STAGE(PG8_SA(1, 0), a3, voffA);
            PG8_BAR; PG8_WAIT_L(0); PG8_MMA(1, 0, At, B0); PG8_BAR; PG8_SCHED;
            PG8_STAGE(PG8_SB(1, 1), b3 + hstep, voffB);
            PG8_WAIT_V(6); PG8_BAR; PG8_MMA(1, 1, At, B1); PG8_BAR;
            }
        }
        if constexpr (ALIGN_EPI) { if (wr == 0) PG8_BAR; }
        if (cur.part < 0) {
            const auto cx = E.begin(cur, wr, wc, fr, fq);
#pragma unroll
            for (int ai = 0; ai < 2; ++ai)
#pragma unroll
                for (int m = 0; m < 4; ++m) { const f32x4 v[2][2] = {{acc[ai][0][m][0], acc[ai][0][m][1]}, {acc[ai][1][m][0], acc[ai][1][m][1]}}; E.rows(cx, v, cur, ai, m, wr, wc, fr, fq); }
        } else {
            bf16_t* sp = (bf16_t*)slab + (size_t)cur.part * 65536 + (size_t)tid * 8;
#pragma unroll
            for (int ai = 0; ai < 2; ++ai)
#pragma unroll
                for (int bj = 0; bj < 2; ++bj)
#pragma unroll
                    for (int m = 0; m < 4; ++m) { const f32x4 a = acc[ai][bj][m][0], b = acc[ai][bj][m][1];
                        u32x4 w; w.x = cvt_pk_bf16(a[0], a[1]); w.y = cvt_pk_bf16(a[2], a[3]); w.z = cvt_pk_bf16(b[0], b[1]); w.w = cvt_pk_bf16(b[2], b[3]);
                        *(u32x4*)(sp + (size_t)(((ai * 2 + bj) * 4 + m) * 4096)) = w; }
        }
        if (!has_next) break;
#pragma unroll
        for (int a = 0; a < 2; ++a)
#pragma unroll
            for (int b = 0; b < 2; ++b)
#pragma unroll
                for (int m = 0; m < 4; ++m)
#pragma unroll
                    for (int n = 0; n < 2; ++n) acc[a][b][m][n] = (f32x4){0.f, 0.f, 0.f, 0.f};
        cur = nxt; cA = nA; cB = nB; ++ui;
        if constexpr (ALIGN_EPI) { if (wr == 1) PG8_BAR; }
    }
    PG8_WAIT_V(0);
    if constexpr (!ALIGN_EPI) { if (wr == 0) PG8_BAR; }
    PG8_BAR;
#undef PG8_SA
#undef PG8_SB
#undef PG8_STAGE
#undef PG8_LDA
#undef PG8_LDB
#undef PG8_MMA
#undef PG8_WAIT_V
#undef PG8_WAIT_L
#undef PG8_BAR
#undef PG8_SCHED
}
template <class Epi, class Sched>
__device__ __forceinline__ void gemm_fixup(const Epi& E, const float* slab) {
    if constexpr (Sched::S > 1) {
    constexpr int NG = 8 / Sched::S;
    const int tid = threadIdx.x, wid = __builtin_amdgcn_readfirstlane(tid >> 6), lane = tid & 63, wr = wid >> 2, wc = wid & 3, fr = lane & 15, fq = lane >> 4;
    for (int b = blockIdx.x; b < Sched::rem * Sched::S; b += Sched::G) {
        const int r = b % Sched::rem, q = b / Sched::rem;
        const Unit u = Sched::unit_of(Sched::nfull + r, 0, Sched::nt, -1);
        f32x4 v[NG][2][2];
#pragma unroll
        for (int gi = 0; gi < NG; ++gi)
#pragma unroll
            for (int bj = 0; bj < 2; ++bj)
#pragma unroll
                for (int n = 0; n < 2; ++n) v[gi][bj][n] = (f32x4){0.f, 0.f, 0.f, 0.f};
#pragma unroll
        for (int gi = 0; gi < NG; ++gi) { const int g = q * NG + gi, ai = g >> 2, m = g & 3;
#pragma unroll
            for (int p = 0; p < Sched::S; ++p) {
                const bf16_t* sp = (const bf16_t*)slab + (size_t)(r + p * Sched::rem) * 65536 + (size_t)tid * 8;
#pragma unroll
                for (int bj = 0; bj < 2; ++bj) { const u32x4 w = *(const u32x4*)(sp + (size_t)(((ai * 2 + bj) * 4 + m) * 4096));
                    v[gi][bj][0] += (f32x4){__builtin_bit_cast(float, w.x << 16), __builtin_bit_cast(float, w.x & 0xffff0000u), __builtin_bit_cast(float, w.y << 16), __builtin_bit_cast(float, w.y & 0xffff0000u)};
                    v[gi][bj][1] += (f32x4){__builtin_bit_cast(float, w.z << 16), __builtin_bit_cast(float, w.z & 0xffff0000u), __builtin_bit_cast(float, w.w << 16), __builtin_bit_cast(float, w.w & 0xffff0000u)}; } } }
        const auto cx = E.begin(u, wr, wc, fr, fq);
#pragma unroll
        for (int gi = 0; gi < NG; ++gi) { const int g = q * NG + gi; E.rows(cx, v[gi], u, g >> 2, g & 3, wr, wc, fr, fq); }
    }
    }
}
}

constexpr int DM = 2048, NTOK = 12288, NCTX = 4096, DFF = 5632, NFF2 = 11264;
constexpr int IN_EVEN = 4160, IN_EVEN_P = 4096, IN_ODD = 3072;
constexpr int NMOD = 18432;
constexpr float EPS = 1e-6f;
constexpr float LOG2E = 1.4426950408889634f;

constexpr size_t O_X = 0, O_CKV = 25165824, O_KROPE = 27262976, O_NAK = 27525120, O_NAV = 31719424, O_GK = 35913728, O_GV = 38010880, O_END = 40108032;

constexpr size_t MiB = 1u << 20;
constexpr size_t WS_CTL = 0;
constexpr size_t WS_MODS = 2 * MiB;
constexpr size_t CTL_ZERO_BYTES = 4 * MiB;
constexpr size_t WS_WFI = 4 * MiB;
constexpr size_t WS_WFO = WS_WFI + 176 * MiB;
constexpr size_t WS_WEI = WS_WFO + 88 * MiB;
constexpr size_t WS_WQU = WS_WEI + 17 * MiB;
constexpr size_t WS_WKU = WS_WQU + 2 * MiB;
constexpr size_t WS_WEO = WS_WKU + 2 * MiB;
constexpr size_t WS_WOI = WS_WEO + 8 * MiB;
constexpr size_t WS_WOO = WS_WOI + 12 * MiB;
constexpr size_t WS_H = WS_WOO + 8 * MiB;
constexpr size_t WS_ACT = WS_H + 48 * MiB;
constexpr size_t WS_P = WS_ACT + 132 * MiB;
constexpr size_t WS_QM = WS_P + 204 * MiB;
constexpr size_t WS_CQN = WS_QM + 72 * MiB;
constexpr size_t WS_CKVA = WS_CQN + 12 * MiB;
constexpr size_t WS_QA = WS_CKVA + 16 * MiB;
constexpr size_t WS_QNA = WS_QA + 48 * MiB;
constexpr size_t WS_KM_CTX = WS_QNA + 24 * MiB;
constexpr size_t WS_KM_LAT = WS_KM_CTX + 12 * MiB;
constexpr size_t WS_KM_CAC = WS_KM_LAT + 24 * MiB;
constexpr size_t WS_VM_CTX = WS_KM_CAC + 12 * MiB;
constexpr size_t WS_VM_LAT = WS_VM_CTX + 8 * MiB;
constexpr size_t WS_VM_CAC = WS_VM_LAT + 16 * MiB;
constexpr size_t WS_KN_CTX = WS_VM_CAC + 8 * MiB;
constexpr size_t WS_KN_LAT = WS_KN_CTX + 8 * MiB;
constexpr size_t WS_KN_CAC = WS_KN_LAT + 16 * MiB;
constexpr size_t WS_VN_CTX = WS_KN_CAC + 8 * MiB;
constexpr size_t WS_VN_LAT = WS_VN_CTX + 8 * MiB;
constexpr size_t WS_VN_CAC = WS_VN_LAT + 16 * MiB;
constexpr size_t WS_KG_CTX = WS_VN_CAC + 8 * MiB;
constexpr size_t WS_KG_LAT = WS_KG_CTX + 4 * MiB;
constexpr size_t WS_KG_CAC = WS_KG_LAT + 8 * MiB;
constexpr size_t WS_VG_CTX = WS_KG_CAC + 4 * MiB;
constexpr size_t WS_VG_LAT = WS_VG_CTX + 4 * MiB;
constexpr size_t WS_VG_CAC = WS_VG_LAT + 8 * MiB;
constexpr size_t WS_O = WS_VG_CAC + 4 * MiB;
constexpr size_t WS_KROPE = WS_O + 48 * MiB;
constexpr size_t WS_END = WS_KROPE + 4 * MiB;
constexpr int CW_BAR = 4096;

constexpr int RING_BYTES = 131072;
constexpr int LDSCTL_OFF = RING_BYTES;
constexpr int LDS_BYTES = 147456;

__device__ __forceinline__ unsigned f2bf(float f) { unsigned u = __builtin_bit_cast(unsigned, f); return (u + 0x7fffu + ((u >> 16) & 1u)) >> 16; }
__device__ __forceinline__ unsigned pk2(float lo, float hi) { return pg8::cvt_pk_bf16(lo, hi); }
__device__ __forceinline__ float wave_sum(float v) {
#pragma unroll
    for (int o = 1; o < 64; o <<= 1) v += __shfl_xor(v, o);
    return v;
}
__device__ __forceinline__ float fast_exp2(float x) { return __builtin_amdgcn_exp2f(x); }
__device__ __forceinline__ float fast_rcp(float x) { return __builtin_amdgcn_rcpf(x); }
__device__ __forceinline__ float silu_f(float g) { return g * fast_rcp(1.0f + fast_exp2(-g * LOG2E)); }
__device__ __forceinline__ float sin_rev(float rev) { return __builtin_amdgcn_sinf(rev); }
__device__ __forceinline__ float cos_rev(float rev) { return __builtin_amdgcn_cosf(rev); }

#define XB_TMO      128
#define XB_XCNT(j)  (256  + 64 * (j))
#define XB_XSUB(j)  (1280 + 64 * (j))
#define XB_XGEN(j)  (2304 + 64 * (j))
#define XB_TOP      3328
#define XB_TOPGEN   3392
#define XCD_BAR_WORDS 3456
#define XB_SPIN_CAP (1u << 18)
__device__ __forceinline__ unsigned xb_ld(unsigned* p)              { return __hip_atomic_load(p, __ATOMIC_RELAXED, __HIP_MEMORY_SCOPE_AGENT); }
__device__ __forceinline__ unsigned xb_add(unsigned* p, unsigned v) { return __hip_atomic_fetch_add(p, v, __ATOMIC_RELAXED, __HIP_MEMORY_SCOPE_AGENT); }
__device__ __forceinline__ unsigned xb_xcc_id() { return (unsigned)__builtin_amdgcn_s_getreg((3 << 11) | 20) & 0xFu; }
#define XB_SPIN(cond, bar) do { unsigned _sp = 0; while (cond) { __builtin_amdgcn_s_sleep(1); \
    if ((++_sp & 255u) == 0u) { if (xb_ld(&(bar)[XB_TMO])) break; if (_sp > XB_SPIN_CAP) { atomicAdd(&(bar)[XB_TMO], 1u); break; } } } } while (0)
struct XcdBarrier { unsigned* bar; unsigned x; volatile LAS unsigned* st; };
__device__ __forceinline__ XcdBarrier xcd_barrier_post(unsigned* bar, volatile LAS unsigned* st) {
    XcdBarrier b; b.bar = bar; b.x = xb_xcc_id(); b.st = st;
    if (threadIdx.x == 0) (void)xb_add(&bar[XB_XCNT(b.x)], 1u);
    return b;
}
__device__ __forceinline__ void xcd_barrier_complete(unsigned* bar, unsigned x, unsigned& nloc, unsigned& nx) {
    const unsigned G = gridDim.x * gridDim.y * gridDim.z;
    unsigned sum, cnt, mine, sp = 0u;
    for (;;) {
        sum = 0u; cnt = 0u; mine = 0u;
#pragma unroll
        for (unsigned j = 0; j < 16; ++j) { const unsigned c = xb_ld(&bar[XB_XCNT(j)]); sum += c; cnt += (c > 0u) ? 1u : 0u; mine = (j == x) ? c : mine; }
        if (sum == G) break;
        __builtin_amdgcn_s_sleep(1);
        if ((++sp & 255u) == 0u) { if (xb_ld(&bar[XB_TMO])) break; if (sp > XB_SPIN_CAP) { atomicAdd(&bar[XB_TMO], 1u); break; } }
    }
    nloc = mine > 0u ? mine : 1u; nx = cnt > 0u ? cnt : 1u;
}
__device__ __forceinline__ void xcd_barrier(const XcdBarrier& b) {
    asm volatile("s_waitcnt vmcnt(0)" ::: "memory");
    __syncthreads();
    if (threadIdx.x == 0) {
        unsigned* bar = b.bar;
        __builtin_amdgcn_s_waitcnt(0);
        unsigned nloc = b.st[0], nx = b.st[1];
        if (nloc == 0u) { xcd_barrier_complete(bar, b.x, nloc, nx); b.st[0] = nloc; b.st[1] = nx; }
        const unsigned old = xb_add(&bar[XB_XSUB(b.x)], 1u);
        const unsigned gen = old / nloc;
        if (old + 1u == (gen + 1u) * nloc) {
            __builtin_amdgcn_fence(__ATOMIC_RELEASE, "agent");
            asm volatile("s_waitcnt vmcnt(0)" ::: "memory");
            const unsigned og = xb_add(&bar[XB_TOP], 1u);
            const unsigned tg = og / nx;
            if (og + 1u == (tg + 1u) * nx) xb_add(&bar[XB_TOPGEN], 1u);
            else XB_SPIN(xb_ld(&bar[XB_TOPGEN]) == tg, bar);
            __builtin_amdgcn_fence(__ATOMIC_ACQUIRE, "agent");
            xb_add(&bar[XB_XGEN(b.x)], 1u);
            asm volatile("s_waitcnt vmcnt(0)" ::: "memory");
        } else {
            XB_SPIN(xb_ld(&bar[XB_XGEN(b.x)]) == gen, bar);
            __builtin_amdgcn_fence(__ATOMIC_ACQUIRE, "agent");
            asm volatile("s_waitcnt vmcnt(0)" ::: "memory");
        }
    }
    __syncthreads();
}

struct Args { const float* in[28]; float* out; unsigned char* ws; int ph_lo, ph_hi; };
struct Frame {
    LAS unsigned char* lds;
    int tid, lane, wave, G, gw, NGW;
    const Args* a; float* out; unsigned char* ws;
};
#define IN_XP 0
#define IN_XS 1
#define IN_C_CKV 2
#define IN_C_KROPE 3
#define IN_C_NAK 4
#define IN_C_NAV 5
#define IN_C_GK 6
#define IN_C_GV 7
#define IN_C 8
#define IN_CCTX 9
#define IN_ADAW 10
#define IN_ADAB 11
#define IN_NORMG 12
#define IN_FFI 13
#define IN_FFO 14
#define IN_EWI 15
#define IN_EWO 16
#define IN_QNORM 17
#define IN_WQUP 18
#define IN_KVNORM 19
#define IN_WKVUP 20
#define IN_MLAQK 21
#define IN_NAQK 22
#define IN_RPB 23
#define IN_OWI 24
#define IN_OWO 25
#define IN_GQK 26
#define IN_SINK 27

__device__ __forceinline__ int opaque_v(int x) { asm volatile("" : "+v"(x)); return x; }
__device__ __forceinline__ int tok_mb(int t) { return t < NCTX ? 0 : 1 + ((t - NCTX) >> 10); }

__device__ __forceinline__ size_t k_chunk_off(int DQK, int key, int c8) { return (size_t)(key >> 5) * (DQK * 32) + (size_t)(c8 >> 1) * 512 + (((c8 & 1) * 32 + (key & 31)) << 3); }
__device__ __forceinline__ void vt_tile_write_h(const bf16_t* src0, size_t pitch, bf16_t* dst, int lane) {
#pragma unroll
    for (int it = 0; it < 8; ++it) {
        const int d = (it & 1) * 64 + lane, s = (it >> 1) & 1, hh = it >> 2;
        unsigned v[8];
#pragma unroll
        for (int j = 0; j < 8; ++j) { const int key = 16 * s + 8 * (j >> 2) + 4 * hh + (j & 3); v[j] = src0[(size_t)key * pitch + d]; }
        u32x4 w; w.x = v[0] | (v[1] << 16); w.y = v[2] | (v[3] << 16); w.z = v[4] | (v[5] << 16); w.w = v[6] | (v[7] << 16);
        *(u32x4*)(dst + (size_t)(((s * 4 + (d >> 5)) * 64 + hh * 32 + (d & 31)) << 3)) = w;
    }
}
__device__ __forceinline__ void vt_tile_write(const float* src0, size_t pitch, bf16_t* dst, int lane) {
#pragma unroll
    for (int it = 0; it < 8; ++it) {
        const int d = (it & 1) * 64 + lane, s = (it >> 1) & 1, hh = it >> 2;
        float v[8];
#pragma unroll
        for (int j = 0; j < 8; ++j) { const int key = 16 * s + 8 * (j >> 2) + 4 * hh + (j & 3); v[j] = src0[(size_t)key * pitch + d]; }
        u32x4 w; w.x = pk2(v[0], v[1]); w.y = pk2(v[2], v[3]); w.z = pk2(v[4], v[5]); w.w = pk2(v[6], v[7]);
        *(u32x4*)(dst + (size_t)(((s * 4 + (d >> 5)) * 64 + hh * 32 + (d & 31)) << 3)) = w;
    }
}

__device__ __forceinline__ void p0_transpose_item(const float* W, int K, int N, bf16_t* WT, int mode, LAS float* scr, int item, int lane) {
    const int nblk = N / 32, kb = item / nblk, nb = item % nblk, k0 = 64 * kb, n0 = 32 * nb;
#pragma unroll 8
    for (int i = 0; i < 32; ++i) { const int kk = 2 * i + (lane >> 5); scr[kk * 33 + (lane & 31)] = __builtin_nontemporal_load(W + (size_t)(k0 + kk) * N + n0 + (lane & 31)); }
    asm volatile("s_waitcnt lgkmcnt(0)" ::: "memory");
    int d0 = n0;
    if (mode == 1) { const int j0 = n0 < DFF ? n0 : n0 - DFF; d0 = 256 * (j0 >> 7) + (j0 & 127) + (n0 < DFF ? 0 : 128); }
    if (mode == 2) d0 = n0 < 1024 ? n0 : (n0 < 1088 ? 4096 + (n0 - 1024) : n0 - 64);
    const int c = lane & 7;
#pragma unroll
    for (int j = 0; j < 4; ++j) { const int n = (lane >> 3) + 8 * j; const LAS float* s = scr + (8 * c) * 33 + n;
        u32x4 o; o.x = pk2(s[0 * 33], s[1 * 33]); o.y = pk2(s[2 * 33], s[3 * 33]); o.z = pk2(s[4 * 33], s[5 * 33]); o.w = pk2(s[6 * 33], s[7 * 33]);
        *(u32x4*)(WT + (size_t)(d0 + n) * K + k0 + 8 * c) = o; }
    asm volatile("s_waitcnt lgkmcnt(0)" ::: "memory");
}

__device__ __forceinline__ const float* p0_mods_wptr(Frame& F, int item) {
    const int layer = item / 1152, rem = item % 1152, slab = rem >> 4, ks = rem & 15;
    return F.a->in[IN_ADAW] + (size_t)layer * DM * NMOD + (size_t)(ks * 128 + F.wave * 16) * NMOD + slab * 256 + 4 * F.lane;
}
__device__ __forceinline__ void phase_mods(Frame& F) {
    LAS float* stab = (LAS float*)(F.lds);
    LAS float* part = (LAS float*)(F.lds + 8192);
    const float* c = F.a->in[IN_C]; const float* cctx = F.a->in[IN_CCTX];
    for (int item = blockIdx.x; item < 2304; item += F.G) {
        const int layer = item / 1152, rem = item % 1152, slab = rem >> 4, ks = rem & 15, n0 = slab * 256, k0 = ks * 128;
        f32x4 w[16];
        { const float* W = p0_mods_wptr(F, item);
#pragma unroll
          for (int kk = 0; kk < 16; ++kk) w[kk] = __builtin_nontemporal_load((const f32x4*)(W + (size_t)kk * NMOD)); }
        for (int i = F.tid; i < 9 * 128; i += 512) { const int b = i >> 7, k = i & 127; const float v = (b == 0) ? cctx[k0 + k] : c[(size_t)(b - 1) * DM + k0 + k]; stab[i] = silu_f(v); }
        __syncthreads();
        f32x4 acc[9];
#pragma unroll
        for (int b = 0; b < 9; ++b) acc[b] = (f32x4){0.f, 0.f, 0.f, 0.f};
#pragma unroll
        for (int kk = 0; kk < 16; ++kk) {
#pragma unroll
            for (int b = 0; b < 9; ++b) { const float sv = stab[b * 128 + F.wave * 16 + kk]; acc[b] += w[kk] * sv; }
        }
#pragma unroll
        for (int b = 0; b < 9; ++b) *(LAS f32x4*)(part + (F.wave * 9 + b) * 256 + 4 * F.lane) = acc[b];
        __syncthreads();
        float* mods = (float*)(F.ws + WS_MODS) + (size_t)layer * 9 * NMOD;
        const float* bias = F.a->in[IN_ADAB] + (size_t)layer * NMOD;
        for (int i = F.tid; i < 9 * 256; i += 512) { const int b = i >> 8, col = i & 255; float sm = 0.f;
#pragma unroll
            for (int ww = 0; ww < 8; ++ww) sm += part[(ww * 9 + b) * 256 + col];
            if (ks == 0) sm += bias[n0 + col];
            atomicAdd(mods + (size_t)b * NMOD + n0 + col, sm); }
        __syncthreads();
    }
}

__device__ __forceinline__ void p0_cacheK_item(const float* src, int H, bf16_t* dstbase, int item, int lane) {
    const int t32 = item & 15, bh = item >> 4, b = bh / H, h = bh % H;
    bf16_t* dst = dstbase + (size_t)bh * (512 * 128);
#pragma unroll
    for (int it = 0; it < 8; ++it) { const int idx = it * 64 + lane, kl = idx >> 4, c8 = idx & 15, key = t32 * 32 + kl;
        const float* s = src + ((size_t)(b * 512 + key) * H + h) * 128 + c8 * 8;
        const f32x4 a = *(const f32x4*)s, bb = *(const f32x4*)(s + 4);
        u32x4 w; w.x = pk2(a[0], a[1]); w.y = pk2(a[2], a[3]); w.z = pk2(bb[0], bb[1]); w.w = pk2(bb[2], bb[3]);
        *(u32x4*)(dst + k_chunk_off(128, key, c8)) = w; }
}
__device__ __forceinline__ void p0_cacheV_item(const float* src, int H, bf16_t* dstbase, int item, int lane) {
    const int t32 = item & 15, bh = item >> 4, b = bh / H, h = bh % H;
    vt_tile_write(src + ((size_t)(b * 512 + t32 * 32) * H + h) * 128, (size_t)H * 128, dstbase + (size_t)bh * (512 * 128) + (size_t)t32 * 4096, lane);
}

__device__ __forceinline__ void phase_prologue(Frame& F) {
    phase_mods(F);
    LAS float* scr = (LAS float*)(F.lds + F.wave * 16384);
    constexpr int I_FI = 32 * 352, I_FO = 88 * 64, I_EI = 32 * 130, I_QU = 8 * 48, I_KU = 8 * 64, I_EO = 32 * 64, I_OI = 32 * 96, I_OO = 32 * 64;
    constexpr int I_PAD = 0, I_CKV = 1024, I_NK = 1024, I_NV = 1024, I_GK = 512, I_GV = 512;
    constexpr int NITEMS = 4 * I_FI + 4 * I_FO + I_EI + I_QU + I_KU + I_EO + I_OI + I_OO + I_PAD + I_CKV + I_NK + I_NV + I_GK + I_GV;
    unsigned char* ws = F.ws;
    for (int it = F.gw; it < NITEMS; it += F.NGW) {
        int r = it;
        if (r < 4 * I_FI) { const int m = r / I_FI; p0_transpose_item(F.a->in[IN_FFI] + (size_t)m * DM * NFF2, DM, NFF2, (bf16_t*)(ws + WS_WFI) + (size_t)m * NFF2 * DM, 1, scr, r % I_FI, F.lane); continue; } r -= 4 * I_FI;
        if (r < 4 * I_FO) { const int m = r / I_FO; p0_transpose_item(F.a->in[IN_FFO] + (size_t)m * DFF * DM, DFF, DM, (bf16_t*)(ws + WS_WFO) + (size_t)m * DM * DFF, 0, scr, r % I_FO, F.lane); continue; } r -= 4 * I_FO;
        if (r < I_EI) { p0_transpose_item(F.a->in[IN_EWI], DM, IN_EVEN, (bf16_t*)(ws + WS_WEI), 2, scr, r, F.lane); continue; } r -= I_EI;
        if (r < I_QU) { p0_transpose_item(F.a->in[IN_WQUP], 512, 1536, (bf16_t*)(ws + WS_WQU), 0, scr, r, F.lane); continue; } r -= I_QU;
        if (r < I_KU) { p0_transpose_item(F.a->in[IN_WKVUP], 512, 2048, (bf16_t*)(ws + WS_WKU), 0, scr, r, F.lane); continue; } r -= I_KU;
        if (r < I_EO) { p0_transpose_item(F.a->in[IN_EWO], DM, DM, (bf16_t*)(ws + WS_WEO), 0, scr, r, F.lane); continue; } r -= I_EO;
        if (r < I_OI) { p0_transpose_item(F.a->in[IN_OWI], DM, IN_ODD, (bf16_t*)(ws + WS_WOI), 0, scr, r, F.lane); continue; } r -= I_OI;
        if (r < I_OO) { p0_transpose_item(F.a->in[IN_OWO], DM, DM, (bf16_t*)(ws + WS_WOO), 0, scr, r, F.lane); continue; } r -= I_OO;
        if (r < I_PAD) { u32x4* p = (u32x4*)((bf16_t*)(ws + WS_WEI) + (size_t)(IN_EVEN + r) * DM); const u32x4 z = {0u, 0u, 0u, 0u};
#pragma unroll
            for (int j = 0; j < 4; ++j) p[j * 64 + F.lane] = z; continue; } r -= I_PAD;
        if (r < I_CKV) {
#pragma unroll
            for (int j = 0; j < 4; ++j) { const int row = 4 * r + j; const float* s = F.a->in[IN_C_CKV] + (size_t)row * 512 + 8 * F.lane;
                const f32x4 a = *(const f32x4*)s, b = *(const f32x4*)(s + 4);
                u32x4 w; w.x = pk2(a[0], a[1]); w.y = pk2(a[2], a[3]); w.z = pk2(b[0], b[1]); w.w = pk2(b[2], b[3]);
                *(u32x4*)((bf16_t*)(ws + WS_CKVA) + (size_t)(NTOK + row) * 512 + 8 * F.lane) = w; }
            continue; } r -= I_CKV;
        if (r < I_NK) { p0_cacheK_item(F.a->in[IN_C_NAK], 8, (bf16_t*)(ws + WS_KN_CAC), r, F.lane); continue; } r -= I_NK;
        if (r < I_NV) { p0_cacheV_item(F.a->in[IN_C_NAV], 8, (bf16_t*)(ws + WS_VN_CAC), r, F.lane); continue; } r -= I_NV;
        if (r < I_GK) { p0_cacheK_item(F.a->in[IN_C_GK], 4, (bf16_t*)(ws + WS_KG_CAC), r, F.lane); continue; } r -= I_GK;
        p0_cacheV_item(F.a->in[IN_C_GV], 4, (bf16_t*)(ws + WS_VG_CAC), r, F.lane);
    }
}

__device__ __forceinline__ const float* x_in_row(Frame& F, int t) { return t < NCTX ? F.a->in[IN_XP] + (size_t)t * DM : F.a->in[IN_XS] + (size_t)(t - NCTX) * DM; }
__device__ __forceinline__ void phase_norm(Frame& F, bool from_input, int layer, int sub) {
    const float* g = F.a->in[IN_NORMG] + (size_t)(layer * 3 + sub) * DM;
    bf16_t* H = (bf16_t*)(F.ws + WS_H);
    const int lane = opaque_v(F.lane);
    for (int t = F.gw; t < NTOK; t += F.NGW) {
        const float* xr = from_input ? x_in_row(F, t) : F.out + (size_t)t * DM;
        const float* md = (const float*)(F.ws + WS_MODS) + ((size_t)layer * 9 + tok_mb(t)) * NMOD + (size_t)(3 * sub) * DM;
        f32x4 v[8]; float ss = 0.f;
#pragma unroll
        for (int j = 0; j < 8; ++j) { v[j] = *(const f32x4*)(xr + 256 * j + 4 * lane); ss += (v[j][0] * v[j][0] + v[j][1] * v[j][1]) + (v[j][2] * v[j][2] + v[j][3] * v[j][3]); }
        const float rstd = __builtin_amdgcn_rsqf(wave_sum(ss) * (1.0f / DM) + EPS);
#pragma unroll
        for (int j = 0; j < 8; ++j) { const int c = 256 * j + 4 * lane;
            const f32x4 gg = *(const f32x4*)(g + c), sh = *(const f32x4*)(md + c), sc = *(const f32x4*)(md + DM + c);
            const f32x4 y = (v[j] * rstd * gg) * (sc + 1.0f) + sh;
            u32x2 w; w.x = pk2(y[0], y[1]); w.y = pk2(y[2], y[3]);
            *(u32x2*)(H + (size_t)t * DM + c) = w; }
    }
}

struct EpiSwiGLU {
    static constexpr bool PERM = true;
    bf16_t* O;
    struct Ctx { int row0, col0; };
    __device__ __forceinline__ Ctx begin(const pg8::Unit& u, int wr, int wc, int fr, int fq) const { return Ctx{u.pm * 256 + wr * 64 + fr, u.pn * 128 + wc * 32 + 8 * fq}; }
    __device__ __forceinline__ void rows(const Ctx& c, const f32x4 (&v)[2][2], const pg8::Unit&, int ai, int m, int, int, int, int) const {
        float r[8];
#pragma unroll
        for (int n = 0; n < 2; ++n)
#pragma unroll
            for (int j = 0; j < 4; ++j) r[4 * n + j] = silu_f(v[0][n][j]) * v[1][n][j];
        u32x4 w; w.x = pk2(r[0], r[1]); w.y = pk2(r[2], r[3]); w.z = pk2(r[4], r[5]); w.w = pk2(r[6], r[7]);
        *(u32x4*)(O + (size_t)(c.row0 + ai * 128 + m * 16) * DFF + c.col0) = w;
    }
};
struct EpiResid {
    static constexpr bool PERM = false;
    const float* xp; const float* xs; bool from_input; float* out; const float* gate_base; float coef;
    struct Ctx { const float* xin; f32x4 gv[2][2]; int row0, col0; };
    __device__ __forceinline__ Ctx begin(const pg8::Unit& u, int wr, int wc, int fr, int fq) const {
        Ctx c; const int rowt = u.pm * 256; c.row0 = rowt + wr * 64 + fr; c.col0 = u.pn * 256 + wc * 32 + 4 * fq;
        const float* gt = gate_base + (size_t)tok_mb(rowt) * NMOD;
        c.xin = from_input ? (rowt < NCTX ? xp : xs - (size_t)NCTX * DM) : out;
#pragma unroll
        for (int bj = 0; bj < 2; ++bj)
#pragma unroll
            for (int n = 0; n < 2; ++n) c.gv[bj][n] = *(const f32x4*)(gt + c.col0 + bj * 128 + n * 16) * coef;
        return c;
    }
    __device__ __forceinline__ void rows(const Ctx& c, const f32x4 (&v)[2][2], const pg8::Unit&, int ai, int m, int, int, int, int) const {
        const size_t off = (size_t)(c.row0 + ai * 128 + m * 16) * DM + c.col0;
#pragma unroll
        for (int bj = 0; bj < 2; ++bj)
#pragma unroll
            for (int n = 0; n < 2; ++n) { const f32x4 xv = *(const f32x4*)(c.xin + off + bj * 128 + n * 16);
                *(f32x4*)(out + off + bj * 128 + n * 16) = xv + c.gv[bj][n] * v[bj][n]; }
        asm volatile("" ::: "memory");
    }
};
struct EpiBf16 {
    static constexpr bool PERM = true;
    bf16_t* C; int ldc;
    struct Ctx { int row0, col0; };
    __device__ __forceinline__ Ctx begin(const pg8::Unit& u, int wr, int wc, int fr, int fq) const { return Ctx{u.pm * 256 + wr * 64 + fr, u.pn * 256 + wc * 32 + 8 * fq}; }
    __device__ __forceinline__ void rows(const Ctx& c, const f32x4 (&v)[2][2], const pg8::Unit&, int ai, int m, int, int, int, int) const {
        bf16_t* rowp = C + (size_t)(c.row0 + ai * 128 + m * 16) * ldc + c.col0;
#pragma unroll
        for (int bj = 0; bj < 2; ++bj) { u32x4 w; w.x = pk2(v[bj][0][0], v[bj][0][1]); w.y = pk2(v[bj][0][2], v[bj][0][3]); w.z = pk2(v[bj][1][0], v[bj][1][1]); w.w = pk2(v[bj][1][2], v[bj][1][3]);
            *(u32x4*)(rowp + bj * 128) = w; }
    }
};
struct EpiF32 {
    static constexpr bool PERM = false;
    float* C; int ldc;
    struct Ctx { int row0, col0; };
    __device__ __forceinline__ Ctx begin(const pg8::Unit& u, int wr, int wc, int fr, int fq) const { return Ctx{u.pm * 256 + wr * 64 + fr, u.pn * 256 + wc * 32 + 4 * fq}; }
    __device__ __forceinline__ void rows(const Ctx& c, const f32x4 (&v)[2][2], const pg8::Unit&, int ai, int m, int, int, int, int) const {
        float* rowp = C + (size_t)(c.row0 + ai * 128 + m * 16) * ldc + c.col0;
#pragma unroll
        for (int bj = 0; bj < 2; ++bj)
#pragma unroll
            for (int n = 0; n < 2; ++n) *(f32x4*)(rowp + bj * 128 + n * 16) = v[bj][n];
    }
};

__device__ __forceinline__ void load8(const float* p, float (&v)[8]) { const f32x4 a = *(const f32x4*)p, b = *(const f32x4*)(p + 4); v[0] = a[0]; v[1] = a[1]; v[2] = a[2]; v[3] = a[3]; v[4] = b[0]; v[5] = b[1]; v[6] = b[2]; v[7] = b[3]; }
__device__ __forceinline__ void load8h(const bf16_t* p, float (&v)[8]) { const u32x4 w = *(const u32x4*)p;
    v[0] = __builtin_bit_cast(float, w.x << 16); v[1] = __builtin_bit_cast(float, w.x & 0xffff0000u); v[2] = __builtin_bit_cast(float, w.y << 16); v[3] = __builtin_bit_cast(float, w.y & 0xffff0000u);
    v[4] = __builtin_bit_cast(float, w.z << 16); v[5] = __builtin_bit_cast(float, w.z & 0xffff0000u); v[6] = __builtin_bit_cast(float, w.w << 16); v[7] = __builtin_bit_cast(float, w.w & 0xffff0000u); }
__device__ __forceinline__ u32x4 pack8(const float (&v)[8]) { u32x4 w; w.x = pk2(v[0], v[1]); w.y = pk2(v[2], v[3]); w.z = pk2(v[4], v[5]); w.w = pk2(v[6], v[7]); return w; }
__device__ __forceinline__ void store8f(float* p, const float (&v)[8]) { *(f32x4*)p = (f32x4){v[0], v[1], v[2], v[3]}; *(f32x4*)(p + 4) = (f32x4){v[4], v[5], v[6], v[7]}; }
template <int W> __device__ __forceinline__ float group_sum(float v) {
#pragma unroll
    for (int o = 1; o < W; o <<= 1) v += __shfl_xor(v, o);
    return v;
}

__device__ __forceinline__ void phase_post1_even(Frame& F) {
    const bf16_t* P = (const bf16_t*)(F.ws + WS_P);
    const float* qn_g = F.a->in[IN_QNORM]; const float* kvn_g = F.a->in[IN_KVNORM]; const float* naq_g = F.a->in[IN_NAQK]; const float* nak_g = F.a->in[IN_NAQK] + 128;
    bf16_t* CQN = (bf16_t*)(F.ws + WS_CQN); bf16_t* CKVA = (bf16_t*)(F.ws + WS_CKVA); bf16_t* QNA = (bf16_t*)(F.ws + WS_QNA);
    constexpr int NVT_CTX = 16 * 8 * 8, NVT_LAT = 8 * 8 * 32, NKR = NTOK / 16;
    for (int it = F.gw; it < NKR; it += F.NGW) {
        const int t0 = it * 16, lane = F.lane, lr = lane & 15, lq = lane >> 4;
        const bf16_t* ap = (const bf16_t*)(F.ws + WS_H) + (size_t)(t0 + lr) * DM + 8 * lq;
        const bf16_t* bp = (const bf16_t*)(F.ws + WS_WEI) + (size_t)(4096 + lr) * DM + 8 * lq;
        f32x4 acc[4];
#pragma unroll
        for (int j = 0; j < 4; ++j) acc[j] = (f32x4){0.f, 0.f, 0.f, 0.f};
#pragma unroll 8
        for (int kk = 0; kk < 64; ++kk) {
            const bf16x8 af = *(const bf16x8*)(ap + kk * 32);
#pragma unroll
            for (int j = 0; j < 4; ++j) { const bf16x8 bf = *(const bf16x8*)(bp + (size_t)j * 16 * DM + kk * 32); acc[j] = __builtin_amdgcn_mfma_f32_16x16x32_bf16(af, bf, acc[j], 0, 0, 0); }
        }
        float* kr = (float*)(F.ws + WS_KROPE);
#pragma unroll
        for (int j = 0; j < 4; ++j)
#pragma unroll
            for (int r = 0; r < 4; ++r) { const int t = t0 + 4 * lq + r, c = 16 * j + lr; kr[(size_t)t * 64 + c] = acc[j][r]; if (t < NCTX) F.out[O_KROPE + (size_t)t * 64 + c] = acc[j][r]; }
    }
    for (int it = F.gw; it < NTOK + NVT_CTX + NVT_LAT; it += F.NGW) {
        if (it < NTOK) {
            const int t = it, lane = F.lane; const bf16_t* pr = P + (size_t)t * IN_EVEN_P; const bool ctx = t < NCTX;
            float v[8], g[8];
            load8h(pr + 8 * lane, v); float ss = 0.f;
#pragma unroll
            for (int i = 0; i < 8; ++i) ss += v[i] * v[i];
            float rstd = __builtin_amdgcn_rsqf(wave_sum(ss) * (1.0f / 512) + EPS);
            load8(qn_g + 8 * lane, g);
#pragma unroll
            for (int i = 0; i < 8; ++i) v[i] = v[i] * rstd * g[i];
            *(u32x4*)(CQN + (size_t)t * 512 + 8 * lane) = pack8(v);
            load8h(pr + 512 + 8 * lane, v); ss = 0.f;
#pragma unroll
            for (int i = 0; i < 8; ++i) ss += v[i] * v[i];
            rstd = __builtin_amdgcn_rsqf(wave_sum(ss) * (1.0f / 512) + EPS);
            load8(kvn_g + 8 * lane, g);
#pragma unroll
            for (int i = 0; i < 8; ++i) v[i] = v[i] * rstd * g[i];
            if (ctx) store8f(F.out + O_CKV + (size_t)t * 512 + 8 * lane, v);
            *(u32x4*)(CKVA + (size_t)t * 512 + 8 * lane) = pack8(v);
            const int head = lane >> 3, d0 = (lane & 7) * 16;
            int b, s; if (ctx) { b = t >> 8; s = t & 255; } else { b = (t - NCTX) >> 10; s = (t - NCTX) & 1023; }
#pragma unroll
            for (int which = 0; which < 2; ++which) {
                const bf16_t* src = pr + 1024 + which * 1024 + head * 128 + d0; const float* gg = which ? nak_g : naq_g;
                float a[8], c[8], ga[8], gc[8]; load8h(src, a); load8h(src + 8, c); load8(gg + d0, ga); load8(gg + d0 + 8, gc);
                float q = 0.f;
#pragma unroll
                for (int i = 0; i < 8; ++i) q += a[i] * a[i] + c[i] * c[i];
                const float r2 = __builtin_amdgcn_rsqf(group_sum<8>(q) * (1.0f / 128) + EPS);
#pragma unroll
                for (int i = 0; i < 8; ++i) { a[i] = a[i] * r2 * ga[i]; c[i] = c[i] * r2 * gc[i]; }
                if (which == 0) { bf16_t* qd = QNA + (size_t)t * 1024 + head * 128 + d0; *(u32x4*)qd = pack8(a); *(u32x4*)(qd + 8) = pack8(c); }
                else {
                    if (ctx) { float* od = F.out + O_NAK + (size_t)t * 1024 + head * 128 + d0; store8f(od, a); store8f(od + 8, c); }
                    bf16_t* kb = ctx ? (bf16_t*)(F.ws + WS_KN_CTX) + (size_t)(b * 8 + head) * (256 * 128) : (bf16_t*)(F.ws + WS_KN_LAT) + (size_t)(b * 8 + head) * (1024 * 128);
                    *(u32x4*)(kb + k_chunk_off(128, s, d0 >> 3)) = pack8(a); *(u32x4*)(kb + k_chunk_off(128, s, (d0 >> 3) + 1)) = pack8(c);
                }
            }
            { const bf16_t* src = pr + 3072 + 16 * lane; float a[8], c[8]; load8h(src, a); load8h(src + 8, c); if (ctx) { float* od = F.out + O_NAV + (size_t)t * 1024 + 16 * lane; store8f(od, a); store8f(od + 8, c); } }
        } else {
            int r = it - NTOK;
            if (r < NVT_CTX) { const int t32 = r & 7, bh = r >> 3, b = bh >> 3, h = bh & 7;
                vt_tile_write_h(P + (size_t)(b * 256 + t32 * 32) * IN_EVEN_P + 3072 + h * 128, IN_EVEN_P, (bf16_t*)(F.ws + WS_VN_CTX) + (size_t)bh * (256 * 128) + (size_t)t32 * 4096, F.lane);
            } else { r -= NVT_CTX; const int t32 = r & 31, bh = r >> 5, b = bh >> 3, h = bh & 7;
                vt_tile_write_h(P + (size_t)(NCTX + b * 1024 + t32 * 32) * IN_EVEN_P + 3072 + h * 128, IN_EVEN_P, (bf16_t*)(F.ws + WS_VN_LAT) + (size_t)bh * (1024 * 128) + (size_t)t32 * 4096, F.lane);
            }
        }
    }
}

__device__ __forceinline__ void rope8(float (&v)[8], const float (&vp)[8], bool is_x1, float pos, int f0, float inv_nf) {
#pragma unroll
    for (int i = 0; i < 8; ++i) {
        const float invf = fast_exp2(-(float)(f0 + i) * inv_nf * 13.287712379549449f);
        const float rev = pos * invf * 0.15915494309189535f;
        const float cs = cos_rev(rev), sn = sin_rev(rev);
        v[i] = is_x1 ? (v[i] * cs - vp[i] * sn) : (vp[i] * sn + v[i] * cs);
    }
}

__device__ __forceinline__ void phase_post2_even(Frame& F) {
    const bf16_t* P = (const bf16_t*)(F.ws + WS_P); const bf16_t* QM = (const bf16_t*)(F.ws + WS_QM); const bf16_t* KVM = (const bf16_t*)(F.ws + WS_ACT);
    const float* gq = F.a->in[IN_MLAQK]; const float* gk = F.a->in[IN_MLAQK] + 192;
    bf16_t* QA = (bf16_t*)(F.ws + WS_QA);
    constexpr int NROW = 16384, NVT_CTX = 1024, NVT_LAT = 2048, NVT_CAC = 1024;
    const int lane = F.lane, hsub = lane >> 5, c = lane & 31; const bool act = c < 24;
    for (int it = F.gw; it < NTOK + NROW + NVT_CTX + NVT_LAT + NVT_CAC; it += F.NGW) {
        if (it < NTOK) {
            const int t = it; const bool lat = t >= NCTX; const int s = (t - NCTX) & 1023; const float row = (float)(s >> 6), col = (float)(s & 63);
            const int cc = act ? c : 23, cpq = cc >= 16 ? (cc ^ 2) : cc;
            float g[8], gp[8]; load8(gq + 8 * cc, g); load8(gq + 8 * cpq, gp);
            float v[4][8], vp[4][8];
#pragma unroll
            for (int pass = 0; pass < 4; ++pass) { const bf16_t* src = QM + (size_t)t * 1536 + (2 * pass + hsub) * 192; load8h(src + 8 * cc, v[pass]); load8h(src + 8 * cpq, vp[pass]); }
#pragma unroll
            for (int pass = 0; pass < 4; ++pass) {
                const int head = 2 * pass + hsub;
                float q = 0.f;
#pragma unroll
                for (int i = 0; i < 8; ++i) { v[pass][i] = act ? v[pass][i] : 0.f; q += v[pass][i] * v[pass][i]; }
                const float rstd = __builtin_amdgcn_rsqf(group_sum<32>(q) * (1.0f / 192) + EPS);
#pragma unroll
                for (int i = 0; i < 8; ++i) { v[pass][i] = v[pass][i] * rstd * g[i]; vp[pass][i] = vp[pass][i] * rstd * gp[i]; }
                if (lat && c >= 16 && act) rope8(v[pass], vp[pass], (c & 2) == 0, c < 20 ? row : col, (c & 1) * 8, 1.0f / 16);
                if (act) *(u32x4*)(QA + (size_t)t * 1536 + head * 192 + 8 * c) = pack8(v[pass]);
            }
        } else if (it < NTOK + NROW) {
            const int r = it - NTOK; const bool istok = r < NTOK; const bool lat = istok && r >= NCTX;
            int bsel, s; bf16_t* kb0; int nkeys;
            if (!istok) { bsel = (r - NTOK) >> 9; s = (r - NTOK) & 511; kb0 = (bf16_t*)(F.ws + WS_KM_CAC); nkeys = 512; }
            else if (lat) { bsel = (r - NCTX) >> 10; s = (r - NCTX) & 1023; kb0 = (bf16_t*)(F.ws + WS_KM_LAT); nkeys = 1024; }
            else { bsel = r >> 8; s = r & 255; kb0 = (bf16_t*)(F.ws + WS_KM_CTX); nkeys = 256; }
            const float* krp_f = istok ? (const float*)(F.ws + WS_KROPE) + (size_t)r * 64 : F.a->in[IN_C_KROPE] + (size_t)(r - NTOK) * 64;
            const float row = (float)(s >> 6), col = (float)(s & 63);
            const int cc = act ? c : 23, cpq = cc >= 16 ? (cc ^ 2) : cc, cn = c < 16 ? c : 15, cr = cc >= 16 ? cc - 16 : 0, crp = cc >= 16 ? cpq - 16 : 0;
            float g[8], gp[8], kr[8], krp[8]; load8(gk + 8 * cc, g); load8(gk + 8 * cpq, gp); load8(krp_f + 8 * cr, kr); load8(krp_f + 8 * crp, krp);
            float v[4][8];
#pragma unroll
            for (int pass = 0; pass < 4; ++pass) load8h(KVM + (size_t)r * 2048 + (2 * pass + hsub) * 256 + 8 * cn, v[pass]);
#pragma unroll
            for (int pass = 0; pass < 4; ++pass) {
                const int head = 2 * pass + hsub;
                float vp[8]; float q = 0.f;
#pragma unroll
                for (int i = 0; i < 8; ++i) { v[pass][i] = c < 16 ? v[pass][i] : (act ? kr[i] : 0.f); q += v[pass][i] * v[pass][i]; }
                const float rstd = __builtin_amdgcn_rsqf(group_sum<32>(q) * (1.0f / 192) + EPS);
#pragma unroll
                for (int i = 0; i < 8; ++i) { v[pass][i] = v[pass][i] * rstd * g[i]; vp[i] = krp[i] * rstd * gp[i]; }
                if (lat && c >= 16 && act) rope8(v[pass], vp, (c & 2) == 0, c < 20 ? row : col, (c & 1) * 8, 1.0f / 16);
                if (act) *(u32x4*)(kb0 + (size_t)(bsel * 8 + head) * ((size_t)nkeys * 192) + k_chunk_off(192, s, c)) = pack8(v[pass]);
            }
        } else {
            int r = it - NTOK - NROW;
            if (r < NVT_CTX) { const int t32 = r & 7, bh = r >> 3, b = bh >> 3, h = bh & 7;
                vt_tile_write_h(KVM + (size_t)(b * 256 + t32 * 32) * 2048 + h * 256 + 128, 2048, (bf16_t*)(F.ws + WS_VM_CTX) + (size_t)bh * (256 * 128) + (size_t)t32 * 4096, lane);
            } else if (r < NVT_CTX + NVT_LAT) { r -= NVT_CTX; const int t32 = r & 31, bh = r >> 5, b = bh >> 3, h = bh & 7;
                vt_tile_write_h(KVM + (size_t)(NCTX + b * 1024 + t32 * 32) * 2048 + h * 256 + 128, 2048, (bf16_t*)(F.ws + WS_VM_LAT) + (size_t)bh * (1024 * 128) + (size_t)t32 * 4096, lane);
            } else { r -= NVT_CTX + NVT_LAT; const int t32 = r & 15, bh = r >> 4, b = bh >> 3, h = bh & 7;
                vt_tile_write_h(KVM + (size_t)(NTOK + b * 512 + t32 * 32) * 2048 + h * 256 + 128, 2048, (bf16_t*)(F.ws + WS_VM_CAC) + (size_t)bh * (512 * 128) + (size_t)t32 * 4096, lane);
            }
        }
    }
}

__device__ __forceinline__ void phase_post_odd(Frame& F) {
    const bf16_t* P = (const bf16_t*)(F.ws + WS_P); const float* gq = F.a->in[IN_GQK]; const float* gk = F.a->in[IN_GQK] + 128;
    bf16_t* QA = (bf16_t*)(F.ws + WS_QA);
    constexpr int NVT_CTX = 16 * 4 * 8, NVT_LAT = 8 * 4 * 32;
    const int lane = F.lane, hsub = lane >> 4, c = lane & 15;
    for (int it = F.gw; it < NTOK + NVT_CTX + NVT_LAT; it += F.NGW) {
        if (it < NTOK) {
            const int t = it; const bool ctx = t < NCTX, lat = !ctx; const bf16_t* pr = P + (size_t)t * IN_ODD;
            int b, s; if (ctx) { b = t >> 8; s = t & 255; } else { b = (t - NCTX) >> 10; s = (t - NCTX) & 1023; }
            const float row = (float)(s >> 6), col = (float)(s & 63);
            const int cp = c ^ 4;
            float gqv[8], gqp[8], gkv[8], gkp[8]; load8(gq + 8 * c, gqv); load8(gq + 8 * cp, gqp); load8(gk + 8 * c, gkv); load8(gk + 8 * cp, gkp);
            float v[5][8], vp[5][8];
#pragma unroll
            for (int pass = 0; pass < 5; ++pass) { const bf16_t* src = pr + (pass == 4 ? 2048 + hsub * 128 : (4 * pass + hsub) * 128); load8h(src + 8 * c, v[pass]); load8h(src + 8 * cp, vp[pass]); }
#pragma unroll
            for (int pass = 0; pass < 5; ++pass) {
                const bool isk = pass == 4; const int head = isk ? hsub : 4 * pass + hsub;
                float q = 0.f;
#pragma unroll
                for (int i = 0; i < 8; ++i) q += v[pass][i] * v[pass][i];
                const float rstd = __builtin_amdgcn_rsqf(group_sum<16>(q) * (1.0f / 128) + EPS);
#pragma unroll
                for (int i = 0; i < 8; ++i) { v[pass][i] = v[pass][i] * rstd * (isk ? gkv[i] : gqv[i]); vp[pass][i] = vp[pass][i] * rstd * (isk ? gkp[i] : gqp[i]); }
                if (isk && ctx) store8f(F.out + O_GK + (size_t)t * 512 + head * 128 + 8 * c, v[pass]);
                if (lat) rope8(v[pass], vp[pass], (c & 4) == 0, c < 8 ? row : col, (c & 3) * 8, 1.0f / 32);
                if (!isk) *(u32x4*)(QA + (size_t)t * 2048 + head * 128 + 8 * c) = pack8(v[pass]);
                else { bf16_t* kb = ctx ? (bf16_t*)(F.ws + WS_KG_CTX) + (size_t)(b * 4 + head) * (256 * 128) : (bf16_t*)(F.ws + WS_KG_LAT) + (size_t)(b * 4 + head) * (1024 * 128);
                    *(u32x4*)(kb + k_chunk_off(128, s, c)) = pack8(v[pass]); }
            }
            { float vv[8]; load8h(pr + 2560 + 8 * lane, vv); if (ctx) store8f(F.out + O_GV + (size_t)t * 512 + 8 * lane, vv); }
        } else {
            int r = it - NTOK;
            if (r < NVT_CTX) { const int t32 = r & 7, bh = r >> 3, b = bh >> 2, h = bh & 3;
                vt_tile_write_h(P + (size_t)(b * 256 + t32 * 32) * IN_ODD + 2560 + h * 128, IN_ODD, (bf16_t*)(F.ws + WS_VG_CTX) + (size_t)bh * (256 * 128) + (size_t)t32 * 4096, lane);
            } else { r -= NVT_CTX; const int t32 = r & 31, bh = r >> 5, b = bh >> 2, h = bh & 3;
                vt_tile_write_h(P + (size_t)(NCTX + b * 1024 + t32 * 32) * IN_ODD + 2560 + h * 128, IN_ODD, (bf16_t*)(F.ws + WS_VG_LAT) + (size_t)bh * (1024 * 128) + (size_t)t32 * 4096, lane);
            }
        }
    }
}

struct WgUnit {
    const bf16_t* kc; const bf16_t* vc; int nctx;
    const bf16_t* kl; const bf16_t* vl; int t_lo, t_hi;
};
struct WvUnit {
    const bf16_t* qb; unsigned qoff; int qpitch; bf16_t* ob; unsigned ooff;
    int qpos;
    int qcol0;
    int w_lo, w_hi;
    float sink; int has_sink; float scale;
};
constexpr int ATT_RPB_OFF = RING_BYTES + 512;
constexpr float ATT_THR = 8.0f;
template <int MODE>
__device__ __forceinline__ float attn_mask(float v, int tile32, int r, int hh, int ql, bool masked, const WvUnit& U, const LAS float* rpb) {
    const int kk = (r & 3) + 8 * (r >> 2) + 4 * hh;
    if (MODE == 1) { const int df = U.qpos + ql - (tile32 * 32 + kk); if (masked && (df > 128 || df < -128)) v = -1e30f; }
    if (MODE == 2 && masked) { const int krow = tile32 >> 1, kcol = (tile32 & 1) * 32 + kk, qc = U.qcol0 + ql;
        int ws = qc - 8; ws = ws < 0 ? 0 : (ws > 48 ? 48 : ws);
        const bool valid = (kcol >= ws) && (kcol < ws + 16);
        int co = kcol - qc; co = co < -15 ? -15 : (co > 15 ? 15 : co);
        const float bias = rpb[(krow - U.qpos + 7) * 31 + co + 15];
        v = valid ? v + bias * LOG2E : -1e30f; }
    return v;
}
template <int OFF> __device__ __forceinline__ bf16x8 lds_rd(unsigned addr) { bf16x8 r; asm volatile("ds_read_b128 %0, %1 offset:%2" : "=v"(r) : "v"(addr), "i"(OFF)); return r; }
template <int BASE, int H1> __device__ __forceinline__ void lds_rd8(unsigned addr, bf16x8 (&a)[8]) {
    a[0] = lds_rd<BASE>(addr); a[1] = lds_rd<BASE + 1024>(addr); a[2] = lds_rd<BASE + 2048>(addr); a[3] = lds_rd<BASE + 3072>(addr);
    a[4] = lds_rd<BASE + H1>(addr); a[5] = lds_rd<BASE + H1 + 1024>(addr); a[6] = lds_rd<BASE + H1 + 2048>(addr); a[7] = lds_rd<BASE + H1 + 3072>(addr);
}
#define LDS_WAIT8(n, a) asm volatile("s_waitcnt lgkmcnt(" #n ")" : "+v"(a[0]), "+v"(a[1]), "+v"(a[2]), "+v"(a[3]), "+v"(a[4]), "+v"(a[5]), "+v"(a[6]), "+v"(a[7]))
#define QK_MMA8(a, kb) do { _Pragma("unroll") for (int _j = 0; _j < 4; ++_j) { s0 = __builtin_amdgcn_mfma_f32_32x32x16_bf16(a[_j], qf[(kb) * 4 + _j], s0, 0, 0, 0); s1 = __builtin_amdgcn_mfma_f32_32x32x16_bf16(a[4 + _j], qf[(kb) * 4 + _j], s1, 0, 0, 0); } } while (0)
__device__ __forceinline__ void na_mask16(f32x16& sx, int tile32, int hh, int ql, bool masked, const WvUnit& U, const LAS float* rpb) {
    const int krow = tile32 >> 1, kc0 = (tile32 & 1) * 32 + 4 * hh, qc = U.qcol0 + ql;
    int ws = qc - 8; ws = ws < 0 ? 0 : (ws > 48 ? 48 : ws);
    int ro = krow - U.qpos + 7; ro = ro < 0 ? 0 : (ro > 14 ? 14 : ro);
    const LAS float* rrow = rpb + ro * 31 + 15;
    float bias[16];
#pragma unroll
    for (int r = 0; r < 16; ++r) { int co = kc0 + (r & 3) + 8 * (r >> 2) - qc; co = co < -15 ? -15 : (co > 15 ? 15 : co); bias[r] = rrow[co]; }
#pragma unroll
    for (int r = 0; r < 16; ++r) { const int kcol = kc0 + (r & 3) + 8 * (r >> 2); const float mv = ((unsigned)(kcol - ws) < 16u) ? sx[r] + bias[r] * LOG2E : -1e30f; sx[r] = masked ? mv : sx[r]; }
}
template <int DQK, int MODE>
__device__ __forceinline__ void attn_tile64(const LAS unsigned char* sl, int t64, bool masked, const bf16x8 (&qf)[DQK / 16], f32x16 (&o)[4], float& m, float& l, const WvUnit& U, const LAS float* rpb, int lane, float sl2) {
    constexpr int NKS = DQK / 16, KB = DQK * 128;
    const int ql = lane & 31, hh = lane >> 5;
    const unsigned addr = (unsigned)(unsigned long)sl + (unsigned)lane * 16u;
    f32x16 s0, s1;
#pragma unroll
    for (int r = 0; r < 16; ++r) { s0[r] = 0.f; s1[r] = 0.f; }
    bf16x8 pb[4];
#define ATT_SMA(sx, T32) do { float mt = -1e30f; \
    if (MODE == 1) { if (masked) {   \
            _Pragma("unroll") for (int r = 0; r < 16; ++r) sx[r] = attn_mask<MODE>(sx[r] * sl2, (T32), r, hh, ql, true, U, rpb); } } \
    if (MODE == 2) { _Pragma("unroll") for (int r = 0; r < 16; ++r) sx[r] *= sl2; na_mask16(sx, (T32), hh, ql, masked, U, rpb); } \
    _Pragma("unroll") for (int r = 0; r < 16; ++r) mt = fmaxf(mt, sx[r]); \
    if (MODE == 0 || (MODE == 1 && !masked)) mt *= sl2;     \
    mt = fmaxf(mt, __shfl_xor(mt, 32)); \
    if (!__all(mt - m <= ATT_THR)) { const float mn = fmaxf(m, mt), alpha = fast_exp2(m - mn); m = mn; l *= alpha; \
        _Pragma("unroll") for (int db = 0; db < 4; ++db) _Pragma("unroll") for (int r = 0; r < 16; ++r) o[db][r] *= alpha; } } while (0)
#define ATT_SMB(sx, PBI) do { float ps = 0.f; const float esc = (MODE == 0 || (MODE == 1 && !masked)) ? sl2 : 1.0f; \
    _Pragma("unroll") for (int r = 0; r < 16; ++r) { sx[r] = fast_exp2(fmaf(sx[r], esc, -m)); ps += sx[r]; } \
    l += ps; \
    _Pragma("unroll") for (int s2 = 0; s2 < 2; ++s2) { \
        u32x4 w; w.x = pk2(sx[8 * s2 + 0], sx[8 * s2 + 1]); w.y = pk2(sx[8 * s2 + 2], sx[8 * s2 + 3]); w.z = pk2(sx[8 * s2 + 4], sx[8 * s2 + 5]); w.w = pk2(sx[8 * s2 + 6], sx[8 * s2 + 7]); pb[(PBI) + s2] = __builtin_bit_cast(bf16x8, w); } } while (0)
#define MFMA32(a_, b_, c_) __builtin_amdgcn_mfma_f32_32x32x16_bf16(a_, b_, c_, 0, 0, 0)
    if constexpr (NKS == 8) {
        bf16x8 ka[8], kb_[8];
        lds_rd8<0, 4096>(addr, ka); lds_rd8<KB / 2, 4096>(addr, kb_);
        LDS_WAIT8(8, ka);
#pragma unroll
        for (int j = 0; j < 8; ++j) s0 = MFMA32(ka[j], qf[j], s0);
        if (MODE != 2) { lds_rd8<KB, 4096>(addr, ka); LDS_WAIT8(8, kb_); } else LDS_WAIT8(0, kb_);
#pragma unroll
        for (int j = 0; j < 4; ++j) s1 = MFMA32(kb_[j], qf[j], s1);
        ATT_SMA(s0, 2 * t64);
        if (MODE == 2) lds_rd8<KB, 4096>(addr, ka);
#pragma unroll
        for (int j = 4; j < 8; ++j) s1 = MFMA32(kb_[j], qf[j], s1);
        ATT_SMB(s0, 0);
        lds_rd8<KB + 8192, 4096>(addr, kb_);
        LDS_WAIT8(8, ka);
#pragma unroll
        for (int db = 0; db < 4; ++db) o[db] = MFMA32(ka[db], pb[0], o[db]);
        ATT_SMA(s1, 2 * t64 + 1);
#pragma unroll
        for (int db = 0; db < 4; ++db) o[db] = MFMA32(ka[4 + db], pb[1], o[db]);
        ATT_SMB(s1, 2);
        LDS_WAIT8(0, kb_);
#pragma unroll
        for (int s2 = 0; s2 < 2; ++s2)
#pragma unroll
            for (int db = 0; db < 4; ++db) o[db] = MFMA32(kb_[s2 * 4 + db], pb[2 + s2], o[db]);
    } else {
        bf16x8 ka[4], kb_[4];
#define RDK4(a, h, b) do { a[0] = lds_rd<(h) * (KB / 2) + (b) * 4096>(addr); a[1] = lds_rd<(h) * (KB / 2) + (b) * 4096 + 1024>(addr); a[2] = lds_rd<(h) * (KB / 2) + (b) * 4096 + 2048>(addr); a[3] = lds_rd<(h) * (KB / 2) + (b) * 4096 + 3072>(addr); } while (0)
#define RDV4(a, q) do { a[0] = lds_rd<KB + (q) * 4096>(addr); a[1] = lds_rd<KB + (q) * 4096 + 1024>(addr); a[2] = lds_rd<KB + (q) * 4096 + 2048>(addr); a[3] = lds_rd<KB + (q) * 4096 + 3072>(addr); } while (0)
#define WAIT4(n, a) asm volatile("s_waitcnt lgkmcnt(" #n ")" : "+v"(a[0]), "+v"(a[1]), "+v"(a[2]), "+v"(a[3]))
#define QK4(a, sx, b) do { _Pragma("unroll") for (int j = 0; j < 4; ++j) sx = MFMA32(a[j], qf[4 * (b) + j], sx); } while (0)
#define PV4(a, q) do { _Pragma("unroll") for (int db = 0; db < 4; ++db) o[db] = MFMA32(a[db], pb[q], o[db]); } while (0)
        RDK4(ka, 0, 0); RDK4(kb_, 0, 1);
        WAIT4(4, ka); QK4(ka, s0, 0); RDK4(ka, 0, 2);
        WAIT4(4, kb_); QK4(kb_, s0, 1); RDK4(kb_, 1, 0);
        WAIT4(4, ka); QK4(ka, s0, 2); RDK4(ka, 1, 1);
        WAIT4(4, kb_); QK4(kb_, s1, 0); RDK4(kb_, 1, 2);
        ATT_SMA(s0, 2 * t64);
        WAIT4(4, ka); QK4(ka, s1, 1); RDV4(ka, 0);
        ATT_SMB(s0, 0);
        WAIT4(4, kb_); QK4(kb_, s1, 2); RDV4(kb_, 1);
        WAIT4(4, ka); PV4(ka, 0); RDV4(ka, 2);
        ATT_SMA(s1, 2 * t64 + 1);
        WAIT4(4, kb_); PV4(kb_, 1); RDV4(kb_, 3);
        ATT_SMB(s1, 2);
        WAIT4(4, ka); PV4(ka, 2);
        WAIT4(0, kb_); PV4(kb_, 3);
#undef RDK4
#undef RDV4
#undef WAIT4
#undef QK4
#undef PV4
    }
#undef ATT_SMA
#undef ATT_SMB
#undef MFMA32
}
template <int DQK, int MODE, int VAR = 0>
__device__ __forceinline__ void attn_wg_unit(LAS unsigned char* ring, const WgUnit& G, const WvUnit& U, const float* rpb_g, int tid, int wave, int lane) {
    constexpr int NKS = DQK / 16, KB = DQK * 128, NLK = KB / 8192;
    constexpr int NS = (DQK == 128) ? 4 : 3, SLOTB = KB + 16384;
    const int ql = lane & 31, hh = lane >> 5;
    const int ntiles = G.nctx + (G.t_hi - G.t_lo);
    const LAS float* rpb = (const LAS float*)(ring + ATT_RPB_OFF);
#define ATT_ISSUE(i, SLOTC) do { const int _i = (i); const bool _c = _i < G.nctx; const int _t = _c ? _i : G.t_lo + (_i - G.nctx); \
        const char* _kg = (const char*)(_c ? G.kc : G.kl) + (size_t)_t * KB + tid * 16; const char* _vg = (const char*)(_c ? G.vc : G.vl) + (size_t)_t * 16384 + tid * 16; \
        LAS unsigned char* _sl = ring + (SLOTC) * SLOTB + wave * 1024; \
        _Pragma("unroll") for (int _p = 0; _p < NLK; ++_p) __builtin_amdgcn_global_load_lds((const unsigned*)(_kg + _p * 8192), (LAS unsigned*)(_sl + _p * 8192), 16, 0, 0); \
        _Pragma("unroll") for (int _p = 0; _p < 2; ++_p) __builtin_amdgcn_global_load_lds((const unsigned*)(_vg + _p * 8192), (LAS unsigned*)(_sl + KB + _p * 8192), 16, 0, 0); } while (0)
    asm volatile("s_waitcnt lgkmcnt(0)" ::: "memory"); __builtin_amdgcn_s_barrier(); asm volatile("" ::: "memory");
    bf16x8 qf[NKS];
#pragma unroll
    for (int ks = 0; ks < NKS; ++ks) qf[ks] = *(const bf16x8*)(U.qb + (size_t)(U.qoff + (unsigned)(ql * U.qpitch + 16 * ks + 8 * hh)));
    if (MODE == 2) { const int i = opaque_v(tid); if (i < 15 * 31) ((LAS float*)(ring + ATT_RPB_OFF))[i] = rpb_g[i]; }
    if (VAR != 2) { ATT_ISSUE(0, 0); if (ntiles > 1) ATT_ISSUE(1, 1); if (NS == 4 && ntiles > 2) ATT_ISSUE(2, 2); }
    f32x16 o[4];
#pragma unroll
    for (int db = 0; db < 4; ++db)
#pragma unroll
        for (int r = 0; r < 16; ++r) o[db][r] = 0.f;
    float m = -1e30f, l = 0.f;
    const float sl2 = U.scale * LOG2E;
#define ATT_STEP(i_, SLOTC) do { const int i = (i_); if (i < ntiles) { \
        if (NS == 4) { if (i + 2 < ntiles) asm volatile("s_waitcnt vmcnt(8)" ::: "memory"); else if (i + 1 < ntiles) asm volatile("s_waitcnt vmcnt(4)" ::: "memory"); else asm volatile("s_waitcnt vmcnt(0)" ::: "memory"); } \
        else { if (i + 1 < ntiles) asm volatile("s_waitcnt vmcnt(5)" ::: "memory"); else asm volatile("s_waitcnt vmcnt(0)" ::: "memory"); } \
        asm volatile("s_waitcnt lgkmcnt(0)" ::: "memory"); __builtin_amdgcn_s_barrier(); asm volatile("" ::: "memory"); \
        if (VAR != 2 && i + NS - 1 < ntiles) ATT_ISSUE(i + NS - 1, ((SLOTC) + NS - 1) % NS); \
        const bool isctx = i < G.nctx; const int t64 = isctx ? 0 : G.t_lo + (i - G.nctx); \
        if (VAR != 1 && (isctx || (t64 >= U.w_lo && t64 < U.w_hi))) attn_tile64<DQK, MODE>(ring + (SLOTC) * SLOTB, t64, !isctx, qf, o, m, l, U, rpb, lane, sl2); } } while (0)
    if constexpr (NS == 4) { for (int i0 = 0; i0 < ntiles; i0 += 4) { ATT_STEP(i0, 0); ATT_STEP(i0 + 1, 1); ATT_STEP(i0 + 2, 2); ATT_STEP(i0 + 3, 3); } }
    else { for (int i0 = 0; i0 < ntiles; i0 += 3) { ATT_STEP(i0, 0); ATT_STEP(i0 + 1, 1); ATT_STEP(i0 + 2, 2); } }
#undef ATT_STEP
#undef ATT_ISSUE
    l += __shfl_xor(l, 32);
    if (U.has_sink) l += fast_exp2(U.sink * LOG2E - m);
    const float inv = 1.0f / l;
    bf16_t* op = U.ob + (size_t)(U.ooff + (unsigned)(opaque_v(ql) * DM));
#pragma unroll
    for (int db = 0; db < 4; ++db)
#pragma unroll
        for (int k = 0; k < 2; ++k) {
            const unsigned p0x = pk2(o[db][8 * k] * inv, o[db][8 * k + 1] * inv), p0y = pk2(o[db][8 * k + 2] * inv, o[db][8 * k + 3] * inv);
            const unsigned p1x = pk2(o[db][8 * k + 4] * inv, o[db][8 * k + 5] * inv), p1y = pk2(o[db][8 * k + 6] * inv, o[db][8 * k + 7] * inv);
            const auto sx = __builtin_amdgcn_permlane32_swap(p0x, p1x, false, false);
            const auto sy = __builtin_amdgcn_permlane32_swap(p0y, p1y, false, false);
            u32x4 w; w.x = sx[0]; w.y = sy[0]; w.z = sx[1]; w.w = sy[1];
            *(u32x4*)(op + 32 * db + 16 * k + 8 * hh) = w; }
}

template <int VAR>
__device__ __forceinline__ void phase_attn_even(Frame& F, bf16_t* O) {
 const bf16_t* QA = (const bf16_t*)(F.ws + WS_QA); const bf16_t* QNA = (const bf16_t*)(F.ws + WS_QNA);
    const int wave = F.wave, lane = F.lane, tid = F.tid;
    WgUnit G; WvUnit U; U.sink = 0.f; U.has_sink = 0; U.qpos = 0; U.qcol0 = 0;
    const int vcu = (F.G % 8 == 0) ? ((int)blockIdx.x % 8) * (F.G / 8) + (int)blockIdx.x / 8 : (int)blockIdx.x;
    for (int u = vcu; u < 256; u += F.G) { const int bh = u >> 2, q4 = u & 3, b = bh >> 3, h = bh & 7, t0 = NCTX + b * 1024 + q4 * 256 + 32 * wave;
        U.qb = QA; U.qoff = (unsigned)(t0 * 1536 + h * 192); U.qpitch = 1536; U.scale = 0.07216878364870322f; U.ob = O; U.ooff = (unsigned)(t0 * DM + h * 128);
        G.kc = (const bf16_t*)(F.ws + WS_KM_CAC) + (size_t)bh * (512 * 192); G.vc = (const bf16_t*)(F.ws + WS_VM_CAC) + (size_t)bh * (512 * 128); G.nctx = 8;
        G.kl = (const bf16_t*)(F.ws + WS_KM_LAT) + (size_t)bh * (1024 * 192); G.vl = (const bf16_t*)(F.ws + WS_VM_LAT) + (size_t)bh * (1024 * 128); G.t_lo = 0; G.t_hi = 16; U.w_lo = 0; U.w_hi = 16;
        attn_wg_unit<192, 0, VAR>(F.lds, G, U, nullptr, tid, wave, lane); }
    for (int u = vcu; u < 256; u += F.G) { const int bh = u >> 2, r0 = (u & 3) * 4, b = bh >> 3, h = bh & 7, r = r0 + (wave >> 1), c0 = (wave & 1) * 32, t0 = NCTX + b * 1024 + r * 64 + c0;
        int rs = r - 4; rs = rs < 0 ? 0 : (rs > 8 ? 8 : rs);
        int glo = r0 - 4; glo = glo < 0 ? 0 : (glo > 8 ? 8 : glo); int ghi = r0 - 1; ghi = ghi < 0 ? 0 : (ghi > 8 ? 8 : ghi);
        U.qb = QNA; U.qoff = (unsigned)(t0 * 1024 + h * 128); U.qpitch = 1024; U.scale = 0.08838834764831845f; U.ob = O; U.ooff = (unsigned)(t0 * DM + 1024 + h * 128);
        G.kc = (const bf16_t*)(F.ws + WS_KN_CAC) + (size_t)bh * (512 * 128); G.vc = (const bf16_t*)(F.ws + WS_VN_CAC) + (size_t)bh * (512 * 128); G.nctx = 8;
        G.kl = (const bf16_t*)(F.ws + WS_KN_LAT) + (size_t)bh * (1024 * 128); G.vl = (const bf16_t*)(F.ws + WS_VN_LAT) + (size_t)bh * (1024 * 128); G.t_lo = glo; G.t_hi = ghi + 8; U.w_lo = rs; U.w_hi = rs + 8;
        U.qpos = r; U.qcol0 = c0;
        attn_wg_unit<128, 2, VAR>(F.lds, G, U, F.a->in[IN_RPB] + h * (15 * 31), tid, wave, lane); }
    U.qpos = 0; U.qcol0 = 0; U.w_lo = 0; U.w_hi = 4; G.nctx = 0; G.kc = nullptr; G.vc = nullptr; G.t_lo = 0; G.t_hi = 4;
    for (int u = vcu; u < 256; u += F.G) { const int bh = u & 127, b = bh >> 3, h = bh & 7, t0 = b * 256 + 32 * wave;
        if (u < 128) {
            U.qb = QA; U.qoff = (unsigned)(t0 * 1536 + h * 192); U.qpitch = 1536; U.scale = 0.07216878364870322f; U.ob = O; U.ooff = (unsigned)(t0 * DM + h * 128);
            G.kl = (const bf16_t*)(F.ws + WS_KM_CTX) + (size_t)bh * (256 * 192); G.vl = (const bf16_t*)(F.ws + WS_VM_CTX) + (size_t)bh * (256 * 128);
            attn_wg_unit<192, 0, VAR>(F.lds, G, U, nullptr, tid, wave, lane);
        } else {
            U.qb = QNA; U.qoff = (unsigned)(t0 * 1024 + h * 128); U.qpitch = 1024; U.scale = 0.08838834764831845f; U.ob = O; U.ooff = (unsigned)(t0 * DM + 1024 + h * 128);
            G.kl = (const bf16_t*)(F.ws + WS_KN_CTX) + (size_t)bh * (256 * 128); G.vl = (const bf16_t*)(F.ws + WS_VN_CTX) + (size_t)bh * (256 * 128);
            attn_wg_unit<128, 0, VAR>(F.lds, G, U, nullptr, tid, wave, lane);
        } }
    asm volatile("s_waitcnt vmcnt(0) lgkmcnt(0)" ::: "memory"); __syncthreads();
}
__device__ __forceinline__ void phase_attn_odd(Frame& F) {
    bf16_t* O = (bf16_t*)(F.ws + WS_O); const bf16_t* QA = (const bf16_t*)(F.ws + WS_QA);
    const int wave = F.wave, lane = F.lane, tid = F.tid;
    WgUnit G; WvUnit U; U.has_sink = 1; U.qcol0 = 0; U.qpitch = 2048; U.scale = 0.08838834764831845f;
    const int vcu = (F.G % 8 == 0) ? ((int)blockIdx.x % 8) * (F.G / 8) + (int)blockIdx.x / 8 : (int)blockIdx.x;
    const float* sink = F.a->in[IN_SINK];
    for (int u = vcu; u < 512; u += F.G) { const int bk = u >> 4, q64 = u & 15, b = bk >> 2, kvh = bk & 3, g = wave >> 1, hq = kvh * 4 + g, qs = q64 * 64 + (wave & 1) * 32, t0 = NCTX + b * 1024 + qs;
        U.qb = QA; U.qoff = (unsigned)(t0 * 2048 + hq * 128); U.ob = O; U.ooff = (unsigned)(t0 * DM + hq * 128); U.qpos = qs; U.sink = sink[hq];
        G.kc = (const bf16_t*)(F.ws + WS_KG_CAC) + (size_t)bk * (512 * 128); G.vc = (const bf16_t*)(F.ws + WS_VG_CAC) + (size_t)bk * (512 * 128); G.nctx = 8;
        G.kl = (const bf16_t*)(F.ws + WS_KG_LAT) + (size_t)bk * (1024 * 128); G.vl = (const bf16_t*)(F.ws + WS_VG_LAT) + (size_t)bk * (1024 * 128);
        G.t_lo = q64 - 2 < 0 ? 0 : q64 - 2; G.t_hi = (q64 + 2 > 15 ? 15 : q64 + 2) + 1; U.w_lo = G.t_lo; U.w_hi = G.t_hi;
        attn_wg_unit<128, 1>(F.lds, G, U, nullptr, tid, wave, lane); }
    G.nctx = 0; G.kc = nullptr; G.vc = nullptr; G.t_lo = 0; G.t_hi = 4; U.w_lo = 0; U.w_hi = 4;
    for (int u = vcu; u < 256; u += F.G) { const int bk = u >> 2, q64 = u & 3, b = bk >> 2, kvh = bk & 3, g = wave >> 1, hq = kvh * 4 + g, qs = q64 * 64 + (wave & 1) * 32, t0 = b * 256 + qs;
        U.qb = QA; U.qoff = (unsigned)(t0 * 2048 + hq * 128); U.ob = O; U.ooff = (unsigned)(t0 * DM + hq * 128); U.qpos = 0; U.sink = sink[hq];
        G.kl = (const bf16_t*)(F.ws + WS_KG_CTX) + (size_t)bk * (256 * 128); G.vl = (const bf16_t*)(F.ws + WS_VG_CTX) + (size_t)bk * (256 * 128);
        attn_wg_unit<128, 0>(F.lds, G, U, nullptr, tid, wave, lane); }
    asm volatile("s_waitcnt vmcnt(0) lgkmcnt(0)" ::: "memory"); __syncthreads();
}

constexpr int N_PHASES = 36;
__global__ void __launch_bounds__(512, 2) fwd_kernel(Args args) {
    extern __shared__ __attribute__((aligned(16))) unsigned char lds_raw[];
    Frame F;
    F.lds = (LAS unsigned char*)lds_raw;
    F.tid = threadIdx.x; F.lane = F.tid & 63; F.wave = __builtin_amdgcn_readfirstlane(F.tid >> 6);
    F.G = gridDim.x; F.gw = blockIdx.x * 8 + F.wave; F.NGW = F.G * 8;
    F.a = &args; F.out = args.out; F.ws = args.ws;
    volatile LAS unsigned* MISC = (volatile LAS unsigned*)(F.lds + LDSCTL_OFF);
    for (int u = F.tid; u < (LDS_BYTES - LDSCTL_OFF) / 4; u += 512) ((LAS unsigned*)(F.lds + LDSCTL_OFF))[u] = 0u;
    __syncthreads();
    unsigned* ctl = (unsigned*)(F.ws + WS_CTL);
    const int lo = args.ph_lo, hi = args.ph_hi;
    const bool multi = (hi - lo) > 1;
    XcdBarrier bar; bar.bar = ctl + CW_BAR; bar.x = 0; bar.st = nullptr;
    if (multi) bar = xcd_barrier_post(ctl + CW_BAR, MISC + 8);
#define IN(k) (lo <= (k) && (k) < hi)
    int ph = 0;
#define PHASE(...) do { if (IN(ph)) { __VA_ARGS__ } if (IN(ph) && IN(ph + 1)) xcd_barrier(bar); ++ph; } while (0)
    const float* mods = (const float*)(F.ws + WS_MODS);
    bf16_t* H = (bf16_t*)(F.ws + WS_H); bf16_t* ACT = (bf16_t*)(F.ws + WS_ACT); float* P = (float*)(F.ws + WS_P); bf16_t* OB = (bf16_t*)(F.ws + WS_O);
    LAS unsigned char* ring = F.lds;
    const int cid = (int)blockIdx.x;
#define GEMM2(EPI_T, EDEF, A_, B_, M_, N_, K_, SLAB) \
    PHASE( pg8::Gemm g{(A_), (B_), (M_), (N_), (K_)}; typedef pg8::SplitOrder<(M_), (N_), (K_), true> SO; SO S; S.init(cid); EDEF; pg8::gemm_phase<EPI_T, SO, true, true>(ring, g, S, E, (SLAB)); ); \
    PHASE( typedef pg8::SplitOrder<(M_), (N_), (K_), true> SO; EDEF; pg8::gemm_fixup<EPI_T, SO>(E, (SLAB)); )
#define GEMM1(EPI_T, EDEF, A_, B_, M_, N_, K_) \
    PHASE( pg8::Gemm g{(A_), (B_), (M_), (N_), (K_)}; typedef pg8::SplitOrder<(M_), (N_), (K_), false> SO; SO S; S.init(cid); EDEF; pg8::gemm_phase<EPI_T, SO, true, true>(ring, g, S, E, nullptr); )
#define W_FI(layer, f) ((const bf16_t*)(F.ws + WS_WFI) + (size_t)((layer) * 2 + (f)) * NFF2 * DM)
#define W_FO(layer, f) ((const bf16_t*)(F.ws + WS_WFO) + (size_t)((layer) * 2 + (f)) * DM * DFF)
#define E_SWIGLU EpiSwiGLU E{ACT}
#define E_RESID(layer, gidx, coef, from_in) EpiResid E{F.a->in[IN_XP], F.a->in[IN_XS], (from_in), F.out, mods + (size_t)(layer) * 9 * NMOD + (size_t)(gidx) * DM, (coef)}
#define FFN(layer, f, from_in) \
    GEMM2(EpiSwiGLU, E_SWIGLU, H, W_FI(layer, f), NTOK, NFF2, DM, P); \
    GEMM2(EpiResid, E_RESID(layer, (f) ? 8 : 2, 0.5f, from_in), ACT, W_FO(layer, f), NTOK, DM, DFF, P)

    PHASE( phase_prologue(F); );
    PHASE( phase_norm(F, true, 0, 0); );
    FFN(0, 0, true);
    PHASE( phase_norm(F, false, 0, 1); );
    GEMM1(EpiBf16, EpiBf16 E{(bf16_t*)P COMMA IN_EVEN_P}, H, (const bf16_t*)(F.ws + WS_WEI), NTOK, IN_EVEN_P, DM);
    PHASE( phase_post1_even(F); );
    PHASE( { pg8::Gemm g{(const bf16_t*)(F.ws + WS_CQN), (const bf16_t*)(F.ws + WS_WQU), NTOK, 1536, 512}; typedef pg8::SplitOrder<NTOK, 1536, 512, false> SO; SO S; S.init(cid);
             EpiBf16 E{(bf16_t*)(F.ws + WS_QM), 1536}; pg8::gemm_phase<EpiBf16, SO, true, true>(ring, g, S, E, nullptr); }
           { pg8::Gemm g{(const bf16_t*)(F.ws + WS_CKVA), (const bf16_t*)(F.ws + WS_WKU), 16384, 2048, 512}; typedef pg8::SplitOrder<16384, 2048, 512, false> SO; SO S; S.init(cid);
             EpiBf16 E{(bf16_t*)(F.ws + WS_ACT), 2048}; pg8::gemm_phase<EpiBf16, SO, true, true>(ring, g, S, E, nullptr); } );
    PHASE( phase_post2_even(F); );
    PHASE( phase_attn_even<0>(F, (bf16_t*)(F.ws + WS_O)); );
    GEMM2(EpiResid, E_RESID(0, 5, 1.0f, false), OB, (const bf16_t*)(F.ws + WS_WEO), NTOK, DM, DM, P);
    PHASE( phase_norm(F, false, 0, 2); );
    FFN(0, 1, false);
    PHASE( phase_norm(F, false, 1, 0); );
    FFN(1, 0, false);
    PHASE( phase_norm(F, false, 1, 1); );
    GEMM2(EpiBf16, EpiBf16 E{(bf16_t*)P COMMA IN_ODD}, H, (const bf16_t*)(F.ws + WS_WOI), NTOK, IN_ODD, DM, (float*)(F.ws + WS_ACT));
    PHASE( phase_post_odd(F); );
    PHASE( phase_attn_odd(F); );
    GEMM2(EpiResid, E_RESID(1, 5, 1.0f, false), OB, (const bf16_t*)(F.ws + WS_WOO), NTOK, DM, DM, P);
    PHASE( phase_norm(F, false, 1, 2); );
    FFN(1, 1, false);
#undef IN
}

extern "C" void kernel_launch(void* const* d_in, const int* in_sizes, int n_in, void* d_out, int out_size, void* d_ws, size_t ws_size, hipStream_t stream) {
    static int grid = 0;
    if (grid == 0) {
        if (n_in != 28 || (size_t)out_size != O_END || ws_size < WS_END) { fprintf(stderr, "kernel_launch: unexpected shapes (n_in %d, out %d, ws %zu; need ws >= %zu); nothing launched\n", n_in, out_size, ws_size, (size_t)WS_END); grid = -1; return; }
        int dev = 0, cus = 0, per_cu = 0;
        if (hipGetDevice(&dev) != hipSuccess || hipDeviceGetAttribute(&cus, hipDeviceAttributeMultiprocessorCount, dev) != hipSuccess) { grid = -1; return; }
        if (hipFuncSetAttribute((const void*)fwd_kernel, hipFuncAttributeMaxDynamicSharedMemorySize, LDS_BYTES) != hipSuccess) { fprintf(stderr, "kernel_launch: hipFuncSetAttribute failed\n"); grid = -1; return; }
        if (hipOccupancyMaxActiveBlocksPerMultiprocessor(&per_cu, (const void*)fwd_kernel, 512, LDS_BYTES) != hipSuccess || per_cu < 1) { fprintf(stderr, "kernel_launch: occupancy query says %d blocks per CU\n", per_cu); }
        (void)hipGetLastError();
        if (cus < pg8::GRID) { fprintf(stderr, "kernel_launch: %d CUs < %d workgroups: not resident; nothing launched\n", cus, pg8::GRID); grid = -1; return; }
        grid = pg8::GRID;
    }
    if (grid < 0) return;
    if (hipMemsetAsync((char*)d_ws + WS_CTL, 0, CTL_ZERO_BYTES, stream) != hipSuccess) return;
    Args a{};
    for (int i = 0; i < 28; ++i) a.in[i] = (const float*)d_in[i];
    a.out = (float*)d_out; a.ws = (unsigned char*)d_ws;
#if MK_ONE_LAUNCH
    a.ph_lo = 0; a.ph_hi = N_PHASES;
    hipLaunchKernelGGL(fwd_kernel, dim3(grid), dim3(512), LDS_BYTES, stream, a);
#else
    for (int p = 0; p < N_PHASES; ++p) { a.ph_lo = p; a.ph_hi = p + 1; hipLaunchKernelGGL(fwd_kernel, dim3(grid), dim3(512), LDS_BYTES, stream, a); }
#endif
}
```

```cpp
#include <hip/hip_runtime.h>
#include <cstdio>
#include <cstdint>

#ifndef MK_ONE_LAUNCH
#define MK_ONE_LAUNCH 1
#endif

#define COMMA ,
#define GAS __attribute__((address_space(1)))
#define LAS __attribute__((address_space(3)))
typedef unsigned short bf16_t;
typedef short bf16x8 __attribute__((ext_vector_type(8)));
typedef float f32x4 __attribute__((ext_vector_type(4)));
typedef float f32x16 __attribute__((ext_vector_type(16)));
typedef unsigned u32x4 __attribute__((ext_vector_type(4)));
typedef unsigned u32x2 __attribute__((ext_vector_type(2)));

namespace pg8 {
constexpr int BM = 256, BK = 64, HALF = 128, HTB = HALF * BK * 2, STAGE_BYTES = 8 * HTB, NXCD = 8, WGM = 8;
__host__ __device__ __forceinline__ int lds_byte(int r, int c) { const int st = (r >> 4) * 2 + (c >> 5), rr = r & 15, cc = c & 31, ob = rr * 64 + cc * 2; return st * 1024 + (ob ^ (((ob >> 9) & 1) << 5)); }
__host__ __device__ __forceinline__ void stage_rc(int b, int& R, int& C) { const int st = b / 1024, sb = b % 1024, swz = sb ^ (((sb >> 9) & 1) << 5); R = (st >> 1) * 16 + swz / 64; C = (st & 1) * 32 + (swz % 64) / 2; }
__host__ __device__ __forceinline__ int perm32(int rho) { const int n = rho >> 4, i = rho & 15; return 8 * (i >> 2) + 4 * n + (i & 3); }
struct Unit { int pm, pn, kt0, nkt, part; };
struct Gemm { const bf16_t* A; const bf16_t* Bt; int M, N, K; };
constexpr int GRID = 256;
template <int M, int N, int K, bool SPLIT>
struct SplitOrder {
    static constexpr int nM = M / BM, nN = N / BM, nwg = nM * nN, G = GRID, nt = K / BK, nfull = (nwg / G) * G, rem = nwg - nfull, NR = nfull / G;
    static constexpr int S0 = (SPLIT && rem > 0 && G % rem == 0) ? G / rem : 1;
    static constexpr int S = ((S0 == 2 || S0 == 4) && nt % (2 * S0) == 0) ? S0 : 1;
    int c;
    __host__ __device__ void init(int c_) { c = c_; }
    __host__ __device__ static Unit unit_of(int L, int kt0, int nkt, int part) {
        int wgid = L; { constexpr int q = nwg / NXCD, r = nwg % NXCD; const int xcd = wgid % NXCD, off = wgid / NXCD; wgid = (xcd < r ? xcd * (q + 1) : r * (q + 1) + (xcd - r) * q) + off; }
        constexpr int nig = WGM * nN; const int gid = wgid / nig, fm = gid * WGM, gsz = (nM - fm) < WGM ? (nM - fm) : WGM;
        Unit u; u.pm = fm + ((wgid % nig) % gsz); u.pn = (wgid % nig) / gsz; u.kt0 = kt0; u.nkt = nkt; u.part = part; return u;
    }
    __host__ __device__ bool next(int i, Unit& u) const {
        int L = i * G + c, kt0 = 0, nkt = nt, part = -1; bool ok = L < nwg;
        if (S > 1 && i >= NR) { constexpr int R1 = rem > 0 ? rem : 1; L = nfull + (c % R1); nkt = nt / S; kt0 = (c / R1) * (nt / S); part = c; ok = (i == NR); }
        if (!ok) return false;
        u = unit_of(L, kt0, nkt, part); return true;
    }
};
typedef float f32x2_t __attribute__((ext_vector_type(2)));
typedef __bf16 bf16x2_t __attribute__((ext_vector_type(2)));
__device__ __forceinline__ unsigned cvt_pk_bf16(float lo, float hi) { const f32x2_t v = {lo, hi}; return __builtin_bit_cast(unsigned, __builtin_convertvector(v, bf16x2_t)); }

template <class Epi, class Sched, bool ALIGN_EPI = false, bool SP2 = false>
__device__ __forceinline__ void gemm_phase(LAS unsigned char* lds, const Gemm g, const Sched& S, const Epi& E, float* slab) {
    const int tid = threadIdx.x, wid = __builtin_amdgcn_readfirstlane(tid >> 6), lane = tid & 63, wr = wid >> 2, wc = wid & 3, fr = lane & 15, fq = lane >> 4;
    const int K = g.K;
    unsigned voffA[2], voffB[2];
#pragma unroll
    for (int i = 0; i < 2; ++i) { int R, C; stage_rc(tid * 16 + i * 8192, R, C); const int Rb = Epi::PERM ? ((R & ~31) + perm32(R & 31)) : R;
        voffA[i] = (unsigned)(R * K + C) * 2u; voffB[i] = (unsigned)(Rb * K + C) * 2u; }
    const size_t kstep = (size_t)(BK * 2);
    const size_t hstep = (size_t)HALF * K * 2;
    const size_t tstep = 2 * hstep;
    const unsigned ldsw = (unsigned)wid * 1024u;
    const int aoff = lds_byte(wr * 64 + fr, fq * 8), boff = lds_byte(wc * 32 + fr, fq * 8);
#define PG8_SA(b, h) (((b) * 2 + (h)) * HTB)
#define PG8_SB(b, h) ((4 + (b) * 2 + (h)) * HTB)
#define PG8_STAGE(bufoff, gbase, voff) do { _Pragma("unroll") for (int _i = 0; _i < 2; ++_i) \
        __builtin_amdgcn_global_load_lds((const unsigned*)((const char*)(gbase) + (voff)[_i]), (LAS unsigned*)(lds + (bufoff) + ldsw + _i * 8192), 16, 0, 0); } while (0)
#define PG8_LDA(dst, b, h) do { _Pragma("unroll") for (int m = 0; m < 4; ++m) _Pragma("unroll") for (int k = 0; k < 2; ++k) dst[m][k] = *(const LAS bf16x8*)(lds + PG8_SA(b, h) + aoff + m * 2048 + k * 1024); } while (0)
#define PG8_LDB(dst, b, h) do { _Pragma("unroll") for (int n = 0; n < 2; ++n) _Pragma("unroll") for (int k = 0; k < 2; ++k) dst[n][k] = *(const LAS bf16x8*)(lds + PG8_SB(b, h) + boff + n * 2048 + k * 1024); } while (0)
#define PG8_MMA(ai, bj, At, Bt) do { __builtin_amdgcn_s_setprio(1); _Pragma("unroll") for (int m = 0; m < 4; ++m) _Pragma("unroll") for (int n = 0; n < 2; ++n) _Pragma("unroll") for (int k = 0; k < 2; ++k) \
        acc[ai][bj][m][n] = __builtin_amdgcn_mfma_f32_16x16x32_bf16(Bt[n][k], At[m][k], acc[ai][bj][m][n], 0, 0, 0); __builtin_amdgcn_s_setprio(0); } while (0)
#define PG8_WAIT_V(n) asm volatile("s_waitcnt vmcnt(" #n ")" ::: "memory")
#define PG8_WAIT_L(n) asm volatile("s_waitcnt lgkmcnt(" #n ")" ::: "memory")
#define PG8_BAR __builtin_amdgcn_s_barrier()
#define PG8_SCHED __builtin_amdgcn_sched_barrier(0)
    Unit cur, nxt; int ui = 0;
    if (!S.next(0, cur)) return;
    f32x4 acc[2][2][4][2];
#pragma unroll
    for (int a = 0; a < 2; ++a)
#pragma unroll
        for (int b = 0; b < 2; ++b)
#pragma unroll
            for (int m = 0; m < 4; ++m)
#pragma unroll
                for (int n = 0; n < 2; ++n) acc[a][b][m][n] = (f32x4){0.f, 0.f, 0.f, 0.f};
    bf16x8 At[4][2], B0[2][2], B1[2][2];
    const char* cA = (const char*)g.A + (size_t)cur.pm * tstep + (size_t)cur.kt0 * kstep; const char* cB = (const char*)g.Bt + (size_t)cur.pn * tstep + (size_t)cur.kt0 * kstep;
    if constexpr (SP2) {
        PG8_STAGE(PG8_SB(0, 0), cB, voffB); PG8_STAGE(PG8_SB(0, 1), cB + hstep, voffB); PG8_STAGE(PG8_SA(0, 0), cA, voffA); PG8_STAGE(PG8_SA(0, 1), cA + hstep, voffA);
        if (wr == 1) PG8_BAR;
        PG8_WAIT_V(2); PG8_BAR;
        PG8_STAGE(PG8_SB(1, 0), cB + kstep, voffB); PG8_STAGE(PG8_SA(1, 0), cA + kstep, voffA); PG8_STAGE(PG8_SB(1, 1), cB + hstep + kstep, voffB);
        PG8_WAIT_V(6); PG8_BAR;
    } else {
        PG8_STAGE(PG8_SB(0, 0), cB, voffB); PG8_STAGE(PG8_SA(0, 0), cA, voffA); PG8_STAGE(PG8_SB(0, 1), cB + hstep, voffB); PG8_STAGE(PG8_SA(0, 1), cA + hstep, voffA);
        if (wr == 1) PG8_BAR;
        PG8_WAIT_V(4); PG8_BAR;
        PG8_STAGE(PG8_SB(1, 0), cB + kstep, voffB); PG8_STAGE(PG8_SA(1, 0), cA + kstep, voffA); PG8_STAGE(PG8_SB(1, 1), cB + hstep + kstep, voffB);
        PG8_WAIT_V(6); PG8_BAR;
    }
    for (;;) {
        const bool has_next = S.next(ui + 1, nxt);
        const char* nA = has_next ? (const char*)g.A + (size_t)nxt.pm * tstep + (size_t)nxt.kt0 * kstep : cA; const char* nB = has_next ? (const char*)g.Bt + (size_t)nxt.pn * tstep + (size_t)nxt.kt0 * kstep : cB;
        const int nt = cur.nkt;
        for (int t = 0; t < nt; t += 2) {
            const bool last = (t == nt - 2);
            const char* a1 = cA + (size_t)(t + 1) * kstep;
            const char* a2 = last ? nA : cA + (size_t)(t + 2) * kstep; const char* b2 = last ? nB : cB + (size_t)(t + 2) * kstep;
            const char* a3 = a2 + kstep; const char* b3 = b2 + kstep;
            if constexpr (SP2) {
            PG8_LDB(B0, 0, 0); PG8_LDB(B1, 0, 1); PG8_SCHED; PG8_LDA(At, 0, 0); PG8_STAGE(PG8_SA(1, 1), a1 + hstep, voffA);
            PG8_WAIT_V(8); PG8_WAIT_L(0); PG8_BAR; PG8_MMA(0, 0, At, B0); PG8_MMA(0, 1, At, B1); PG8_BAR; PG8_SCHED;
            PG8_LDA(At, 0, 1); PG8_STAGE(PG8_SB(0, 0), b2, voffB); PG8_STAGE(PG8_SB(0, 1), b2 + hstep, voffB); PG8_STAGE(PG8_SA(0, 0), a2, voffA);
            PG8_WAIT_V(8); PG8_WAIT_L(0); PG8_BAR; PG8_MMA(1, 0, At, B0); PG8_MMA(1, 1, At, B1); PG8_BAR; PG8_SCHED;
            PG8_LDB(B0, 1, 0); PG8_LDB(B1, 1, 1); PG8_SCHED; PG8_LDA(At, 1, 0); PG8_STAGE(PG8_SA(0, 1), a2 + hstep, voffA);
            PG8_WAIT_V(8); PG8_WAIT_L(0); PG8_BAR; PG8_MMA(0, 0, At, B0); PG8_MMA(0, 1, At, B1); PG8_BAR; PG8_SCHED;
            PG8_LDA(At, 1, 1); PG8_STAGE(PG8_SB(1, 0), b3, voffB); PG8_STAGE(PG8_SB(1, 1), b3 + hstep, voffB); PG8_STAGE(PG8_SA(1, 0), a3, voffA);
            PG8_WAIT_V(8); PG8_WAIT_L(0); PG8_BAR; PG8_MMA(1, 0, At, B0); PG8_MMA(1, 1, At, B1); PG8_BAR; PG8_SCHED;
            } else {
            PG8_LDB(B0, 0, 0); PG8_SCHED; PG8_LDA(At, 0, 0); PG8_STAGE(PG8_SA(1, 1), a1 + hstep, voffA);
            PG8_WAIT_L(8); PG8_BAR; PG8_WAIT_L(0); PG8_MMA(0, 0, At, B0); PG8_BAR; PG8_SCHED;
            PG8_LDB(B1, 0, 1); PG8_STAGE(PG8_SB(0, 0), b2, voffB);
            PG8_BAR; PG8_WAIT_L(0); PG8_MMA(0, 1, At, B1); PG8_BAR;
            PG8_LDA(At, 0, 1); PG8_STAGE(PG8_SA(0, 0), a2, voffA);
            PG8_BAR; PG8_WAIT_L(0); PG8_MMA(1, 0, At, B0); PG8_BAR; PG8_SCHED;
            PG8_STAGE(PG8_SB(0, 1), b2 + hstep, voffB);
            PG8_WAIT_V(6); PG8_BAR; PG8_MMA(1, 1, At, B1); PG8_BAR;
            PG8_LDB(B0, 1, 0); PG8_SCHED; PG8_LDA(At, 1, 0); PG8_STAGE(PG8_SA(0, 1), a2 + hstep, voffA);
            PG8_WAIT_L(8); PG8_BAR; PG8_WAIT_L(0); PG8_MMA(0, 0, At, B0); PG8_BAR; PG8_SCHED;
            PG8_LDB(B1, 1, 1); PG8_STAGE(PG8_SB(1, 0), b3, voffB);
            PG8_BAR; PG8_WAIT_L(0); PG8_MMA(0, 1, At, B1); PG8_BAR;
            PG8_LDA(At, 1, 1); PG8_STAGE(PG8_SA(1, 0), a3, voffA);
            PG8_BAR; PG8_WAIT_L(0); PG8_MMA(1, 0, At, B0); PG8_BAR; PG8_SCHED;
            PG8_STAGE(PG8_SB(1, 1), b3 + hstep, voffB);
            PG8_WAIT_V(6); PG8_BAR; PG8_MMA(1, 1, At, B1); PG8_BAR;
            }
        }
        if constexpr (ALIGN_EPI) { if (wr == 0) PG8_BAR; }
        if (cur.part < 0) {
            const auto cx = E.begin(cur, wr, wc, fr, fq);
#pragma unroll
            for (int ai = 0; ai < 2; ++ai)
#pragma unroll
                for (int m = 0; m < 4; ++m) { const f32x4 v[2][2] = {{acc[ai][0][m][0], acc[ai][0][m][1]}, {acc[ai][1][m][0], acc[ai][1][m][1]}}; E.rows(cx, v, cur, ai, m, wr, wc, fr, fq); }
        } else {
            bf16_t* sp = (bf16_t*)slab + (size_t)cur.part * 65536 + (size_t)tid * 8;
#pragma unroll
            for (int ai = 0; ai < 2; ++ai)
#pragma unroll
                for (int bj = 0; bj < 2; ++bj)
#pragma unroll
                    for (int m = 0; m < 4; ++m) { const f32x4 a = acc[ai][bj][m][0], b = acc[ai][bj][m][1];
                        u32x4 w; w.x = cvt_pk_bf16(a[0], a[1]); w.y = cvt_pk_bf16(a[2], a[3]); w.z = cvt_pk_bf16(b[0], b[1]); w.w = cvt_pk_bf16(b[2], b[3]);
                        *(u32x4*)(sp + (size_t)(((ai * 2 + bj) * 4 + m) * 4096)) = w; }
        }
        if (!has_next) break;
#pragma unroll
        for (int a = 0; a < 2; ++a)
#pragma unroll
            for (int b = 0; b < 2; ++b)
#pragma unroll
                for (int m = 0; m < 4; ++m)
#pragma unroll
                    for (int n = 0; n < 2; ++n) acc[a][b][m][n] = (f32x4){0.f, 0.f, 0.f, 0.f};
        cur = nxt; cA = nA; cB = nB; ++ui;
        if constexpr (ALIGN_EPI) { if (wr == 1) PG8_BAR; }
    }
    PG8_WAIT_V(0);
    if constexpr (!ALIGN_EPI) { if (wr == 0) PG8_BAR; }
    PG8_BAR;
#undef PG8_SA
#undef PG8_SB
#undef PG8_STAGE
#undef PG8_LDA
#undef PG8_LDB
#undef PG8_MMA
#undef PG8_WAIT_V
#undef PG8_WAIT_L
#undef PG8_BAR
#undef PG8_SCHED
}
template <class Epi, class Sched>
__device__ __forceinline__ void gemm_fixup(const Epi& E, const float* slab) {
    if constexpr (Sched::S > 1) {
    constexpr int NG = 8 / Sched::S;
    const int tid = threadIdx.x, wid = __builtin_amdgcn_readfirstlane(tid >> 6), lane = tid & 63, wr = wid >> 2, wc = wid & 3, fr = lane & 15, fq = lane >> 4;
    for (int b = blockIdx.x; b < Sched::rem * Sched::S; b += Sched::G) {
        const int r = b % Sched::rem, q = b / Sched::rem;
        const Unit u = Sched::unit_of(Sched::nfull + r, 0, Sched::nt, -1);
        f32x4 v[NG][2][2];
#pragma unroll
        for (int gi = 0; gi < NG; ++gi)
#pragma unroll
            for (int bj = 0; bj < 2; ++bj)
#pragma unroll
                for (int n = 0; n < 2; ++n) v[gi][bj][n] = (f32x4){0.f, 0.f, 0.f, 0.f};
#pragma unroll
        for (int gi = 0; gi < NG; ++gi) { const int g = q * NG + gi, ai = g >> 2, m = g & 3;
#pragma unroll
            for (int p = 0; p < Sched::S; ++p) {
                const bf16_t* sp = (const bf16_t*)slab + (size_t)(r + p * Sched::rem) * 65536 + (size_t)tid * 8;
#pragma unroll
                for (int bj = 0; bj < 2; ++bj) { const u32x4 w = *(const u32x4*)(sp + (size_t)(((ai * 2 + bj) * 4 + m) * 4096));
                    v[gi][bj][0] += (f32x4){__builtin_bit_cast(float, w.x << 16), __builtin_bit_cast(float, w.x & 0xffff0000u), __builtin_bit_cast(float, w.y << 16), __builtin_bit_cast(float, w.y & 0xffff0000u)};
                    v[gi][bj][1] += (f32x4){__builtin_bit_cast(float, w.z << 16), __builtin_bit_cast(float, w.z & 0xffff0000u), __builtin_bit_cast(float, w.w << 16), __builtin_bit_cast(float, w.w & 0xffff0000u)}; } } }
        const auto cx = E.begin(u, wr, wc, fr, fq);
#pragma unroll
        for (int gi = 0; gi < NG; ++gi) { const int g = q * NG + gi; E.rows(cx, v[gi], u, g >> 2, g & 3, wr, wc, fr, fq); }
    }
    }
}
}

constexpr int DM = 2048, NTOK = 12288, NCTX = 4096, DFF = 5632, NFF2 = 11264;
constexpr int IN_EVEN = 4160, IN_EVEN_P = 4096, IN_ODD = 3072;
constexpr int NMOD = 18432;
constexpr float EPS = 1e-6f;
constexpr float LOG2E = 1.4426950408889634f;

constexpr size_t O_X = 0, O_CKV = 25165824, O_KROPE = 27262976, O_NAK = 27525120, O_NAV = 31719424, O_GK = 35913728, O_GV = 38010880, O_END = 40108032;

constexpr size_t MiB = 1u << 20;
constexpr size_t WS_CTL = 0;
constexpr size_t WS_MODS = 2 * MiB;
constexpr size_t CTL_ZERO_BYTES = 4 * MiB;
constexpr size_t WS_WFI = 4 * MiB;
constexpr size_t WS_WFO = WS_WFI + 176 * MiB;
constexpr size_t WS_WEI = WS_WFO + 88 * MiB;
constexpr size_t WS_WQU = WS_WEI + 17 * MiB;
constexpr size_t WS_WKU = WS_WQU + 2 * MiB;
constexpr size_t WS_WEO = WS_WKU + 2 * MiB;
constexpr size_t WS_WOI = WS_WEO + 8 * MiB;
constexpr size_t WS_WOO = WS_WOI + 12 * MiB;
constexpr size_t WS_H = WS_WOO + 8 * MiB;
constexpr size_t WS_ACT = WS_H + 48 * MiB;
constexpr size_t WS_P = WS_ACT + 132 * MiB;
constexpr size_t WS_XB = WS_P + 128 * MiB;
constexpr size_t WS_QM = WS_P + 204 * MiB;
constexpr size_t WS_CQN = WS_QM + 72 * MiB;
constexpr size_t WS_CKVA = WS_CQN + 12 * MiB;
constexpr size_t WS_QA = WS_CKVA + 16 * MiB;
constexpr size_t WS_QNA = WS_QA + 48 * MiB;
constexpr size_t WS_KM_CTX = WS_QNA + 24 * MiB;
constexpr size_t WS_KM_LAT = WS_KM_CTX + 12 * MiB;
constexpr size_t WS_KM_CAC = WS_KM_LAT + 24 * MiB;
constexpr size_t WS_VM_CTX = WS_KM_CAC + 12 * MiB;
constexpr size_t WS_VM_LAT = WS_VM_CTX + 8 * MiB;
constexpr size_t WS_VM_CAC = WS_VM_LAT + 16 * MiB;
constexpr size_t WS_KN_CTX = WS_VM_CAC + 8 * MiB;
constexpr size_t WS_KN_LAT = WS_KN_CTX + 8 * MiB;
constexpr size_t WS_KN_CAC = WS_KN_LAT + 16 * MiB;
constexpr size_t WS_VN_CTX = WS_KN_CAC + 8 * MiB;
constexpr size_t WS_VN_LAT = WS_VN_CTX + 8 * MiB;
constexpr size_t WS_VN_CAC = WS_VN_LAT + 16 * MiB;
constexpr size_t WS_KG_CTX = WS_VN_CAC + 8 * MiB;
constexpr size_t WS_KG_LAT = WS_KG_CTX + 4 * MiB;
constexpr size_t WS_KG_CAC = WS_KG_LAT + 8 * MiB;
constexpr size_t WS_VG_CTX = WS_KG_CAC + 4 * MiB;
constexpr size_t WS_VG_LAT = WS_VG_CTX + 4 * MiB;
constexpr size_t WS_VG_CAC = WS_VG_LAT + 8 * MiB;
constexpr size_t WS_O = WS_VG_CAC + 4 * MiB;
constexpr size_t WS_KROPE = WS_O + 48 * MiB;
constexpr size_t WS_END = WS_KROPE + 4 * MiB;
constexpr int CW_BAR = 4096;

constexpr int RING_BYTES = 131072;
constexpr int LDSCTL_OFF = RING_BYTES;
constexpr int LDS_BYTES = 147456;

__device__ __forceinline__ unsigned f2bf(float f) { unsigned u = __builtin_bit_cast(unsigned, f); return (u + 0x7fffu + ((u >> 16) & 1u)) >> 16; }
__device__ __forceinline__ unsigned pk2(float lo, float hi) { return pg8::cvt_pk_bf16(lo, hi); }
__device__ __forceinline__ float wave_sum(float v) {
#pragma unroll
    for (int o = 1; o < 64; o <<= 1) v += __shfl_xor(v, o);
    return v;
}
__device__ __forceinline__ float fast_exp2(float x) { return __builtin_amdgcn_exp2f(x); }
__device__ __forceinline__ float fast_rcp(float x) { return __builtin_amdgcn_rcpf(x); }
__device__ __forceinline__ float silu_f(float g) { return g * fast_rcp(1.0f + fast_exp2(-g * LOG2E)); }
__device__ __forceinline__ float sin_rev(float rev) { return __builtin_amdgcn_sinf(rev); }
__device__ __forceinline__ float cos_rev(float rev) { return __builtin_amdgcn_cosf(rev); }

#define XB_TMO      128
#define XB_XCNT(j)  (256  + 64 * (j))
#define XB_XSUB(j)  (1280 + 64 * (j))
#define XB_XGEN(j)  (2304 + 64 * (j))
#define XB_TOP      3328
#define XB_TOPGEN   3392
#define XCD_BAR_WORDS 3456
#define XB_SPIN_CAP (1u << 18)
__device__ __forceinline__ unsigned xb_ld(unsigned* p)              { return __hip_atomic_load(p, __ATOMIC_RELAXED, __HIP_MEMORY_SCOPE_AGENT); }
__device__ __forceinline__ unsigned xb_add(unsigned* p, unsigned v) { return __hip_atomic_fetch_add(p, v, __ATOMIC_RELAXED, __HIP_MEMORY_SCOPE_AGENT); }
__device__ __forceinline__ unsigned xb_xcc_id() { return (unsigned)__builtin_amdgcn_s_getreg((3 << 11) | 20) & 0xFu; }
#define XB_SPIN(cond, bar) do { unsigned _sp = 0; while (cond) { __builtin_amdgcn_s_sleep(1); \
    if ((++_sp & 255u) == 0u) { if (xb_ld(&(bar)[XB_TMO])) break; if (_sp > XB_SPIN_CAP) { atomicAdd(&(bar)[XB_TMO], 1u); break; } } } } while (0)
struct XcdBarrier { unsigned* bar; unsigned x; volatile LAS unsigned* st; };
__device__ __forceinline__ XcdBarrier xcd_barrier_post(unsigned* bar, volatile LAS unsigned* st) {
    XcdBarrier b; b.bar = bar; b.x = xb_xcc_id(); b.st = st;
    if (threadIdx.x == 0) (void)xb_add(&bar[XB_XCNT(b.x)], 1u);
    return b;
}
__device__ __forceinline__ void xcd_barrier_complete(unsigned* bar, unsigned x, unsigned& nloc, unsigned& nx) {
    const unsigned G = gridDim.x * gridDim.y * gridDim.z;
    unsigned sum, cnt, mine, sp = 0u;
    for (;;) {
        sum = 0u; cnt = 0u; mine = 0u;
#pragma unroll
        for (unsigned j = 0; j < 16; ++j) { const unsigned c = xb_ld(&bar[XB_XCNT(j)]); sum += c; cnt += (c > 0u) ? 1u : 0u; mine = (j == x) ? c : mine; }
        if (sum == G) break;
        __builtin_amdgcn_s_sleep(1);
        if ((++sp & 255u) == 0u) { if (xb_ld(&bar[XB_TMO])) break; if (sp > XB_SPIN_CAP) { atomicAdd(&bar[XB_TMO], 1u); break; } }
    }
    nloc = mine > 0u ? mine : 1u; nx = cnt > 0u ? cnt : 1u;
}
__device__ __forceinline__ void xcd_barrier(const XcdBarrier& b) {
    asm volatile("s_waitcnt vmcnt(0)" ::: "memory");
    __syncthreads();
    if (threadIdx.x == 0) {
        unsigned* bar = b.bar;
        __builtin_amdgcn_s_waitcnt(0);
        unsigned nloc = b.st[0], nx = b.st[1];
        if (nloc == 0u) { xcd_barrier_complete(bar, b.x, nloc, nx); b.st[0] = nloc; b.st[1] = nx; }
        const unsigned old = xb_add(&bar[XB_XSUB(b.x)], 1u);
        const unsigned gen = old / nloc;
        if (old + 1u == (gen + 1u) * nloc) {
            __builtin_amdgcn_fence(__ATOMIC_RELEASE, "agent");
            asm volatile("s_waitcnt vmcnt(0)" ::: "memory");
            const unsigned og = xb_add(&bar[XB_TOP], 1u);
            const unsigned tg = og / nx;
            if (og + 1u == (tg + 1u) * nx) xb_add(&bar[XB_TOPGEN], 1u);
            else XB_SPIN(xb_ld(&bar[XB_TOPGEN]) == tg, bar);
            __builtin_amdgcn_fence(__ATOMIC_ACQUIRE, "agent");
            xb_add(&bar[XB_XGEN(b.x)], 1u);
            asm volatile("s_waitcnt vmcnt(0)" ::: "memory");
        } else {
            XB_SPIN(xb_ld(&bar[XB_XGEN(b.x)]) == gen, bar);
            __builtin_amdgcn_fence(__ATOMIC_ACQUIRE, "agent");
            asm volatile("s_waitcnt vmcnt(0)" ::: "memory");
        }
    }
    __syncthreads();
}

struct Args { const float* in[28]; float* out; unsigned char* ws; int ph_lo, ph_hi; };
struct Frame {
    LAS unsigned char* lds;
    int tid, lane, wave, G, gw, NGW;
    const Args* a; float* out; unsigned char* ws;
};
#define IN_XP 0
#define IN_XS 1
#define IN_C_CKV 2
#define IN_C_KROPE 3
#define IN_C_NAK 4
#define IN_C_NAV 5
#define IN_C_GK 6
#define IN_C_GV 7
#define IN_C 8
#define IN_CCTX 9
#define IN_ADAW 10
#define IN_ADAB 11
#define IN_NORMG 12
#define IN_FFI 13
#define IN_FFO 14
#define IN_EWI 15
#define IN_EWO 16
#define IN_QNORM 17
#define IN_WQUP 18
#define IN_KVNORM 19
#define IN_WKVUP 20
#define IN_MLAQK 21
#define IN_NAQK 22
#define IN_RPB 23
#define IN_OWI 24
#define IN_OWO 25
#define IN_GQK 26
#define IN_SINK 27

__device__ __forceinline__ int opaque_v(int x) { asm volatile("" : "+v"(x)); return x; }
__device__ __forceinline__ int tok_mb(int t) { return t < NCTX ? 0 : 1 + ((t - NCTX) >> 10); }

__device__ __forceinline__ size_t k_chunk_off(int DQK, int key, int c8) { return (size_t)(key >> 5) * (DQK * 32) + (size_t)(c8 >> 1) * 512 + (((c8 & 1) * 32 + (key & 31)) << 3); }
__device__ __forceinline__ void vt_tile_write_h(const bf16_t* src0, size_t pitch, bf16_t* dst, int lane) {
#pragma unroll
    for (int it = 0; it < 8; ++it) {
        const int d = (it & 1) * 64 + lane, s = (it >> 1) & 1, hh = it >> 2;
        unsigned v[8];
#pragma unroll
        for (int j = 0; j < 8; ++j) { const int key = 16 * s + 8 * (j >> 2) + 4 * hh + (j & 3); v[j] = src0[(size_t)key * pitch + d]; }
        u32x4 w; w.x = v[0] | (v[1] << 16); w.y = v[2] | (v[3] << 16); w.z = v[4] | (v[5] << 16); w.w = v[6] | (v[7] << 16);
        *(u32x4*)(dst + (size_t)(((s * 4 + (d >> 5)) * 64 + hh * 32 + (d & 31)) << 3)) = w;
    }
}
__device__ __forceinline__ void vt_tile_write(const float* src0, size_t pitch, bf16_t* dst, int lane) {
#pragma unroll
    for (int it = 0; it < 8; ++it) {
        const int d = (it & 1) * 64 + lane, s = (it >> 1) & 1, hh = it >> 2;
        float v[8];
#pragma unroll
        for (int j = 0; j < 8; ++j) { const int key = 16 * s + 8 * (j >> 2) + 4 * hh + (j & 3); v[j] = src0[(size_t)key * pitch + d]; }
        u32x4 w; w.x = pk2(v[0], v[1]); w.y = pk2(v[2], v[3]); w.z = pk2(v[4], v[5]); w.w = pk2(v[6], v[7]);
        *(u32x4*)(dst + (size_t)(((s * 4 + (d >> 5)) * 64 + hh * 32 + (d & 31)) << 3)) = w;
    }
}

__device__ __forceinline__ void p0_transpose_item(const float* W, int K, int N, bf16_t* WT, int mode, LAS float* scr, int item, int lane) {
    const int nblk = N / 32, kb = item / nblk, nb = item % nblk, k0 = 64 * kb, n0 = 32 * nb;
#pragma unroll 8
    for (int i = 0; i < 32; ++i) { const int kk = 2 * i + (lane >> 5); scr[kk * 33 + (lane & 31)] = __builtin_nontemporal_load(W + (size_t)(k0 + kk) * N + n0 + (lane & 31)); }
    asm volatile("s_waitcnt lgkmcnt(0)" ::: "memory");
    int d0 = n0;
    if (mode == 1) { const int j0 = n0 < DFF ? n0 : n0 - DFF; d0 = 256 * (j0 >> 7) + (j0 & 127) + (n0 < DFF ? 0 : 128); }
    if (mode == 2) d0 = n0 < 1024 ? n0 : (n0 < 1088 ? 4096 + (n0 - 1024) : n0 - 64);
    const int c = lane & 7;
#pragma unroll
    for (int j = 0; j < 4; ++j) { const int n = (lane >> 3) + 8 * j; const LAS float* s = scr + (8 * c) * 33 + n;
        u32x4 o; o.x = pk2(s[0 * 33], s[1 * 33]); o.y = pk2(s[2 * 33], s[3 * 33]); o.z = pk2(s[4 * 33], s[5 * 33]); o.w = pk2(s[6 * 33], s[7 * 33]);
        *(u32x4*)(WT + (size_t)(d0 + n) * K + k0 + 8 * c) = o; }
    asm volatile("s_waitcnt lgkmcnt(0)" ::: "memory");
}

__device__ __forceinline__ const float* p0_mods_wptr(Frame& F, int item) {
    const int layer = item / 1152, rem = item % 1152, slab = rem >> 4, ks = rem & 15;
    return F.a->in[IN_ADAW] + (size_t)layer * DM * NMOD + (size_t)(ks * 128 + F.wave * 16) * NMOD + slab * 256 + 4 * F.lane;
}
__device__ __forceinline__ void phase_mods(Frame& F) {
    LAS float* stab = (LAS float*)(F.lds);
    LAS float* part = (LAS float*)(F.lds + 8192);
    const float* c = F.a->in[IN_C]; const float* cctx = F.a->in[IN_CCTX];
    for (int item = blockIdx.x; item < 2304; item += F.G) {
        const int layer = item / 1152, rem = item % 1152, slab = rem >> 4, ks = rem & 15, n0 = slab * 256, k0 = ks * 128;
        f32x4 w[16];
        { const float* W = p0_mods_wptr(F, item);
#pragma unroll
          for (int kk = 0; kk < 16; ++kk) w[kk] = __builtin_nontemporal_load((const f32x4*)(W + (size_t)kk * NMOD)); }
        for (int i = F.tid; i < 9 * 128; i += 512) { const int b = i >> 7, k = i & 127; const float v = (b == 0) ? cctx[k0 + k] : c[(size_t)(b - 1) * DM + k0 + k]; stab[i] = silu_f(v); }
        __syncthreads();
        f32x4 acc[9];
#pragma unroll
        for (int b = 0; b < 9; ++b) acc[b] = (f32x4){0.f, 0.f, 0.f, 0.f};
#pragma unroll
        for (int kk = 0; kk < 16; ++kk) {
#pragma unroll
            for (int b = 0; b < 9; ++b) { const float sv = stab[b * 128 + F.wave * 16 + kk]; acc[b] += w[kk] * sv; }
        }
#pragma unroll
        for (int b = 0; b < 9; ++b) *(LAS f32x4*)(part + (F.wave * 9 + b) * 256 + 4 * F.lane) = acc[b];
        __syncthreads();
        float* mods = (float*)(F.ws + WS_MODS) + (size_t)layer * 9 * NMOD;
        const float* bias = F.a->in[IN_ADAB] + (size_t)layer * NMOD;
        for (int i = F.tid; i < 9 * 256; i += 512) { const int b = i >> 8, col = i & 255; float sm = 0.f;
#pragma unroll
            for (int ww = 0; ww < 8; ++ww) sm += part[(ww * 9 + b) * 256 + col];
            if (ks == 0) sm += bias[n0 + col];
            atomicAdd(mods + (size_t)b * NMOD + n0 + col, sm); }
        __syncthreads();
    }
}

__device__ __forceinline__ void p0_cacheK_item(const float* src, int H, bf16_t* dstbase, int item, int lane) {
    const int t32 = item & 15, bh = item >> 4, b = bh / H, h = bh % H;
    bf16_t* dst = dstbase + (size_t)bh * (512 * 128);
#pragma unroll
    for (int it = 0; it < 8; ++it) { const int idx = it * 64 + lane, kl = idx >> 4, c8 = idx & 15, key = t32 * 32 + kl;
        const float* s = src + ((size_t)(b * 512 + key) * H + h) * 128 + c8 * 8;
        const f32x4 a = *(const f32x4*)s, bb = *(const f32x4*)(s + 4);
        u32x4 w; w.x = pk2(a[0], a[1]); w.y = pk2(a[2], a[3]); w.z = pk2(bb[0], bb[1]); w.w = pk2(bb[2], bb[3]);
        *(u32x4*)(dst + k_chunk_off(128, key, c8)) = w; }
}
__device__ __forceinline__ void p0_cacheV_item(const float* src, int H, bf16_t* dstbase, int item, int lane) {
    const int t32 = item & 15, bh = item >> 4, b = bh / H, h = bh % H;
    vt_tile_write(src + ((size_t)(b * 512 + t32 * 32) * H + h) * 128, (size_t)H * 128, dstbase + (size_t)bh * (512 * 128) + (size_t)t32 * 4096, lane);
}

__device__ __forceinline__ void phase_prologue(Frame& F) {
    phase_mods(F);
    LAS float* scr = (LAS float*)(F.lds + F.wave * 16384);
    constexpr int I_FI = 32 * 352, I_FO = 88 * 64, I_EI = 32 * 130, I_QU = 8 * 48, I_KU = 8 * 64, I_EO = 32 * 64, I_OI = 32 * 96, I_OO = 32 * 64;
    constexpr int I_PAD = 0, I_CKV = 1024, I_NK = 1024, I_NV = 1024, I_GK = 512, I_GV = 512;
    constexpr int NITEMS = 4 * I_FI + 4 * I_FO + I_EI + I_QU + I_KU + I_EO + I_OI + I_OO + I_PAD + I_CKV + I_NK + I_NV + I_GK + I_GV;
    unsigned char* ws = F.ws;
    for (int it = F.gw; it < NITEMS; it += F.NGW) {
        int r = it;
        if (r < 4 * I_FI) { const int m = r / I_FI; p0_transpose_item(F.a->in[IN_FFI] + (size_t)m * DM * NFF2, DM, NFF2, (bf16_t*)(ws + WS_WFI) + (size_t)m * NFF2 * DM, 1, scr, r % I_FI, F.lane); continue; } r -= 4 * I_FI;
        if (r < 4 * I_FO) { const int m = r / I_FO; p0_transpose_item(F.a->in[IN_FFO] + (size_t)m * DFF * DM, DFF, DM, (bf16_t*)(ws + WS_WFO) + (size_t)m * DM * DFF, 0, scr, r % I_FO, F.lane); continue; } r -= 4 * I_FO;
        if (r < I_EI) { p0_transpose_item(F.a->in[IN_EWI], DM, IN_EVEN, (bf16_t*)(ws + WS_WEI), 2, scr, r, F.lane); continue; } r -= I_EI;
        if (r < I_QU) { p0_transpose_item(F.a->in[IN_WQUP], 512, 1536, (bf16_t*)(ws + WS_WQU), 0, scr, r, F.lane); continue; } r -= I_QU;
        if (r < I_KU) { p0_transpose_item(F.a->in[IN_WKVUP], 512, 2048, (bf16_t*)(ws + WS_WKU), 0, scr, r, F.lane); continue; } r -= I_KU;
        if (r < I_EO) { p0_transpose_item(F.a->in[IN_EWO], DM, DM, (bf16_t*)(ws + WS_WEO), 0, scr, r, F.lane); continue; } r -= I_EO;
        if (r < I_OI) { p0_transpose_item(F.a->in[IN_OWI], DM, IN_ODD, (bf16_t*)(ws + WS_WOI), 0, scr, r, F.lane); continue; } r -= I_OI;
        if (r < I_OO) { p0_transpose_item(F.a->in[IN_OWO], DM, DM, (bf16_t*)(ws + WS_WOO), 0, scr, r, F.lane); continue; } r -= I_OO;
        if (r < I_PAD) { u32x4* p = (u32x4*)((bf16_t*)(ws + WS_WEI) + (size_t)(IN_EVEN + r) * DM); const u32x4 z = {0u, 0u, 0u, 0u};
#pragma unroll
            for (int j = 0; j < 4; ++j) p[j * 64 + F.lane] = z; continue; } r -= I_PAD;
        if (r < I_CKV) {
#pragma unroll
            for (int j = 0; j < 4; ++j) { const int row = 4 * r + j; const float* s = F.a->in[IN_C_CKV] + (size_t)row * 512 + 8 * F.lane;
                const f32x4 a = *(const f32x4*)s, b = *(const f32x4*)(s + 4);
                u32x4 w; w.x = pk2(a[0], a[1]); w.y = pk2(a[2], a[3]); w.z = pk2(b[0], b[1]); w.w = pk2(b[2], b[3]);
                *(u32x4*)((bf16_t*)(ws + WS_CKVA) + (size_t)(NTOK + row) * 512 + 8 * F.lane) = w; }
            continue; } r -= I_CKV;
        if (r < I_NK) { p0_cacheK_item(F.a->in[IN_C_NAK], 8, (bf16_t*)(ws + WS_KN_CAC), r, F.lane); continue; } r -= I_NK;
        if (r < I_NV) { p0_cacheV_item(F.a->in[IN_C_NAV], 8, (bf16_t*)(ws + WS_VN_CAC), r, F.lane); continue; } r -= I_NV;
        if (r < I_GK) { p0_cacheK_item(F.a->in[IN_C_GK], 4, (bf16_t*)(ws + WS_KG_CAC), r, F.lane); continue; } r -= I_GK;
        p0_cacheV_item(F.a->in[IN_C_GV], 4, (bf16_t*)(ws + WS_VG_CAC), r, F.lane);
    }
}

__device__ __forceinline__ void load8(const float* p, float (&v)[8]) { const f32x4 a = *(const f32x4*)p, b = *(const f32x4*)(p + 4); v[0] = a[0]; v[1] = a[1]; v[2] = a[2]; v[3] = a[3]; v[4] = b[0]; v[5] = b[1]; v[6] = b[2]; v[7] = b[3]; }
__device__ __forceinline__ void load8h(const bf16_t* p, float (&v)[8]) { const u32x4 w = *(const u32x4*)p;
    v[0] = __builtin_bit_cast(float, w.x << 16); v[1] = __builtin_bit_cast(float, w.x & 0xffff0000u); v[2] = __builtin_bit_cast(float, w.y << 16); v[3] = __builtin_bit_cast(float, w.y & 0xffff0000u);
    v[4] = __builtin_bit_cast(float, w.z << 16); v[5] = __builtin_bit_cast(float, w.z & 0xffff0000u); v[6] = __builtin_bit_cast(float, w.w << 16); v[7] = __builtin_bit_cast(float, w.w & 0xffff0000u); }

__device__ __forceinline__ const float* x_in_row(Frame& F, int t) { return t < NCTX ? F.a->in[IN_XP] + (size_t)t * DM : F.a->in[IN_XS] + (size_t)(t - NCTX) * DM; }
__device__ __forceinline__ void phase_norm(Frame& F, bool from_input, int layer, int sub) {
    const float* g = F.a->in[IN_NORMG] + (size_t)(layer * 3 + sub) * DM;
    bf16_t* H = (bf16_t*)(F.ws + WS_H);
    const bf16_t* XB = (const bf16_t*)(F.ws + WS_XB);
    const int lane = opaque_v(F.lane);
    for (int t = F.gw; t < NTOK; t += F.NGW) {
        const float* md = (const float*)(F.ws + WS_MODS) + ((size_t)layer * 9 + tok_mb(t)) * NMOD + (size_t)(3 * sub) * DM;
        float v[4][8]; float ss = 0.f;
        if (from_input) { const float* xr = x_in_row(F, t);
#pragma unroll
            for (int j = 0; j < 4; ++j) load8(xr + 512 * j + 8 * lane, v[j]);
        } else { const bf16_t* xr = XB + (size_t)t * DM;
#pragma unroll
            for (int j = 0; j < 4; ++j) load8h(xr + 512 * j + 8 * lane, v[j]);
        }
#pragma unroll
        for (int j = 0; j < 4; ++j) ss += ((v[j][0] * v[j][0] + v[j][1] * v[j][1]) + (v[j][2] * v[j][2] + v[j][3] * v[j][3])) + ((v[j][4] * v[j][4] + v[j][5] * v[j][5]) + (v[j][6] * v[j][6] + v[j][7] * v[j][7]));
        const float rstd = __builtin_amdgcn_rsqf(wave_sum(ss) * (1.0f / DM) + EPS);
#pragma unroll
        for (int j = 0; j < 4; ++j) { const int c = 512 * j + 8 * lane;
            float gg[8], sh[8], sc[8], y[8]; load8(g + c, gg); load8(md + c, sh); load8(md + DM + c, sc);
#pragma unroll
            for (int e = 0; e < 8; ++e) y[e] = (v[j][e] * rstd * gg[e]) * (sc[e] + 1.0f) + sh[e];
            u32x4 w; w.x = pk2(y[0], y[1]); w.y = pk2(y[2], y[3]); w.z = pk2(y[4], y[5]); w.w = pk2(y[6], y[7]);
            *(u32x4*)(H + (size_t)t * DM + c) = w; }
    }
}

struct EpiSwiGLU {
    static constexpr bool PERM = true;
    bf16_t* O;
    struct Ctx { int row0, col0; };
    __device__ __forceinline__ Ctx begin(const pg8::Unit& u, int wr, int wc, int fr, int fq) const { return Ctx{u.pm * 256 + wr * 64 + fr, u.pn * 128 + wc * 32 + 8 * fq}; }
    __device__ __forceinline__ void rows(const Ctx& c, const f32x4 (&v)[2][2], const pg8::Unit&, int ai, int m, int, int, int, int) const {
        float r[8];
#pragma unroll
        for (int n = 0; n < 2; ++n)
#pragma unroll
            for (int j = 0; j < 4; ++j) r[4 * n + j] = silu_f(v[0][n][j]) * v[1][n][j];
        u32x4 w; w.x = pk2(r[0], r[1]); w.y = pk2(r[2], r[3]); w.z = pk2(r[4], r[5]); w.w = pk2(r[6], r[7]);
        *(u32x4*)(O + (size_t)(c.row0 + ai * 128 + m * 16) * DFF + c.col0) = w;
    }
};
template <bool INF, bool OUTF>
struct EpiResid {
    static constexpr bool PERM = true;
    const float* xp; const float* xs; bf16_t* xb; float* out; const float* gate_base; float coef;
    struct Ctx { const float* xin; f32x4 gv[2][2]; int row0, col0; };
    __device__ __forceinline__ Ctx begin(const pg8::Unit& u, int wr, int wc, int fr, int fq) const {
        Ctx c; const int rowt = u.pm * 256; c.row0 = rowt + wr * 64 + fr; c.col0 = u.pn * 256 + wc * 32 + 8 * fq;
        const float* gt = gate_base + (size_t)tok_mb(rowt) * NMOD;
        c.xin = rowt < NCTX ? xp : xs - (size_t)NCTX * DM;
#pragma unroll
        for (int bj = 0; bj < 2; ++bj)
#pragma unroll
            for (int n = 0; n < 2; ++n) c.gv[bj][n] = *(const f32x4*)(gt + c.col0 + bj * 128 + n * 4) * coef;
        return c;
    }
    __device__ __forceinline__ void rows(const Ctx& c, const f32x4 (&v)[2][2], const pg8::Unit&, int ai, int m, int, int, int, int) const {
        const size_t off = (size_t)(c.row0 + ai * 128 + m * 16) * DM + c.col0;
        f32x4 x[2][2];
#pragma unroll
        for (int bj = 0; bj < 2; ++bj) {
            if constexpr (INF) { x[bj][0] = *(const f32x4*)(c.xin + off + bj * 128); x[bj][1] = *(const f32x4*)(c.xin + off + bj * 128 + 4); }
            else { const u32x4 w = *(const u32x4*)(xb + off + bj * 128);
                x[bj][0] = (f32x4){__builtin_bit_cast(float, w.x << 16), __builtin_bit_cast(float, w.x & 0xffff0000u), __builtin_bit_cast(float, w.y << 16), __builtin_bit_cast(float, w.y & 0xffff0000u)};
                x[bj][1] = (f32x4){__builtin_bit_cast(float, w.z << 16), __builtin_bit_cast(float, w.z & 0xffff0000u), __builtin_bit_cast(float, w.w << 16), __builtin_bit_cast(float, w.w & 0xffff0000u)}; }
        }
#pragma unroll
        for (int bj = 0; bj < 2; ++bj) { const f32x4 r0 = x[bj][0] + c.gv[bj][0] * v[bj][0], r1 = x[bj][1] + c.gv[bj][1] * v[bj][1];
            if constexpr (OUTF) { *(f32x4*)(out + off + bj * 128) = r0; *(f32x4*)(out + off + bj * 128 + 4) = r1; }
            else { u32x4 w; w.x = pk2(r0[0], r0[1]); w.y = pk2(r0[2], r0[3]); w.z = pk2(r1[0], r1[1]); w.w = pk2(r1[2], r1[3]); *(u32x4*)(xb + off + bj * 128) = w; }
        }
        asm volatile("" ::: "memory");
    }
};
typedef EpiResid<true, false> ResidIn; typedef EpiResid<false, false> ResidMid; typedef EpiResid<false, true> ResidOut;
struct EpiBf16 {
    static constexpr bool PERM = true;
    bf16_t* C; int ldc;
    struct Ctx { int row0, col0; };
    __device__ __forceinline__ Ctx begin(const pg8::Unit& u, int wr, int wc, int fr, int fq) const { return Ctx{u.pm * 256 + wr * 64 + fr, u.pn * 256 + wc * 32 + 8 * fq}; }
    __device__ __forceinline__ void rows(const Ctx& c, const f32x4 (&v)[2][2], const pg8::Unit&, int ai, int m, int, int, int, int) const {
        bf16_t* rowp = C + (size_t)(c.row0 + ai * 128 + m * 16) * ldc + c.col0;
#pragma unroll
        for (int bj = 0; bj < 2; ++bj) { u32x4 w; w.x = pk2(v[bj][0][0], v[bj][0][1]); w.y = pk2(v[bj][0][2], v[bj][0][3]); w.z = pk2(v[bj][1][0], v[bj][1][1]); w.w = pk2(v[bj][1][2], v[bj][1][3]);
            *(u32x4*)(rowp + bj * 128) = w; }
    }
};
struct EpiF32 {
    static constexpr bool PERM = false;
    float* C; int ldc;
    struct Ctx { int row0, col0; };
    __device__ __forceinline__ Ctx begin(const pg8::Unit& u, int wr, int wc, int fr, int fq) const { return Ctx{u.pm * 256 + wr * 64 + fr, u.pn * 256 + wc * 32 + 4 * fq}; }
    __device__ __forceinline__ void rows(const Ctx& c, const f32x4 (&v)[2][2], const pg8::Unit&, int ai, int m, int, int, int, int) const {
        float* rowp = C + (size_t)(c.row0 + ai * 128 + m * 16) * ldc + c.col0;
#pragma unroll
        for (int bj = 0; bj < 2; ++bj)
#pragma unroll
            for (int n = 0; n < 2; ++n) *(f32x4*)(rowp + bj * 128 + n * 16) = v[bj][n];
    }
};

__device__ __forceinline__ u32x4 pack8(const float (&v)[8]) { u32x4 w; w.x = pk2(v[0], v[1]); w.y = pk2(v[2], v[3]); w.z = pk2(v[4], v[5]); w.w = pk2(v[6], v[7]); return w; }
__device__ __forceinline__ void store8f(float* p, const float (&v)[8]) { *(f32x4*)p = (f32x4){v[0], v[1], v[2], v[3]}; *(f32x4*)(p + 4) = (f32x4){v[4], v[5], v[6], v[7]}; }
template <int W> __device__ __forceinline__ float group_sum(float v) {
#pragma unroll
    for (int o = 1; o < W; o <<= 1) v += __shfl_xor(v, o);
    return v;
}

__device__ __forceinline__ void phase_post1_even(Frame& F) {
    const bf16_t* P = (const bf16_t*)(F.ws + WS_P);
    const float* qn_g = F.a->in[IN_QNORM]; const float* kvn_g = F.a->in[IN_KVNORM]; const float* naq_g = F.a->in[IN_NAQK]; const float* nak_g = F.a->in[IN_NAQK] + 128;
    bf16_t* CQN = (bf16_t*)(F.ws + WS_CQN); bf16_t* CKVA = (bf16_t*)(F.ws + WS_CKVA); bf16_t* QNA = (bf16_t*)(F.ws + WS_QNA);
    constexpr int NVT_CTX = 16 * 8 * 8, NVT_LAT = 8 * 8 * 32, NKR = NTOK / 16;
    for (int it = F.gw; it < NKR; it += F.NGW) {
        const int t0 = it * 16, lane = F.lane, lr = lane & 15, lq = lane >> 4;
        const bf16_t* ap = (const bf16_t*)(F.ws + WS_H) + (size_t)(t0 + lr) * DM + 8 * lq;
        const bf16_t* bp = (const bf16_t*)(F.ws + WS_WEI) + (size_t)(4096 + lr) * DM + 8 * lq;
        f32x4 acc[4];
#pragma unroll
        for (int j = 0; j < 4; ++j) acc[j] = (f32x4){0.f, 0.f, 0.f, 0.f};
#pragma unroll 8
        for (int kk = 0; kk < 64; ++kk) {
            const bf16x8 af = *(const bf16x8*)(ap + kk * 32);
#pragma unroll
            for (int j = 0; j < 4; ++j) { const bf16x8 bf = *(const bf16x8*)(bp + (size_t)j * 16 * DM + kk * 32); acc[j] = __builtin_amdgcn_mfma_f32_16x16x32_bf16(af, bf, acc[j], 0, 0, 0); }
        }
        float* kr = (float*)(F.ws + WS_KROPE);
#pragma unroll
        for (int j = 0; j < 4; ++j)
#pragma unroll
            for (int r = 0; r < 4; ++r) { const int t = t0 + 4 * lq + r, c = 16 * j + lr; kr[(size_t)t * 64 + c] = acc[j][r]; if (t < NCTX) F.out[O_KROPE + (size_t)t * 64 + c] = acc[j][r]; }
    }
    for (int it = F.gw; it < NTOK + NVT_CTX + NVT_LAT; it += F.NGW) {
        if (it < NTOK) {
            const int t = it, lane = F.lane; const bf16_t* pr = P + (size_t)t * IN_EVEN_P; const bool ctx = t < NCTX;
            float v[8], g[8];
            load8h(pr + 8 * lane, v); float ss = 0.f;
#pragma unroll
            for (int i = 0; i < 8; ++i) ss += v[i] * v[i];
            float rstd = __builtin_amdgcn_rsqf(wave_sum(ss) * (1.0f / 512) + EPS);
            load8(qn_g + 8 * lane, g);
#pragma unroll
            for (int i = 0; i < 8; ++i) v[i] = v[i] * rstd * g[i];
            *(u32x4*)(CQN + (size_t)t * 512 + 8 * lane) = pack8(v);
            load8h(pr + 512 + 8 * lane, v); ss = 0.f;
#pragma unroll
            for (int i = 0; i < 8; ++i) ss += v[i] * v[i];
            rstd = __builtin_amdgcn_rsqf(wave_sum(ss) * (1.0f / 512) + EPS);
            load8(kvn_g + 8 * lane, g);
#pragma unroll
            for (int i = 0; i < 8; ++i) v[i] = v[i] * rstd * g[i];
            if (ctx) store8f(F.out + O_CKV + (size_t)t * 512 + 8 * lane, v);
            *(u32x4*)(CKVA + (size_t)t * 512 + 8 * lane) = pack8(v);
            const int head = lane >> 3, d0 = (lane & 7) * 16;
            int b, s; if (ctx) { b = t >> 8; s = t & 255; } else { b = (t - NCTX) >> 10; s = (t - NCTX) & 1023; }
#pragma unroll
            for (int which = 0; which < 2; ++which) {
                const bf16_t* src = pr + 1024 + which * 1024 + head * 128 + d0; const float* gg = which ? nak_g : naq_g;
                float a[8], c[8], ga[8], gc[8]; load8h(src, a); load8h(src + 8, c); load8(gg + d0, ga); load8(gg + d0 + 8, gc);
                float q = 0.f;
#pragma unroll
                for (int i = 0; i < 8; ++i) q += a[i] * a[i] + c[i] * c[i];
                const float r2 = __builtin_amdgcn_rsqf(group_sum<8>(q) * (1.0f / 128) + EPS);
#pragma unroll
                for (int i = 0; i < 8; ++i) { a[i] = a[i] * r2 * ga[i]; c[i] = c[i] * r2 * gc[i]; }
                if (which == 0) { bf16_t* qd = QNA + (size_t)t * 1024 + head * 128 + d0; *(u32x4*)qd = pack8(a); *(u32x4*)(qd + 8) = pack8(c); }
                else {
                    if (ctx) { float* od = F.out + O_NAK + (size_t)t * 1024 + head * 128 + d0; store8f(od, a); store8f(od + 8, c); }
                    bf16_t* kb = ctx ? (bf16_t*)(F.ws + WS_KN_CTX) + (size_t)(b * 8 + head) * (256 * 128) : (bf16_t*)(F.ws + WS_KN_LAT) + (size_t)(b * 8 + head) * (1024 * 128);
                    *(u32x4*)(kb + k_chunk_off(128, s, d0 >> 3)) = pack8(a); *(u32x4*)(kb + k_chunk_off(128, s, (d0 >> 3) + 1)) = pack8(c);
                }
            }
            { const bf16_t* src = pr + 3072 + 16 * lane; float a[8], c[8]; load8h(src, a); load8h(src + 8, c); if (ctx) { float* od = F.out + O_NAV + (size_t)t * 1024 + 16 * lane; store8f(od, a); store8f(od + 8, c); } }
        } else {
            int r = it - NTOK;
            if (r < NVT_CTX) { const int t32 = r & 7, bh = r >> 3, b = bh >> 3, h = bh & 7;
                vt_tile_write_h(P + (size_t)(b * 256 + t32 * 32) * IN_EVEN_P + 3072 + h * 128, IN_EVEN_P, (bf16_t*)(F.ws + WS_VN_CTX) + (size_t)bh * (256 * 128) + (size_t)t32 * 4096, F.lane);
            } else { r -= NVT_CTX; const int t32 = r & 31, bh = r >> 5, b = bh >> 3, h = bh & 7;
                vt_tile_write_h(P + (size_t)(NCTX + b * 1024 + t32 * 32) * IN_EVEN_P + 3072 + h * 128, IN_EVEN_P, (bf16_t*)(F.ws + WS_VN_LAT) + (size_t)bh * (1024 * 128) + (size_t)t32 * 4096, F.lane);
            }
        }
    }
}

__device__ __forceinline__ void rope8(float (&v)[8], const float (&vp)[8], bool is_x1, float pos, int f0, float inv_nf) {
#pragma unroll
    for (int i = 0; i < 8; ++i) {
        const float invf = fast_exp2(-(float)(f0 + i) * inv_nf * 13.287712379549449f);
        const float rev = pos * invf * 0.15915494309189535f;
        const float cs = cos_rev(rev), sn = sin_rev(rev);
        v[i] = is_x1 ? (v[i] * cs - vp[i] * sn) : (vp[i] * sn + v[i] * cs);
    }
}

__device__ __forceinline__ void phase_post2_even(Frame& F) {
    const bf16_t* P = (const bf16_t*)(F.ws + WS_P); const bf16_t* QM = (const bf16_t*)(F.ws + WS_QM); const bf16_t* KVM = (const bf16_t*)(F.ws + WS_ACT);
    const float* gq = F.a->in[IN_MLAQK]; const float* gk = F.a->in[IN_MLAQK] + 192;
    bf16_t* QA = (bf16_t*)(F.ws + WS_QA);
    constexpr int NROW = 16384, NVT_CTX = 1024, NVT_LAT = 2048, NVT_CAC = 1024;
    const int lane = F.lane, hsub = lane >> 5, c = lane & 31; const bool act = c < 24;
    for (int it = F.gw; it < NTOK + NROW + NVT_CTX + NVT_LAT + NVT_CAC; it += F.NGW) {
        if (it < NTOK) {
            const int t = it; const bool lat = t >= NCTX; const int s = (t - NCTX) & 1023; const float row = (float)(s >> 6), col = (float)(s & 63);
            const int cc = act ? c : 23, cpq = cc >= 16 ? (cc ^ 2) : cc;
            float g[8], gp[8]; load8(gq + 8 * cc, g); load8(gq + 8 * cpq, gp);
            float v[4][8], vp[4][8];
#pragma unroll
            for (int pass = 0; pass < 4; ++pass) { const bf16_t* src = QM + (size_t)t * 1536 + (2 * pass + hsub) * 192; load8h(src + 8 * cc, v[pass]); load8h(src + 8 * cpq, vp[pass]); }
#pragma unroll
            for (int pass = 0; pass < 4; ++pass) {
                const int head = 2 * pass + hsub;
                float q = 0.f;
#pragma unroll
                for (int i = 0; i < 8; ++i) { v[pass][i] = act ? v[pass][i] : 0.f; q += v[pass][i] * v[pass][i]; }
                const float rstd = __builtin_amdgcn_rsqf(group_sum<32>(q) * (1.0f / 192) + EPS);
#pragma unroll
                for (int i = 0; i < 8; ++i) { v[pass][i] = v[pass][i] * rstd * g[i]; vp[pass][i] = vp[pass][i] * rstd * gp[i]; }
                if (lat && c >= 16 && act) rope8(v[pass], vp[pass], (c & 2) == 0, c < 20 ? row : col, (c & 1) * 8, 1.0f / 16);
                if (act) *(u32x4*)(QA + (size_t)t * 1536 + head * 192 + 8 * c) = pack8(v[pass]);
            }
        } else if (it < NTOK + NROW) {
            const int r = it - NTOK; const bool istok = r < NTOK; const bool lat = istok && r >= NCTX;
            int bsel, s; bf16_t* kb0; int nkeys;
            if (!istok) { bsel = (r - NTOK) >> 9; s = (r - NTOK) & 511; kb0 = (bf16_t*)(F.ws + WS_KM_CAC); nkeys = 512; }
            else if (lat) { bsel = (r - NCTX) >> 10; s = (r - NCTX) & 1023; kb0 = (bf16_t*)(F.ws + WS_KM_LAT); nkeys = 1024; }
            else { bsel = r >> 8; s = r & 255; kb0 = (bf16_t*)(F.ws + WS_KM_CTX); nkeys = 256; }
            const float* krp_f = istok ? (const float*)(F.ws + WS_KROPE) + (size_t)r * 64 : F.a->in[IN_C_KROPE] + (size_t)(r - NTOK) * 64;
            const float row = (float)(s >> 6), col = (float)(s & 63);
            const int cc = act ? c : 23, cpq = cc >= 16 ? (cc ^ 2) : cc, cn = c < 16 ? c : 15, cr = cc >= 16 ? cc - 16 : 0, crp = cc >= 16 ? cpq - 16 : 0;
            float g[8], gp[8], kr[8], krp[8]; load8(gk + 8 * cc, g); load8(gk + 8 * cpq, gp); load8(krp_f + 8 * cr, kr); load8(krp_f + 8 * crp, krp);
            float v[4][8];
#pragma unroll
            for (int pass = 0; pass < 4; ++pass) load8h(KVM + (size_t)r * 2048 + (2 * pass + hsub) * 256 + 8 * cn, v[pass]);
#pragma unroll
            for (int pass = 0; pass < 4; ++pass) {
                const int head = 2 * pass + hsub;
                float vp[8]; float q = 0.f;
#pragma unroll
                for (int i = 0; i < 8; ++i) { v[pass][i] = c < 16 ? v[pass][i] : (act ? kr[i] : 0.f); q += v[pass][i] * v[pass][i]; }
                const float rstd = __builtin_amdgcn_rsqf(group_sum<32>(q) * (1.0f / 192) + EPS);
#pragma unroll
                for (int i = 0; i < 8; ++i) { v[pass][i] = v[pass][i] * rstd * g[i]; vp[i] = krp[i] * rstd * gp[i]; }
                if (lat && c >= 16 && act) rope8(v[pass], vp, (c & 2) == 0, c < 20 ? row : col, (c & 1) * 8, 1.0f / 16);
                if (act) *(u32x4*)(kb0 + (size_t)(bsel * 8 + head) * ((size_t)nkeys * 192) + k_chunk_off(192, s, c)) = pack8(v[pass]);
            }
        } else {
            int r = it - NTOK - NROW;
            if (r < NVT_CTX) { const int t32 = r & 7, bh = r >> 3, b = bh >> 3, h = bh & 7;
                vt_tile_write_h(KVM + (size_t)(b * 256 + t32 * 32) * 2048 + h * 256 + 128, 2048, (bf16_t*)(F.ws + WS_VM_CTX) + (size_t)bh * (256 * 128) + (size_t)t32 * 4096, lane);
            } else if (r < NVT_CTX + NVT_LAT) { r -= NVT_CTX; const int t32 = r & 31, bh = r >> 5, b = bh >> 3, h = bh & 7;
                vt_tile_write_h(KVM + (size_t)(NCTX + b * 1024 + t32 * 32) * 2048 + h * 256 + 128, 2048, (bf16_t*)(F.ws + WS_VM_LAT) + (size_t)bh * (1024 * 128) + (size_t)t32 * 4096, lane);
            } else { r -= NVT_CTX + NVT_LAT; const int t32 = r & 15, bh = r >> 4, b = bh >> 3, h = bh & 7;
                vt_tile_write_h(KVM + (size_t)(NTOK + b * 512 + t32 * 32) * 2048 + h * 256 + 128, 2048, (bf16_t*)(F.ws + WS_VM_CAC) + (size_t)bh * (512 * 128) + (size_t)t32 * 4096, lane);
            }
        }
    }
}

__device__ __forceinline__ void phase_post_odd(Frame& F) {
    const bf16_t* P = (const bf16_t*)(F.ws + WS_P); const float* gq = F.a->in[IN_GQK]; const float* gk = F.a->in[IN_GQK] + 128;
    bf16_t* QA = (bf16_t*)(F.ws + WS_QA);
    constexpr int NVT_CTX = 16 * 4 * 8, NVT_LAT = 8 * 4 * 32;
    const int lane = F.lane, hsub = lane >> 4, c = lane & 15;
    for (int it = F.gw; it < NTOK + NVT_CTX + NVT_LAT; it += F.NGW) {
        if (it < NTOK) {
            const int t = it; const bool ctx = t < NCTX, lat = !ctx; const bf16_t* pr = P + (size_t)t * IN_ODD;
            int b, s; if (ctx) { b = t >> 8; s = t & 255; } else { b = (t - NCTX) >> 10; s = (t - NCTX) & 1023; }
            const float row = (float)(s >> 6), col = (float)(s & 63);
            const int cp = c ^ 4;
            float gqv[8], gqp[8], gkv[8], gkp[8]; load8(gq + 8 * c, gqv); load8(gq + 8 * cp, gqp); load8(gk + 8 * c, gkv); load8(gk + 8 * cp, gkp);
            float v[5][8], vp[5][8];
#pragma unroll
            for (int pass = 0; pass < 5; ++pass) { const bf16_t* src = pr + (pass == 4 ? 2048 + hsub * 128 : (4 * pass + hsub) * 128); load8h(src + 8 * c, v[pass]); load8h(src + 8 * cp, vp[pass]); }
#pragma unroll
            for (int pass = 0; pass < 5; ++pass) {
                const bool isk = pass == 4; const int head = isk ? hsub : 4 * pass + hsub;
                float q = 0.f;
#pragma unroll
                for (int i = 0; i < 8; ++i) q += v[pass][i] * v[pass][i];
                const float rstd = __builtin_amdgcn_rsqf(group_sum<16>(q) * (1.0f / 128) + EPS);
#pragma unroll
                for (int i = 0; i < 8; ++i) { v[pass][i] = v[pass][i] * rstd * (isk ? gkv[i] : gqv[i]); vp[pass][i] = vp[pass][i] * rstd * (isk ? gkp[i] : gqp[i]); }
                if (isk && ctx) store8f(F.out + O_GK + (size_t)t * 512 + head * 128 + 8 * c, v[pass]);
                if (lat) rope8(v[pass], vp[pass], (c & 4) == 0, c < 8 ? row : col, (c & 3) * 8, 1.0f / 32);
                if (!isk) *(u32x4*)(QA + (size_t)t * 2048 + head * 128 + 8 * c) = pack8(v[pass]);
                else { bf16_t* kb = ctx ? (bf16_t*)(F.ws + WS_KG_CTX) + (size_t)(b * 4 + head) * (256 * 128) : (bf16_t*)(F.ws + WS_KG_LAT) + (size_t)(b * 4 + head) * (1024 * 128);
                    *(u32x4*)(kb + k_chunk_off(128, s, c)) = pack8(v[pass]); }
            }
            { float vv[8]; load8h(pr + 2560 + 8 * lane, vv); if (ctx) store8f(F.out + O_GV + (size_t)t * 512 + 8 * lane, vv); }
        } else {
            int r = it - NTOK;
            if (r < NVT_CTX) { const int t32 = r & 7, bh = r >> 3, b = bh >> 2, h = bh & 3;
                vt_tile_write_h(P + (size_t)(b * 256 + t32 * 32) * IN_ODD + 2560 + h * 128, IN_ODD, (bf16_t*)(F.ws + WS_VG_CTX) + (size_t)bh * (256 * 128) + (size_t)t32 * 4096, lane);
            } else { r -= NVT_CTX; const int t32 = r & 31, bh = r >> 5, b = bh >> 2, h = bh & 3;
                vt_tile_write_h(P + (size_t)(NCTX + b * 1024 + t32 * 32) * IN_ODD + 2560 + h * 128, IN_ODD, (bf16_t*)(F.ws + WS_VG_LAT) + (size_t)bh * (1024 * 128) + (size_t)t32 * 4096, lane);
            }
        }
    }
}

struct WgUnit {
    const bf16_t* kc; const bf16_t* vc; int nctx;
    const bf16_t* kl; const bf16_t* vl; int t_lo, t_hi;
};
struct WvUnit {
    const bf16_t* qb; unsigned qoff; int qpitch; bf16_t* ob; unsigned ooff;
    int qpos;
    int qcol0;
    int w_lo, w_hi;
    float sink; int has_sink; float scale;
};
constexpr int ATT_RPB_OFF = RING_BYTES + 512;
constexpr float ATT_THR = 8.0f;
template <int MODE>
__device__ __forceinline__ float attn_mask(float v, int tile32, int r, int hh, int ql, bool masked, const WvUnit& U, const LAS float* rpb) {
    const int kk = (r & 3) + 8 * (r >> 2) + 4 * hh;
    if (MODE == 1) { const int df = U.qpos + ql - (tile32 * 32 + kk); if (masked && (df > 128 || df < -128)) v = -1e30f; }
    if (MODE == 2 && masked) { const int krow = tile32 >> 1, kcol = (tile32 & 1) * 32 + kk, qc = U.qcol0 + ql;
        int ws = qc - 8; ws = ws < 0 ? 0 : (ws > 48 ? 48 : ws);
        const bool valid = (kcol >= ws) && (kcol < ws + 16);
        int co = kcol - qc; co = co < -15 ? -15 : (co > 15 ? 15 : co);
        const float bias = rpb[(krow - U.qpos + 7) * 31 + co + 15];
        v = valid ? v + bias * LOG2E : -1e30f; }
    return v;
}
template <int OFF> __device__ __forceinline__ bf16x8 lds_rd(unsigned addr) { bf16x8 r; asm volatile("ds_read_b128 %0, %1 offset:%2" : "=v"(r) : "v"(addr), "i"(OFF)); return r; }
template <int BASE, int H1> __device__ __forceinline__ void lds_rd8(unsigned addr, bf16x8 (&a)[8]) {
    a[0] = lds_rd<BASE>(addr); a[1] = lds_rd<BASE + 1024>(addr); a[2] = lds_rd<BASE + 2048>(addr); a[3] = lds_rd<BASE + 3072>(addr);
    a[4] = lds_rd<BASE + H1>(addr); a[5] = lds_rd<BASE + H1 + 1024>(addr); a[6] = lds_rd<BASE + H1 + 2048>(addr); a[7] = lds_rd<BASE + H1 + 3072>(addr);
}
#define LDS_WAIT8(n, a) asm volatile("s_waitcnt lgkmcnt(" #n ")" : "+v"(a[0]), "+v"(a[1]), "+v"(a[2]), "+v"(a[3]), "+v"(a[4]), "+v"(a[5]), "+v"(a[6]), "+v"(a[7]))
#define QK_MMA8(a, kb) do { _Pragma("unroll") for (int _j = 0; _j < 4; ++_j) { s0 = __builtin_amdgcn_mfma_f32_32x32x16_bf16(a[_j], qf[(kb) * 4 + _j], s0, 0, 0, 0); s1 = __builtin_amdgcn_mfma_f32_32x32x16_bf16(a[4 + _j], qf[(kb) * 4 + _j], s1, 0, 0, 0); } } while (0)
__device__ __forceinline__ void na_mask16(f32x16& sx, int tile32, int hh, int ql, bool masked, const WvUnit& U, const LAS float* rpb) {
    const int krow = tile32 >> 1, kc0 = (tile32 & 1) * 32 + 4 * hh, qc = U.qcol0 + ql;
    int ws = qc - 8; ws = ws < 0 ? 0 : (ws > 48 ? 48 : ws);
    int ro = krow - U.qpos + 7; ro = ro < 0 ? 0 : (ro > 14 ? 14 : ro);
    const LAS float* rrow = rpb + ro * 31 + 15;
    float bias[16];
#pragma unroll
    for (int r = 0; r < 16; ++r) { int co = kc0 + (r & 3) + 8 * (r >> 2) - qc; co = co < -15 ? -15 : (co > 15 ? 15 : co); bias[r] = rrow[co]; }
#pragma unroll
    for (int r = 0; r < 16; ++r) { const int kcol = kc0 + (r & 3) + 8 * (r >> 2); const float mv = ((unsigned)(kcol - ws) < 16u) ? sx[r] + bias[r] * LOG2E : -1e30f; sx[r] = masked ? mv : sx[r]; }
}
template <int DQK, int MODE>
__device__ __forceinline__ void attn_tile64(const LAS unsigned char* sl, int t64, bool masked, const bf16x8 (&qf)[DQK / 16], f32x16 (&o)[4], float& m, float& l, const WvUnit& U, const LAS float* rpb, int lane, float sl2) {
    constexpr int NKS = DQK / 16, KB = DQK * 128;
    const int ql = lane & 31, hh = lane >> 5;
    const unsigned addr = (unsigned)(unsigned long)sl + (unsigned)lane * 16u;
    f32x16 s0, s1;
#pragma unroll
    for (int r = 0; r < 16; ++r) { s0[r] = 0.f; s1[r] = 0.f; }
    bf16x8 pb[4];
#define ATT_SMA(sx, T32) do { float mt = -1e30f; \
    if (MODE == 1) { if (masked) {   \
            _Pragma("unroll") for (int r = 0; r < 16; ++r) sx[r] = attn_mask<MODE>(sx[r] * sl2, (T32), r, hh, ql, true, U, rpb); } } \
    if (MODE == 2) { _Pragma("unroll") for (int r = 0; r < 16; ++r) sx[r] *= sl2; na_mask16(sx, (T32), hh, ql, masked, U, rpb); } \
    _Pragma("unroll") for (int r = 0; r < 16; ++r) mt = fmaxf(mt, sx[r]); \
    if (MODE == 0 || (MODE == 1 && !masked)) mt *= sl2;     \
    mt = fmaxf(mt, __shfl_xor(mt, 32)); \
    if (!__all(mt - m <= ATT_THR)) { const float mn = fmaxf(m, mt), alpha = fast_exp2(m - mn); m = mn; l *= alpha; \
        _Pragma("unroll") for (int db = 0; db < 4; ++db) _Pragma("unroll") for (int r = 0; r < 16; ++r) o[db][r] *= alpha; } } while (0)
#define ATT_SMB(sx, PBI) do { float ps = 0.f; const float esc = (MODE == 0 || (MODE == 1 && !masked)) ? sl2 : 1.0f; \
    _Pragma("unroll") for (int r = 0; r < 16; ++r) { sx[r] = fast_exp2(fmaf(sx[r], esc, -m)); ps += sx[r]; } \
    l += ps; \
    _Pragma("unroll") for (int s2 = 0; s2 < 2; ++s2) { \
        u32x4 w; w.x = pk2(sx[8 * s2 + 0], sx[8 * s2 + 1]); w.y = pk2(sx[8 * s2 + 2], sx[8 * s2 + 3]); w.z = pk2(sx[8 * s2 + 4], sx[8 * s2 + 5]); w.w = pk2(sx[8 * s2 + 6], sx[8 * s2 + 7]); pb[(PBI) + s2] = __builtin_bit_cast(bf16x8, w); } } while (0)
#define MFMA32(a_, b_, c_) __builtin_amdgcn_mfma_f32_32x32x16_bf16(a_, b_, c_, 0, 0, 0)
    if constexpr (NKS == 8) {
        bf16x8 ka[8], kb_[8];
        lds_rd8<0, 4096>(addr, ka); lds_rd8<KB / 2, 4096>(addr, kb_);
        LDS_WAIT8(8, ka);
#pragma unroll
        for (int j = 0; j < 8; ++j) s0 = MFMA32(ka[j], qf[j], s0);
        if (MODE != 2) { lds_rd8<KB, 4096>(addr, ka); LDS_WAIT8(8, kb_); } else LDS_WAIT8(0, kb_);
#pragma unroll
        for (int j = 0; j < 4; ++j) s1 = MFMA32(kb_[j], qf[j], s1);
        ATT_SMA(s0, 2 * t64);
        if (MODE == 2) lds_rd8<KB, 4096>(addr, ka);
#pragma unroll
        for (int j = 4; j < 8; ++j) s1 = MFMA32(kb_[j], qf[j], s1);
        ATT_SMB(s0, 0);
        lds_rd8<KB + 8192, 4096>(addr, kb_);
        LDS_WAIT8(8, ka);
#pragma unroll
        for (int db = 0; db < 4; ++db) o[db] = MFMA32(ka[db], pb[0], o[db]);
        ATT_SMA(s1, 2 * t64 + 1);
#pragma unroll
        for (int db = 0; db < 4; ++db) o[db] = MFMA32(ka[4 + db], pb[1], o[db]);
        ATT_SMB(s1, 2);
        LDS_WAIT8(0, kb_);
#pragma unroll
        for (int s2 = 0; s2 < 2; ++s2)
#pragma unroll
            for (int db = 0; db < 4; ++db) o[db] = MFMA32(kb_[s2 * 4 + db], pb[2 + s2], o[db]);
    } else {
        bf16x8 ka[4], kb_[4];
#define RDK4(a, h, b) do { a[0] = lds_rd<(h) * (KB / 2) + (b) * 4096>(addr); a[1] = lds_rd<(h) * (KB / 2) + (b) * 4096 + 1024>(addr); a[2] = lds_rd<(h) * (KB / 2) + (b) * 4096 + 2048>(addr); a[3] = lds_rd<(h) * (KB / 2) + (b) * 4096 + 3072>(addr); } while (0)
#define RDV4(a, q) do { a[0] = lds_rd<KB + (q) * 4096>(addr); a[1] = lds_rd<KB + (q) * 4096 + 1024>(addr); a[2] = lds_rd<KB + (q) * 4096 + 2048>(addr); a[3] = lds_rd<KB + (q) * 4096 + 3072>(addr); } while (0)
#define WAIT4(n, a) asm volatile("s_waitcnt lgkmcnt(" #n ")" : "+v"(a[0]), "+v"(a[1]), "+v"(a[2]), "+v"(a[3]))
#define QK4(a, sx, b) do { _Pragma("unroll") for (int j = 0; j < 4; ++j) sx = MFMA32(a[j], qf[4 * (b) + j], sx); } while (0)
#define PV4(a, q) do { _Pragma("unroll") for (int db = 0; db < 4; ++db) o[db] = MFMA32(a[db], pb[q], o[db]); } while (0)
        RDK4(ka, 0, 0); RDK4(kb_, 0, 1);
        WAIT4(4, ka); QK4(ka, s0, 0); RDK4(ka, 0, 2);
        WAIT4(4, kb_); QK4(kb_, s0, 1); RDK4(kb_, 1, 0);
        WAIT4(4, ka); QK4(ka, s0, 2); RDK4(ka, 1, 1);
        WAIT4(4, kb_); QK4(kb_, s1, 0); RDK4(kb_, 1, 2);
        ATT_SMA(s0, 2 * t64);
        WAIT4(4, ka); QK4(ka, s1, 1); RDV4(ka, 0);
        ATT_SMB(s0, 0);
        WAIT4(4, kb_); QK4(kb_, s1, 2); RDV4(kb_, 1);
        WAIT4(4, ka); PV4(ka, 0); RDV4(ka, 2);
        ATT_SMA(s1, 2 * t64 + 1);
        WAIT4(4, kb_); PV4(kb_, 1); RDV4(kb_, 3);
        ATT_SMB(s1, 2);
        WAIT4(4, ka); PV4(ka, 2);
        WAIT4(0, kb_); PV4(kb_, 3);
#undef RDK4
#undef RDV4
#undef WAIT4
#undef QK4
#undef PV4
    }
#undef ATT_SMA
#undef ATT_SMB
#undef MFMA32
}
template <int DQK, int MODE, int VAR = 0>
__device__ __forceinline__ void attn_wg_unit(LAS unsigned char* ring, const WgUnit& G, const WvUnit& U, const float* rpb_g, int tid, int wave, int lane) {
    constexpr int NKS = DQK / 16, KB = DQK * 128, NLK = KB / 8192;
    constexpr int NS = (DQK == 128) ? 4 : 3, SLOTB = KB + 16384;
    const int ql = lane & 31, hh = lane >> 5;
    const int ntiles = G.nctx + (G.t_hi - G.t_lo);
    const LAS float* rpb = (const LAS float*)(ring + ATT_RPB_OFF);
#define ATT_ISSUE(i, SLOTC) do { const int _i = (i); const bool _c = _i < G.nctx; const int _t = _c ? _i : G.t_lo + (_i - G.nctx); \
        const char* _kg = (const char*)(_c ? G.kc : G.kl) + (size_t)_t * KB + tid * 16; const char* _vg = (const char*)(_c ? G.vc : G.vl) + (size_t)_t * 16384 + tid * 16; \
        LAS unsigned char* _sl = ring + (SLOTC) * SLOTB + wave * 1024; \
        _Pragma("unroll") for (int _p = 0; _p < NLK; ++_p) __builtin_amdgcn_global_load_lds((const unsigned*)(_kg + _p * 8192), (LAS unsigned*)(_sl + _p * 8192), 16, 0, 0); \
        _Pragma("unroll") for (int _p = 0; _p < 2; ++_p) __builtin_amdgcn_global_load_lds((const unsigned*)(_vg + _p * 8192), (LAS unsigned*)(_sl + KB + _p * 8192), 16, 0, 0); } while (0)
    asm volatile("s_waitcnt lgkmcnt(0)" ::: "memory"); __builtin_amdgcn_s_barrier(); asm volatile("" ::: "memory");
    bf16x8 qf[NKS];
#pragma unroll
    for (int ks = 0; ks < NKS; ++ks) qf[ks] = *(const bf16x8*)(U.qb + (size_t)(U.qoff + (unsigned)(ql * U.qpitch + 16 * ks + 8 * hh)));
    if (MODE == 2) { const int i = opaque_v(tid); if (i < 15 * 31) ((LAS float*)(ring + ATT_RPB_OFF))[i] = rpb_g[i]; }
    if (VAR != 2) { ATT_ISSUE(0, 0); if (ntiles > 1) ATT_ISSUE(1, 1); if (NS == 4 && ntiles > 2) ATT_ISSUE(2, 2); }
    f32x16 o[4];
#pragma unroll
    for (int db = 0; db < 4; ++db)
#pragma unroll
        for (int r = 0; r < 16; ++r) o[db][r] = 0.f;
    float m = -1e30f, l = 0.f;
    const float sl2 = U.scale * LOG2E;
#define ATT_STEP(i_, SLOTC) do { const int i = (i_); if (i < ntiles) { \
        if (NS == 4) { if (i + 2 < ntiles) asm volatile("s_waitcnt vmcnt(8)" ::: "memory"); else if (i + 1 < ntiles) asm volatile("s_waitcnt vmcnt(4)" ::: "memory"); else asm volatile("s_waitcnt vmcnt(0)" ::: "memory"); } \
        else { if (i + 1 < ntiles) asm volatile("s_waitcnt vmcnt(5)" ::: "memory"); else asm volatile("s_waitcnt vmcnt(0)" ::: "memory"); } \
        asm volatile("s_waitcnt lgkmcnt(0)" ::: "memory"); __builtin_amdgcn_s_barrier(); asm volatile("" ::: "memory"); \
        if (VAR != 2 && i + NS - 1 < ntiles) ATT_ISSUE(i + NS - 1, ((SLOTC) + NS - 1) % NS); \
        const bool isctx = i < G.nctx; const int t64 = isctx ? 0 : G.t_lo + (i - G.nctx); \
        if (VAR != 1 && (isctx || (t64 >= U.w_lo && t64 < U.w_hi))) attn_tile64<DQK, MODE>(ring + (SLOTC) * SLOTB, t64, !isctx, qf, o, m, l, U, rpb, lane, sl2); } } while (0)
    if constexpr (NS == 4) { for (int i0 = 0; i0 < ntiles; i0 += 4) { ATT_STEP(i0, 0); ATT_STEP(i0 + 1, 1); ATT_STEP(i0 + 2, 2); ATT_STEP(i0 + 3, 3); } }
    else { for (int i0 = 0; i0 < ntiles; i0 += 3) { ATT_STEP(i0, 0); ATT_STEP(i0 + 1, 1); ATT_STEP(i0 + 2, 2); } }
#undef ATT_STEP
#undef ATT_ISSUE
    l += __shfl_xor(l, 32);
    if (U.has_sink) l += fast_exp2(U.sink * LOG2E - m);
    const float inv = 1.0f / l;
    bf16_t* op = U.ob + (size_t)(U.ooff + (unsigned)(opaque_v(ql) * DM));
#pragma unroll
    for (int db = 0; db < 4; ++db)
#pragma unroll
        for (int k = 0; k < 2; ++k) {
            const unsigned p0x = pk2(o[db][8 * k] * inv, o[db][8 * k + 1] * inv), p0y = pk2(o[db][8 * k + 2] * inv, o[db][8 * k + 3] * inv);
            const unsigned p1x = pk2(o[db][8 * k + 4] * inv, o[db][8 * k + 5] * inv), p1y = pk2(o[db][8 * k + 6] * inv, o[db][8 * k + 7] * inv);
            const auto sx = __builtin_amdgcn_permlane32_swap(p0x, p1x, false, false);
            const auto sy = __builtin_amdgcn_permlane32_swap(p0y, p1y, false, false);
            u32x4 w; w.x = sx[0]; w.y = sy[0]; w.z = sx[1]; w.w = sy[1];
            *(u32x4*)(op + 32 * db + 16 * k + 8 * hh) = w; }
}

template <int VAR>
__device__ __forceinline__ void phase_attn_even(Frame& F, bf16_t* O) {
 const bf16_t* QA = (const bf16_t*)(F.ws + WS_QA); const bf16_t* QNA = (const bf16_t*)(F.ws + WS_QNA);
    const int wave = F.wave, lane = F.lane, tid = F.tid;
    WgUnit G; WvUnit U; U.sink = 0.f; U.has_sink = 0; U.qpos = 0; U.qcol0 = 0;
    const int vcu = (F.G % 8 == 0) ? ((int)blockIdx.x % 8) * (F.G / 8) + (int)blockIdx.x / 8 : (int)blockIdx.x;
    for (int u = vcu; u < 256; u += F.G) { const int bh = u >> 2, q4 = u & 3, b = bh >> 3, h = bh & 7, t0 = NCTX + b * 1024 + q4 * 256 + 32 * wave;
        U.qb = QA; U.qoff = (unsigned)(t0 * 1536 + h * 192); U.qpitch = 1536; U.scale = 0.07216878364870322f; U.ob = O; U.ooff = (unsigned)(t0 * DM + h * 128);
        G.kc = (const bf16_t*)(F.ws + WS_KM_CAC) + (size_t)bh * (512 * 192); G.vc = (const bf16_t*)(F.ws + WS_VM_CAC) + (size_t)bh * (512 * 128); G.nctx = 8;
        G.kl = (const bf16_t*)(F.ws + WS_KM_LAT) + (size_t)bh * (1024 * 192); G.vl = (const bf16_t*)(F.ws + WS_VM_LAT) + (size_t)bh * (1024 * 128); G.t_lo = 0; G.t_hi = 16; U.w_lo = 0; U.w_hi = 16;
        attn_wg_unit<192, 0, VAR>(F.lds, G, U, nullptr, tid, wave, lane); }
    for (int u = vcu; u < 256; u += F.G) { const int bh = u >> 2, r0 = (u & 3) * 4, b = bh >> 3, h = bh & 7, r = r0 + (wave >> 1), c0 = (wave & 1) * 32, t0 = NCTX + b * 1024 + r * 64 + c0;
        int rs = r - 4; rs = rs < 0 ? 0 : (rs > 8 ? 8 : rs);
        int glo = r0 - 4; glo = glo < 0 ? 0 : (glo > 8 ? 8 : glo); int ghi = r0 - 1; ghi = ghi < 0 ? 0 : (ghi > 8 ? 8 : ghi);
        U.qb = QNA; U.qoff = (unsigned)(t0 * 1024 + h * 128); U.qpitch = 1024; U.scale = 0.08838834764831845f; U.ob = O; U.ooff = (unsigned)(t0 * DM + 1024 + h * 128);
        G.kc = (const bf16_t*)(F.ws + WS_KN_CAC) + (size_t)bh * (512 * 128); G.vc = (const bf16_t*)(F.ws + WS_VN_CAC) + (size_t)bh * (512 * 128); G.nctx = 8;
        G.kl = (const bf16_t*)(F.ws + WS_KN_LAT) + (size_t)bh * (1024 * 128); G.vl = (const bf16_t*)(F.ws + WS_VN_LAT) + (size_t)bh * (1024 * 128); G.t_lo = glo; G.t_hi = ghi + 8; U.w_lo = rs; U.w_hi = rs + 8;
        U.qpos = r; U.qcol0 = c0;
        attn_wg_unit<128, 2, VAR>(F.lds, G, U, F.a->in[IN_RPB] + h * (15 * 31), tid, wave, lane); }
    U.qpos = 0; U.qcol0 = 0; U.w_lo = 0; U.w_hi = 4; G.nctx = 0; G.kc = nullptr; G.vc = nullptr; G.t_lo = 0; G.t_hi = 4;
    for (int u = vcu; u < 256; u += F.G) { const int bh = u & 127, b = bh >> 3, h = bh & 7, t0 = b * 256 + 32 * wave;
        if (u < 128) {
            U.qb = QA; U.qoff = (unsigned)(t0 * 1536 + h * 192); U.qpitch = 1536; U.scale = 0.07216878364870322f; U.ob = O; U.ooff = (unsigned)(t0 * DM + h * 128);
            G.kl = (const bf16_t*)(F.ws + WS_KM_CTX) + (size_t)bh * (256 * 192); G.vl = (const bf16_t*)(F.ws + WS_VM_CTX) + (size_t)bh * (256 * 128);
            attn_wg_unit<192, 0, VAR>(F.lds, G, U, nullptr, tid, wave, lane);
        } else {
            U.qb = QNA; U.qoff = (unsigned)(t0 * 1024 + h * 128); U.qpitch = 1024; U.scale = 0.08838834764831845f; U.ob = O; U.ooff = (unsigned)(t0 * DM + 1024 + h * 128);
            G.kl = (const bf16_t*)(F.ws + WS_KN_CTX) + (size_t)bh * (256 * 128); G.vl = (const bf16_t*)(F.ws + WS_VN_CTX) + (size_t)bh * (256 * 128);
            attn_wg_unit<128, 0, VAR>(F.lds, G, U, nullptr, tid, wave, lane);
        } }
    asm volatile("s_waitcnt vmcnt(0) lgkmcnt(0)" ::: "memory"); __syncthreads();
}
__device__ __forceinline__ void phase_attn_odd(Frame& F) {
    bf16_t* O = (bf16_t*)(F.ws + WS_O); const bf16_t* QA = (const bf16_t*)(F.ws + WS_QA);
    const int wave = F.wave, lane = F.lane, tid = F.tid;
    WgUnit G; WvUnit U; U.has_sink = 1; U.qcol0 = 0; U.qpitch = 2048; U.scale = 0.08838834764831845f;
    const int vcu = (F.G % 8 == 0) ? ((int)blockIdx.x % 8) * (F.G / 8) + (int)blockIdx.x / 8 : (int)blockIdx.x;
    const float* sink = F.a->in[IN_SINK];
    for (int u = vcu; u < 512; u += F.G) { const int bk = u >> 4, q64 = u & 15, b = bk >> 2, kvh = bk & 3, g = wave >> 1, hq = kvh * 4 + g, qs = q64 * 64 + (wave & 1) * 32, t0 = NCTX + b * 1024 + qs;
        U.qb = QA; U.qoff = (unsigned)(t0 * 2048 + hq * 128); U.ob = O; U.ooff = (unsigned)(t0 * DM + hq * 128); U.qpos = qs; U.sink = sink[hq];
        G.kc = (const bf16_t*)(F.ws + WS_KG_CAC) + (size_t)bk * (512 * 128); G.vc = (const bf16_t*)(F.ws + WS_VG_CAC) + (size_t)bk * (512 * 128); G.nctx = 8;
        G.kl = (const bf16_t*)(F.ws + WS_KG_LAT) + (size_t)bk * (1024 * 128); G.vl = (const bf16_t*)(F.ws + WS_VG_LAT) + (size_t)bk * (1024 * 128);
        G.t_lo = q64 - 2 < 0 ? 0 : q64 - 2; G.t_hi = (q64 + 2 > 15 ? 15 : q64 + 2) + 1; U.w_lo = G.t_lo; U.w_hi = G.t_hi;
        attn_wg_unit<128, 1>(F.lds, G, U, nullptr, tid, wave, lane); }
    G.nctx = 0; G.kc = nullptr; G.vc = nullptr; G.t_lo = 0; G.t_hi = 4; U.w_lo = 0; U.w_hi = 4;
    for (int u = vcu; u < 256; u += F.G) { const int bk = u >> 2, q64 = u & 3, b = bk >> 2, kvh = bk & 3, g = wave >> 1, hq = kvh * 4 + g, qs = q64 * 64 + (wave & 1) * 32, t0 = b * 256 + qs;
        U.qb = QA; U.qoff = (unsigned)(t0 * 2048 + hq * 128); U.ob = O; U.ooff = (unsigned)(t0 * DM + hq * 128); U.qpos = 0; U.sink = sink[hq];
        G.kl = (const bf16_t*)(F.ws + WS_KG_CTX) + (size_t)bk * (256 * 128); G.vl = (const bf16_t*)(F.ws + WS_VG_CTX) + (size_t)bk * (256 * 128);
        attn_wg_unit<128, 0>(F.lds, G, U, nullptr, tid, wave, lane); }
    asm volatile("s_waitcnt vmcnt(0) lgkmcnt(0)" ::: "memory"); __syncthreads();
}

constexpr int N_PHASES = 36;
__global__ void __launch_bounds__(512, 2) fwd_kernel(Args args) {
    extern __shared__ __attribute__((aligned(16))) unsigned char lds_raw[];
    Frame F;
    F.lds = (LAS unsigned char*)lds_raw;
    F.tid = threadIdx.x; F.lane = F.tid & 63; F.wave = __builtin_amdgcn_readfirstlane(F.tid >> 6);
    F.G = gridDim.x; F.gw = blockIdx.x * 8 + F.wave; F.NGW = F.G * 8;
    F.a = &args; F.out = args.out; F.ws = args.ws;
    volatile LAS unsigned* MISC = (volatile LAS unsigned*)(F.lds + LDSCTL_OFF);
    for (int u = F.tid; u < (LDS_BYTES - LDSCTL_OFF) / 4; u += 512) ((LAS unsigned*)(F.lds + LDSCTL_OFF))[u] = 0u;
    __syncthreads();
    unsigned* ctl = (unsigned*)(F.ws + WS_CTL);
    const int lo = args.ph_lo, hi = args.ph_hi;
    const bool multi = (hi - lo) > 1;
    XcdBarrier bar; bar.bar = ctl + CW_BAR; bar.x = 0; bar.st = nullptr;
    if (multi) bar = xcd_barrier_post(ctl + CW_BAR, MISC + 8);
#define IN(k) (lo <= (k) && (k) < hi)
    int ph = 0;
#define PHASE(...) do { if (IN(ph)) { __VA_ARGS__ } if (IN(ph) && IN(ph + 1)) xcd_barrier(bar); ++ph; } while (0)
    const float* mods = (const float*)(F.ws + WS_MODS);
    bf16_t* H = (bf16_t*)(F.ws + WS_H); bf16_t* ACT = (bf16_t*)(F.ws + WS_ACT); float* P = (float*)(F.ws + WS_P); bf16_t* OB = (bf16_t*)(F.ws + WS_O);
    LAS unsigned char* ring = F.lds;
    const int cid = (int)blockIdx.x;
#define GEMM2(EPI_T, EDEF, A_, B_, M_, N_, K_, SLAB) \
    PHASE( pg8::Gemm g{(A_), (B_), (M_), (N_), (K_)}; typedef pg8::SplitOrder<(M_), (N_), (K_), true> SO; SO S; S.init(cid); EDEF; pg8::gemm_phase<EPI_T, SO, true, true>(ring, g, S, E, (SLAB)); ); \
    PHASE( typedef pg8::SplitOrder<(M_), (N_), (K_), true> SO; EDEF; pg8::gemm_fixup<EPI_T, SO>(E, (SLAB)); )
#define GEMM1(EPI_T, EDEF, A_, B_, M_, N_, K_) \
    PHASE( pg8::Gemm g{(A_), (B_), (M_), (N_), (K_)}; typedef pg8::SplitOrder<(M_), (N_), (K_), false> SO; SO S; S.init(cid); EDEF; pg8::gemm_phase<EPI_T, SO, true, true>(ring, g, S, E, nullptr); )
#define W_FI(layer, f) ((const bf16_t*)(F.ws + WS_WFI) + (size_t)((layer) * 2 + (f)) * NFF2 * DM)
#define W_FO(layer, f) ((const bf16_t*)(F.ws + WS_WFO) + (size_t)((layer) * 2 + (f)) * DM * DFF)
#define E_SWIGLU EpiSwiGLU E{ACT}
#define E_RESID(RT, layer, gidx, coef) RT E{F.a->in[IN_XP], F.a->in[IN_XS], (bf16_t*)(F.ws + WS_XB), F.out, mods + (size_t)(layer) * 9 * NMOD + (size_t)(gidx) * DM, (coef)}
#define FFN(layer, f, RT) \
    GEMM2(EpiSwiGLU, E_SWIGLU, H, W_FI(layer, f), NTOK, NFF2, DM, P); \
    GEMM2(RT, E_RESID(RT, layer, (f) ? 8 : 2, 0.5f), ACT, W_FO(layer, f), NTOK, DM, DFF, P)

    PHASE( phase_prologue(F); );
    PHASE( phase_norm(F, true, 0, 0); );
    FFN(0, 0, ResidIn);
    PHASE( phase_norm(F, false, 0, 1); );
    GEMM1(EpiBf16, EpiBf16 E{(bf16_t*)P COMMA IN_EVEN_P}, H, (const bf16_t*)(F.ws + WS_WEI), NTOK, IN_EVEN_P, DM);
    PHASE( phase_post1_even(F); );
    PHASE( { pg8::Gemm g{(const bf16_t*)(F.ws + WS_CQN), (const bf16_t*)(F.ws + WS_WQU), NTOK, 1536, 512}; typedef pg8::SplitOrder<NTOK, 1536, 512, false> SO; SO S; S.init(cid);
             EpiBf16 E{(bf16_t*)(F.ws + WS_QM), 1536}; pg8::gemm_phase<EpiBf16, SO, true, true>(ring, g, S, E, nullptr); }
           { pg8::Gemm g{(const bf16_t*)(F.ws + WS_CKVA), (const bf16_t*)(F.ws + WS_WKU), 16384, 2048, 512}; typedef pg8::SplitOrder<16384, 2048, 512, false> SO; SO S; S.init(cid);
             EpiBf16 E{(bf16_t*)(F.ws + WS_ACT), 2048}; pg8::gemm_phase<EpiBf16, SO, true, true>(ring, g, S, E, nullptr); } );
    PHASE( phase_post2_even(F); );
    PHASE( phase_attn_even<0>(F, (bf16_t*)(F.ws + WS_O)); );
    GEMM2(ResidMid, E_RESID(ResidMid, 0, 5, 1.0f), OB, (const bf16_t*)(F.ws + WS_WEO), NTOK, DM, DM, P);
    PHASE( phase_norm(F, false, 0, 2); );
    FFN(0, 1, ResidMid);
    PHASE( phase_norm(F, false, 1, 0); );
    FFN(1, 0, ResidMid);
    PHASE( phase_norm(F, false, 1, 1); );
    GEMM2(EpiBf16, EpiBf16 E{(bf16_t*)P COMMA IN_ODD}, H, (const bf16_t*)(F.ws + WS_WOI), NTOK, IN_ODD, DM, (float*)(F.ws + WS_ACT));
    PHASE( phase_post_odd(F); );
    PHASE( phase_attn_odd(F); );
    GEMM2(ResidMid, E_RESID(ResidMid, 1, 5, 1.0f), OB, (const bf16_t*)(F.ws + WS_WOO), NTOK, DM, DM, P);
    PHASE( phase_norm(F, false, 1, 2); );
    FFN(1, 1, ResidOut);
#undef IN
}

extern "C" void kernel_launch(void* const* d_in, const int* in_sizes, int n_in, void* d_out, int out_size, void* d_ws, size_t ws_size, hipStream_t stream) {
    static int grid = 0;
    if (grid == 0) {
        if (n_in != 28 || (size_t)out_size != O_END || ws_size < WS_END) { fprintf(stderr, "kernel_launch: unexpected shapes (n_in %d, out %d, ws %zu; need ws >= %zu); nothing launched\n", n_in, out_size, ws_size, (size_t)WS_END); grid = -1; return; }
        int dev = 0, cus = 0, per_cu = 0;
        if (hipGetDevice(&dev) != hipSuccess || hipDeviceGetAttribute(&cus, hipDeviceAttributeMultiprocessorCount, dev) != hipSuccess) { grid = -1; return; }
        if (hipFuncSetAttribute((const void*)fwd_kernel, hipFuncAttributeMaxDynamicSharedMemorySize, LDS_BYTES) != hipSuccess) { fprintf(stderr, "kernel_launch: hipFuncSetAttribute failed\n"); grid = -1; return; }
        if (hipOccupancyMaxActiveBlocksPerMultiprocessor(&per_cu, (const void*)fwd_kernel, 512, LDS_BYTES) != hipSuccess || per_cu < 1) { fprintf(stderr, "kernel_launch: occupancy query says %d blocks per CU\n", per_cu); }
        (void)hipGetLastError();
        if (cus < pg8::GRID) { fprintf(stderr, "kernel_launch: %d CUs < %d workgroups: not resident; nothing launched\n", cus, pg8::GRID); grid = -1; return; }
        grid = pg8::GRID;
    }
    if (grid < 0) return;
    if (hipMemsetAsync((char*)d_ws + WS_CTL, 0, CTL_ZERO_BYTES, stream) != hipSuccess) return;
    Args a{};
    for (int i = 0; i < 28; ++i) a.in[i] = (const float*)d_in[i];
    a.out = (float*)d_out; a.ws = (unsigned char*)d_ws;
#if MK_ONE_LAUNCH
    a.ph_lo = 0; a.ph_hi = N_PHASES;
    hipLaunchKernelGGL(fwd_kernel, dim3(grid), dim3(512), LDS_BYTES, stream, a);
#else
    for (int p = 0; p < N_PHASES; ++p) { a.ph_lo = p; a.ph_hi = p + 1; hipLaunchKernelGGL(fwd_kernel, dim3(grid), dim3(512), LDS_BYTES, stream, a); }
#endif
}
```

```cpp
#include <hip/hip_runtime.h>
#include <cstdio>
#include <cstdint>

#ifndef MK_ONE_LAUNCH
#define MK_ONE_LAUNCH 1
#endif

#define COMMA ,
#define GAS __attribute__((address_space(1)))
#define LAS __attribute__((address_space(3)))
typedef unsigned short bf16_t;
typedef short bf16x8 __attribute__((ext_vector_type(8)));
typedef float f32x4 __attribute__((ext_vector_type(4)));
typedef float f32x16 __attribute__((ext_vector_type(16)));
typedef unsigned u32x4 __attribute__((ext_vector_type(4)));
typedef unsigned u32x2 __attribute__((ext_vector_type(2)));

namespace pg8 {
constexpr int BM = 256, BK = 64, HALF = 128, HTB = HALF * BK * 2, STAGE_BYTES = 8 * HTB, NXCD = 8, WGM = 8;
__host__ __device__ __forceinline__ int lds_byte(int r, int c) { const int st = (r >> 4) * 2 + (c >> 5), rr = r & 15, cc = c & 31, ob = rr * 64 + cc * 2; return st * 1024 + (ob ^ (((ob >> 9) & 1) << 5)); }
__host__ __device__ __forceinline__ void stage_rc(int b, int& R, int& C) { const int st = b / 1024, sb = b % 1024, swz = sb ^ (((sb >> 9) & 1) << 5); R = (st >> 1) * 16 + swz / 64; C = (st & 1) * 32 + (swz % 64) / 2; }
__host__ __device__ __forceinline__ int perm32(int rho) { const int n = rho >> 4, i = rho & 15; return 8 * (i >> 2) + 4 * n + (i & 3); }
struct Unit { int pm, pn, kt0, nkt, part; };
struct Gemm { const bf16_t* A; const bf16_t* Bt; int M, N, K; };
constexpr int GRID = 256;
template <int M, int N, int K, bool SPLIT>
struct SplitOrder {
    static constexpr int nM = M / BM, nN = N / BM, nwg = nM * nN, G = GRID, nt = K / BK, nfull = (nwg / G) * G, rem = nwg - nfull, NR = nfull / G;
    static constexpr int S0 = (SPLIT && rem > 0 && G % rem == 0) ? G / rem : 1;
    static constexpr int S = ((S0 == 2 || S0 == 4) && nt % (2 * S0) == 0) ? S0 : 1;
    int c;
    __host__ __device__ void init(int c_) { c = c_; }
    __host__ __device__ static Unit unit_of(int L, int kt0, int nkt, int part) {
        int wgid = L; { constexpr int q = nwg / NXCD, r = nwg % NXCD; const int xcd = wgid % NXCD, off = wgid / NXCD; wgid = (xcd < r ? xcd * (q + 1) : r * (q + 1) + (xcd - r) * q) + off; }
        constexpr int nig = WGM * nN; const int gid = wgid / nig, fm = gid * WGM, gsz = (nM - fm) < WGM ? (nM - fm) : WGM;
        Unit u; u.pm = fm + ((wgid % nig) % gsz); u.pn = (wgid % nig) / gsz; u.kt0 = kt0; u.nkt = nkt; u.part = part; return u;
    }
    __host__ __device__ bool next(int i, Unit& u) const {
        int j = i;
        if (S > 1 && NR > 0 && (c & 4)) j = (i == 0) ? NR : i - 1;
        int L = j * G + c, kt0 = 0, nkt = nt, part = -1; bool ok = (S > 1) ? (i <= NR) : (L < nwg);
        if (S > 1 && j >= NR) { constexpr int R1 = rem > 0 ? rem : 1; L = nfull + (c % R1); nkt = nt / S; kt0 = (c / R1) * (nt / S); part = c; }
        if (!ok) return false;
        u = unit_of(L, kt0, nkt, part); return true;
    }
};
typedef float f32x2_t __attribute__((ext_vector_type(2)));
typedef __bf16 bf16x2_t __attribute__((ext_vector_type(2)));
__device__ __forceinline__ unsigned cvt_pk_bf16(float lo, float hi) { const f32x2_t v = {lo, hi}; return __builtin_bit_cast(unsigned, __builtin_convertvector(v, bf16x2_t)); }

template <class Epi, class Sched, bool ALIGN_EPI = false, bool SP2 = false>
__device__ __forceinline__ void gemm_phase(LAS unsigned char* lds, const Gemm g, const Sched& S, const Epi& E, float* slab) {
    const int tid = threadIdx.x, wid = __builtin_amdgcn_readfirstlane(tid >> 6), lane = tid & 63, wr = wid >> 2, wc = wid & 3, fr = lane & 15, fq = lane >> 4;
    const int K = g.K;
    unsigned voffA[2], voffB[2];
#pragma unroll
    for (int i = 0; i < 2; ++i) { int R, C; stage_rc(tid * 16 + i * 8192, R, C); const int Rb = Epi::PERM ? ((R & ~31) + perm32(R & 31)) : R;
        voffA[i] = (unsigned)(R * K + C) * 2u; voffB[i] = (unsigned)(Rb * K + C) * 2u; }
    const size_t kstep = (size_t)(BK * 2);
    const size_t hstep = (size_t)HALF * K * 2;
    const size_t tstep = 2 * hstep;
    const unsigned ldsw = (unsigned)wid * 1024u;
    const int aoff = lds_byte(wr * 64 + fr, fq * 8), boff = lds_byte(wc * 32 + fr, fq * 8);
#define PG8_SA(b, h) (((b) * 2 + (h)) * HTB)
#define PG8_SB(b, h) ((4 + (b) * 2 + (h)) * HTB)
#define PG8_STAGE(bufoff, gbase, voff) do { _Pragma("unroll") for (int _i = 0; _i < 2; ++_i) \
        __builtin_amdgcn_global_load_lds((const unsigned*)((const char*)(gbase) + (voff)[_i]), (LAS unsigned*)(lds + (bufoff) + ldsw + _i * 8192), 16, 0, 0); } while (0)
#define PG8_LDA(dst, b, h) do { _Pragma("unroll") for (int m = 0; m < 4; ++m) _Pragma("unroll") for (int k = 0; k < 2; ++k) dst[m][k] = *(const LAS bf16x8*)(lds + PG8_SA(b, h) + aoff + m * 2048 + k * 1024); } while (0)
#define PG8_LDB(dst, b, h) do { _Pragma("unroll") for (int n = 0; n < 2; ++n) _Pragma("unroll") for (int k = 0; k < 2; ++k) dst[n][k] = *(const LAS bf16x8*)(lds + PG8_SB(b, h) + boff + n * 2048 + k * 1024); } while (0)
#define PG8_MMA(ai, bj, At, Bt) do { __builtin_amdgcn_s_setprio(1); _Pragma("unroll") for (int m = 0; m < 4; ++m) _Pragma("unroll") for (int n = 0; n < 2; ++n) _Pragma("unroll") for (int k = 0; k < 2; ++k) \
        acc[ai][bj][m][n] = __builtin_amdgcn_mfma_f32_16x16x32_bf16(Bt[n][k], At[m][k], acc[ai][bj][m][n], 0, 0, 0); __builtin_amdgcn_s_setprio(0); } while (0)
#define PG8_WAIT_V(n) asm volatile("s_waitcnt vmcnt(" #n ")" ::: "memory")
#define PG8_WAIT_L(n) asm volatile("s_waitcnt lgkmcnt(" #n ")" ::: "memory")
#define PG8_BAR __builtin_amdgcn_s_barrier()
#define PG8_SCHED __builtin_amdgcn_sched_barrier(0)
    Unit cur, nxt; int ui = 0;
    if (!S.next(0, cur)) return;
    f32x4 acc[2][2][4][2];
#pragma unroll
    for (int a = 0; a < 2; ++a)
#pragma unroll
        for (int b = 0; b < 2; ++b)
#pragma unroll
            for (int m = 0; m < 4; ++m)
#pragma unroll
                for (int n = 0; n < 2; ++n) acc[a][b][m][n] = (f32x4){0.f, 0.f, 0.f, 0.f};
    bf16x8 At[4][2], B0[2][2], B1[2][2];
    const char* cA = (const char*)g.A + (size_t)cur.pm * tstep + (size_t)cur.kt0 * kstep; const char* cB = (const char*)g.Bt + (size_t)cur.pn * tstep + (size_t)cur.kt0 * kstep;
    if constexpr (SP2) {
        PG8_STAGE(PG8_SB(0, 0), cB, voffB); PG8_STAGE(PG8_SB(0, 1), cB + hstep, voffB); PG8_STAGE(PG8_SA(0, 0), cA, voffA); PG8_STAGE(PG8_SA(0, 1), cA + hstep, voffA);
        if (wr == 1) PG8_BAR;
        PG8_WAIT_V(2); PG8_BAR;
        PG8_STAGE(PG8_SB(1, 0), cB + kstep, voffB); PG8_STAGE(PG8_SA(1, 0), cA + kstep, voffA); PG8_STAGE(PG8_SB(1, 1), cB + hstep + kstep, voffB);
        PG8_WAIT_V(6); PG8_BAR;
    } else {
        PG8_STAGE(PG8_SB(0, 0), cB, voffB); PG8_STAGE(PG8_SA(0, 0), cA, voffA); PG8_STAGE(PG8_SB(0, 1), cB + hstep, voffB); PG8_STAGE(PG8_SA(0, 1), cA + hstep, voffA);
        if (wr == 1) PG8_BAR;
        PG8_WAIT_V(4); PG8_BAR;
        PG8_STAGE(PG8_SB(1, 0), cB + kstep, voffB); PG8_STAGE(PG8_SA(1, 0), cA + kstep, voffA); PG8_STAGE(PG8_SB(1, 1), cB + hstep + kstep, voffB);
        PG8_WAIT_V(6); PG8_BAR;
    }
    for (;;) {
        const bool has_next = S.next(ui + 1, nxt);
        const char* nA = has_next ? (const char*)g.A + (size_t)nxt.pm * tstep + (size_t)nxt.kt0 * kstep : cA; const char* nB = has_next ? (const char*)g.Bt + (size_t)nxt.pn * tstep + (size_t)nxt.kt0 * kstep : cB;
        const int nt = cur.nkt;
        for (int t = 0; t < nt; t += 2) {
            const bool last = (t == nt - 2);
            const char* a1 = cA + (size_t)(t + 1) * kstep;
            const char* a2 = last ? nA : cA + (size_t)(t + 2) * kstep; const char* b2 = last ? nB : cB + (size_t)(t + 2) * kstep;
            const char* a3 = a2 + kstep; const char* b3 = b2 + kstep;
            if constexpr (SP2) {
            PG8_LDB(B0, 0, 0); PG8_LDB(B1, 0, 1); PG8_SCHED; PG8_LDA(At, 0, 0); PG8_STAGE(PG8_SA(1, 1), a1 + hstep, voffA);
            PG8_WAIT_V(8); PG8_WAIT_L(0); PG8_BAR; PG8_MMA(0, 0, At, B0); PG8_MMA(0, 1, At, B1); PG8_BAR; PG8_SCHED;
            PG8_LDA(At, 0, 1); PG8_STAGE(PG8_SB(0, 0), b2, voffB); PG8_STAGE(PG8_SB(0, 1), b2 + hstep, voffB); PG8_STAGE(PG8_SA(0, 0), a2, voffA);
            PG8_WAIT_V(8); PG8_WAIT_L(0); PG8_BAR; PG8_MMA(1, 0, At, B0); PG8_MMA(1, 1, At, B1); PG8_BAR; PG8_SCHED;
            PG8_LDB(B0, 1, 0); PG8_LDB(B1, 1, 1); PG8_SCHED; PG8_LDA(At, 1, 0); PG8_STAGE(PG8_SA(0, 1), a2 + hstep, voffA);
            PG8_WAIT_V(8); PG8_WAIT_L(0); PG8_BAR; PG8_MMA(0, 0, At, B0); PG8_MMA(0, 1, At, B1); PG8_BAR; PG8_SCHED;
            PG8_LDA(At, 1, 1); PG8_STAGE(PG8_SB(1, 0), b3, voffB); PG8_STAGE(PG8_SB(1, 1), b3 + hstep, voffB); PG8_STAGE(PG8_SA(1, 0), a3, voffA);
            PG8_WAIT_V(8); PG8_WAIT_L(0); PG8_BAR; PG8_MMA(1, 0, At, B0); PG8_MMA(1, 1, At, B1); PG8_BAR; PG8_SCHED;
            } else {
            PG8_LDB(B0, 0, 0); PG8_SCHED; PG8_LDA(At, 0, 0); PG8_STAGE(PG8_SA(1, 1), a1 + hstep, voffA);
            PG8_WAIT_L(8); PG8_BAR; PG8_WAIT_L(0); PG8_MMA(0, 0, At, B0); PG8_BAR; PG8_SCHED;
            PG8_LDB(B1, 0, 1); PG8_STAGE(PG8_SB(0, 0), b2, voffB);
            PG8_BAR; PG8_WAIT_L(0); PG8_MMA(0, 1, At, B1); PG8_BAR;
            PG8_LDA(At, 0, 1); PG8_STAGE(PG8_SA(0, 0), a2, voffA);
            PG8_BAR; PG8_WAIT_L(0); PG8_MMA(1, 0, At, B0); PG8_BAR; PG8_SCHED;
            PG8_STAGE(PG8_SB(0, 1), b2 + hstep, voffB);
            PG8_WAIT_V(6); PG8_BAR; PG8_MMA(1, 1, At, B1); PG8_BAR;
            PG8_LDB(B0, 1, 0); PG8_SCHED; PG8_LDA(At, 1, 0); PG8_STAGE(PG8_SA(0, 1), a2 + hstep, voffA);
            PG8_WAIT_L(8); PG8_BAR; PG8_WAIT_L(0); PG8_MMA(0, 0, At, B0); PG8_BAR; PG8_SCHED;
            PG8_LDB(B1, 1, 1); PG8_STAGE(PG8_SB(1, 0), b3, voffB);
            PG8_BAR; PG8_WAIT_L(0); PG8_MMA(0, 1, At, B1); PG8_BAR;
            PG8_LDA(At, 1, 1); PG8_STAGE(PG8_SA(1, 0), a3, voffA);
            PG8_BAR; PG8_WAIT_L(0); PG8_MMA(1, 0, At, B0); PG8_BAR; PG8_SCHED;
            PG8_STAGE(PG8_SB(1, 1), b3 + hstep, voffB);
            PG8_WAIT_V(6); PG8_BAR; PG8_MMA(1, 1, At, B1); PG8_BAR;
            }
        }
        if constexpr (ALIGN_EPI) { if (wr == 0) PG8_BAR; }
        if (cur.part < 0) {
            const auto cx = E.begin(cur, wr, wc, fr, fq);
#pragma unroll
            for (int ai = 0; ai < 2; ++ai)
#pragma unroll
                for (int m = 0; m < 4; ++m) { const f32x4 v[2][2] = {{acc[ai][0][m][0], acc[ai][0][m][1]}, {acc[ai][1][m][0], acc[ai][1][m][1]}}; E.rows(cx, v, cur, ai, m, wr, wc, fr, fq); }
        } else {
            bf16_t* sp = (bf16_t*)slab + (size_t)cur.part * 65536 + (size_t)tid * 8;
#pragma unroll
            for (int ai = 0; ai < 2; ++ai)
#pragma unroll
                for (int bj = 0; bj < 2; ++bj)
#pragma unroll
                    for (int m = 0; m < 4; ++m) { const f32x4 a = acc[ai][bj][m][0], b = acc[ai][bj][m][1];
                        u32x4 w; w.x = cvt_pk_bf16(a[0], a[1]); w.y = cvt_pk_bf16(a[2], a[3]); w.z = cvt_pk_bf16(b[0], b[1]); w.w = cvt_pk_bf16(b[2], b[3]);
                        *(u32x4*)(sp + (size_t)(((ai * 2 + bj) * 4 + m) * 4096)) = w; }
        }
        if (!has_next) break;
#pragma unroll
        for (int a = 0; a < 2; ++a)
#pragma unroll
            for (int b = 0; b < 2; ++b)
#pragma unroll
                for (int m = 0; m < 4; ++m)
#pragma unroll
                    for (int n = 0; n < 2; ++n) acc[a][b][m][n] = (f32x4){0.f, 0.f, 0.f, 0.f};
        cur = nxt; cA = nA; cB = nB; ++ui;
        if constexpr (ALIGN_EPI) { if (wr == 1) PG8_BAR; }
    }
    PG8_WAIT_V(0);
    if constexpr (!ALIGN_EPI) { if (wr == 0) PG8_BAR; }
    PG8_BAR;
#undef PG8_SA
#undef PG8_SB
#undef PG8_STAGE
#undef PG8_LDA
#undef PG8_LDB
#undef PG8_MMA
#undef PG8_WAIT_V
#undef PG8_WAIT_L
#undef PG8_BAR
#undef PG8_SCHED
}
template <class Epi, class Sched>
__device__ __forceinline__ void gemm_fixup(const Epi& E, const float* slab) {
    if constexpr (Sched::S > 1) {
    constexpr int NG = 8 / Sched::S;
    const int tid = threadIdx.x, wid = __builtin_amdgcn_readfirstlane(tid >> 6), lane = tid & 63, wr = wid >> 2, wc = wid & 3, fr = lane & 15, fq = lane >> 4;
    for (int b = blockIdx.x; b < Sched::rem * Sched::S; b += Sched::G) {
        const int r = b % Sched::rem, q = b / Sched::rem;
        const Unit u = Sched::unit_of(Sched::nfull + r, 0, Sched::nt, -1);
        f32x4 v[NG][2][2];
#pragma unroll
        for (int gi = 0; gi < NG; ++gi)
#pragma unroll
            for (int bj = 0; bj < 2; ++bj)
#pragma unroll
                for (int n = 0; n < 2; ++n) v[gi][bj][n] = (f32x4){0.f, 0.f, 0.f, 0.f};
#pragma unroll
        for (int gi = 0; gi < NG; ++gi) { const int g = q * NG + gi, ai = g >> 2, m = g & 3;
#pragma unroll
            for (int p = 0; p < Sched::S; ++p) {
                const bf16_t* sp = (const bf16_t*)slab + (size_t)(r + p * Sched::rem) * 65536 + (size_t)tid * 8;
#pragma unroll
                for (int bj = 0; bj < 2; ++bj) { const u32x4 w = *(const u32x4*)(sp + (size_t)(((ai * 2 + bj) * 4 + m) * 4096));
                    v[gi][bj][0] += (f32x4){__builtin_bit_cast(float, w.x << 16), __builtin_bit_cast(float, w.x & 0xffff0000u), __builtin_bit_cast(float, w.y << 16), __builtin_bit_cast(float, w.y & 0xffff0000u)};
                    v[gi][bj][1] += (f32x4){__builtin_bit_cast(float, w.z << 16), __builtin_bit_cast(float, w.z & 0xffff0000u), __builtin_bit_cast(float, w.w << 16), __builtin_bit_cast(float, w.w & 0xffff0000u)}; } } }
        const auto cx = E.begin(u, wr, wc, fr, fq);
#pragma unroll
        for (int gi = 0; gi < NG; ++gi) { const int g = q * NG + gi; E.rows(cx, v[gi], u, g >> 2, g & 3, wr, wc, fr, fq); }
    }
    }
}
}

constexpr int DM = 2048, NTOK = 12288, NCTX = 4096, DFF = 5632, NFF2 = 11264;
constexpr int IN_EVEN = 4160, IN_EVEN_P = 4096, IN_ODD = 3072;
constexpr int NMOD = 18432;
constexpr float EPS = 1e-6f;
constexpr float LOG2E = 1.4426950408889634f;

constexpr size_t O_X = 0, O_CKV = 25165824, O_KROPE = 27262976, O_NAK = 27525120, O_NAV = 31719424, O_GK = 35913728, O_GV = 38010880, O_END = 40108032;

constexpr size_t MiB = 1u << 20;
constexpr size_t WS_CTL = 0;
constexpr size_t WS_MODS = 2 * MiB;
constexpr size_t CTL_ZERO_BYTES = 4 * MiB;
constexpr size_t WS_WFI = 4 * MiB;
constexpr size_t WS_WFO = WS_WFI + 176 * MiB;
constexpr size_t WS_WEI = WS_WFO + 88 * MiB;
constexpr size_t WS_WQU = WS_WEI + 17 * MiB;
constexpr size_t WS_WKU = WS_WQU + 2 * MiB;
constexpr size_t WS_WEO = WS_WKU + 2 * MiB;
constexpr size_t WS_WOI = WS_WEO + 8 * MiB;
constexpr size_t WS_WOO = WS_WOI + 12 * MiB;
constexpr size_t WS_H = WS_WOO + 8 * MiB;
constexpr size_t WS_ACT = WS_H + 48 * MiB;
constexpr size_t WS_P = WS_ACT + 132 * MiB;
constexpr size_t WS_XB = WS_P + 128 * MiB;
constexpr size_t WS_QM = WS_P + 204 * MiB;
constexpr size_t WS_CQN = WS_QM + 72 * MiB;
constexpr size_t WS_CKVA = WS_CQN + 12 * MiB;
constexpr size_t WS_QA = WS_CKVA + 16 * MiB;
constexpr size_t WS_QNA = WS_QA + 48 * MiB;
constexpr size_t WS_KM_CTX = WS_QNA + 24 * MiB;
constexpr size_t WS_KM_LAT = WS_KM_CTX + 12 * MiB;
constexpr size_t WS_KM_CAC = WS_KM_LAT + 24 * MiB;
constexpr size_t WS_VM_CTX = WS_KM_CAC + 12 * MiB;
constexpr size_t WS_VM_LAT = WS_VM_CTX + 8 * MiB;
constexpr size_t WS_VM_CAC = WS_VM_LAT + 16 * MiB;
constexpr size_t WS_KN_CTX = WS_VM_CAC + 8 * MiB;
constexpr size_t WS_KN_LAT = WS_KN_CTX + 8 * MiB;
constexpr size_t WS_KN_CAC = WS_KN_LAT + 16 * MiB;
constexpr size_t WS_VN_CTX = WS_KN_CAC + 8 * MiB;
constexpr size_t WS_VN_LAT = WS_VN_CTX + 8 * MiB;
constexpr size_t WS_VN_CAC = WS_VN_LAT + 16 * MiB;
constexpr size_t WS_KG_CTX = WS_VN_CAC + 8 * MiB;
constexpr size_t WS_KG_LAT = WS_KG_CTX + 4 * MiB;
constexpr size_t WS_KG_CAC = WS_KG_LAT + 8 * MiB;
constexpr size_t WS_VG_CTX = WS_KG_CAC + 4 * MiB;
constexpr size_t WS_VG_LAT = WS_VG_CTX + 4 * MiB;
constexpr size_t WS_VG_CAC = WS_VG_LAT + 8 * MiB;
constexpr size_t WS_O = WS_VG_CAC + 4 * MiB;
constexpr size_t WS_KROPE = WS_O + 48 * MiB;
constexpr size_t WS_END = WS_KROPE + 4 * MiB;
constexpr int CW_BAR = 4096;

constexpr int RING_BYTES = 131072;
constexpr int LDSCTL_OFF = RING_BYTES;
constexpr int LDS_BYTES = 147456;

__device__ __forceinline__ unsigned f2bf(float f) { unsigned u = __builtin_bit_cast(unsigned, f); return (u + 0x7fffu + ((u >> 16) & 1u)) >> 16; }
__device__ __forceinline__ unsigned pk2(float lo, float hi) { return pg8::cvt_pk_bf16(lo, hi); }
__device__ __forceinline__ float wave_sum(float v) {
#pragma unroll
    for (int o = 1; o < 64; o <<= 1) v += __shfl_xor(v, o);
    return v;
}
__device__ __forceinline__ float fast_exp2(float x) { return __builtin_amdgcn_exp2f(x); }
__device__ __forceinline__ float fast_rcp(float x) { return __builtin_amdgcn_rcpf(x); }
__device__ __forceinline__ float silu_f(float g) { return g * fast_rcp(1.0f + fast_exp2(-g * LOG2E)); }
__device__ __forceinline__ float sin_rev(float rev) { return __builtin_amdgcn_sinf(rev); }
__device__ __forceinline__ float cos_rev(float rev) { return __builtin_amdgcn_cosf(rev); }

#define XB_TMO      128
#define XB_XCNT(j)  (256  + 64 * (j))
#define XB_XSUB(j)  (1280 + 64 * (j))
#define XB_XGEN(j)  (2304 + 64 * (j))
#define XB_TOP      3328
#define XB_TOPGEN   3392
#define XCD_BAR_WORDS 3456
#define XB_SPIN_CAP (1u << 18)
__device__ __forceinline__ unsigned xb_ld(unsigned* p)              { return __hip_atomic_load(p, __ATOMIC_RELAXED, __HIP_MEMORY_SCOPE_AGENT); }
__device__ __forceinline__ unsigned xb_add(unsigned* p, unsigned v) { return __hip_atomic_fetch_add(p, v, __ATOMIC_RELAXED, __HIP_MEMORY_SCOPE_AGENT); }
__device__ __forceinline__ unsigned xb_xcc_id() { return (unsigned)__builtin_amdgcn_s_getreg((3 << 11) | 20) & 0xFu; }
#define XB_SPIN(cond, bar) do { unsigned _sp = 0; while (cond) { __builtin_amdgcn_s_sleep(1); \
    if ((++_sp & 255u) == 0u) { if (xb_ld(&(bar)[XB_TMO])) break; if (_sp > XB_SPIN_CAP) { atomicAdd(&(bar)[XB_TMO], 1u); break; } } } } while (0)
struct XcdBarrier { unsigned* bar; unsigned x; volatile LAS unsigned* st; };
__device__ __forceinline__ XcdBarrier xcd_barrier_post(unsigned* bar, volatile LAS unsigned* st) {
    XcdBarrier b; b.bar = bar; b.x = xb_xcc_id(); b.st = st;
    if (threadIdx.x == 0) (void)xb_add(&bar[XB_XCNT(b.x)], 1u);
    return b;
}
__device__ __forceinline__ void xcd_barrier_complete(unsigned* bar, unsigned x, unsigned& nloc, unsigned& nx) {
    const unsigned G = gridDim.x * gridDim.y * gridDim.z;
    unsigned sum, cnt, mine, sp = 0u;
    for (;;) {
        sum = 0u; cnt = 0u; mine = 0u;
#pragma unroll
        for (unsigned j = 0; j < 16; ++j) { const unsigned c = xb_ld(&bar[XB_XCNT(j)]); sum += c; cnt += (c > 0u) ? 1u : 0u; mine = (j == x) ? c : mine; }
        if (sum == G) break;
        __builtin_amdgcn_s_sleep(1);
        if ((++sp & 255u) == 0u) { if (xb_ld(&bar[XB_TMO])) break; if (sp > XB_SPIN_CAP) { atomicAdd(&bar[XB_TMO], 1u); break; } }
    }
    nloc = mine > 0u ? mine : 1u; nx = cnt > 0u ? cnt : 1u;
}
__device__ __forceinline__ void xcd_barrier(const XcdBarrier& b) {
    asm volatile("s_waitcnt vmcnt(0)" ::: "memory");
    __syncthreads();
    if (threadIdx.x == 0) {
        unsigned* bar = b.bar;
        __builtin_amdgcn_s_waitcnt(0);
        unsigned nloc = b.st[0], nx = b.st[1];
        if (nloc == 0u) { xcd_barrier_complete(bar, b.x, nloc, nx); b.st[0] = nloc; b.st[1] = nx; }
        const unsigned old = xb_add(&bar[XB_XSUB(b.x)], 1u);
        const unsigned gen = old / nloc;
        if (old + 1u == (gen + 1u) * nloc) {
            __builtin_amdgcn_fence(__ATOMIC_RELEASE, "agent");
            asm volatile("s_waitcnt vmcnt(0)" ::: "memory");
            const unsigned og = xb_add(&bar[XB_TOP], 1u);
            const unsigned tg = og / nx;
            if (og + 1u == (tg + 1u) * nx) xb_add(&bar[XB_TOPGEN], 1u);
            else XB_SPIN(xb_ld(&bar[XB_TOPGEN]) == tg, bar);
            __builtin_amdgcn_fence(__ATOMIC_ACQUIRE, "agent");
            xb_add(&bar[XB_XGEN(b.x)], 1u);
            asm volatile("s_waitcnt vmcnt(0)" ::: "memory");
        } else {
            XB_SPIN(xb_ld(&bar[XB_XGEN(b.x)]) == gen, bar);
            __builtin_amdgcn_fence(__ATOMIC_ACQUIRE, "agent");
            asm volatile("s_waitcnt vmcnt(0)" ::: "memory");
        }
    }
    __syncthreads();
}

struct Args { const float* in[28]; float* out; unsigned char* ws; int ph_lo, ph_hi; };
struct Frame {
    LAS unsigned char* lds;
    int tid, lane, wave, G, gw, NGW;
    const Args* a; float* out; unsigned char* ws;
};
#define IN_XP 0
#define IN_XS 1
#define IN_C_CKV 2
#define IN_C_KROPE 3
#define IN_C_NAK 4
#define IN_C_NAV 5
#define IN_C_GK 6
#define IN_C_GV 7
#define IN_C 8
#define IN_CCTX 9
#define IN_ADAW 10
#define IN_ADAB 11
#define IN_NORMG 12
#define IN_FFI 13
#define IN_FFO 14
#define IN_EWI 15
#define IN_EWO 16
#define IN_QNORM 17
#define IN_WQUP 18
#define IN_KVNORM 19
#define IN_WKVUP 20
#define IN_MLAQK 21
#define IN_NAQK 22
#define IN_RPB 23
#define IN_OWI 24
#define IN_OWO 25
#define IN_GQK 26
#define IN_SINK 27

__device__ __forceinline__ int opaque_v(int x) { asm volatile("" : "+v"(x)); return x; }
__device__ __forceinline__ int tok_mb(int t) { return t < NCTX ? 0 : 1 + ((t - NCTX) >> 10); }

__device__ __forceinline__ size_t k_chunk_off(int DQK, int key, int c8) { return (size_t)(key >> 5) * (DQK * 32) + (size_t)(c8 >> 1) * 512 + (((c8 & 1) * 32 + (key & 31)) << 3); }
__device__ __forceinline__ void vt_tile_write_h(const bf16_t* src0, size_t pitch, bf16_t* dst, int lane) {
#pragma unroll
    for (int it = 0; it < 8; ++it) {
        const int d = (it & 1) * 64 + lane, s = (it >> 1) & 1, hh = it >> 2;
        unsigned v[8];
#pragma unroll
        for (int j = 0; j < 8; ++j) { const int key = 16 * s + 8 * (j >> 2) + 4 * hh + (j & 3); v[j] = src0[(size_t)key * pitch + d]; }
        u32x4 w; w.x = v[0] | (v[1] << 16); w.y = v[2] | (v[3] << 16); w.z = v[4] | (v[5] << 16); w.w = v[6] | (v[7] << 16);
        *(u32x4*)(dst + (size_t)(((s * 4 + (d >> 5)) * 64 + hh * 32 + (d & 31)) << 3)) = w;
    }
}
__device__ __forceinline__ void vt_tile_write(const float* src0, size_t pitch, bf16_t* dst, int lane) {
#pragma unroll
    for (int it = 0; it < 8; ++it) {
        const int d = (it & 1) * 64 + lane, s = (it >> 1) & 1, hh = it >> 2;
        float v[8];
#pragma unroll
        for (int j = 0; j < 8; ++j) { const int key = 16 * s + 8 * (j >> 2) + 4 * hh + (j & 3); v[j] = src0[(size_t)key * pitch + d]; }
        u32x4 w; w.x = pk2(v[0], v[1]); w.y = pk2(v[2], v[3]); w.z = pk2(v[4], v[5]); w.w = pk2(v[6], v[7]);
        *(u32x4*)(dst + (size_t)(((s * 4 + (d >> 5)) * 64 + hh * 32 + (d & 31)) << 3)) = w;
    }
}

__device__ __forceinline__ void p0_transpose_item(const float* W, int K, int N, bf16_t* WT, int mode, LAS float* scr, int item, int lane) {
    const int nblk = N / 32, kb = item / nblk, nb = item % nblk, k0 = 64 * kb, n0 = 32 * nb;
#pragma unroll 8
    for (int i = 0; i < 32; ++i) { const int kk = 2 * i + (lane >> 5); scr[kk * 33 + (lane & 31)] = __builtin_nontemporal_load(W + (size_t)(k0 + kk) * N + n0 + (lane & 31)); }
    asm volatile("s_waitcnt lgkmcnt(0)" ::: "memory");
    int d0 = n0;
    if (mode == 1) { const int j0 = n0 < DFF ? n0 : n0 - DFF; d0 = 256 * (j0 >> 7) + (j0 & 127) + (n0 < DFF ? 0 : 128); }
    if (mode == 2) d0 = n0 < 1024 ? n0 : (n0 < 1088 ? 4096 + (n0 - 1024) : n0 - 64);
    const int c = lane & 7;
#pragma unroll
    for (int j = 0; j < 4; ++j) { const int n = (lane >> 3) + 8 * j; const LAS float* s = scr + (8 * c) * 33 + n;
        u32x4 o; o.x = pk2(s[0 * 33], s[1 * 33]); o.y = pk2(s[2 * 33], s[3 * 33]); o.z = pk2(s[4 * 33], s[5 * 33]); o.w = pk2(s[6 * 33], s[7 * 33]);
        *(u32x4*)(WT + (size_t)(d0 + n) * K + k0 + 8 * c) = o; }
    asm volatile("s_waitcnt lgkmcnt(0)" ::: "memory");
}

__device__ __forceinline__ const float* p0_mods_wptr(Frame& F, int item) {
    const int layer = item / 1152, rem = item % 1152, slab = rem >> 4, ks = rem & 15;
    return F.a->in[IN_ADAW] + (size_t)layer * DM * NMOD + (size_t)(ks * 128 + F.wave * 16) * NMOD + slab * 256 + 4 * F.lane;
}
__device__ __forceinline__ void phase_mods(Frame& F) {
    LAS float* stab = (LAS float*)(F.lds);
    LAS float* part = (LAS float*)(F.lds + 8192);
    const float* c = F.a->in[IN_C]; const float* cctx = F.a->in[IN_CCTX];
    for (int item = blockIdx.x; item < 2304; item += F.G) {
        const int layer = item / 1152, rem = item % 1152, slab = rem >> 4, ks = rem & 15, n0 = slab * 256, k0 = ks * 128;
        f32x4 w[16];
        { const float* W = p0_mods_wptr(F, item);
#pragma unroll
          for (int kk = 0; kk < 16; ++kk) w[kk] = __builtin_nontemporal_load((const f32x4*)(W + (size_t)kk * NMOD)); }
        for (int i = F.tid; i < 9 * 128; i += 512) { const int b = i >> 7, k = i & 127; const float v = (b == 0) ? cctx[k0 + k] : c[(size_t)(b - 1) * DM + k0 + k]; stab[i] = silu_f(v); }
        __syncthreads();
        f32x4 acc[9];
#pragma unroll
        for (int b = 0; b < 9; ++b) acc[b] = (f32x4){0.f, 0.f, 0.f, 0.f};
#pragma unroll
        for (int kk = 0; kk < 16; ++kk) {
#pragma unroll
            for (int b = 0; b < 9; ++b) { const float sv = stab[b * 128 + F.wave * 16 + kk]; acc[b] += w[kk] * sv; }
        }
#pragma unroll
        for (int b = 0; b < 9; ++b) *(LAS f32x4*)(part + (F.wave * 9 + b) * 256 + 4 * F.lane) = acc[b];
        __syncthreads();
        float* mods = (float*)(F.ws + WS_MODS) + (size_t)layer * 9 * NMOD;
        const float* bias = F.a->in[IN_ADAB] + (size_t)layer * NMOD;
        for (int i = F.tid; i < 9 * 256; i += 512) { const int b = i >> 8, col = i & 255; float sm = 0.f;
#pragma unroll
            for (int ww = 0; ww < 8; ++ww) sm += part[(ww * 9 + b) * 256 + col];
            if (ks == 0) sm += bias[n0 + col];
            atomicAdd(mods + (size_t)b * NMOD + n0 + col, sm); }
        __syncthreads();
    }
}

__device__ __forceinline__ void p0_cacheK_item(const float* src, int H, bf16_t* dstbase, int item, int lane) {
    const int t32 = item & 15, bh = item >> 4, b = bh / H, h = bh % H;
    bf16_t* dst = dstbase + (size_t)bh * (512 * 128);
#pragma unroll
    for (int it = 0; it < 8; ++it) { const int idx = it * 64 + lane, kl = idx >> 4, c8 = idx & 15, key = t32 * 32 + kl;
        const float* s = src + ((size_t)(b * 512 + key) * H + h) * 128 + c8 * 8;
        const f32x4 a = *(const f32x4*)s, bb = *(const f32x4*)(s + 4);
        u32x4 w; w.x = pk2(a[0], a[1]); w.y = pk2(a[2], a[3]); w.z = pk2(bb[0], bb[1]); w.w = pk2(bb[2], bb[3]);
        *(u32x4*)(dst + k_chunk_off(128, key, c8)) = w; }
}
__device__ __forceinline__ void p0_cacheV_item(const float* src, int H, bf16_t* dstbase, int item, int lane) {
    const int t32 = item & 15, bh = item >> 4, b = bh / H, h = bh % H;
    vt_tile_write(src + ((size_t)(b * 512 + t32 * 32) * H + h) * 128, (size_t)H * 128, dstbase + (size_t)bh * (512 * 128) + (size_t)t32 * 4096, lane);
}

__device__ __forceinline__ void phase_prologue(Frame& F) {
    phase_mods(F);
    LAS float* scr = (LAS float*)(F.lds + F.wave * 16384);
    constexpr int I_FI = 32 * 352, I_FO = 88 * 64, I_EI = 32 * 130, I_QU = 8 * 48, I_KU = 8 * 64, I_EO = 32 * 64, I_OI = 32 * 96, I_OO = 32 * 64;
    constexpr int I_PAD = 0, I_CKV = 1024, I_NK = 1024, I_NV = 1024, I_GK = 512, I_GV = 512;
    constexpr int NITEMS = 4 * I_FI + 4 * I_FO + I_EI + I_QU + I_KU + I_EO + I_OI + I_OO + I_PAD + I_CKV + I_NK + I_NV + I_GK + I_GV;
    unsigned char* ws = F.ws;
    for (int it = F.gw; it < NITEMS; it += F.NGW) {
        int r = it;
        if (r < 4 * I_FI) { const int m = r / I_FI; p0_transpose_item(F.a->in[IN_FFI] + (size_t)m * DM * NFF2, DM, NFF2, (bf16_t*)(ws + WS_WFI) + (size_t)m * NFF2 * DM, 1, scr, r % I_FI, F.lane); continue; } r -= 4 * I_FI;
        if (r < 4 * I_FO) { const int m = r / I_FO; p0_transpose_item(F.a->in[IN_FFO] + (size_t)m * DFF * DM, DFF, DM, (bf16_t*)(ws + WS_WFO) + (size_t)m * DM * DFF, 0, scr, r % I_FO, F.lane); continue; } r -= 4 * I_FO;
        if (r < I_EI) { p0_transpose_item(F.a->in[IN_EWI], DM, IN_EVEN, (bf16_t*)(ws + WS_WEI), 2, scr, r, F.lane); continue; } r -= I_EI;
        if (r < I_QU) { p0_transpose_item(F.a->in[IN_WQUP], 512, 1536, (bf16_t*)(ws + WS_WQU), 0, scr, r, F.lane); continue; } r -= I_QU;
        if (r < I_KU) { p0_transpose_item(F.a->in[IN_WKVUP], 512, 2048, (bf16_t*)(ws + WS_WKU), 0, scr, r, F.lane); continue; } r -= I_KU;
        if (r < I_EO) { p0_transpose_item(F.a->in[IN_EWO], DM, DM, (bf16_t*)(ws + WS_WEO), 0, scr, r, F.lane); continue; } r -= I_EO;
        if (r < I_OI) { p0_transpose_item(F.a->in[IN_OWI], DM, IN_ODD, (bf16_t*)(ws + WS_WOI), 0, scr, r, F.lane); continue; } r -= I_OI;
        if (r < I_OO) { p0_transpose_item(F.a->in[IN_OWO], DM, DM, (bf16_t*)(ws + WS_WOO), 0, scr, r, F.lane); continue; } r -= I_OO;
        if (r < I_PAD) { u32x4* p = (u32x4*)((bf16_t*)(ws + WS_WEI) + (size_t)(IN_EVEN + r) * DM); const u32x4 z = {0u, 0u, 0u, 0u};
#pragma unroll
            for (int j = 0; j < 4; ++j) p[j * 64 + F.lane] = z; continue; } r -= I_PAD;
        if (r < I_CKV) {
#pragma unroll
            for (int j = 0; j < 4; ++j) { const int row = 4 * r + j; const float* s = F.a->in[IN_C_CKV] + (size_t)row * 512 + 8 * F.lane;
                const f32x4 a = *(const f32x4*)s, b = *(const f32x4*)(s + 4);
                u32x4 w; w.x = pk2(a[0], a[1]); w.y = pk2(a[2], a[3]); w.z = pk2(b[0], b[1]); w.w = pk2(b[2], b[3]);
                *(u32x4*)((bf16_t*)(ws + WS_CKVA) + (size_t)(NTOK + row) * 512 + 8 * F.lane) = w; }
            continue; } r -= I_CKV;
        if (r < I_NK) { p0_cacheK_item(F.a->in[IN_C_NAK], 8, (bf16_t*)(ws + WS_KN_CAC), r, F.lane); continue; } r -= I_NK;
        if (r < I_NV) { p0_cacheV_item(F.a->in[IN_C_NAV], 8, (bf16_t*)(ws + WS_VN_CAC), r, F.lane); continue; } r -= I_NV;
        if (r < I_GK) { p0_cacheK_item(F.a->in[IN_C_GK], 4, (bf16_t*)(ws + WS_KG_CAC), r, F.lane); continue; } r -= I_GK;
        p0_cacheV_item(F.a->in[IN_C_GV], 4, (bf16_t*)(ws + WS_VG_CAC), r, F.lane);
    }
}

__device__ __forceinline__ void load8(const float* p, float (&v)[8]) { const f32x4 a = *(const f32x4*)p, b = *(const f32x4*)(p + 4); v[0] = a[0]; v[1] = a[1]; v[2] = a[2]; v[3] = a[3]; v[4] = b[0]; v[5] = b[1]; v[6] = b[2]; v[7] = b[3]; }
__device__ __forceinline__ void load8h(const bf16_t* p, float (&v)[8]) { const u32x4 w = *(const u32x4*)p;
    v[0] = __builtin_bit_cast(float, w.x << 16); v[1] = __builtin_bit_cast(float, w.x & 0xffff0000u); v[2] = __builtin_bit_cast(float, w.y << 16); v[3] = __builtin_bit_cast(float, w.y & 0xffff0000u);
    v[4] = __builtin_bit_cast(float, w.z << 16); v[5] = __builtin_bit_cast(float, w.z & 0xffff0000u); v[6] = __builtin_bit_cast(float, w.w << 16); v[7] = __builtin_bit_cast(float, w.w & 0xffff0000u); }

__device__ __forceinline__ const float* x_in_row(Frame& F, int t) { return t < NCTX ? F.a->in[IN_XP] + (size_t)t * DM : F.a->in[IN_XS] + (size_t)(t - NCTX) * DM; }
__device__ __forceinline__ void phase_norm(Frame& F, bool from_input, int layer, int sub) {
    const float* g = F.a->in[IN_NORMG] + (size_t)(layer * 3 + sub) * DM;
    bf16_t* H = (bf16_t*)(F.ws + WS_H);
    const bf16_t* XB = (const bf16_t*)(F.ws + WS_XB);
    const int lane = opaque_v(F.lane);
    for (int t = F.gw; t < NTOK; t += F.NGW) {
        const float* md = (const float*)(F.ws + WS_MODS) + ((size_t)layer * 9 + tok_mb(t)) * NMOD + (size_t)(3 * sub) * DM;
        float v[4][8]; float ss = 0.f;
        if (from_input) { const float* xr = x_in_row(F, t);
#pragma unroll
            for (int j = 0; j < 4; ++j) load8(xr + 512 * j + 8 * lane, v[j]);
        } else { const bf16_t* xr = XB + (size_t)t * DM;
#pragma unroll
            for (int j = 0; j < 4; ++j) load8h(xr + 512 * j + 8 * lane, v[j]);
        }
#pragma unroll
        for (int j = 0; j < 4; ++j) ss += ((v[j][0] * v[j][0] + v[j][1] * v[j][1]) + (v[j][2] * v[j][2] + v[j][3] * v[j][3])) + ((v[j][4] * v[j][4] + v[j][5] * v[j][5]) + (v[j][6] * v[j][6] + v[j][7] * v[j][7]));
        const float rstd = __builtin_amdgcn_rsqf(wave_sum(ss) * (1.0f / DM) + EPS);
#pragma unroll
        for (int j = 0; j < 4; ++j) { const int c = 512 * j + 8 * lane;
            float gg[8], sh[8], sc[8], y[8]; load8(g + c, gg); load8(md + c, sh); load8(md + DM + c, sc);
#pragma unroll
            for (int e = 0; e < 8; ++e) y[e] = (v[j][e] * rstd * gg[e]) * (sc[e] + 1.0f) + sh[e];
            u32x4 w; w.x = pk2(y[0], y[1]); w.y = pk2(y[2], y[3]); w.z = pk2(y[4], y[5]); w.w = pk2(y[6], y[7]);
            *(u32x4*)(H + (size_t)t * DM + c) = w; }
    }
}

struct EpiSwiGLU {
    static constexpr bool PERM = true;
    bf16_t* O;
    struct Ctx { int row0, col0; };
    __device__ __forceinline__ Ctx begin(const pg8::Unit& u, int wr, int wc, int fr, int fq) const { return Ctx{u.pm * 256 + wr * 64 + fr, u.pn * 128 + wc * 32 + 8 * fq}; }
    __device__ __forceinline__ void rows(const Ctx& c, const f32x4 (&v)[2][2], const pg8::Unit&, int ai, int m, int, int, int, int) const {
        float r[8];
#pragma unroll
        for (int n = 0; n < 2; ++n)
#pragma unroll
            for (int j = 0; j < 4; ++j) r[4 * n + j] = silu_f(v[0][n][j]) * v[1][n][j];
        u32x4 w; w.x = pk2(r[0], r[1]); w.y = pk2(r[2], r[3]); w.z = pk2(r[4], r[5]); w.w = pk2(r[6], r[7]);
        *(u32x4*)(O + (size_t)(c.row0 + ai * 128 + m * 16) * DFF + c.col0) = w;
    }
};
template <bool INF, bool OUTF>
struct EpiResid {
    static constexpr bool PERM = true;
    const float* xp; const float* xs; bf16_t* xb; float* out; const float* gate_base; float coef;
    struct Ctx { const float* xin; f32x4 gv[2][2]; int row0, col0; };
    __device__ __forceinline__ Ctx begin(const pg8::Unit& u, int wr, int wc, int fr, int fq) const {
        Ctx c; const int rowt = u.pm * 256; c.row0 = rowt + wr * 64 + fr; c.col0 = u.pn * 256 + wc * 32 + 8 * fq;
        const float* gt = gate_base + (size_t)tok_mb(rowt) * NMOD;
        c.xin = rowt < NCTX ? xp : xs - (size_t)NCTX * DM;
#pragma unroll
        for (int bj = 0; bj < 2; ++bj)
#pragma unroll
            for (int n = 0; n < 2; ++n) c.gv[bj][n] = *(const f32x4*)(gt + c.col0 + bj * 128 + n * 4) * coef;
        return c;
    }
    __device__ __forceinline__ void rows(const Ctx& c, const f32x4 (&v)[2][2], const pg8::Unit&, int ai, int m, int, int, int, int) const {
        const size_t off = (size_t)(c.row0 + ai * 128 + m * 16) * DM + c.col0;
        f32x4 x[2][2];
#pragma unroll
        for (int bj = 0; bj < 2; ++bj) {
            if constexpr (INF) { x[bj][0] = *(const f32x4*)(c.xin + off + bj * 128); x[bj][1] = *(const f32x4*)(c.xin + off + bj * 128 + 4); }
            else { const u32x4 w = *(const u32x4*)(xb + off + bj * 128);
                x[bj][0] = (f32x4){__builtin_bit_cast(float, w.x << 16), __builtin_bit_cast(float, w.x & 0xffff0000u), __builtin_bit_cast(float, w.y << 16), __builtin_bit_cast(float, w.y & 0xffff0000u)};
                x[bj][1] = (f32x4){__builtin_bit_cast(float, w.z << 16), __builtin_bit_cast(float, w.z & 0xffff0000u), __builtin_bit_cast(float, w.w << 16), __builtin_bit_cast(float, w.w & 0xffff0000u)}; }
        }
#pragma unroll
        for (int bj = 0; bj < 2; ++bj) { const f32x4 r0 = x[bj][0] + c.gv[bj][0] * v[bj][0], r1 = x[bj][1] + c.gv[bj][1] * v[bj][1];
            if constexpr (OUTF) { *(f32x4*)(out + off + bj * 128) = r0; *(f32x4*)(out + off + bj * 128 + 4) = r1; }
            else { u32x4 w; w.x = pk2(r0[0], r0[1]); w.y = pk2(r0[2], r0[3]); w.z = pk2(r1[0], r1[1]); w.w = pk2(r1[2], r1[3]); *(u32x4*)(xb + off + bj * 128) = w; }
        }
        asm volatile("" ::: "memory");
    }
};
typedef EpiResid<true, false> ResidIn; typedef EpiResid<false, false> ResidMid; typedef EpiResid<false, true> ResidOut;
struct EpiBf16 {
    static constexpr bool PERM = true;
    bf16_t* C; int ldc;
    struct Ctx { int row0, col0; };
    __device__ __forceinline__ Ctx begin(const pg8::Unit& u, int wr, int wc, int fr, int fq) const { return Ctx{u.pm * 256 + wr * 64 + fr, u.pn * 256 + wc * 32 + 8 * fq}; }
    __device__ __forceinline__ void rows(const Ctx& c, const f32x4 (&v)[2][2], const pg8::Unit&, int ai, int m, int, int, int, int) const {
        bf16_t* rowp = C + (size_t)(c.row0 + ai * 128 + m * 16) * ldc + c.col0;
#pragma unroll
        for (int bj = 0; bj < 2; ++bj) { u32x4 w; w.x = pk2(v[bj][0][0], v[bj][0][1]); w.y = pk2(v[bj][0][2], v[bj][0][3]); w.z = pk2(v[bj][1][0], v[bj][1][1]); w.w = pk2(v[bj][1][2], v[bj][1][3]);
            *(u32x4*)(rowp + bj * 128) = w; }
    }
};
struct EpiF32 {
    static constexpr bool PERM = false;
    float* C; int ldc;
    struct Ctx { int row0, col0; };
    __device__ __forceinline__ Ctx begin(const pg8::Unit& u, int wr, int wc, int fr, int fq) const { return Ctx{u.pm * 256 + wr * 64 + fr, u.pn * 256 + wc * 32 + 4 * fq}; }
    __device__ __forceinline__ void rows(const Ctx& c, const f32x4 (&v)[2][2], const pg8::Unit&, int ai, int m, int, int, int, int) const {
        float* rowp = C + (size_t)(c.row0 + ai * 128 + m * 16) * ldc + c.col0;
#pragma unroll
        for (int bj = 0; bj < 2; ++bj)
#pragma unroll
            for (int n = 0; n < 2; ++n) *(f32x4*)(rowp + bj * 128 + n * 16) = v[bj][n];
    }
};

__device__ __forceinline__ u32x4 pack8(const float (&v)[8]) { u32x4 w; w.x = pk2(v[0], v[1]); w.y = pk2(v[2], v[3]); w.z = pk2(v[4], v[5]); w.w = pk2(v[6], v[7]); return w; }
__device__ __forceinline__ void store8f(float* p, const float (&v)[8]) { *(f32x4*)p = (f32x4){v[0], v[1], v[2], v[3]}; *(f32x4*)(p + 4) = (f32x4){v[4], v[5], v[6], v[7]}; }
template <int W> __device__ __forceinline__ float group_sum(float v) {
#pragma unroll
    for (int o = 1; o < W; o <<= 1) v += __shfl_xor(v, o);
    return v;
}

__device__ __forceinline__ void phase_post1_even(Frame& F) {
    const bf16_t* P = (const bf16_t*)(F.ws + WS_P);
    const float* qn_g = F.a->in[IN_QNORM]; const float* kvn_g = F.a->in[IN_KVNORM]; const float* naq_g = F.a->in[IN_NAQK]; const float* nak_g = F.a->in[IN_NAQK] + 128;
    bf16_t* CQN = (bf16_t*)(F.ws + WS_CQN); bf16_t* CKVA = (bf16_t*)(F.ws + WS_CKVA); bf16_t* QNA = (bf16_t*)(F.ws + WS_QNA);
    constexpr int NVT_CTX = 16 * 8 * 8, NVT_LAT = 8 * 8 * 32, NKR = NTOK / 16;
    for (int it = F.gw; it < NKR; it += F.NGW) {
        const int t0 = it * 16, lane = F.lane, lr = lane & 15, lq = lane >> 4;
        const bf16_t* ap = (const bf16_t*)(F.ws + WS_H) + (size_t)(t0 + lr) * DM + 8 * lq;
        const bf16_t* bp = (const bf16_t*)(F.ws + WS_WEI) + (size_t)(4096 + lr) * DM + 8 * lq;
        f32x4 acc[4];
#pragma unroll
        for (int j = 0; j < 4; ++j) acc[j] = (f32x4){0.f, 0.f, 0.f, 0.f};
#pragma unroll 8
        for (int kk = 0; kk < 64; ++kk) {
            const bf16x8 af = *(const bf16x8*)(ap + kk * 32);
#pragma unroll
            for (int j = 0; j < 4; ++j) { const bf16x8 bf = *(const bf16x8*)(bp + (size_t)j * 16 * DM + kk * 32); acc[j] = __builtin_amdgcn_mfma_f32_16x16x32_bf16(af, bf, acc[j], 0, 0, 0); }
        }
        float* kr = (float*)(F.ws + WS_KROPE);
#pragma unroll
        for (int j = 0; j < 4; ++j)
#pragma unroll
            for (int r = 0; r < 4; ++r) { const int t = t0 + 4 * lq + r, c = 16 * j + lr; kr[(size_t)t * 64 + c] = acc[j][r]; if (t < NCTX) F.out[O_KROPE + (size_t)t * 64 + c] = acc[j][r]; }
    }
    for (int it = F.gw; it < NTOK + NVT_CTX + NVT_LAT; it += F.NGW) {
        if (it < NTOK) {
            const int t = it, lane = F.lane; const bf16_t* pr = P + (size_t)t * IN_EVEN_P; const bool ctx = t < NCTX;
            float v[8], g[8];
            load8h(pr + 8 * lane, v); float ss = 0.f;
#pragma unroll
            for (int i = 0; i < 8; ++i) ss += v[i] * v[i];
            float rstd = __builtin_amdgcn_rsqf(wave_sum(ss) * (1.0f / 512) + EPS);
            load8(qn_g + 8 * lane, g);
#pragma unroll
            for (int i = 0; i < 8; ++i) v[i] = v[i] * rstd * g[i];
            *(u32x4*)(CQN + (size_t)t * 512 + 8 * lane) = pack8(v);
            load8h(pr + 512 + 8 * lane, v); ss = 0.f;
#pragma unroll
            for (int i = 0; i < 8; ++i) ss += v[i] * v[i];
            rstd = __builtin_amdgcn_rsqf(wave_sum(ss) * (1.0f / 512) + EPS);
            load8(kvn_g + 8 * lane, g);
#pragma unroll
            for (int i = 0; i < 8; ++i) v[i] = v[i] * rstd * g[i];
            if (ctx) store8f(F.out + O_CKV + (size_t)t * 512 + 8 * lane, v);
            *(u32x4*)(CKVA + (size_t)t * 512 + 8 * lane) = pack8(v);
            const int head = lane >> 3, d0 = (lane & 7) * 16;
            int b, s; if (ctx) { b = t >> 8; s = t & 255; } else { b = (t - NCTX) >> 10; s = (t - NCTX) & 1023; }
#pragma unroll
            for (int which = 0; which < 2; ++which) {
                const bf16_t* src = pr + 1024 + which * 1024 + head * 128 + d0; const float* gg = which ? nak_g : naq_g;
                float a[8], c[8], ga[8], gc[8]; load8h(src, a); load8h(src + 8, c); load8(gg + d0, ga); load8(gg + d0 + 8, gc);
                float q = 0.f;
#pragma unroll
                for (int i = 0; i < 8; ++i) q += a[i] * a[i] + c[i] * c[i];
                const float r2 = __builtin_amdgcn_rsqf(group_sum<8>(q) * (1.0f / 128) + EPS);
#pragma unroll
                for (int i = 0; i < 8; ++i) { a[i] = a[i] * r2 * ga[i]; c[i] = c[i] * r2 * gc[i]; }
                if (which == 0) { bf16_t* qd = QNA + (size_t)t * 1024 + head * 128 + d0; *(u32x4*)qd = pack8(a); *(u32x4*)(qd + 8) = pack8(c); }
                else {
                    if (ctx) { float* od = F.out + O_NAK + (size_t)t * 1024 + head * 128 + d0; store8f(od, a); store8f(od + 8, c); }
                    bf16_t* kb = ctx ? (bf16_t*)(F.ws + WS_KN_CTX) + (size_t)(b * 8 + head) * (256 * 128) : (bf16_t*)(F.ws + WS_KN_LAT) + (size_t)(b * 8 + head) * (1024 * 128);
                    *(u32x4*)(kb + k_chunk_off(128, s, d0 >> 3)) = pack8(a); *(u32x4*)(kb + k_chunk_off(128, s, (d0 >> 3) + 1)) = pack8(c);
                }
            }
            { const bf16_t* src = pr + 3072 + 16 * lane; float a[8], c[8]; load8h(src, a); load8h(src + 8, c); if (ctx) { float* od = F.out + O_NAV + (size_t)t * 1024 + 16 * lane; store8f(od, a); store8f(od + 8, c); } }
        } else {
            int r = it - NTOK;
            if (r < NVT_CTX) { const int t32 = r & 7, bh = r >> 3, b = bh >> 3, h = bh & 7;
                vt_tile_write_h(P + (size_t)(b * 256 + t32 * 32) * IN_EVEN_P + 3072 + h * 128, IN_EVEN_P, (bf16_t*)(F.ws + WS_VN_CTX) + (size_t)bh * (256 * 128) + (size_t)t32 * 4096, F.lane);
            } else { r -= NVT_CTX; const int t32 = r & 31, bh = r >> 5, b = bh >> 3, h = bh & 7;
                vt_tile_write_h(P + (size_t)(NCTX + b * 1024 + t32 * 32) * IN_EVEN_P + 3072 + h * 128, IN_EVEN_P, (bf16_t*)(F.ws + WS_VN_LAT) + (size_t)bh * (1024 * 128) + (size_t)t32 * 4096, F.lane);
            }
        }
    }
}

__device__ __forceinline__ void rope8(float (&v)[8], const float (&vp)[8], bool is_x1, float pos, int f0, float inv_nf) {
#pragma unroll
    for (int i = 0; i < 8; ++i) {
        const float invf = fast_exp2(-(float)(f0 + i) * inv_nf * 13.287712379549449f);
        const float rev = pos * invf * 0.15915494309189535f;
        const float cs = cos_rev(rev), sn = sin_rev(rev);
        v[i] = is_x1 ? (v[i] * cs - vp[i] * sn) : (vp[i] * sn + v[i] * cs);
    }
}

__device__ __forceinline__ void phase_post2_even(Frame& F) {
    const bf16_t* P = (const bf16_t*)(F.ws + WS_P); const bf16_t* QM = (const bf16_t*)(F.ws + WS_QM); const bf16_t* KVM = (const bf16_t*)(F.ws + WS_ACT);
    const float* gq = F.a->in[IN_MLAQK]; const float* gk = F.a->in[IN_MLAQK] + 192;
    bf16_t* QA = (bf16_t*)(F.ws + WS_QA);
    constexpr int NROW = 16384, NVT_CTX = 1024, NVT_LAT = 2048, NVT_CAC = 1024;
    const int lane = F.lane, hsub = lane >> 5, c = lane & 31; const bool act = c < 24;
    for (int it = F.gw; it < NTOK + NROW + NVT_CTX + NVT_LAT + NVT_CAC; it += F.NGW) {
        if (it < NTOK) {
            const int t = it; const bool lat = t >= NCTX; const int s = (t - NCTX) & 1023; const float row = (float)(s >> 6), col = (float)(s & 63);
            const int cc = act ? c : 23, cpq = cc >= 16 ? (cc ^ 2) : cc;
            float g[8], gp[8]; load8(gq + 8 * cc, g); load8(gq + 8 * cpq, gp);
            float v[4][8], vp[4][8];
#pragma unroll
            for (int pass = 0; pass < 4; ++pass) { const bf16_t* src = QM + (size_t)t * 1536 + (2 * pass + hsub) * 192; load8h(src + 8 * cc, v[pass]); load8h(src + 8 * cpq, vp[pass]); }
#pragma unroll
            for (int pass = 0; pass < 4; ++pass) {
                const int head = 2 * pass + hsub;
                float q = 0.f;
#pragma unroll
                for (int i = 0; i < 8; ++i) { v[pass][i] = act ? v[pass][i] : 0.f; q += v[pass][i] * v[pass][i]; }
                const float rstd = __builtin_amdgcn_rsqf(group_sum<32>(q) * (1.0f / 192) + EPS);
#pragma unroll
                for (int i = 0; i < 8; ++i) { v[pass][i] = v[pass][i] * rstd * g[i]; vp[pass][i] = vp[pass][i] * rstd * gp[i]; }
                if (lat && c >= 16 && act) rope8(v[pass], vp[pass], (c & 2) == 0, c < 20 ? row : col, (c & 1) * 8, 1.0f / 16);
                if (act) *(u32x4*)(QA + (size_t)t * 1536 + head * 192 + 8 * c) = pack8(v[pass]);
            }
        } else if (it < NTOK + NROW) {
            const int r = it - NTOK; const bool istok = r < NTOK; const bool lat = istok && r >= NCTX;
            int bsel, s; bf16_t* kb0; int nkeys;
            if (!istok) { bsel = (r - NTOK) >> 9; s = (r - NTOK) & 511; kb0 = (bf16_t*)(F.ws + WS_KM_CAC); nkeys = 512; }
            else if (lat) { bsel = (r - NCTX) >> 10; s = (r - NCTX) & 1023; kb0 = (bf16_t*)(F.ws + WS_KM_LAT); nkeys = 1024; }
            else { bsel = r >> 8; s = r & 255; kb0 = (bf16_t*)(F.ws + WS_KM_CTX); nkeys = 256; }
            const float* krp_f = istok ? (const float*)(F.ws + WS_KROPE) + (size_t)r * 64 : F.a->in[IN_C_KROPE] + (size_t)(r - NTOK) * 64;
            const float row = (float)(s >> 6), col = (float)(s & 63);
            const int cc = act ? c : 23, cpq = cc >= 16 ? (cc ^ 2) : cc, cn = c < 16 ? c : 15, cr = cc >= 16 ? cc - 16 : 0, crp = cc >= 16 ? cpq - 16 : 0;
            float g[8], gp[8], kr[8], krp[8]; load8(gk + 8 * cc, g); load8(gk + 8 * cpq, gp); load8(krp_f + 8 * cr, kr); load8(krp_f + 8 * crp, krp);
            float v[4][8];
#pragma unroll
            for (int pass = 0; pass < 4; ++pass) load8h(KVM + (size_t)r * 2048 + (2 * pass + hsub) * 256 + 8 * cn, v[pass]);
#pragma unroll
            for (int pass = 0; pass < 4; ++pass) {
                const int head = 2 * pass + hsub;
                float vp[8]; float q = 0.f;
#pragma unroll
                for (int i = 0; i < 8; ++i) { v[pass][i] = c < 16 ? v[pass][i] : (act ? kr[i] : 0.f); q += v[pass][i] * v[pass][i]; }
                const float rstd = __builtin_amdgcn_rsqf(group_sum<32>(q) * (1.0f / 192) + EPS);
#pragma unroll
                for (int i = 0; i < 8; ++i) { v[pass][i] = v[pass][i] * rstd * g[i]; vp[i] = krp[i] * rstd * gp[i]; }
                if (lat && c >= 16 && act) rope8(v[pass], vp, (c & 2) == 0, c < 20 ? row : col, (c & 1) * 8, 1.0f / 16);
                if (act) *(u32x4*)(kb0 + (size_t)(bsel * 8 + head) * ((size_t)nkeys * 192) + k_chunk_off(192, s, c)) = pack8(v[pass]);
            }
        } else {
            int r = it - NTOK - NROW;
            if (r < NVT_CTX) { const int t32 = r & 7, bh = r >> 3, b = bh >> 3, h = bh & 7;
                vt_tile_write_h(KVM + (size_t)(b * 256 + t32 * 32) * 2048 + h * 256 + 128, 2048, (bf16_t*)(F.ws + WS_VM_CTX) + (size_t)bh * (256 * 128) + (size_t)t32 * 4096, lane);
            } else if (r < NVT_CTX + NVT_LAT) { r -= NVT_CTX; const int t32 = r & 31, bh = r >> 5, b = bh >> 3, h = bh & 7;
                vt_tile_write_h(KVM + (size_t)(NCTX + b * 1024 + t32 * 32) * 2048 + h * 256 + 128, 2048, (bf16_t*)(F.ws + WS_VM_LAT) + (size_t)bh * (1024 * 128) + (size_t)t32 * 4096, lane);
            } else { r -= NVT_CTX + NVT_LAT; const int t32 = r & 15, bh = r >> 4, b = bh >> 3, h = bh & 7;
                vt_tile_write_h(KVM + (size_t)(NTOK + b * 512 + t32 * 32) * 2048 + h * 256 + 128, 2048, (bf16_t*)(F.ws + WS_VM_CAC) + (size_t)bh * (512 * 128) + (size_t)t32 * 4096, lane);
            }
        }
    }
}

__device__ __forceinline__ void phase_post_odd(Frame& F) {
    const bf16_t* P = (const bf16_t*)(F.ws + WS_P); const float* gq = F.a->in[IN_GQK]; const float* gk = F.a->in[IN_GQK] + 128;
    bf16_t* QA = (bf16_t*)(F.ws + WS_QA);
    constexpr int NVT_CTX = 16 * 4 * 8, NVT_LAT = 8 * 4 * 32;
    const int lane = F.lane, hsub = lane >> 4, c = lane & 15;
    for (int it = F.gw; it < NTOK + NVT_CTX + NVT_LAT; it += F.NGW) {
        if (it < NTOK) {
            const int t = it; const bool ctx = t < NCTX, lat = !ctx; const bf16_t* pr = P + (size_t)t * IN_ODD;
            int b, s; if (ctx) { b = t >> 8; s = t & 255; } else { b = (t - NCTX) >> 10; s = (t - NCTX) & 1023; }
            const float row = (float)(s >> 6), col = (float)(s & 63);
            const int cp = c ^ 4;
            float gqv[8], gqp[8], gkv[8], gkp[8]; load8(gq + 8 * c, gqv); load8(gq + 8 * cp, gqp); load8(gk + 8 * c, gkv); load8(gk + 8 * cp, gkp);
            float v[5][8], vp[5][8];
#pragma unroll
            for (int pass = 0; pass < 5; ++pass) { const bf16_t* src = pr + (pass == 4 ? 2048 + hsub * 128 : (4 * pass + hsub) * 128); load8h(src + 8 * c, v[pass]); load8h(src + 8 * cp, vp[pass]); }
#pragma unroll
            for (int pass = 0; pass < 5; ++pass) {
                const bool isk = pass == 4; const int head = isk ? hsub : 4 * pass + hsub;
                float q = 0.f;
#pragma unroll
                for (int i = 0; i < 8; ++i) q += v[pass][i] * v[pass][i];
                const float rstd = __builtin_amdgcn_rsqf(group_sum<16>(q) * (1.0f / 128) + EPS);
#pragma unroll
                for (int i = 0; i < 8; ++i) { v[pass][i] = v[pass][i] * rstd * (isk ? gkv[i] : gqv[i]); vp[pass][i] = vp[pass][i] * rstd * (isk ? gkp[i] : gqp[i]); }
                if (isk && ctx) store8f(F.out + O_GK + (size_t)t * 512 + head * 128 + 8 * c, v[pass]);
                if (lat) rope8(v[pass], vp[pass], (c & 4) == 0, c < 8 ? row : col, (c & 3) * 8, 1.0f / 32);
                if (!isk) *(u32x4*)(QA + (size_t)t * 2048 + head * 128 + 8 * c) = pack8(v[pass]);
                else { bf16_t* kb = ctx ? (bf16_t*)(F.ws + WS_KG_CTX) + (size_t)(b * 4 + head) * (256 * 128) : (bf16_t*)(F.ws + WS_KG_LAT) + (size_t)(b * 4 + head) * (1024 * 128);
                    *(u32x4*)(kb + k_chunk_off(128, s, c)) = pack8(v[pass]); }
            }
            { float vv[8]; load8h(pr + 2560 + 8 * lane, vv); if (ctx) store8f(F.out + O_GV + (size_t)t * 512 + 8 * lane, vv); }
        } else {
            int r = it - NTOK;
            if (r < NVT_CTX) { const int t32 = r & 7, bh = r >> 3, b = bh >> 2, h = bh & 3;
                vt_tile_write_h(P + (size_t)(b * 256 + t32 * 32) * IN_ODD + 2560 + h * 128, IN_ODD, (bf16_t*)(F.ws + WS_VG_CTX) + (size_t)bh * (256 * 128) + (size_t)t32 * 4096, lane);
            } else { r -= NVT_CTX; const int t32 = r & 31, bh = r >> 5, b = bh >> 2, h = bh & 3;
                vt_tile_write_h(P + (size_t)(NCTX + b * 1024 + t32 * 32) * IN_ODD + 2560 + h * 128, IN_ODD, (bf16_t*)(F.ws + WS_VG_LAT) + (size_t)bh * (1024 * 128) + (size_t)t32 * 4096, lane);
            }
        }
    }
}

struct WgUnit {
    const bf16_t* kc; const bf16_t* vc; int nctx;
    const bf16_t* kl; const bf16_t* vl; int t_lo, t_hi;
};
struct WvUnit {
    const bf16_t* qb; unsigned qoff; int qpitch; bf16_t* ob; unsigned ooff;
    int qpos;
    int qcol0;
    int w_lo, w_hi;
    float sink; int has_sink; float scale;
};
constexpr int ATT_RPB_OFF = RING_BYTES + 512;
constexpr float ATT_THR = 8.0f;
template <int MODE>
__device__ __forceinline__ float attn_mask(float v, int tile32, int r, int hh, int ql, bool masked, const WvUnit& U, const LAS float* rpb) {
    const int kk = (r & 3) + 8 * (r >> 2) + 4 * hh;
    if (MODE == 1) { const int df = U.qpos + ql - (tile32 * 32 + kk); if (masked && (df > 128 || df < -128)) v = -1e30f; }
    if (MODE == 2 && masked) { const int krow = tile32 >> 1, kcol = (tile32 & 1) * 32 + kk, qc = U.qcol0 + ql;
        int ws = qc - 8; ws = ws < 0 ? 0 : (ws > 48 ? 48 : ws);
        const bool valid = (kcol >= ws) && (kcol < ws + 16);
        int co = kcol - qc; co = co < -15 ? -15 : (co > 15 ? 15 : co);
        const float bias = rpb[(krow - U.qpos + 7) * 31 + co + 15];
        v = valid ? v + bias * LOG2E : -1e30f; }
    return v;
}
template <int OFF> __device__ __forceinline__ bf16x8 lds_rd(unsigned addr) { bf16x8 r; asm volatile("ds_read_b128 %0, %1 offset:%2" : "=v"(r) : "v"(addr), "i"(OFF)); return r; }
template <int BASE, int H1> __device__ __forceinline__ void lds_rd8(unsigned addr, bf16x8 (&a)[8]) {
    a[0] = lds_rd<BASE>(addr); a[1] = lds_rd<BASE + 1024>(addr); a[2] = lds_rd<BASE + 2048>(addr); a[3] = lds_rd<BASE + 3072>(addr);
    a[4] = lds_rd<BASE + H1>(addr); a[5] = lds_rd<BASE + H1 + 1024>(addr); a[6] = lds_rd<BASE + H1 + 2048>(addr); a[7] = lds_rd<BASE + H1 + 3072>(addr);
}
#define LDS_WAIT8(n, a) asm volatile("s_waitcnt lgkmcnt(" #n ")" : "+v"(a[0]), "+v"(a[1]), "+v"(a[2]), "+v"(a[3]), "+v"(a[4]), "+v"(a[5]), "+v"(a[6]), "+v"(a[7]))
#define QK_MMA8(a, kb) do { _Pragma("unroll") for (int _j = 0; _j < 4; ++_j) { s0 = __builtin_amdgcn_mfma_f32_32x32x16_bf16(a[_j], qf[(kb) * 4 + _j], s0, 0, 0, 0); s1 = __builtin_amdgcn_mfma_f32_32x32x16_bf16(a[4 + _j], qf[(kb) * 4 + _j], s1, 0, 0, 0); } } while (0)
__device__ __forceinline__ void na_mask16(f32x16& sx, int tile32, int hh, int ql, bool masked, const WvUnit& U, const LAS float* rpb) {
    const int krow = tile32 >> 1, kc0 = (tile32 & 1) * 32 + 4 * hh, qc = U.qcol0 + ql;
    int ws = qc - 8; ws = ws < 0 ? 0 : (ws > 48 ? 48 : ws);
    int ro = krow - U.qpos + 7; ro = ro < 0 ? 0 : (ro > 14 ? 14 : ro);
    const LAS float* rrow = rpb + ro * 31 + 15;
    float bias[16];
#pragma unroll
    for (int r = 0; r < 16; ++r) { int co = kc0 + (r & 3) + 8 * (r >> 2) - qc; co = co < -15 ? -15 : (co > 15 ? 15 : co); bias[r] = rrow[co]; }
#pragma unroll
    for (int r = 0; r < 16; ++r) { const int kcol = kc0 + (r & 3) + 8 * (r >> 2); const float mv = ((unsigned)(kcol - ws) < 16u) ? sx[r] + bias[r] * LOG2E : -1e30f; sx[r] = masked ? mv : sx[r]; }
}
template <int DQK, int MODE>
__device__ __forceinline__ void attn_tile64(const LAS unsigned char* sl, int t64, bool masked, const bf16x8 (&qf)[DQK / 16], f32x16 (&o)[4], float& m, float& l, const WvUnit& U, const LAS float* rpb, int lane, float sl2) {
    constexpr int NKS = DQK / 16, KB = DQK * 128;
    const int ql = lane & 31, hh = lane >> 5;
    const unsigned addr = (unsigned)(unsigned long)sl + (unsigned)lane * 16u;
    f32x16 s0, s1;
#pragma unroll
    for (int r = 0; r < 16; ++r) { s0[r] = 0.f; s1[r] = 0.f; }
    bf16x8 pb[4];
#define ATT_SMA(sx, T32) do { float mt = -1e30f; \
    if (MODE == 1) { if (masked) {   \
            _Pragma("unroll") for (int r = 0; r < 16; ++r) sx[r] = attn_mask<MODE>(sx[r] * sl2, (T32), r, hh, ql, true, U, rpb); } } \
    if (MODE == 2) { _Pragma("unroll") for (int r = 0; r < 16; ++r) sx[r] *= sl2; na_mask16(sx, (T32), hh, ql, masked, U, rpb); } \
    _Pragma("unroll") for (int r = 0; r < 16; ++r) mt = fmaxf(mt, sx[r]); \
    if (MODE == 0 || (MODE == 1 && !masked)) mt *= sl2;     \
    mt = fmaxf(mt, __shfl_xor(mt, 32)); \
    if (!__all(mt - m <= ATT_THR)) { const float mn = fmaxf(m, mt), alpha = fast_exp2(m - mn); m = mn; l *= alpha; \
        _Pragma("unroll") for (int db = 0; db < 4; ++db) _Pragma("unroll") for (int r = 0; r < 16; ++r) o[db][r] *= alpha; } } while (0)
#define ATT_SMB(sx, PBI) do { float ps = 0.f; const float esc = (MODE == 0 || (MODE == 1 && !masked)) ? sl2 : 1.0f; \
    _Pragma("unroll") for (int r = 0; r < 16; ++r) { sx[r] = fast_exp2(fmaf(sx[r], esc, -m)); ps += sx[r]; } \
    l += ps; \
    _Pragma("unroll") for (int s2 = 0; s2 < 2; ++s2) { \
        u32x4 w; w.x = pk2(sx[8 * s2 + 0], sx[8 * s2 + 1]); w.y = pk2(sx[8 * s2 + 2], sx[8 * s2 + 3]); w.z = pk2(sx[8 * s2 + 4], sx[8 * s2 + 5]); w.w = pk2(sx[8 * s2 + 6], sx[8 * s2 + 7]); pb[(PBI) + s2] = __builtin_bit_cast(bf16x8, w); } } while (0)
#define MFMA32(a_, b_, c_) __builtin_amdgcn_mfma_f32_32x32x16_bf16(a_, b_, c_, 0, 0, 0)
    if constexpr (NKS == 8) {
        bf16x8 ka[8], kb_[8];
        lds_rd8<0, 4096>(addr, ka); lds_rd8<KB / 2, 4096>(addr, kb_);
        LDS_WAIT8(8, ka);
#pragma unroll
        for (int j = 0; j < 8; ++j) s0 = MFMA32(ka[j], qf[j], s0);
        if (MODE != 2) { lds_rd8<KB, 4096>(addr, ka); LDS_WAIT8(8, kb_); } else LDS_WAIT8(0, kb_);
#pragma unroll
        for (int j = 0; j < 4; ++j) s1 = MFMA32(kb_[j], qf[j], s1);
        ATT_SMA(s0, 2 * t64);
        if (MODE == 2) lds_rd8<KB, 4096>(addr, ka);
#pragma unroll
        for (int j = 4; j < 8; ++j) s1 = MFMA32(kb_[j], qf[j], s1);
        ATT_SMB(s0, 0);
        lds_rd8<KB + 8192, 4096>(addr, kb_);
        LDS_WAIT8(8, ka);
#pragma unroll
        for (int db = 0; db < 4; ++db) o[db] = MFMA32(ka[db], pb[0], o[db]);
        ATT_SMA(s1, 2 * t64 + 1);
#pragma unroll
        for (int db = 0; db < 4; ++db) o[db] = MFMA32(ka[4 + db], pb[1], o[db]);
        ATT_SMB(s1, 2);
        LDS_WAIT8(0, kb_);
#pragma unroll
        for (int s2 = 0; s2 < 2; ++s2)
#pragma unroll
            for (int db = 0; db < 4; ++db) o[db] = MFMA32(kb_[s2 * 4 + db], pb[2 + s2], o[db]);
    } else {
        bf16x8 ka[4], kb_[4];
#define RDK4(a, h, b) do { a[0] = lds_rd<(h) * (KB / 2) + (b) * 4096>(addr); a[1] = lds_rd<(h) * (KB / 2) + (b) * 4096 + 1024>(addr); a[2] = lds_rd<(h) * (KB / 2) + (b) * 4096 + 2048>(addr); a[3] = lds_rd<(h) * (KB / 2) + (b) * 4096 + 3072>(addr); } while (0)
#define RDV4(a, q) do { a[0] = lds_rd<KB + (q) * 4096>(addr); a[1] = lds_rd<KB + (q) * 4096 + 1024>(addr); a[2] = lds_rd<KB + (q) * 4096 + 2048>(addr); a[3] = lds_rd<KB + (q) * 4096 + 3072>(addr); } while (0)
#define WAIT4(n, a) asm volatile("s_waitcnt lgkmcnt(" #n ")" : "+v"(a[0]), "+v"(a[1]), "+v"(a[2]), "+v"(a[3]))
#define QK4(a, sx, b) do { _Pragma("unroll") for (int j = 0; j < 4; ++j) sx = MFMA32(a[j], qf[4 * (b) + j], sx); } while (0)
#define PV4(a, q) do { _Pragma("unroll") for (int db = 0; db < 4; ++db) o[db] = MFMA32(a[db], pb[q], o[db]); } while (0)
        RDK4(ka, 0, 0); RDK4(kb_, 0, 1);
        WAIT4(4, ka); QK4(ka, s0, 0); RDK4(ka, 0, 2);
        WAIT4(4, kb_); QK4(kb_, s0, 1); RDK4(kb_, 1, 0);
        WAIT4(4, ka); QK4(ka, s0, 2); RDK4(ka, 1, 1);
        WAIT4(4, kb_); QK4(kb_, s1, 0); RDK4(kb_, 1, 2);
        ATT_SMA(s0, 2 * t64);
        WAIT4(4, ka); QK4(ka, s1, 1); RDV4(ka, 0);
        ATT_SMB(s0, 0);
        WAIT4(4, kb_); QK4(kb_, s1, 2); RDV4(kb_, 1);
        WAIT4(4, ka); PV4(ka, 0); RDV4(ka, 2);
        ATT_SMA(s1, 2 * t64 + 1);
        WAIT4(4, kb_); PV4(kb_, 1); RDV4(kb_, 3);
        ATT_SMB(s1, 2);
        WAIT4(4, ka); PV4(ka, 2);
        WAIT4(0, kb_); PV4(kb_, 3);
#undef RDK4
#undef RDV4
#undef WAIT4
#undef QK4
#undef PV4
    }
#undef ATT_SMA
#undef ATT_SMB
#undef MFMA32
}
template <int DQK, int MODE, int VAR = 0>
__device__ __forceinline__ void attn_wg_unit(LAS unsigned char* ring, const WgUnit& G, const WvUnit& U, const float* rpb_g, int tid, int wave, int lane) {
    constexpr int NKS = DQK / 16, KB = DQK * 128, NLK = KB / 8192;
    constexpr int NS = (DQK == 128) ? 4 : 3, SLOTB = KB + 16384;
    const int ql = lane & 31, hh = lane >> 5;
    const int ntiles = G.nctx + (G.t_hi - G.t_lo);
    const LAS float* rpb = (const LAS float*)(ring + ATT_RPB_OFF);
#define ATT_ISSUE(i, SLOTC) do { const int _i = (i); const bool _c = _i < G.nctx; const int _t = _c ? _i : G.t_lo + (_i - G.nctx); \
        const char* _kg = (const char*)(_c ? G.kc : G.kl) + (size_t)_t * KB + tid * 16; const char* _vg = (const char*)(_c ? G.vc : G.vl) + (size_t)_t * 16384 + tid * 16; \
        LAS unsigned char* _sl = ring + (SLOTC) * SLOTB + wave * 1024; \
        _Pragma("unroll") for (int _p = 0; _p < NLK; ++_p) __builtin_amdgcn_global_load_lds((const unsigned*)(_kg + _p * 8192), (LAS unsigned*)(_sl + _p * 8192), 16, 0, 0); \
        _Pragma("unroll") for (int _p = 0; _p < 2; ++_p) __builtin_amdgcn_global_load_lds((const unsigned*)(_vg + _p * 8192), (LAS unsigned*)(_sl + KB + _p * 8192), 16, 0, 0); } while (0)
    asm volatile("s_waitcnt lgkmcnt(0)" ::: "memory"); __builtin_amdgcn_s_barrier(); asm volatile("" ::: "memory");
    bf16x8 qf[NKS];
#pragma unroll
    for (int ks = 0; ks < NKS; ++ks) qf[ks] = *(const bf16x8*)(U.qb + (size_t)(U.qoff + (unsigned)(ql * U.qpitch + 16 * ks + 8 * hh)));
    if (MODE == 2) { const int i = opaque_v(tid); if (i < 15 * 31) ((LAS float*)(ring + ATT_RPB_OFF))[i] = rpb_g[i]; }
    if (VAR != 2) { ATT_ISSUE(0, 0); if (ntiles > 1) ATT_ISSUE(1, 1); if (NS == 4 && ntiles > 2) ATT_ISSUE(2, 2); }
    f32x16 o[4];
#pragma unroll
    for (int db = 0; db < 4; ++db)
#pragma unroll
        for (int r = 0; r < 16; ++r) o[db][r] = 0.f;
    float m = -1e30f, l = 0.f;
    const float sl2 = U.scale * LOG2E;
#define ATT_STEP(i_, SLOTC) do { const int i = (i_); if (i < ntiles) { \
        if (NS == 4) { if (i + 2 < ntiles) asm volatile("s_waitcnt vmcnt(8)" ::: "memory"); else if (i + 1 < ntiles) asm volatile("s_waitcnt vmcnt(4)" ::: "memory"); else asm volatile("s_waitcnt vmcnt(0)" ::: "memory"); } \
        else { if (i + 1 < ntiles) asm volatile("s_waitcnt vmcnt(5)" ::: "memory"); else asm volatile("s_waitcnt vmcnt(0)" ::: "memory"); } \
        asm volatile("s_waitcnt lgkmcnt(0)" ::: "memory"); __builtin_amdgcn_s_barrier(); asm volatile("" ::: "memory"); \
        if (VAR != 2 && i + NS - 1 < ntiles) ATT_ISSUE(i + NS - 1, ((SLOTC) + NS - 1) % NS); \
        const bool isctx = i < G.nctx; const int t64 = isctx ? 0 : G.t_lo + (i - G.nctx); \
        if (VAR != 1 && (isctx || (t64 >= U.w_lo && t64 < U.w_hi))) attn_tile64<DQK, MODE>(ring + (SLOTC) * SLOTB, t64, !isctx, qf, o, m, l, U, rpb, lane, sl2); } } while (0)
    if constexpr (NS == 4) { for (int i0 = 0; i0 < ntiles; i0 += 4) { ATT_STEP(i0, 0); ATT_STEP(i0 + 1, 1); ATT_STEP(i0 + 2, 2); ATT_STEP(i0 + 3, 3); } }
    else { for (int i0 = 0; i0 < ntiles; i0 += 3) { ATT_STEP(i0, 0); ATT_STEP(i0 + 1, 1); ATT_STEP(i0 + 2, 2); } }
#undef ATT_STEP
#undef ATT_ISSUE
    l += __shfl_xor(l, 32);
    if (U.has_sink) l += fast_exp2(U.sink * LOG2E - m);
    const float inv = 1.0f / l;
    bf16_t* op = U.ob + (size_t)(U.ooff + (unsigned)(opaque_v(ql) * DM));
#pragma unroll
    for (int db = 0; db < 4; ++db)
#pragma unroll
        for (int k = 0; k < 2; ++k) {
            const unsigned p0x = pk2(o[db][8 * k] * inv, o[db][8 * k + 1] * inv), p0y = pk2(o[db][8 * k + 2] * inv, o[db][8 * k + 3] * inv);
            const unsigned p1x = pk2(o[db][8 * k + 4] * inv, o[db][8 * k + 5] * inv), p1y = pk2(o[db][8 * k + 6] * inv, o[db][8 * k + 7] * inv);
            const auto sx = __builtin_amdgcn_permlane32_swap(p0x, p1x, false, false);
            const auto sy = __builtin_amdgcn_permlane32_swap(p0y, p1y, false, false);
            u32x4 w; w.x = sx[0]; w.y = sy[0]; w.z = sx[1]; w.w = sy[1];
            *(u32x4*)(op + 32 * db + 16 * k + 8 * hh) = w; }
}

template <int VAR>
__device__ __forceinline__ void phase_attn_even(Frame& F, bf16_t* O) {
 const bf16_t* QA = (const bf16_t*)(F.ws + WS_QA); const bf16_t* QNA = (const bf16_t*)(F.ws + WS_QNA);
    const int wave = F.wave, lane = F.lane, tid = F.tid;
    WgUnit G; WvUnit U; U.sink = 0.f; U.has_sink = 0; U.qpos = 0; U.qcol0 = 0;
    const int vcu = (F.G % 8 == 0) ? ((int)blockIdx.x % 8) * (F.G / 8) + (int)blockIdx.x / 8 : (int)blockIdx.x;
    for (int u = vcu; u < 256; u += F.G) { const int bh = u >> 2, q4 = u & 3, b = bh >> 3, h = bh & 7, t0 = NCTX + b * 1024 + q4 * 256 + 32 * wave;
        U.qb = QA; U.qoff = (unsigned)(t0 * 1536 + h * 192); U.qpitch = 1536; U.scale = 0.07216878364870322f; U.ob = O; U.ooff = (unsigned)(t0 * DM + h * 128);
        G.kc = (const bf16_t*)(F.ws + WS_KM_CAC) + (size_t)bh * (512 * 192); G.vc = (const bf16_t*)(F.ws + WS_VM_CAC) + (size_t)bh * (512 * 128); G.nctx = 8;
        G.kl = (const bf16_t*)(F.ws + WS_KM_LAT) + (size_t)bh * (1024 * 192); G.vl = (const bf16_t*)(F.ws + WS_VM_LAT) + (size_t)bh * (1024 * 128); G.t_lo = 0; G.t_hi = 16; U.w_lo = 0; U.w_hi = 16;
        attn_wg_unit<192, 0, VAR>(F.lds, G, U, nullptr, tid, wave, lane); }
    for (int u = vcu; u < 256; u += F.G) { const int bh = u >> 2, r0 = (u & 3) * 4, b = bh >> 3, h = bh & 7, r = r0 + (wave >> 1), c0 = (wave & 1) * 32, t0 = NCTX + b * 1024 + r * 64 + c0;
        int rs = r - 4; rs = rs < 0 ? 0 : (rs > 8 ? 8 : rs);
        int glo = r0 - 4; glo = glo < 0 ? 0 : (glo > 8 ? 8 : glo); int ghi = r0 - 1; ghi = ghi < 0 ? 0 : (ghi > 8 ? 8 : ghi);
        U.qb = QNA; U.qoff = (unsigned)(t0 * 1024 + h * 128); U.qpitch = 1024; U.scale = 0.08838834764831845f; U.ob = O; U.ooff = (unsigned)(t0 * DM + 1024 + h * 128);
        G.kc = (const bf16_t*)(F.ws + WS_KN_CAC) + (size_t)bh * (512 * 128); G.vc = (const bf16_t*)(F.ws + WS_VN_CAC) + (size_t)bh * (512 * 128); G.nctx = 8;
        G.kl = (const bf16_t*)(F.ws + WS_KN_LAT) + (size_t)bh * (1024 * 128); G.vl = (const bf16_t*)(F.ws + WS_VN_LAT) + (size_t)bh * (1024 * 128); G.t_lo = glo; G.t_hi = ghi + 8; U.w_lo = rs; U.w_hi = rs + 8;
        U.qpos = r; U.qcol0 = c0;
        attn_wg_unit<128, 2, VAR>(F.lds, G, U, F.a->in[IN_RPB] + h * (15 * 31), tid, wave, lane); }
    U.qpos = 0; U.qcol0 = 0; U.w_lo = 0; U.w_hi = 4; G.nctx = 0; G.kc = nullptr; G.vc = nullptr; G.t_lo = 0; G.t_hi = 4;
    for (int u = vcu; u < 256; u += F.G) { const int bh = u & 127, b = bh >> 3, h = bh & 7, t0 = b * 256 + 32 * wave;
        if (u < 128) {
            U.qb = QA; U.qoff = (unsigned)(t0 * 1536 + h * 192); U.qpitch = 1536; U.scale = 0.07216878364870322f; U.ob = O; U.ooff = (unsigned)(t0 * DM + h * 128);
            G.kl = (const bf16_t*)(F.ws + WS_KM_CTX) + (size_t)bh * (256 * 192); G.vl = (const bf16_t*)(F.ws + WS_VM_CTX) + (size_t)bh * (256 * 128);
            attn_wg_unit<192, 0, VAR>(F.lds, G, U, nullptr, tid, wave, lane);
        } else {
            U.qb = QNA; U.qoff = (unsigned)(t0 * 1024 + h * 128); U.qpitch = 1024; U.scale = 0.08838834764831845f; U.ob = O; U.ooff = (unsigned)(t0 * DM + 1024 + h * 128);
            G.kl = (const bf16_t*)(F.ws + WS_KN_CTX) + (size_t)bh * (256 * 128); G.vl = (const bf16_t*)(F.ws + WS_VN_CTX) + (size_t)bh * (256 * 128);
            attn_wg_unit<128, 0, VAR>(F.lds, G, U, nullptr, tid, wave, lane);
        } }
    asm volatile("s_waitcnt vmcnt(0) lgkmcnt(0)" ::: "memory"); __syncthreads();
}
__device__ __forceinline__ void phase_attn_odd(Frame& F) {
    bf16_t* O = (bf16_t*)(F.ws + WS_O); const bf16_t* QA = (const bf16_t*)(F.ws + WS_QA);
    const int wave = F.wave, lane = F.lane, tid = F.tid;
    WgUnit G; WvUnit U; U.has_sink = 1; U.qcol0 = 0; U.qpitch = 2048; U.scale = 0.08838834764831845f;
    const int vcu = (F.G % 8 == 0) ? ((int)blockIdx.x % 8) * (F.G / 8) + (int)blockIdx.x / 8 : (int)blockIdx.x;
    const float* sink = F.a->in[IN_SINK];
    for (int u = vcu; u < 512; u += F.G) { const int bk = u >> 4, q64 = u & 15, b = bk >> 2, kvh = bk & 3, g = wave >> 1, hq = kvh * 4 + g, qs = q64 * 64 + (wave & 1) * 32, t0 = NCTX + b * 1024 + qs;
        U.qb = QA; U.qoff = (unsigned)(t0 * 2048 + hq * 128); U.ob = O; U.ooff = (unsigned)(t0 * DM + hq * 128); U.qpos = qs; U.sink = sink[hq];
        G.kc = (const bf16_t*)(F.ws + WS_KG_CAC) + (size_t)bk * (512 * 128); G.vc = (const bf16_t*)(F.ws + WS_VG_CAC) + (size_t)bk * (512 * 128); G.nctx = 8;
        G.kl = (const bf16_t*)(F.ws + WS_KG_LAT) + (size_t)bk * (1024 * 128); G.vl = (const bf16_t*)(F.ws + WS_VG_LAT) + (size_t)bk * (1024 * 128);
        G.t_lo = q64 - 2 < 0 ? 0 : q64 - 2; G.t_hi = (q64 + 2 > 15 ? 15 : q64 + 2) + 1; U.w_lo = G.t_lo; U.w_hi = G.t_hi;
        attn_wg_unit<128, 1>(F.lds, G, U, nullptr, tid, wave, lane); }
    G.nctx = 0; G.kc = nullptr; G.vc = nullptr; G.t_lo = 0; G.t_hi = 4; U.w_lo = 0; U.w_hi = 4;
    for (int u = vcu; u < 256; u += F.G) { const int bk = u >> 2, q64 = u & 3, b = bk >> 2, kvh = bk & 3, g = wave >> 1, hq = kvh * 4 + g, qs = q64 * 64 + (wave & 1) * 32, t0 = b * 256 + qs;
        U.qb = QA; U.qoff = (unsigned)(t0 * 2048 + hq * 128); U.ob = O; U.ooff = (unsigned)(t0 * DM + hq * 128); U.qpos = 0; U.sink = sink[hq];
        G.kl = (const bf16_t*)(F.ws + WS_KG_CTX) + (size_t)bk * (256 * 128); G.vl = (const bf16_t*)(F.ws + WS_VG_CTX) + (size_t)bk * (256 * 128);
        attn_wg_unit<128, 0>(F.lds, G, U, nullptr, tid, wave, lane); }
    asm volatile("s_waitcnt vmcnt(0) lgkmcnt(0)" ::: "memory"); __syncthreads();
}

constexpr int N_PHASES = 36;
__global__ void __launch_bounds__(512, 2) fwd_kernel(Args args) {
    extern __shared__ __attribute__((aligned(16))) unsigned char lds_raw[];
    Frame F;
    F.lds = (LAS unsigned char*)lds_raw;
    F.tid = threadIdx.x; F.lane = F.tid & 63; F.wave = __builtin_amdgcn_readfirstlane(F.tid >> 6);
    F.G = gridDim.x; F.gw = blockIdx.x * 8 + F.wave; F.NGW = F.G * 8;
    F.a = &args; F.out = args.out; F.ws = args.ws;
    volatile LAS unsigned* MISC = (volatile LAS unsigned*)(F.lds + LDSCTL_OFF);
    for (int u = F.tid; u < (LDS_BYTES - LDSCTL_OFF) / 4; u += 512) ((LAS unsigned*)(F.lds + LDSCTL_OFF))[u] = 0u;
    __syncthreads();
    unsigned* ctl = (unsigned*)(F.ws + WS_CTL);
    const int lo = args.ph_lo, hi = args.ph_hi;
    const bool multi = (hi - lo) > 1;
    XcdBarrier bar; bar.bar = ctl + CW_BAR; bar.x = 0; bar.st = nullptr;
    if (multi) bar = xcd_barrier_post(ctl + CW_BAR, MISC + 8);
#define IN(k) (lo <= (k) && (k) < hi)
    int ph = 0;
#define PHASE(...) do { if (IN(ph)) { __VA_ARGS__ } if (IN(ph) && IN(ph + 1)) xcd_barrier(bar); ++ph; } while (0)
    const float* mods = (const float*)(F.ws + WS_MODS);
    bf16_t* H = (bf16_t*)(F.ws + WS_H); bf16_t* ACT = (bf16_t*)(F.ws + WS_ACT); float* P = (float*)(F.ws + WS_P); bf16_t* OB = (bf16_t*)(F.ws + WS_O);
    LAS unsigned char* ring = F.lds;
    const int cid = (int)blockIdx.x;
#define GEMM2(EPI_T, EDEF, A_, B_, M_, N_, K_, SLAB) \
    PHASE( pg8::Gemm g{(A_), (B_), (M_), (N_), (K_)}; typedef pg8::SplitOrder<(M_), (N_), (K_), true> SO; SO S; S.init(cid); EDEF; pg8::gemm_phase<EPI_T, SO, true, true>(ring, g, S, E, (SLAB)); ); \
    PHASE( typedef pg8::SplitOrder<(M_), (N_), (K_), true> SO; EDEF; pg8::gemm_fixup<EPI_T, SO>(E, (SLAB)); )
#define GEMM1(EPI_T, EDEF, A_, B_, M_, N_, K_) \
    PHASE( pg8::Gemm g{(A_), (B_), (M_), (N_), (K_)}; typedef pg8::SplitOrder<(M_), (N_), (K_), false> SO; SO S; S.init(cid); EDEF; pg8::gemm_phase<EPI_T, SO, true, true>(ring, g, S, E, nullptr); )
#define W_FI(layer, f) ((const bf16_t*)(F.ws + WS_WFI) + (size_t)((layer) * 2 + (f)) * NFF2 * DM)
#define W_FO(layer, f) ((const bf16_t*)(F.ws + WS_WFO) + (size_t)((layer) * 2 + (f)) * DM * DFF)
#define E_SWIGLU EpiSwiGLU E{ACT}
#define E_RESID(RT, layer, gidx, coef) RT E{F.a->in[IN_XP], F.a->in[IN_XS], (bf16_t*)(F.ws + WS_XB), F.out, mods + (size_t)(layer) * 9 * NMOD + (size_t)(gidx) * DM, (coef)}
#define FFN(layer, f, RT) \
    GEMM2(EpiSwiGLU, E_SWIGLU, H, W_FI(layer, f), NTOK, NFF2, DM, P); \
    GEMM2(RT, E_RESID(RT, layer, (f) ? 8 : 2, 0.5f), ACT, W_FO(layer, f), NTOK, DM, DFF, P)

    PHASE( phase_prologue(F); );
    PHASE( phase_norm(F, true, 0, 0); );
    FFN(0, 0, ResidIn);
    PHASE( phase_norm(F, false, 0, 1); );
    GEMM1(EpiBf16, EpiBf16 E{(bf16_t*)P COMMA IN_EVEN_P}, H, (const bf16_t*)(F.ws + WS_WEI), NTOK, IN_EVEN_P, DM);
    PHASE( phase_post1_even(F); );
    PHASE( { pg8::Gemm g{(const bf16_t*)(F.ws + WS_CQN), (const bf16_t*)(F.ws + WS_WQU), NTOK, 1536, 512}; typedef pg8::SplitOrder<NTOK, 1536, 512, false> SO; SO S; S.init(cid);
             EpiBf16 E{(bf16_t*)(F.ws + WS_QM), 1536}; pg8::gemm_phase<EpiBf16, SO, true, true>(ring, g, S, E, nullptr); }
           { pg8::Gemm g{(const bf16_t*)(F.ws + WS_CKVA), (const bf16_t*)(F.ws + WS_WKU), 16384, 2048, 512}; typedef pg8::SplitOrder<16384, 2048, 512, false> SO; SO S; S.init(cid);
             EpiBf16 E{(bf16_t*)(F.ws + WS_ACT), 2048}; pg8::gemm_phase<EpiBf16, SO, true, true>(ring, g, S, E, nullptr); } );
    PHASE( phase_post2_even(F); );
    PHASE( phase_attn_even<0>(F, (bf16_t*)(F.ws + WS_O)); );
    GEMM2(ResidMid, E_RESID(ResidMid, 0, 5, 1.0f), OB, (const bf16_t*)(F.ws + WS_WEO), NTOK, DM, DM, P);
    PHASE( phase_norm(F, false, 0, 2); );
    FFN(0, 1, ResidMid);
    PHASE( phase_norm(F, false, 1, 0); );
    FFN(1, 0, ResidMid);
    PHASE( phase_norm(F, false, 1, 1); );
    GEMM2(EpiBf16, EpiBf16 E{(bf16_t*)P COMMA IN_ODD}, H, (const bf16_t*)(F.ws + WS_WOI), NTOK, IN_ODD, DM, (float*)(F.ws + WS_ACT));
    PHASE( phase_post_odd(F); );
    PHASE( phase_attn_odd(F); );
    GEMM2(ResidMid, E_RESID(ResidMid, 1, 5, 1.0f), OB, (const bf16_t*)(F.ws + WS_WOO), NTOK, DM, DM, P);
    PHASE( phase_norm(F, false, 1, 2); );
    FFN(1, 1, ResidOut);
#undef IN
}

extern "C" void kernel_launch(void* const* d_in, const int* in_sizes, int n_in, void* d_out, int out_size, void* d_ws, size_t ws_size, hipStream_t stream) {
    static int grid = 0;
    if (grid == 0) {
        if (n_in != 28 || (size_t)out_size != O_END || ws_size < WS_END) { fprintf(stderr, "kernel_launch: unexpected shapes (n_in %d, out %d, ws %zu; need ws >= %zu); nothing launched\n", n_in, out_size, ws_size, (size_t)WS_END); grid = -1; return; }
        int dev = 0, cus = 0, per_cu = 0;
        if (hipGetDevice(&dev) != hipSuccess || hipDeviceGetAttribute(&cus, hipDeviceAttributeMultiprocessorCount, dev) != hipSuccess) { grid = -1; return; }
        if (hipFuncSetAttribute((const void*)fwd_kernel, hipFuncAttributeMaxDynamicSharedMemorySize, LDS_BYTES) != hipSuccess) { fprintf(stderr, "kernel_launch: hipFuncSetAttribute failed\n"); grid = -1; return; }
        if (hipOccupancyMaxActiveBlocksPerMultiprocessor(&per_cu, (const void*)fwd_kernel, 512, LDS_BYTES) != hipSuccess || per_cu < 1) { fprintf(stderr, "kernel_launch: occupancy query says %d blocks per CU\n", per_cu); }
        (void)hipGetLastError();
        if (cus < pg8::GRID) { fprintf(stderr, "kernel_launch: %d CUs < %d workgroups: not resident; nothing launched\n", cus, pg8::GRID); grid = -1; return; }
        grid = pg8::GRID;
    }
    if (grid < 0) return;
    if (hipMemsetAsync((char*)d_ws + WS_CTL, 0, CTL_ZERO_BYTES, stream) != hipSuccess) return;
    Args a{};
    for (int i = 0; i < 28; ++i) a.in[i] = (const float*)d_in[i];
    a.out = (float*)d_out; a.ws = (unsigned char*)d_ws;
#if MK_ONE_LAUNCH
    a.ph_lo = 0; a.ph_hi = N_PHASES;
    hipLaunchKernelGGL(fwd_kernel, dim3(grid), dim3(512), LDS_BYTES, stream, a);
#else
    for (int p = 0; p < N_PHASES; ++p) { a.ph_lo = p; a.ph_hi = p + 1; hipLaunchKernelGGL(fwd_kernel, dim3(grid), dim3(512), LDS_BYTES, stream, a); }
#endif
}
```

```cpp
#include <hip/hip_runtime.h>
#include <cstdio>
#include <cstdint>

#ifndef MK_ONE_LAUNCH
#define MK_ONE_LAUNCH 1
#endif

#define COMMA ,
#define GAS __attribute__((address_space(1)))
#define LAS __attribute__((address_space(3)))
typedef unsigned short bf16_t;
typedef short bf16x8 __attribute__((ext_vector_type(8)));
typedef float f32x4 __attribute__((ext_vector_type(4)));
typedef float f32x16 __attribute__((ext_vector_type(16)));
typedef unsigned u32x4 __attribute__((ext_vector_type(4)));
typedef unsigned u32x2 __attribute__((ext_vector_type(2)));

namespace pg8 {
constexpr int BM = 256, BK = 64, HALF = 128, HTB = HALF * BK * 2, STAGE_BYTES = 8 * HTB, NXCD = 8, WGM = 8;
__host__ __device__ __forceinline__ int lds_byte(int r, int c) { const int st = (r >> 4) * 2 + (c >> 5), rr = r & 15, cc = c & 31, ob = rr * 64 + cc * 2; return st * 1024 + (ob ^ (((ob >> 9) & 1) << 5)); }
__host__ __device__ __forceinline__ void stage_rc(int b, int& R, int& C) { const int st = b / 1024, sb = b % 1024, swz = sb ^ (((sb >> 9) & 1) << 5); R = (st >> 1) * 16 + swz / 64; C = (st & 1) * 32 + (swz % 64) / 2; }
__host__ __device__ __forceinline__ int perm32(int rho) { const int n = rho >> 4, i = rho & 15; return 8 * (i >> 2) + 4 * n + (i & 3); }
struct Unit { int pm, pn, kt0, nkt, part; };
struct Gemm { const bf16_t* A; const bf16_t* Bt; int M, N, K; };
constexpr int GRID = 256;
template <int M, int N, int K, bool SPLIT>
struct SplitOrder {
    static constexpr int nM = M / BM, nN = N / BM, nwg = nM * nN, G = GRID, nt = K / BK, nfull = (nwg / G) * G, rem = nwg - nfull, NR = nfull / G;
    static constexpr int S0 = (SPLIT && rem > 0 && G % rem == 0) ? G / rem : 1;
    static constexpr int S = ((S0 == 2 || S0 == 4) && nt % (2 * S0) == 0) ? S0 : 1;
    int c;
    __host__ __device__ void init(int c_) { c = c_; }
    __host__ __device__ static Unit unit_of(int L, int kt0, int nkt, int part) {
        int wgid = L; { constexpr int q = nwg / NXCD, r = nwg % NXCD; const int xcd = wgid % NXCD, off = wgid / NXCD; wgid = (xcd < r ? xcd * (q + 1) : r * (q + 1) + (xcd - r) * q) + off; }
        constexpr int nig = WGM * nN; const int gid = wgid / nig, fm = gid * WGM, gsz = (nM - fm) < WGM ? (nM - fm) : WGM;
        Unit u; u.pm = fm + ((wgid % nig) % gsz); u.pn = (wgid % nig) / gsz; u.kt0 = kt0; u.nkt = nkt; u.part = part; return u;
    }
    __host__ __device__ bool next(int i, Unit& u) const {
        int j = i;
        if (S > 1 && NR > 0 && (c & 4)) j = (i == 0) ? NR : i - 1;
        int L = j * G + c, kt0 = 0, nkt = nt, part = -1; bool ok = (S > 1) ? (i <= NR) : (L < nwg);
        if (S > 1 && j >= NR) { constexpr int R1 = rem > 0 ? rem : 1; L = nfull + (c % R1); nkt = nt / S; kt0 = (c / R1) * (nt / S); part = c; }
        if (!ok) return false;
        u = unit_of(L, kt0, nkt, part); return true;
    }
};
typedef float f32x2_t __attribute__((ext_vector_type(2)));
typedef __bf16 bf16x2_t __attribute__((ext_vector_type(2)));
__device__ __forceinline__ unsigned cvt_pk_bf16(float lo, float hi) { const f32x2_t v = {lo, hi}; return __builtin_bit_cast(unsigned, __builtin_convertvector(v, bf16x2_t)); }

template <class Epi, class Sched, bool ALIGN_EPI = false, bool SP2 = false>
__device__ __forceinline__ void gemm_phase(LAS unsigned char* lds, const Gemm g, const Sched& S, const Epi& E, float* slab) {
    const int tid = threadIdx.x, wid = __builtin_amdgcn_readfirstlane(tid >> 6), lane = tid & 63, wr = wid >> 2, wc = wid & 3, fr = lane & 15, fq = lane >> 4;
    const int K = g.K;
    unsigned voffA[2], voffB[2];
#pragma unroll
    for (int i = 0; i < 2; ++i) { int R, C; stage_rc(tid * 16 + i * 8192, R, C); const int Rb = Epi::PERM ? ((R & ~31) + perm32(R & 31)) : R;
        voffA[i] = (unsigned)(R * K + C) * 2u; voffB[i] = (unsigned)(Rb * K + C) * 2u; }
    const size_t kstep = (size_t)(BK * 2);
    const size_t hstep = (size_t)HALF * K * 2;
    const size_t tstep = 2 * hstep;
    const unsigned ldsw = (unsigned)wid * 1024u;
    const int aoff = lds_byte(wr * 64 + fr, fq * 8), boff = lds_byte(wc * 32 + fr, fq * 8);
#define PG8_SA(b, h) (((b) * 2 + (h)) * HTB)
#define PG8_SB(b, h) ((4 + (b) * 2 + (h)) * HTB)
#define PG8_STAGE(bufoff, gbase, voff) do { _Pragma("unroll") for (int _i = 0; _i < 2; ++_i) \
        __builtin_amdgcn_global_load_lds((const unsigned*)((const char*)(gbase) + (voff)[_i]), (LAS unsigned*)(lds + (bufoff) + ldsw + _i * 8192), 16, 0, 0); } while (0)
#define PG8_LDA(dst, b, h) do { _Pragma("unroll") for (int m = 0; m < 4; ++m) _Pragma("unroll") for (int k = 0; k < 2; ++k) dst[m][k] = *(const LAS bf16x8*)(lds + PG8_SA(b, h) + aoff + m * 2048 + k * 1024); } while (0)
#define PG8_LDB(dst, b, h) do { _Pragma("unroll") for (int n = 0; n < 2; ++n) _Pragma("unroll") for (int k = 0; k < 2; ++k) dst[n][k] = *(const LAS bf16x8*)(lds + PG8_SB(b, h) + boff + n * 2048 + k * 1024); } while (0)
#define PG8_MMA(ai, bj, At, Bt) do { __builtin_amdgcn_s_setprio(1); _Pragma("unroll") for (int m = 0; m < 4; ++m) _Pragma("unroll") for (int n = 0; n < 2; ++n) _Pragma("unroll") for (int k = 0; k < 2; ++k) \
        acc[ai][bj][m][n] = __builtin_amdgcn_mfma_f32_16x16x32_bf16(Bt[n][k], At[m][k], acc[ai][bj][m][n], 0, 0, 0); __builtin_amdgcn_s_setprio(0); } while (0)
#define PG8_WAIT_V(n) asm volatile("s_waitcnt vmcnt(" #n ")" ::: "memory")
#define PG8_WAIT_L(n) asm volatile("s_waitcnt lgkmcnt(" #n ")" ::: "memory")
#define PG8_BAR __builtin_amdgcn_s_barrier()
#define PG8_SCHED __builtin_amdgcn_sched_barrier(0)
    Unit cur, nxt; int ui = 0;
    if (!S.next(0, cur)) return;
    f32x4 acc[2][2][4][2];
#pragma unroll
    for (int a = 0; a < 2; ++a)
#pragma unroll
        for (int b = 0; b < 2; ++b)
#pragma unroll
            for (int m = 0; m < 4; ++m)
#pragma unroll
                for (int n = 0; n < 2; ++n) acc[a][b][m][n] = (f32x4){0.f, 0.f, 0.f, 0.f};
    bf16x8 At[4][2], B0[2][2], B1[2][2];
    const char* cA = (const char*)g.A + (size_t)cur.pm * tstep + (size_t)cur.kt0 * kstep; const char* cB = (const char*)g.Bt + (size_t)cur.pn * tstep + (size_t)cur.kt0 * kstep;
    if constexpr (SP2) {
        PG8_STAGE(PG8_SB(0, 0), cB, voffB); PG8_STAGE(PG8_SB(0, 1), cB + hstep, voffB); PG8_STAGE(PG8_SA(0, 0), cA, voffA); PG8_STAGE(PG8_SA(0, 1), cA + hstep, voffA);
        if (wr == 1) PG8_BAR;
        PG8_WAIT_V(2); PG8_BAR;
        PG8_STAGE(PG8_SB(1, 0), cB + kstep, voffB); PG8_STAGE(PG8_SA(1, 0), cA + kstep, voffA); PG8_STAGE(PG8_SB(1, 1), cB + hstep + kstep, voffB);
        PG8_WAIT_V(6); PG8_BAR;
    } else {
        PG8_STAGE(PG8_SB(0, 0), cB, voffB); PG8_STAGE(PG8_SA(0, 0), cA, voffA); PG8_STAGE(PG8_SB(0, 1), cB + hstep, voffB); PG8_STAGE(PG8_SA(0, 1), cA + hstep, voffA);
        if (wr == 1) PG8_BAR;
        PG8_WAIT_V(4); PG8_BAR;
        PG8_STAGE(PG8_SB(1, 0), cB + kstep, voffB); PG8_STAGE(PG8_SA(1, 0), cA + kstep, voffA); PG8_STAGE(PG8_SB(1, 1), cB + hstep + kstep, voffB);
        PG8_WAIT_V(6); PG8_BAR;
    }
    for (;;) {
        const bool has_next = S.next(ui + 1, nxt);
        const char* nA = has_next ? (const char*)g.A + (size_t)nxt.pm * tstep + (size_t)nxt.kt0 * kstep : cA; const char* nB = has_next ? (const char*)g.Bt + (size_t)nxt.pn * tstep + (size_t)nxt.kt0 * kstep : cB;
        const int nt = cur.nkt;
        for (int t = 0; t < nt; t += 2) {
            const bool last = (t == nt - 2);
            const char* a1 = cA + (size_t)(t + 1) * kstep;
            const char* a2 = last ? nA : cA + (size_t)(t + 2) * kstep; const char* b2 = last ? nB : cB + (size_t)(t + 2) * kstep;
            const char* a3 = a2 + kstep; const char* b3 = b2 + kstep;
            if constexpr (SP2) {
            PG8_LDB(B0, 0, 0); PG8_LDB(B1, 0, 1); PG8_SCHED; PG8_LDA(At, 0, 0); PG8_STAGE(PG8_SA(1, 1), a1 + hstep, voffA);
            PG8_WAIT_V(8); PG8_WAIT_L(0); PG8_BAR; PG8_MMA(0, 0, At, B0); PG8_MMA(0, 1, At, B1); PG8_BAR; PG8_SCHED;
            PG8_LDA(At, 0, 1); PG8_STAGE(PG8_SB(0, 0), b2, voffB); PG8_STAGE(PG8_SB(0, 1), b2 + hstep, voffB); PG8_STAGE(PG8_SA(0, 0), a2, voffA);
            PG8_WAIT_V(8); PG8_WAIT_L(0); PG8_BAR; PG8_MMA(1, 0, At, B0); PG8_MMA(1, 1, At, B1); PG8_BAR; PG8_SCHED;
            PG8_LDB(B0, 1, 0); PG8_LDB(B1, 1, 1); PG8_SCHED; PG8_LDA(At, 1, 0); PG8_STAGE(PG8_SA(0, 1), a2 + hstep, voffA);
            PG8_WAIT_V(8); PG8_WAIT_L(0); PG8_BAR; PG8_MMA(0, 0, At, B0); PG8_MMA(0, 1, At, B1); PG8_BAR; PG8_SCHED;
            PG8_LDA(At, 1, 1); PG8_STAGE(PG8_SB(1, 0), b3, voffB); PG8_STAGE(PG8_SB(1, 1), b3 + hstep, voffB); PG8_STAGE(PG8_SA(1, 0), a3, voffA);
            PG8_WAIT_V(8); PG8_WAIT_L(0); PG8_BAR; PG8_MMA(1, 0, At, B0); PG8_MMA(1, 1, At, B1); PG8_BAR; PG8_SCHED;
            } else {
            PG8_LDB(B0, 0, 0); PG8_SCHED; PG8_LDA(At, 0, 0); PG8_STAGE(PG8_SA(1, 1), a1 + hstep, voffA);
            PG8_WAIT_L(8); PG8_BAR; PG8_WAIT_L(0); PG8_MMA(0, 0, At, B0); PG8_BAR; PG8_SCHED;
            PG8_LDB(B1, 0, 1); PG8_STAGE(PG8_SB(0, 0), b2, voffB);
            PG8_BAR; PG8_WAIT_L(0); PG8_MMA(0, 1, At, B1); PG8_BAR;
            PG8_LDA(At, 0, 1); PG8_STAGE(PG8_SA(0, 0), a2, voffA);
            PG8_BAR; PG8_WAIT_L(0); PG8_MMA(1, 0, At, B0); PG8_BAR; PG8_SCHED;
            PG8_STAGE(PG8_SB(0, 1), b2 + hstep, voffB);
            PG8_WAIT_V(6); PG8_BAR; PG8_MMA(1, 1, At, B1); PG8_BAR;
            PG8_LDB(B0, 1, 0); PG8_SCHED; PG8_LDA(At, 1, 0); PG8_STAGE(PG8_SA(0, 1), a2 + hstep, voffA);
            PG8_WAIT_L(8); PG8_BAR; PG8_WAIT_L(0); PG8_MMA(0, 0, At, B0); PG8_BAR; PG8_SCHED;
            PG8_LDB(B1, 1, 1); PG8_STAGE(PG8_SB(1, 0), b3, voffB);
            PG8_BAR; PG8_WAIT_L(0); PG8_MMA(0, 1, At, B1); PG8_BAR;
            PG8_LDA(At, 1, 1); PG8_STAGE(PG8_SA(1, 0), a3, voffA);
            PG8_BAR; PG8_WAIT_L(0); PG8_MMA(1, 0, At, B0); PG8_BAR; PG8_SCHED;
            PG8_STAGE(PG8_SB(1, 1), b3 + hstep, voffB);
            PG8_WAIT_V(6); PG8_BAR; PG8_MMA(1, 1, At, B1); PG8_BAR;
            }
        }
        if constexpr (ALIGN_EPI) { if (wr == 0) PG8_BAR; }
        if (cur.part < 0) {
            const auto cx = E.begin(cur, wr, wc, fr, fq);
#pragma unroll
            for (int ai = 0; ai < 2; ++ai)
#pragma unroll
                for (int m = 0; m < 4; ++m) { const f32x4 v[2][2] = {{acc[ai][0][m][0], acc[ai][0][m][1]}, {acc[ai][1][m][0], acc[ai][1][m][1]}}; E.rows(cx, v, cur, ai, m, wr, wc, fr, fq); }
        } else {
            bf16_t* sp = (bf16_t*)slab + (size_t)cur.part * 65536 + (size_t)tid * 8;
#pragma unroll
            for (int ai = 0; ai < 2; ++ai)
#pragma unroll
                for (int bj = 0; bj < 2; ++bj)
#pragma unroll
                    for (int m = 0; m < 4; ++m) { const f32x4 a = acc[ai][bj][m][0], b = acc[ai][bj][m][1];
                        u32x4 w; w.x = cvt_pk_bf16(a[0], a[1]); w.y = cvt_pk_bf16(a[2], a[3]); w.z = cvt_pk_bf16(b[0], b[1]); w.w = cvt_pk_bf16(b[2], b[3]);
                        *(u32x4*)(sp + (size_t)(((ai * 2 + bj) * 4 + m) * 4096)) = w; }
        }
        if (!has_next) break;
#pragma unroll
        for (int a = 0; a < 2; ++a)
#pragma unroll
            for (int b = 0; b < 2; ++b)
#pragma unroll
                for (int m = 0; m < 4; ++m)
#pragma unroll
                    for (int n = 0; n < 2; ++n) acc[a][b][m][n] = (f32x4){0.f, 0.f, 0.f, 0.f};
        cur = nxt; cA = nA; cB = nB; ++ui;
        if constexpr (ALIGN_EPI) { if (wr == 1) PG8_BAR; }
    }
    PG8_WAIT_V(0);
    if constexpr (!ALIGN_EPI) { if (wr == 0) PG8_BAR; }
    PG8_BAR;
#undef PG8_SA
#undef PG8_SB
#undef PG8_STAGE
#undef PG8_LDA
#undef PG8_LDB
#undef PG8_MMA
#undef PG8_WAIT_V
#undef PG8_WAIT_L
#undef PG8_BAR
#undef PG8_SCHED
}
template <class Epi, class Sched>
__device__ __forceinline__ void gemm_fixup(const Epi& E, const float* slab) {
    if constexpr (Sched::S > 1) {
    constexpr int NG = 8 / Sched::S;
    const int tid = threadIdx.x, wid = __builtin_amdgcn_readfirstlane(tid >> 6), lane = tid & 63, wr = wid >> 2, wc = wid & 3, fr = lane & 15, fq = lane >> 4;
    for (int b = blockIdx.x; b < Sched::rem * Sched::S; b += Sched::G) {
        const int r = b % Sched::rem, q = b / Sched::rem;
        const Unit u = Sched::unit_of(Sched::nfull + r, 0, Sched::nt, -1);
        f32x4 v[NG][2][2];
#pragma unroll
        for (int gi = 0; gi < NG; ++gi)
#pragma unroll
            for (int bj = 0; bj < 2; ++bj)
#pragma unroll
                for (int n = 0; n < 2; ++n) v[gi][bj][n] = (f32x4){0.f, 0.f, 0.f, 0.f};
#pragma unroll
        for (int gi = 0; gi < NG; ++gi) { const int g = q * NG + gi, ai = g >> 2, m = g & 3;
#pragma unroll
            for (int p = 0; p < Sched::S; ++p) {
                const bf16_t* sp = (const bf16_t*)slab + (size_t)(r + p * Sched::rem) * 65536 + (size_t)tid * 8;
#pragma unroll
                for (int bj = 0; bj < 2; ++bj) { const u32x4 w = *(const u32x4*)(sp + (size_t)(((ai * 2 + bj) * 4 + m) * 4096));
                    v[gi][bj][0] += (f32x4){__builtin_bit_cast(float, w.x << 16), __builtin_bit_cast(float, w.x & 0xffff0000u), __builtin_bit_cast(float, w.y << 16), __builtin_bit_cast(float, w.y & 0xffff0000u)};
                    v[gi][bj][1] += (f32x4){__builtin_bit_cast(float, w.z << 16), __builtin_bit_cast(float, w.z & 0xffff0000u), __builtin_bit_cast(float, w.w << 16), __builtin_bit_cast(float, w.w & 0xffff0000u)}; } } }
        const auto cx = E.begin(u, wr, wc, fr, fq);
#pragma unroll
        for (int gi = 0; gi < NG; ++gi) { const int g = q * NG + gi; E.rows(cx, v[gi], u, g >> 2, g & 3, wr, wc, fr, fq); }
    }
    }
}
}

constexpr int DM = 2048, NTOK = 12288, NCTX = 4096, DFF = 5632, NFF2 = 11264;
constexpr int IN_EVEN = 4160, IN_EVEN_P = 4096, IN_ODD = 3072;
constexpr int NMOD = 18432;
constexpr float EPS = 1e-6f;
constexpr float LOG2E = 1.4426950408889634f;

constexpr size_t O_X = 0, O_CKV = 25165824, O_KROPE = 27262976, O_NAK = 27525120, O_NAV = 31719424, O_GK = 35913728, O_GV = 38010880, O_END = 40108032;

constexpr size_t MiB = 1u << 20;
constexpr size_t WS_CTL = 0;
constexpr size_t WS_MODS = 2 * MiB;
constexpr size_t CTL_ZERO_BYTES = 4 * MiB;
constexpr size_t WS_WFI = 4 * MiB;
constexpr size_t WS_WFO = WS_WFI + 176 * MiB;
constexpr size_t WS_WEI = WS_WFO + 88 * MiB;
constexpr size_t WS_WQU = WS_WEI + 17 * MiB;
constexpr size_t WS_WKU = WS_WQU + 2 * MiB;
constexpr size_t WS_WEO = WS_WKU + 2 * MiB;
constexpr size_t WS_WOI = WS_WEO + 8 * MiB;
constexpr size_t WS_WOO = WS_WOI + 12 * MiB;
constexpr size_t WS_H = WS_WOO + 8 * MiB;
constexpr size_t WS_ACT = WS_H + 48 * MiB;
constexpr size_t WS_P = WS_ACT + 132 * MiB;
constexpr size_t WS_XB = WS_P + 128 * MiB;
constexpr size_t WS_QM = WS_P + 204 * MiB;
constexpr size_t WS_CQN = WS_QM + 72 * MiB;
constexpr size_t WS_CKVA = WS_CQN + 12 * MiB;
constexpr size_t WS_QA = WS_CKVA + 16 * MiB;
constexpr size_t WS_QNA = WS_QA + 48 * MiB;
constexpr size_t WS_KM_CTX = WS_QNA + 24 * MiB;
constexpr size_t WS_KM_LAT = WS_KM_CTX + 12 * MiB;
constexpr size_t WS_KM_CAC = WS_KM_LAT + 24 * MiB;
constexpr size_t WS_VM_CTX = WS_KM_CAC + 12 * MiB;
constexpr size_t WS_VM_LAT = WS_VM_CTX + 8 * MiB;
constexpr size_t WS_VM_CAC = WS_VM_LAT + 16 * MiB;
constexpr size_t WS_KN_CTX = WS_VM_CAC + 8 * MiB;
constexpr size_t WS_KN_LAT = WS_KN_CTX + 8 * MiB;
constexpr size_t WS_KN_CAC = WS_KN_LAT + 16 * MiB;
constexpr size_t WS_VN_CTX = WS_KN_CAC + 8 * MiB;
constexpr size_t WS_VN_LAT = WS_VN_CTX + 8 * MiB;
constexpr size_t WS_VN_CAC = WS_VN_LAT + 16 * MiB;
constexpr size_t WS_KG_CTX = WS_VN_CAC + 8 * MiB;
constexpr size_t WS_KG_LAT = WS_KG_CTX + 4 * MiB;
constexpr size_t WS_KG_CAC = WS_KG_LAT + 8 * MiB;
constexpr size_t WS_VG_CTX = WS_KG_CAC + 4 * MiB;
constexpr size_t WS_VG_LAT = WS_VG_CTX + 4 * MiB;
constexpr size_t WS_VG_CAC = WS_VG_LAT + 8 * MiB;
constexpr size_t WS_O = WS_VG_CAC + 4 * MiB;
constexpr size_t WS_KROPE = WS_O + 48 * MiB;
constexpr size_t WS_END = WS_KROPE + 4 * MiB;
constexpr int CW_BAR = 4096;

constexpr int RING_BYTES = 131072;
constexpr int LDSCTL_OFF = RING_BYTES;
constexpr int LDS_BYTES = 147456;

__device__ __forceinline__ unsigned f2bf(float f) { unsigned u = __builtin_bit_cast(unsigned, f); return (u + 0x7fffu + ((u >> 16) & 1u)) >> 16; }
__device__ __forceinline__ unsigned pk2(float lo, float hi) { return pg8::cvt_pk_bf16(lo, hi); }
__device__ __forceinline__ float wave_sum(float v) {
#pragma unroll
    for (int o = 1; o < 64; o <<= 1) v += __shfl_xor(v, o);
    return v;
}
__device__ __forceinline__ float fast_exp2(float x) { return __builtin_amdgcn_exp2f(x); }
__device__ __forceinline__ float fast_rcp(float x) { return __builtin_amdgcn_rcpf(x); }
__device__ __forceinline__ float silu_f(float g) { return g * fast_rcp(1.0f + fast_exp2(-g * LOG2E)); }
__device__ __forceinline__ float sin_rev(float rev) { return __builtin_amdgcn_sinf(rev); }
__device__ __forceinline__ float cos_rev(float rev) { return __builtin_amdgcn_cosf(rev); }

#define XB_TMO      128
#define XB_XCNT(j)  (256  + 64 * (j))
#define XB_XSUB(j)  (1280 + 64 * (j))
#define XB_XGEN(j)  (2304 + 64 * (j))
#define XB_TOP      3328
#define XB_TOPGEN   3392
#define XCD_BAR_WORDS 3456
#define XB_SPIN_CAP (1u << 18)
__device__ __forceinline__ unsigned xb_ld(unsigned* p)              { return __hip_atomic_load(p, __ATOMIC_RELAXED, __HIP_MEMORY_SCOPE_AGENT); }
__device__ __forceinline__ unsigned xb_add(unsigned* p, unsigned v) { return __hip_atomic_fetch_add(p, v, __ATOMIC_RELAXED, __HIP_MEMORY_SCOPE_AGENT); }
__device__ __forceinline__ unsigned xb_xcc_id() { return (unsigned)__builtin_amdgcn_s_getreg((3 << 11) | 20) & 0xFu; }
#define XB_SPIN(cond, bar) do { unsigned _sp = 0; while (cond) { __builtin_amdgcn_s_sleep(1); \
    if ((++_sp & 255u) == 0u) { if (xb_ld(&(bar)[XB_TMO])) break; if (_sp > XB_SPIN_CAP) { atomicAdd(&(bar)[XB_TMO], 1u); break; } } } } while (0)
struct XcdBarrier { unsigned* bar; unsigned x; volatile LAS unsigned* st; };
__device__ __forceinline__ XcdBarrier xcd_barrier_post(unsigned* bar, volatile LAS unsigned* st) {
    XcdBarrier b; b.bar = bar; b.x = xb_xcc_id(); b.st = st;
    if (threadIdx.x == 0) (void)xb_add(&bar[XB_XCNT(b.x)], 1u);
    return b;
}
__device__ __forceinline__ void xcd_barrier_complete(unsigned* bar, unsigned x, unsigned& nloc, unsigned& nx) {
    const unsigned G = gridDim.x * gridDim.y * gridDim.z;
    unsigned sum, cnt, mine, sp = 0u;
    for (;;) {
        sum = 0u; cnt = 0u; mine = 0u;
#pragma unroll
        for (unsigned j = 0; j < 16; ++j) { const unsigned c = xb_ld(&bar[XB_XCNT(j)]); sum += c; cnt += (c > 0u) ? 1u : 0u; mine = (j == x) ? c : mine; }
        if (sum == G) break;
        __builtin_amdgcn_s_sleep(1);
        if ((++sp & 255u) == 0u) { if (xb_ld(&bar[XB_TMO])) break; if (sp > XB_SPIN_CAP) { atomicAdd(&bar[XB_TMO], 1u); break; } }
    }
    nloc = mine > 0u ? mine : 1u; nx = cnt > 0u ? cnt : 1u;
}
__device__ __forceinline__ void xcd_barrier(const XcdBarrier& b) {
    asm volatile("s_waitcnt vmcnt(0)" ::: "memory");
    __syncthreads();
    if (threadIdx.x == 0) {
        unsigned* bar = b.bar;
        __builtin_amdgcn_s_waitcnt(0);
        unsigned nloc = b.st[0], nx = b.st[1];
        if (nloc == 0u) { xcd_barrier_complete(bar, b.x, nloc, nx); b.st[0] = nloc; b.st[1] = nx; }
        const unsigned old = xb_add(&bar[XB_XSUB(b.x)], 1u);
        const unsigned gen = old / nloc;
        if (old + 1u == (gen + 1u) * nloc) {
            __builtin_amdgcn_fence(__ATOMIC_RELEASE, "agent");
            asm volatile("s_waitcnt vmcnt(0)" ::: "memory");
            const unsigned og = xb_add(&bar[XB_TOP], 1u);
            const unsigned tg = og / nx;
            if (og + 1u == (tg + 1u) * nx) xb_add(&bar[XB_TOPGEN], 1u);
            else XB_SPIN(xb_ld(&bar[XB_TOPGEN]) == tg, bar);
            __builtin_amdgcn_fence(__ATOMIC_ACQUIRE, "agent");
            xb_add(&bar[XB_XGEN(b.x)], 1u);
            asm volatile("s_waitcnt vmcnt(0)" ::: "memory");
        } else {
            XB_SPIN(xb_ld(&bar[XB_XGEN(b.x)]) == gen, bar);
            __builtin_amdgcn_fence(__ATOMIC_ACQUIRE, "agent");
            asm volatile("s_waitcnt vmcnt(0)" ::: "memory");
        }
    }
    __syncthreads();
}

struct Args { const float* in[28]; float* out; unsigned char* ws; int ph_lo, ph_hi; };
struct Frame {
    LAS unsigned char* lds;
    int tid, lane, wave, G, gw, NGW;
    const Args* a; float* out; unsigned char* ws;
};
#define IN_XP 0
#define IN_XS 1
#define IN_C_CKV 2
#define IN_C_KROPE 3
#define IN_C_NAK 4
#define IN_C_NAV 5
#define IN_C_GK 6
#define IN_C_GV 7
#define IN_C 8
#define IN_CCTX 9
#define IN_ADAW 10
#define IN_ADAB 11
#define IN_NORMG 12
#define IN_FFI 13
#define IN_FFO 14
#define IN_EWI 15
#define IN_EWO 16
#define IN_QNORM 17
#define IN_WQUP 18
#define IN_KVNORM 19
#define IN_WKVUP 20
#define IN_MLAQK 21
#define IN_NAQK 22
#define IN_RPB 23
#define IN_OWI 24
#define IN_OWO 25
#define IN_GQK 26
#define IN_SINK 27

__device__ __forceinline__ int opaque_v(int x) { asm volatile("" : "+v"(x)); return x; }
__device__ __forceinline__ int tok_mb(int t) { return t < NCTX ? 0 : 1 + ((t - NCTX) >> 10); }

__device__ __forceinline__ size_t k_chunk_off(int DQK, int key, int c8) { return (size_t)(key >> 5) * (DQK * 32) + (size_t)(c8 >> 1) * 512 + (((c8 & 1) * 32 + (key & 31)) << 3); }
__device__ __forceinline__ void vt_tile_write_h(const bf16_t* src0, size_t pitch, bf16_t* dst, int lane) {
    unsigned v[8][8];
#pragma unroll
    for (int it = 0; it < 8; ++it) {
        const int d = (it & 1) * 64 + lane, s = (it >> 1) & 1, hh = it >> 2;
#pragma unroll
        for (int j = 0; j < 8; ++j) { const int key = 16 * s + 8 * (j >> 2) + 4 * hh + (j & 3); v[it][j] = src0[(size_t)key * pitch + d]; }
    }
#pragma unroll
    for (int it = 0; it < 8; ++it) {
        const int d = (it & 1) * 64 + lane, s = (it >> 1) & 1, hh = it >> 2;
        u32x4 w; w.x = v[it][0] | (v[it][1] << 16); w.y = v[it][2] | (v[it][3] << 16); w.z = v[it][4] | (v[it][5] << 16); w.w = v[it][6] | (v[it][7] << 16);
        *(u32x4*)(dst + (size_t)(((s * 4 + (d >> 5)) * 64 + hh * 32 + (d & 31)) << 3)) = w;
    }
}
__device__ __forceinline__ void vt_tile_write(const float* src0, size_t pitch, bf16_t* dst, int lane) {
#pragma unroll
    for (int it = 0; it < 8; ++it) {
        const int d = (it & 1) * 64 + lane, s = (it >> 1) & 1, hh = it >> 2;
        float v[8];
#pragma unroll
        for (int j = 0; j < 8; ++j) { const int key = 16 * s + 8 * (j >> 2) + 4 * hh + (j & 3); v[j] = src0[(size_t)key * pitch + d]; }
        u32x4 w; w.x = pk2(v[0], v[1]); w.y = pk2(v[2], v[3]); w.z = pk2(v[4], v[5]); w.w = pk2(v[6], v[7]);
        *(u32x4*)(dst + (size_t)(((s * 4 + (d >> 5)) * 64 + hh * 32 + (d & 31)) << 3)) = w;
    }
}

__device__ __forceinline__ void p0_transpose_item(const float* W, int K, int N, bf16_t* WT, int mode, LAS float* scr, int item, int lane) {
    const int nblk = N / 32, kb = item / nblk, nb = item % nblk, k0 = 64 * kb, n0 = 32 * nb;
#pragma unroll 8
    for (int i = 0; i < 32; ++i) { const int kk = 2 * i + (lane >> 5); scr[kk * 33 + (lane & 31)] = __builtin_nontemporal_load(W + (size_t)(k0 + kk) * N + n0 + (lane & 31)); }
    asm volatile("s_waitcnt lgkmcnt(0)" ::: "memory");
    int d0 = n0;
    if (mode == 1) { const int j0 = n0 < DFF ? n0 : n0 - DFF; d0 = 256 * (j0 >> 7) + (j0 & 127) + (n0 < DFF ? 0 : 128); }
    if (mode == 2) d0 = n0 < 1024 ? n0 : (n0 < 1088 ? 4096 + (n0 - 1024) : n0 - 64);
    const int c = lane & 7;
#pragma unroll
    for (int j = 0; j < 4; ++j) { const int n = (lane >> 3) + 8 * j; const LAS float* s = scr + (8 * c) * 33 + n;
        u32x4 o; o.x = pk2(s[0 * 33], s[1 * 33]); o.y = pk2(s[2 * 33], s[3 * 33]); o.z = pk2(s[4 * 33], s[5 * 33]); o.w = pk2(s[6 * 33], s[7 * 33]);
        *(u32x4*)(WT + (size_t)(d0 + n) * K + k0 + 8 * c) = o; }
    asm volatile("s_waitcnt lgkmcnt(0)" ::: "memory");
}

__device__ __forceinline__ const float* p0_mods_wptr(Frame& F, int item) {
    const int layer = item / 1152, rem = item % 1152, slab = rem >> 4, ks = rem & 15;
    return F.a->in[IN_ADAW] + (size_t)layer * DM * NMOD + (size_t)(ks * 128 + F.wave * 16) * NMOD + slab * 256 + 4 * F.lane;
}
__device__ __forceinline__ void phase_mods(Frame& F) {
    LAS float* stab = (LAS float*)(F.lds);
    LAS float* part = (LAS float*)(F.lds + 8192);
    const float* c = F.a->in[IN_C]; const float* cctx = F.a->in[IN_CCTX];
    for (int item = blockIdx.x; item < 2304; item += F.G) {
        const int layer = item / 1152, rem = item % 1152, slab = rem >> 4, ks = rem & 15, n0 = slab * 256, k0 = ks * 128;
        f32x4 w[16];
        { const float* W = p0_mods_wptr(F, item);
#pragma unroll
          for (int kk = 0; kk < 16; ++kk) w[kk] = __builtin_nontemporal_load((const f32x4*)(W + (size_t)kk * NMOD)); }
        for (int i = F.tid; i < 9 * 128; i += 512) { const int b = i >> 7, k = i & 127; const float v = (b == 0) ? cctx[k0 + k] : c[(size_t)(b - 1) * DM + k0 + k]; stab[i] = silu_f(v); }
        __syncthreads();
        f32x4 acc[9];
#pragma unroll
        for (int b = 0; b < 9; ++b) acc[b] = (f32x4){0.f, 0.f, 0.f, 0.f};
#pragma unroll
        for (int kk = 0; kk < 16; ++kk) {
#pragma unroll
            for (int b = 0; b < 9; ++b) { const float sv = stab[b * 128 + F.wave * 16 + kk]; acc[b] += w[kk] * sv; }
        }
#pragma unroll
        for (int b = 0; b < 9; ++b) *(LAS f32x4*)(part + (F.wave * 9 + b) * 256 + 4 * F.lane) = acc[b];
        __syncthreads();
        float* mods = (float*)(F.ws + WS_MODS) + (size_t)layer * 9 * NMOD;
        const float* bias = F.a->in[IN_ADAB] + (size_t)layer * NMOD;
        for (int i = F.tid; i < 9 * 256; i += 512) { const int b = i >> 8, col = i & 255; float sm = 0.f;
#pragma unroll
            for (int ww = 0; ww < 8; ++ww) sm += part[(ww * 9 + b) * 256 + col];
            if (ks == 0) sm += bias[n0 + col];
            atomicAdd(mods + (size_t)b * NMOD + n0 + col, sm); }
        __syncthreads();
    }
}

__device__ __forceinline__ void p0_cacheK_item(const float* src, int H, bf16_t* dstbase, int item, int lane) {
    const int t32 = item & 15, bh = item >> 4, b = bh / H, h = bh % H;
    bf16_t* dst = dstbase + (size_t)bh * (512 * 128);
#pragma unroll
    for (int it = 0; it < 8; ++it) { const int idx = it * 64 + lane, kl = idx >> 4, c8 = idx & 15, key = t32 * 32 + kl;
        const float* s = src + ((size_t)(b * 512 + key) * H + h) * 128 + c8 * 8;
        const f32x4 a = *(const f32x4*)s, bb = *(const f32x4*)(s + 4);
        u32x4 w; w.x = pk2(a[0], a[1]); w.y = pk2(a[2], a[3]); w.z = pk2(bb[0], bb[1]); w.w = pk2(bb[2], bb[3]);
        *(u32x4*)(dst + k_chunk_off(128, key, c8)) = w; }
}
__device__ __forceinline__ void p0_cacheV_item(const float* src, int H, bf16_t* dstbase, int item, int lane) {
    const int t32 = item & 15, bh = item >> 4, b = bh / H, h = bh % H;
    vt_tile_write(src + ((size_t)(b * 512 + t32 * 32) * H + h) * 128, (size_t)H * 128, dstbase + (size_t)bh * (512 * 128) + (size_t)t32 * 4096, lane);
}

__device__ __forceinline__ void phase_prologue(Frame& F) {
    phase_mods(F);
    LAS float* scr = (LAS float*)(F.lds + F.wave * 16384);
    constexpr int I_FI = 32 * 352, I_FO = 88 * 64, I_EI = 32 * 130, I_QU = 8 * 48, I_KU = 8 * 64, I_EO = 32 * 64, I_OI = 32 * 96, I_OO = 32 * 64;
    constexpr int I_PAD = 0, I_CKV = 1024, I_NK = 1024, I_NV = 1024, I_GK = 512, I_GV = 512;
    constexpr int NITEMS = 4 * I_FI + 4 * I_FO + I_EI + I_QU + I_KU + I_EO + I_OI + I_OO + I_PAD + I_CKV + I_NK + I_NV + I_GK + I_GV;
    unsigned char* ws = F.ws;
    for (int it = F.gw; it < NITEMS; it += F.NGW) {
        int r = it;
        if (r < 4 * I_FI) { const int m = r / I_FI; p0_transpose_item(F.a->in[IN_FFI] + (size_t)m * DM * NFF2, DM, NFF2, (bf16_t*)(ws + WS_WFI) + (size_t)m * NFF2 * DM, 1, scr, r % I_FI, F.lane); continue; } r -= 4 * I_FI;
        if (r < 4 * I_FO) { const int m = r / I_FO; p0_transpose_item(F.a->in[IN_FFO] + (size_t)m * DFF * DM, DFF, DM, (bf16_t*)(ws + WS_WFO) + (size_t)m * DM * DFF, 0, scr, r % I_FO, F.lane); continue; } r -= 4 * I_FO;
        if (r < I_EI) { p0_transpose_item(F.a->in[IN_EWI], DM, IN_EVEN, (bf16_t*)(ws + WS_WEI), 2, scr, r, F.lane); continue; } r -= I_EI;
        if (r < I_QU) { p0_transpose_item(F.a->in[IN_WQUP], 512, 1536, (bf16_t*)(ws + WS_WQU), 0, scr, r, F.lane); continue; } r -= I_QU;
        if (r < I_KU) { p0_transpose_item(F.a->in[IN_WKVUP], 512, 2048, (bf16_t*)(ws + WS_WKU), 0, scr, r, F.lane); continue; } r -= I_KU;
        if (r < I_EO) { p0_transpose_item(F.a->in[IN_EWO], DM, DM, (bf16_t*)(ws + WS_WEO), 0, scr, r, F.lane); continue; } r -= I_EO;
        if (r < I_OI) { p0_transpose_item(F.a->in[IN_OWI], DM, IN_ODD, (bf16_t*)(ws + WS_WOI), 0, scr, r, F.lane); continue; } r -= I_OI;
        if (r < I_OO) { p0_transpose_item(F.a->in[IN_OWO], DM, DM, (bf16_t*)(ws + WS_WOO), 0, scr, r, F.lane); continue; } r -= I_OO;
        if (r < I_PAD) { u32x4* p = (u32x4*)((bf16_t*)(ws + WS_WEI) + (size_t)(IN_EVEN + r) * DM); const u32x4 z = {0u, 0u, 0u, 0u};
#pragma unroll
            for (int j = 0; j < 4; ++j) p[j * 64 + F.lane] = z; continue; } r -= I_PAD;
        if (r < I_CKV) {
#pragma unroll
            for (int j = 0; j < 4; ++j) { const int row = 4 * r + j; const float* s = F.a->in[IN_C_CKV] + (size_t)row * 512 + 8 * F.lane;
                const f32x4 a = *(const f32x4*)s, b = *(const f32x4*)(s + 4);
                u32x4 w; w.x = pk2(a[0], a[1]); w.y = pk2(a[2], a[3]); w.z = pk2(b[0], b[1]); w.w = pk2(b[2], b[3]);
                *(u32x4*)((bf16_t*)(ws + WS_CKVA) + (size_t)(NTOK + row) * 512 + 8 * F.lane) = w; }
            continue; } r -= I_CKV;
        if (r < I_NK) { p0_cacheK_item(F.a->in[IN_C_NAK], 8, (bf16_t*)(ws + WS_KN_CAC), r, F.lane); continue; } r -= I_NK;
        if (r < I_NV) { p0_cacheV_item(F.a->in[IN_C_NAV], 8, (bf16_t*)(ws + WS_VN_CAC), r, F.lane); continue; } r -= I_NV;
        if (r < I_GK) { p0_cacheK_item(F.a->in[IN_C_GK], 4, (bf16_t*)(ws + WS_KG_CAC), r, F.lane); continue; } r -= I_GK;
        p0_cacheV_item(F.a->in[IN_C_GV], 4, (bf16_t*)(ws + WS_VG_CAC), r, F.lane);
    }
}

__device__ __forceinline__ void load8(const float* p, float (&v)[8]) { const f32x4 a = *(const f32x4*)p, b = *(const f32x4*)(p + 4); v[0] = a[0]; v[1] = a[1]; v[2] = a[2]; v[3] = a[3]; v[4] = b[0]; v[5] = b[1]; v[6] = b[2]; v[7] = b[3]; }
__device__ __forceinline__ void unpack8h(const u32x4 w, float (&v)[8]) {
    v[0] = __builtin_bit_cast(float, w.x << 16); v[1] = __builtin_bit_cast(float, w.x & 0xffff0000u); v[2] = __builtin_bit_cast(float, w.y << 16); v[3] = __builtin_bit_cast(float, w.y & 0xffff0000u);
    v[4] = __builtin_bit_cast(float, w.z << 16); v[5] = __builtin_bit_cast(float, w.z & 0xffff0000u); v[6] = __builtin_bit_cast(float, w.w << 16); v[7] = __builtin_bit_cast(float, w.w & 0xffff0000u); }
__device__ __forceinline__ void load8h(const bf16_t* p, float (&v)[8]) { unpack8h(*(const u32x4*)p, v); }

__device__ __forceinline__ const float* x_in_row(Frame& F, int t) { return t < NCTX ? F.a->in[IN_XP] + (size_t)t * DM : F.a->in[IN_XS] + (size_t)(t - NCTX) * DM; }
__device__ __forceinline__ void phase_norm(Frame& F, bool from_input, int layer, int sub) {
    const float* g = F.a->in[IN_NORMG] + (size_t)(layer * 3 + sub) * DM;
    bf16_t* H = (bf16_t*)(F.ws + WS_H);
    const bf16_t* XB = (const bf16_t*)(F.ws + WS_XB);
    const int lane = opaque_v(F.lane);
    for (int t = F.gw; t < NTOK; t += F.NGW) {
        const float* md = (const float*)(F.ws + WS_MODS) + ((size_t)layer * 9 + tok_mb(t)) * NMOD + (size_t)(3 * sub) * DM;
        float v[4][8]; float ss = 0.f;
        if (from_input) { const float* xr = x_in_row(F, t);
#pragma unroll
            for (int j = 0; j < 4; ++j) load8(xr + 512 * j + 8 * lane, v[j]);
        } else { const bf16_t* xr = XB + (size_t)t * DM;
#pragma unroll
            for (int j = 0; j < 4; ++j) load8h(xr + 512 * j + 8 * lane, v[j]);
        }
#pragma unroll
        for (int j = 0; j < 4; ++j) ss += ((v[j][0] * v[j][0] + v[j][1] * v[j][1]) + (v[j][2] * v[j][2] + v[j][3] * v[j][3])) + ((v[j][4] * v[j][4] + v[j][5] * v[j][5]) + (v[j][6] * v[j][6] + v[j][7] * v[j][7]));
        const float rstd = __builtin_amdgcn_rsqf(wave_sum(ss) * (1.0f / DM) + EPS);
#pragma unroll
        for (int j = 0; j < 4; ++j) { const int c = 512 * j + 8 * lane;
            float gg[8], sh[8], sc[8], y[8]; load8(g + c, gg); load8(md + c, sh); load8(md + DM + c, sc);
#pragma unroll
            for (int e = 0; e < 8; ++e) y[e] = (v[j][e] * rstd * gg[e]) * (sc[e] + 1.0f) + sh[e];
            u32x4 w; w.x = pk2(y[0], y[1]); w.y = pk2(y[2], y[3]); w.z = pk2(y[4], y[5]); w.w = pk2(y[6], y[7]);
            *(u32x4*)(H + (size_t)t * DM + c) = w; }
    }
}

struct EpiSwiGLU {
    static constexpr bool PERM = true;
    bf16_t* O;
    struct Ctx { int row0, col0; };
    __device__ __forceinline__ Ctx begin(const pg8::Unit& u, int wr, int wc, int fr, int fq) const { return Ctx{u.pm * 256 + wr * 64 + fr, u.pn * 128 + wc * 32 + 8 * fq}; }
    __device__ __forceinline__ void rows(const Ctx& c, const f32x4 (&v)[2][2], const pg8::Unit&, int ai, int m, int, int, int, int) const {
        float r[8];
#pragma unroll
        for (int n = 0; n < 2; ++n)
#pragma unroll
            for (int j = 0; j < 4; ++j) r[4 * n + j] = silu_f(v[0][n][j]) * v[1][n][j];
        u32x4 w; w.x = pk2(r[0], r[1]); w.y = pk2(r[2], r[3]); w.z = pk2(r[4], r[5]); w.w = pk2(r[6], r[7]);
        *(u32x4*)(O + (size_t)(c.row0 + ai * 128 + m * 16) * DFF + c.col0) = w;
    }
};
template <bool INF, bool OUTF>
struct EpiResid {
    static constexpr bool PERM = true;
    const float* xp; const float* xs; bf16_t* xb; float* out; const float* gate_base; float coef;
    struct Ctx { const float* xin; f32x4 gv[2][2]; int row0, col0; };
    __device__ __forceinline__ Ctx begin(const pg8::Unit& u, int wr, int wc, int fr, int fq) const {
        Ctx c; const int rowt = u.pm * 256; c.row0 = rowt + wr * 64 + fr; c.col0 = u.pn * 256 + wc * 32 + 8 * fq;
        const float* gt = gate_base + (size_t)tok_mb(rowt) * NMOD;
        c.xin = rowt < NCTX ? xp : xs - (size_t)NCTX * DM;
#pragma unroll
        for (int bj = 0; bj < 2; ++bj)
#pragma unroll
            for (int n = 0; n < 2; ++n) c.gv[bj][n] = *(const f32x4*)(gt + c.col0 + bj * 128 + n * 4) * coef;
        return c;
    }
    __device__ __forceinline__ void rows(const Ctx& c, const f32x4 (&v)[2][2], const pg8::Unit&, int ai, int m, int, int, int, int) const {
        const size_t off = (size_t)(c.row0 + ai * 128 + m * 16) * DM + c.col0;
        f32x4 x[2][2];
#pragma unroll
        for (int bj = 0; bj < 2; ++bj) {
            if constexpr (INF) { x[bj][0] = *(const f32x4*)(c.xin + off + bj * 128); x[bj][1] = *(const f32x4*)(c.xin + off + bj * 128 + 4); }
            else { const u32x4 w = *(const u32x4*)(xb + off + bj * 128);
                x[bj][0] = (f32x4){__builtin_bit_cast(float, w.x << 16), __builtin_bit_cast(float, w.x & 0xffff0000u), __builtin_bit_cast(float, w.y << 16), __builtin_bit_cast(float, w.y & 0xffff0000u)};
                x[bj][1] = (f32x4){__builtin_bit_cast(float, w.z << 16), __builtin_bit_cast(float, w.z & 0xffff0000u), __builtin_bit_cast(float, w.w << 16), __builtin_bit_cast(float, w.w & 0xffff0000u)}; }
        }
#pragma unroll
        for (int bj = 0; bj < 2; ++bj) { const f32x4 r0 = x[bj][0] + c.gv[bj][0] * v[bj][0], r1 = x[bj][1] + c.gv[bj][1] * v[bj][1];
            if constexpr (OUTF) { *(f32x4*)(out + off + bj * 128) = r0; *(f32x4*)(out + off + bj * 128 + 4) = r1; }
            else { u32x4 w; w.x = pk2(r0[0], r0[1]); w.y = pk2(r0[2], r0[3]); w.z = pk2(r1[0], r1[1]); w.w = pk2(r1[2], r1[3]); *(u32x4*)(xb + off + bj * 128) = w; }
        }
        asm volatile("" ::: "memory");
    }
};
typedef EpiResid<true, false> ResidIn; typedef EpiResid<false, false> ResidMid; typedef EpiResid<false, true> ResidOut;
struct EpiBf16 {
    static constexpr bool PERM = true;
    bf16_t* C; int ldc;
    struct Ctx { int row0, col0; };
    __device__ __forceinline__ Ctx begin(const pg8::Unit& u, int wr, int wc, int fr, int fq) const { return Ctx{u.pm * 256 + wr * 64 + fr, u.pn * 256 + wc * 32 + 8 * fq}; }
    __device__ __forceinline__ void rows(const Ctx& c, const f32x4 (&v)[2][2], const pg8::Unit&, int ai, int m, int, int, int, int) const {
        bf16_t* rowp = C + (size_t)(c.row0 + ai * 128 + m * 16) * ldc + c.col0;
#pragma unroll
        for (int bj = 0; bj < 2; ++bj) { u32x4 w; w.x = pk2(v[bj][0][0], v[bj][0][1]); w.y = pk2(v[bj][0][2], v[bj][0][3]); w.z = pk2(v[bj][1][0], v[bj][1][1]); w.w = pk2(v[bj][1][2], v[bj][1][3]);
            *(u32x4*)(rowp + bj * 128) = w; }
    }
};
struct EpiF32 {
    static constexpr bool PERM = false;
    float* C; int ldc;
    struct Ctx { int row0, col0; };
    __device__ __forceinline__ Ctx begin(const pg8::Unit& u, int wr, int wc, int fr, int fq) const { return Ctx{u.pm * 256 + wr * 64 + fr, u.pn * 256 + wc * 32 + 4 * fq}; }
    __device__ __forceinline__ void rows(const Ctx& c, const f32x4 (&v)[2][2], const pg8::Unit&, int ai, int m, int, int, int, int) const {
        float* rowp = C + (size_t)(c.row0 + ai * 128 + m * 16) * ldc + c.col0;
#pragma unroll
        for (int bj = 0; bj < 2; ++bj)
#pragma unroll
            for (int n = 0; n < 2; ++n) *(f32x4*)(rowp + bj * 128 + n * 16) = v[bj][n];
    }
};

__device__ __forceinline__ u32x4 pack8(const float (&v)[8]) { u32x4 w; w.x = pk2(v[0], v[1]); w.y = pk2(v[2], v[3]); w.z = pk2(v[4], v[5]); w.w = pk2(v[6], v[7]); return w; }
__device__ __forceinline__ void store8f(float* p, const float (&v)[8]) { *(f32x4*)p = (f32x4){v[0], v[1], v[2], v[3]}; *(f32x4*)(p + 4) = (f32x4){v[4], v[5], v[6], v[7]}; }
template <int W> __device__ __forceinline__ float group_sum(float v) {
#pragma unroll
    for (int o = 1; o < W; o <<= 1) v += __shfl_xor(v, o);
    return v;
}

__device__ __forceinline__ void phase_post1_even(Frame& F) {
    const bf16_t* P = (const bf16_t*)(F.ws + WS_P);
    const float* qn_g = F.a->in[IN_QNORM]; const float* kvn_g = F.a->in[IN_KVNORM]; const float* naq_g = F.a->in[IN_NAQK]; const float* nak_g = F.a->in[IN_NAQK] + 128;
    bf16_t* CQN = (bf16_t*)(F.ws + WS_CQN); bf16_t* CKVA = (bf16_t*)(F.ws + WS_CKVA); bf16_t* QNA = (bf16_t*)(F.ws + WS_QNA);
    constexpr int NVT_CTX = 16 * 8 * 8, NVT_LAT = 8 * 8 * 32;
    {
        const int lane = F.lane, lr = lane & 15, lq = lane >> 4, w = F.wave, t0 = (int)blockIdx.x * 48;
        const bf16_t* ap = (const bf16_t*)(F.ws + WS_H) + (size_t)(t0 + lr) * DM + 256 * w + 8 * lq;
        const bf16_t* bp = (const bf16_t*)(F.ws + WS_WEI) + (size_t)(4096 + lr) * DM + 256 * w + 8 * lq;
        f32x4 acc[3][4];
#pragma unroll
        for (int mb = 0; mb < 3; ++mb)
#pragma unroll
            for (int j = 0; j < 4; ++j) acc[mb][j] = (f32x4){0.f, 0.f, 0.f, 0.f};
#pragma unroll
        for (int kk = 0; kk < 8; ++kk) {
            bf16x8 bf[4];
#pragma unroll
            for (int j = 0; j < 4; ++j) bf[j] = *(const bf16x8*)(bp + (size_t)j * 16 * DM + kk * 32);
#pragma unroll
            for (int mb = 0; mb < 3; ++mb) { const bf16x8 af = *(const bf16x8*)(ap + (size_t)mb * 16 * DM + kk * 32);
#pragma unroll
                for (int j = 0; j < 4; ++j) acc[mb][j] = __builtin_amdgcn_mfma_f32_16x16x32_bf16(af, bf[j], acc[mb][j], 0, 0, 0); }
        }
        LAS float* red = (LAS float*)F.lds;
#pragma unroll
        for (int mb = 0; mb < 3; ++mb)
#pragma unroll
            for (int j = 0; j < 4; ++j)
#pragma unroll
                for (int r = 0; r < 4; ++r) red[(w * 48 + 16 * mb + 4 * lq + r) * 64 + 16 * j + lr] = acc[mb][j][r];
        __syncthreads();
        float* kr = (float*)(F.ws + WS_KROPE);
#pragma unroll
        for (int i = 0; i < 6; ++i) { const int o = F.tid + 512 * i; float sum = 0.f;
#pragma unroll
            for (int p = 0; p < 8; ++p) sum += red[p * 3072 + o];
            const int t = t0 + (o >> 6);
            kr[(size_t)t0 * 64 + o] = sum; if (t < NCTX) F.out[O_KROPE + (size_t)t0 * 64 + o] = sum; }
        __syncthreads();
    }
    {
        const int lane = F.lane, head = lane >> 3, d0 = (lane & 7) * 16;
        float gq[8], gkv[8], gqa[8], gqc[8], gka[8], gkc[8];
        load8(qn_g + 8 * lane, gq); load8(kvn_g + 8 * lane, gkv); load8(naq_g + d0, gqa); load8(naq_g + d0 + 8, gqc); load8(nak_g + d0, gka); load8(nak_g + d0 + 8, gkc);
#define P1_LOAD(R, t_) do { const bf16_t* pr_ = P + (size_t)(t_) * IN_EVEN_P; R[0] = *(const u32x4*)(pr_ + 8 * lane); R[1] = *(const u32x4*)(pr_ + 512 + 8 * lane); \
            _Pragma("unroll") for (int w_ = 0; w_ < 3; ++w_) { R[2 + 2 * w_] = *(const u32x4*)(pr_ + 1024 + 1024 * w_ + 16 * lane); R[3 + 2 * w_] = *(const u32x4*)(pr_ + 1024 + 1024 * w_ + 16 * lane + 8); } } while (0)
        u32x4 R[8];
        P1_LOAD(R, F.gw);
        for (int t = F.gw; t < NTOK; t += F.NGW) {
            u32x4 C[8];
#pragma unroll
            for (int i = 0; i < 8; ++i) C[i] = R[i];
            { const int tn = t + F.NGW < NTOK ? t + F.NGW : t; P1_LOAD(R, tn); }
            const bool ctx = t < NCTX;
            float v[8];
            unpack8h(C[0], v); float ss = 0.f;
#pragma unroll
            for (int i = 0; i < 8; ++i) ss += v[i] * v[i];
            float rstd = __builtin_amdgcn_rsqf(wave_sum(ss) * (1.0f / 512) + EPS);
#pragma unroll
            for (int i = 0; i < 8; ++i) v[i] = v[i] * rstd * gq[i];
            *(u32x4*)(CQN + (size_t)t * 512 + 8 * lane) = pack8(v);
            unpack8h(C[1], v); ss = 0.f;
#pragma unroll
            for (int i = 0; i < 8; ++i) ss += v[i] * v[i];
            rstd = __builtin_amdgcn_rsqf(wave_sum(ss) * (1.0f / 512) + EPS);
#pragma unroll
            for (int i = 0; i < 8; ++i) v[i] = v[i] * rstd * gkv[i];
            if (ctx) store8f(F.out + O_CKV + (size_t)t * 512 + 8 * lane, v);
            *(u32x4*)(CKVA + (size_t)t * 512 + 8 * lane) = pack8(v);
            int b, s; if (ctx) { b = t >> 8; s = t & 255; } else { b = (t - NCTX) >> 10; s = (t - NCTX) & 1023; }
#pragma unroll
            for (int which = 0; which < 2; ++which) {
                float a[8], c[8]; unpack8h(C[2 + 2 * which], a); unpack8h(C[3 + 2 * which], c);
                float q = 0.f;
#pragma unroll
                for (int i = 0; i < 8; ++i) q += a[i] * a[i] + c[i] * c[i];
                const float r2 = __builtin_amdgcn_rsqf(group_sum<8>(q) * (1.0f / 128) + EPS);
#pragma unroll
                for (int i = 0; i < 8; ++i) { a[i] = a[i] * r2 * (which ? gka[i] : gqa[i]); c[i] = c[i] * r2 * (which ? gkc[i] : gqc[i]); }
                if (which == 0) { bf16_t* qd = QNA + (size_t)t * 1024 + head * 128 + d0; *(u32x4*)qd = pack8(a); *(u32x4*)(qd + 8) = pack8(c); }
                else {
                    if (ctx) { float* od = F.out + O_NAK + (size_t)t * 1024 + head * 128 + d0; store8f(od, a); store8f(od + 8, c); }
                    bf16_t* kb = ctx ? (bf16_t*)(F.ws + WS_KN_CTX) + (size_t)(b * 8 + head) * (256 * 128) : (bf16_t*)(F.ws + WS_KN_LAT) + (size_t)(b * 8 + head) * (1024 * 128);
                    *(u32x4*)(kb + k_chunk_off(128, s, d0 >> 3)) = pack8(a); *(u32x4*)(kb + k_chunk_off(128, s, (d0 >> 3) + 1)) = pack8(c);
                }
            }
            if (ctx) { float a[8], c[8]; unpack8h(C[6], a); unpack8h(C[7], c); float* od = F.out + O_NAV + (size_t)t * 1024 + 16 * lane; store8f(od, a); store8f(od + 8, c); }
        }
#undef P1_LOAD
    }
    for (int r = F.gw; r < NVT_CTX + NVT_LAT; r += F.NGW) {
        if (r < NVT_CTX) { const int t32 = r & 7, bh = r >> 3, b = bh >> 3, h = bh & 7;
            vt_tile_write_h(P + (size_t)(b * 256 + t32 * 32) * IN_EVEN_P + 3072 + h * 128, IN_EVEN_P, (bf16_t*)(F.ws + WS_VN_CTX) + (size_t)bh * (256 * 128) + (size_t)t32 * 4096, F.lane);
        } else { const int r2 = r - NVT_CTX, t32 = r2 & 31, bh = r2 >> 5, b = bh >> 3, h = bh & 7;
            vt_tile_write_h(P + (size_t)(NCTX + b * 1024 + t32 * 32) * IN_EVEN_P + 3072 + h * 128, IN_EVEN_P, (bf16_t*)(F.ws + WS_VN_LAT) + (size_t)bh * (1024 * 128) + (size_t)t32 * 4096, F.lane);
        }
    }
}

__device__ __forceinline__ void rope8(float (&v)[8], const float (&vp)[8], bool is_x1, float pos, int f0, float inv_nf) {
#pragma unroll
    for (int i = 0; i < 8; ++i) {
        const float invf = fast_exp2(-(float)(f0 + i) * inv_nf * 13.287712379549449f);
        const float rev = pos * invf * 0.15915494309189535f;
        const float cs = cos_rev(rev), sn = sin_rev(rev);
        v[i] = is_x1 ? (v[i] * cs - vp[i] * sn) : (vp[i] * sn + v[i] * cs);
    }
}

__device__ __forceinline__ void phase_post2_even(Frame& F) {
    const bf16_t* P = (const bf16_t*)(F.ws + WS_P); const bf16_t* QM = (const bf16_t*)(F.ws + WS_QM); const bf16_t* KVM = (const bf16_t*)(F.ws + WS_ACT);
    const float* gq = F.a->in[IN_MLAQK]; const float* gk = F.a->in[IN_MLAQK] + 192;
    bf16_t* QA = (bf16_t*)(F.ws + WS_QA);
    constexpr int NROW = 16384, NVT_CTX = 1024, NVT_LAT = 2048, NVT_CAC = 1024;
    const int lane = F.lane, hsub = lane >> 5, c = lane & 31; const bool act = c < 24;
    for (int it = F.gw; it < NTOK + NROW + NVT_CTX + NVT_LAT + NVT_CAC; it += F.NGW) {
        if (it < NTOK) {
            const int t = it; const bool lat = t >= NCTX; const int s = (t - NCTX) & 1023; const float row = (float)(s >> 6), col = (float)(s & 63);
            const int cc = act ? c : 23, cpq = cc >= 16 ? (cc ^ 2) : cc;
            float g[8], gp[8]; load8(gq + 8 * cc, g); load8(gq + 8 * cpq, gp);
            float v[4][8], vp[4][8];
#pragma unroll
            for (int pass = 0; pass < 4; ++pass) { const bf16_t* src = QM + (size_t)t * 1536 + (2 * pass + hsub) * 192; load8h(src + 8 * cc, v[pass]); load8h(src + 8 * cpq, vp[pass]); }
#pragma unroll
            for (int pass = 0; pass < 4; ++pass) {
                const int head = 2 * pass + hsub;
                float q = 0.f;
#pragma unroll
                for (int i = 0; i < 8; ++i) { v[pass][i] = act ? v[pass][i] : 0.f; q += v[pass][i] * v[pass][i]; }
                const float rstd = __builtin_amdgcn_rsqf(group_sum<32>(q) * (1.0f / 192) + EPS);
#pragma unroll
                for (int i = 0; i < 8; ++i) { v[pass][i] = v[pass][i] * rstd * g[i]; vp[pass][i] = vp[pass][i] * rstd * gp[i]; }
                if (lat && c >= 16 && act) rope8(v[pass], vp[pass], (c & 2) == 0, c < 20 ? row : col, (c & 1) * 8, 1.0f / 16);
                if (act) *(u32x4*)(QA + (size_t)t * 1536 + head * 192 + 8 * c) = pack8(v[pass]);
            }
        } else if (it < NTOK + NROW) {
            const int r = it - NTOK; const bool istok = r < NTOK; const bool lat = istok && r >= NCTX;
            int bsel, s; bf16_t* kb0; int nkeys;
            if (!istok) { bsel = (r - NTOK) >> 9; s = (r - NTOK) & 511; kb0 = (bf16_t*)(F.ws + WS_KM_CAC); nkeys = 512; }
            else if (lat) { bsel = (r - NCTX) >> 10; s = (r - NCTX) & 1023; kb0 = (bf16_t*)(F.ws + WS_KM_LAT); nkeys = 1024; }
            else { bsel = r >> 8; s = r & 255; kb0 = (bf16_t*)(F.ws + WS_KM_CTX); nkeys = 256; }
            const float* krp_f = istok ? (const float*)(F.ws + WS_KROPE) + (size_t)r * 64 : F.a->in[IN_C_KROPE] + (size_t)(r - NTOK) * 64;
            const float row = (float)(s >> 6), col = (float)(s & 63);
            const int cc = act ? c : 23, cpq = cc >= 16 ? (cc ^ 2) : cc, cn = c < 16 ? c : 15, cr = cc >= 16 ? cc - 16 : 0, crp = cc >= 16 ? cpq - 16 : 0;
            float g[8], gp[8], kr[8], krp[8]; load8(gk + 8 * cc, g); load8(gk + 8 * cpq, gp); load8(krp_f + 8 * cr, kr); load8(krp_f + 8 * crp, krp);
            float v[4][8];
#pragma unroll
            for (int pass = 0; pass < 4; ++pass) load8h(KVM + (size_t)r * 2048 + (2 * pass + hsub) * 256 + 8 * cn, v[pass]);
#pragma unroll
            for (int pass = 0; pass < 4; ++pass) {
                const int head = 2 * pass + hsub;
                float vp[8]; float q = 0.f;
#pragma unroll
                for (int i = 0; i < 8; ++i) { v[pass][i] = c < 16 ? v[pass][i] : (act ? kr[i] : 0.f); q += v[pass][i] * v[pass][i]; }
                const float rstd = __builtin_amdgcn_rsqf(group_sum<32>(q) * (1.0f / 192) + EPS);
#pragma unroll
                for (int i = 0; i < 8; ++i) { v[pass][i] = v[pass][i] * rstd * g[i]; vp[i] = krp[i] * rstd * gp[i]; }
                if (lat && c >= 16 && act) rope8(v[pass], vp, (c & 2) == 0, c < 20 ? row : col, (c & 1) * 8, 1.0f / 16);
                if (act) *(u32x4*)(kb0 + (size_t)(bsel * 8 + head) * ((size_t)nkeys * 192) + k_chunk_off(192, s, c)) = pack8(v[pass]);
            }
        } else {
            int r = it - NTOK - NROW;
            if (r < NVT_CTX) { const int t32 = r & 7, bh = r >> 3, b = bh >> 3, h = bh & 7;
                vt_tile_write_h(KVM + (size_t)(b * 256 + t32 * 32) * 2048 + h * 256 + 128, 2048, (bf16_t*)(F.ws + WS_VM_CTX) + (size_t)bh * (256 * 128) + (size_t)t32 * 4096, lane);
            } else if (r < NVT_CTX + NVT_LAT) { r -= NVT_CTX; const int t32 = r & 31, bh = r >> 5, b = bh >> 3, h = bh & 7;
                vt_tile_write_h(KVM + (size_t)(NCTX + b * 1024 + t32 * 32) * 2048 + h * 256 + 128, 2048, (bf16_t*)(F.ws + WS_VM_LAT) + (size_t)bh * (1024 * 128) + (size_t)t32 * 4096, lane);
            } else { r -= NVT_CTX + NVT_LAT; const int t32 = r & 15, bh = r >> 4, b = bh >> 3, h = bh & 7;
                vt_tile_write_h(KVM + (size_t)(NTOK + b * 512 + t32 * 32) * 2048 + h * 256 + 128, 2048, (bf16_t*)(F.ws + WS_VM_CAC) + (size_t)bh * (512 * 128) + (size_t)t32 * 4096, lane);
            }
        }
    }
}

__device__ __forceinline__ void phase_post_odd(Frame& F) {
    const bf16_t* P = (const bf16_t*)(F.ws + WS_P); const float* gq = F.a->in[IN_GQK]; const float* gk = F.a->in[IN_GQK] + 128;
    bf16_t* QA = (bf16_t*)(F.ws + WS_QA);
    constexpr int NVT_CTX = 16 * 4 * 8, NVT_LAT = 8 * 4 * 32;
    const int lane = F.lane, hsub = lane >> 4, c = lane & 15;
    for (int it = F.gw; it < NTOK + NVT_CTX + NVT_LAT; it += F.NGW) {
        if (it < NTOK) {
            const int t = it; const bool ctx = t < NCTX, lat = !ctx; const bf16_t* pr = P + (size_t)t * IN_ODD;
            int b, s; if (ctx) { b = t >> 8; s = t & 255; } else { b = (t - NCTX) >> 10; s = (t - NCTX) & 1023; }
            const float row = (float)(s >> 6), col = (float)(s & 63);
            const int cp = c ^ 4;
            float gqv[8], gqp[8], gkv[8], gkp[8]; load8(gq + 8 * c, gqv); load8(gq + 8 * cp, gqp); load8(gk + 8 * c, gkv); load8(gk + 8 * cp, gkp);
            float v[5][8], vp[5][8];
#pragma unroll
            for (int pass = 0; pass < 5; ++pass) { const bf16_t* src = pr + (pass == 4 ? 2048 + hsub * 128 : (4 * pass + hsub) * 128); load8h(src + 8 * c, v[pass]); load8h(src + 8 * cp, vp[pass]); }
#pragma unroll
            for (int pass = 0; pass < 5; ++pass) {
                const bool isk = pass == 4; const int head = isk ? hsub : 4 * pass + hsub;
                float q = 0.f;
#pragma unroll
                for (int i = 0; i < 8; ++i) q += v[pass][i] * v[pass][i];
                const float rstd = __builtin_amdgcn_rsqf(group_sum<16>(q) * (1.0f / 128) + EPS);
#pragma unroll
                for (int i = 0; i < 8; ++i) { v[pass][i] = v[pass][i] * rstd * (isk ? gkv[i] : gqv[i]); vp[pass][i] = vp[pass][i] * rstd * (isk ? gkp[i] : gqp[i]); }
                if (isk && ctx) store8f(F.out + O_GK + (size_t)t * 512 + head * 128 + 8 * c, v[pass]);
                if (lat) rope8(v[pass], vp[pass], (c & 4) == 0, c < 8 ? row : col, (c & 3) * 8, 1.0f / 32);
                if (!isk) *(u32x4*)(QA + (size_t)t * 2048 + head * 128 + 8 * c) = pack8(v[pass]);
                else { bf16_t* kb = ctx ? (bf16_t*)(F.ws + WS_KG_CTX) + (size_t)(b * 4 + head) * (256 * 128) : (bf16_t*)(F.ws + WS_KG_LAT) + (size_t)(b * 4 + head) * (1024 * 128);
                    *(u32x4*)(kb + k_chunk_off(128, s, c)) = pack8(v[pass]); }
            }
            { float vv[8]; load8h(pr + 2560 + 8 * lane, vv); if (ctx) store8f(F.out + O_GV + (size_t)t * 512 + 8 * lane, vv); }
        } else {
            int r = it - NTOK;
            if (r < NVT_CTX) { const int t32 = r & 7, bh = r >> 3, b = bh >> 2, h = bh & 3;
                vt_tile_write_h(P + (size_t)(b * 256 + t32 * 32) * IN_ODD + 2560 + h * 128, IN_ODD, (bf16_t*)(F.ws + WS_VG_CTX) + (size_t)bh * (256 * 128) + (size_t)t32 * 4096, lane);
            } else { r -= NVT_CTX; const int t32 = r & 31, bh = r >> 5, b = bh >> 2, h = bh & 3;
                vt_tile_write_h(P + (size_t)(NCTX + b * 1024 + t32 * 32) * IN_ODD + 2560 + h * 128, IN_ODD, (bf16_t*)(F.ws + WS_VG_LAT) + (size_t)bh * (1024 * 128) + (size_t)t32 * 4096, lane);
            }
        }
    }
}

struct WgUnit {
    const bf16_t* kc; const bf16_t* vc; int nctx;
    const bf16_t* kl; const bf16_t* vl; int t_lo, t_hi;
};
struct WvUnit {
    const bf16_t* qb; unsigned qoff; int qpitch; bf16_t* ob; unsigned ooff;
    int qpos;
    int qcol0;
    int w_lo, w_hi;
    float sink; int has_sink; float scale;
};
constexpr int ATT_RPB_OFF = RING_BYTES + 512;
constexpr float ATT_THR = 8.0f;
template <int MODE>
__device__ __forceinline__ float attn_mask(float v, int tile32, int r, int hh, int ql, bool masked, const WvUnit& U, const LAS float* rpb) {
    const int kk = (r & 3) + 8 * (r >> 2) + 4 * hh;
    if (MODE == 1) { const int df = U.qpos + ql - (tile32 * 32 + kk); if (masked && (df > 128 || df < -128)) v = -1e30f; }
    if (MODE == 2 && masked) { const int krow = tile32 >> 1, kcol = (tile32 & 1) * 32 + kk, qc = U.qcol0 + ql;
        int ws = qc - 8; ws = ws < 0 ? 0 : (ws > 48 ? 48 : ws);
        const bool valid = (kcol >= ws) && (kcol < ws + 16);
        int co = kcol - qc; co = co < -15 ? -15 : (co > 15 ? 15 : co);
        const float bias = rpb[(krow - U.qpos + 7) * 31 + co + 15];
        v = valid ? v + bias * LOG2E : -1e30f; }
    return v;
}
template <int OFF> __device__ __forceinline__ bf16x8 lds_rd(unsigned addr) { bf16x8 r; asm volatile("ds_read_b128 %0, %1 offset:%2" : "=v"(r) : "v"(addr), "i"(OFF)); return r; }
template <int BASE, int H1> __device__ __forceinline__ void lds_rd8(unsigned addr, bf16x8 (&a)[8]) {
    a[0] = lds_rd<BASE>(addr); a[1] = lds_rd<BASE + 1024>(addr); a[2] = lds_rd<BASE + 2048>(addr); a[3] = lds_rd<BASE + 3072>(addr);
    a[4] = lds_rd<BASE + H1>(addr); a[5] = lds_rd<BASE + H1 + 1024>(addr); a[6] = lds_rd<BASE + H1 + 2048>(addr); a[7] = lds_rd<BASE + H1 + 3072>(addr);
}
#define LDS_WAIT8(n, a) asm volatile("s_waitcnt lgkmcnt(" #n ")" : "+v"(a[0]), "+v"(a[1]), "+v"(a[2]), "+v"(a[3]), "+v"(a[4]), "+v"(a[5]), "+v"(a[6]), "+v"(a[7]))
#define QK_MMA8(a, kb) do { _Pragma("unroll") for (int _j = 0; _j < 4; ++_j) { s0 = __builtin_amdgcn_mfma_f32_32x32x16_bf16(a[_j], qf[(kb) * 4 + _j], s0, 0, 0, 0); s1 = __builtin_amdgcn_mfma_f32_32x32x16_bf16(a[4 + _j], qf[(kb) * 4 + _j], s1, 0, 0, 0); } } while (0)
__device__ __forceinline__ void na_mask16(f32x16& sx, int tile32, int hh, int ql, bool masked, const WvUnit& U, const LAS float* rpb) {
    const int krow = tile32 >> 1, kc0 = (tile32 & 1) * 32 + 4 * hh, qc = U.qcol0 + ql;
    int ws = qc - 8; ws = ws < 0 ? 0 : (ws > 48 ? 48 : ws);
    int ro = krow - U.qpos + 7; ro = ro < 0 ? 0 : (ro > 14 ? 14 : ro);
    const LAS float* rrow = rpb + ro * 31 + 15;
    float bias[16];
#pragma unroll
    for (int r = 0; r < 16; ++r) { int co = kc0 + (r & 3) + 8 * (r >> 2) - qc; co = co < -15 ? -15 : (co > 15 ? 15 : co); bias[r] = rrow[co]; }
#pragma unroll
    for (int r = 0; r < 16; ++r) { const int kcol = kc0 + (r & 3) + 8 * (r >> 2); const float mv = ((unsigned)(kcol - ws) < 16u) ? sx[r] + bias[r] * LOG2E : -1e30f; sx[r] = masked ? mv : sx[r]; }
}
template <int DQK, int MODE>
__device__ __forceinline__ void attn_tile64(const LAS unsigned char* sl, int t64, bool masked, const bf16x8 (&qf)[DQK / 16], f32x16 (&o)[4], float& m, float& l, const WvUnit& U, const LAS float* rpb, int lane, float sl2) {
    constexpr int NKS = DQK / 16, KB = DQK * 128;
    const int ql = lane & 31, hh = lane >> 5;
    const unsigned addr = (unsigned)(unsigned long)sl + (unsigned)lane * 16u;
    f32x16 s0, s1;
#pragma unroll
    for (int r = 0; r < 16; ++r) { s0[r] = 0.f; s1[r] = 0.f; }
    bf16x8 pb[4];
#define ATT_SMA(sx, T32) do { float mt = -1e30f; \
    if (MODE == 1) { if (masked) {   \
            _Pragma("unroll") for (int r = 0; r < 16; ++r) sx[r] = attn_mask<MODE>(sx[r] * sl2, (T32), r, hh, ql, true, U, rpb); } } \
    if (MODE == 2) { _Pragma("unroll") for (int r = 0; r < 16; ++r) sx[r] *= sl2; na_mask16(sx, (T32), hh, ql, masked, U, rpb); } \
    _Pragma("unroll") for (int r = 0; r < 16; ++r) mt = fmaxf(mt, sx[r]); \
    if (MODE == 0 || (MODE == 1 && !masked)) mt *= sl2;     \
    mt = fmaxf(mt, __shfl_xor(mt, 32)); \
    if (!__all(mt - m <= ATT_THR)) { const float mn = fmaxf(m, mt), alpha = fast_exp2(m - mn); m = mn; l *= alpha; \
        _Pragma("unroll") for (int db = 0; db < 4; ++db) _Pragma("unroll") for (int r = 0; r < 16; ++r) o[db][r] *= alpha; } } while (0)
#define ATT_SMB(sx, PBI) do { float ps = 0.f; const float esc = (MODE == 0 || (MODE == 1 && !masked)) ? sl2 : 1.0f; \
    _Pragma("unroll") for (int r = 0; r < 16; ++r) { sx[r] = fast_exp2(fmaf(sx[r], esc, -m)); ps += sx[r]; } \
    l += ps; \
    _Pragma("unroll") for (int s2 = 0; s2 < 2; ++s2) { \
        u32x4 w; w.x = pk2(sx[8 * s2 + 0], sx[8 * s2 + 1]); w.y = pk2(sx[8 * s2 + 2], sx[8 * s2 + 3]); w.z = pk2(sx[8 * s2 + 4], sx[8 * s2 + 5]); w.w = pk2(sx[8 * s2 + 6], sx[8 * s2 + 7]); pb[(PBI) + s2] = __builtin_bit_cast(bf16x8, w); } } while (0)
#define MFMA32(a_, b_, c_) __builtin_amdgcn_mfma_f32_32x32x16_bf16(a_, b_, c_, 0, 0, 0)
    if constexpr (NKS == 8) {
        bf16x8 ka[8], kb_[8];
        lds_rd8<0, 4096>(addr, ka); lds_rd8<KB / 2, 4096>(addr, kb_);
        LDS_WAIT8(8, ka);
#pragma unroll
        for (int j = 0; j < 8; ++j) s0 = MFMA32(ka[j], qf[j], s0);
        if (MODE != 2) { lds_rd8<KB, 4096>(addr, ka); LDS_WAIT8(8, kb_); } else LDS_WAIT8(0, kb_);
#pragma unroll
        for (int j = 0; j < 4; ++j) s1 = MFMA32(kb_[j], qf[j], s1);
        ATT_SMA(s0, 2 * t64);
        if (MODE == 2) lds_rd8<KB, 4096>(addr, ka);
#pragma unroll
        for (int j = 4; j < 8; ++j) s1 = MFMA32(kb_[j], qf[j], s1);
        ATT_SMB(s0, 0);
        lds_rd8<KB + 8192, 4096>(addr, kb_);
        LDS_WAIT8(8, ka);
#pragma unroll
        for (int db = 0; db < 4; ++db) o[db] = MFMA32(ka[db], pb[0], o[db]);
        ATT_SMA(s1, 2 * t64 + 1);
#pragma unroll
        for (int db = 0; db < 4; ++db) o[db] = MFMA32(ka[4 + db], pb[1], o[db]);
        ATT_SMB(s1, 2);
        LDS_WAIT8(0, kb_);
#pragma unroll
        for (int s2 = 0; s2 < 2; ++s2)
#pragma unroll
            for (int db = 0; db < 4; ++db) o[db] = MFMA32(kb_[s2 * 4 + db], pb[2 + s2], o[db]);
    } else {
        bf16x8 ka[4], kb_[4];
#define RDK4(a, h, b) do { a[0] = lds_rd<(h) * (KB / 2) + (b) * 4096>(addr); a[1] = lds_rd<(h) * (KB / 2) + (b) * 4096 + 1024>(addr); a[2] = lds_rd<(h) * (KB / 2) + (b) * 4096 + 2048>(addr); a[3] = lds_rd<(h) * (KB / 2) + (b) * 4096 + 3072>(addr); } while (0)
#define RDV4(a, q) do { a[0] = lds_rd<KB + (q) * 4096>(addr); a[1] = lds_rd<KB + (q) * 4096 + 1024>(addr); a[2] = lds_rd<KB + (q) * 4096 + 2048>(addr); a[3] = lds_rd<KB + (q) * 4096 + 3072>(addr); } while (0)
#define WAIT4(n, a) asm volatile("s_waitcnt lgkmcnt(" #n ")" : "+v"(a[0]), "+v"(a[1]), "+v"(a[2]), "+v"(a[3]))
#define QK4(a, sx, b) do { _Pragma("unroll") for (int j = 0; j < 4; ++j) sx = MFMA32(a[j], qf[4 * (b) + j], sx); } while (0)
#define PV4(a, q) do { _Pragma("unroll") for (int db = 0; db < 4; ++db) o[db] = MFMA32(a[db], pb[q], o[db]); } while (0)
        RDK4(ka, 0, 0); RDK4(kb_, 0, 1);
        WAIT4(4, ka); QK4(ka, s0, 0); RDK4(ka, 0, 2);
        WAIT4(4, kb_); QK4(kb_, s0, 1); RDK4(kb_, 1, 0);
        WAIT4(4, ka); QK4(ka, s0, 2); RDK4(ka, 1, 1);
        WAIT4(4, kb_); QK4(kb_, s1, 0); RDK4(kb_, 1, 2);
        ATT_SMA(s0, 2 * t64);
        WAIT4(4, ka); QK4(ka, s1, 1); RDV4(ka, 0);
        ATT_SMB(s0, 0);
        WAIT4(4, kb_); QK4(kb_, s1, 2); RDV4(kb_, 1);
        WAIT4(4, ka); PV4(ka, 0); RDV4(ka, 2);
        ATT_SMA(s1, 2 * t64 + 1);
        WAIT4(4, kb_); PV4(kb_, 1); RDV4(kb_, 3);
        ATT_SMB(s1, 2);
        WAIT4(4, ka); PV4(ka, 2);
        WAIT4(0, kb_); PV4(kb_, 3);
#undef RDK4
#undef RDV4
#undef WAIT4
#undef QK4
#undef PV4
    }
#undef ATT_SMA
#undef ATT_SMB
#undef MFMA32
}
template <int DQK, int MODE, int VAR = 0>
__device__ __forceinline__ void attn_wg_unit(LAS unsigned char* ring, const WgUnit& G, const WvUnit& U, const float* rpb_g, int tid, int wave, int lane) {
    constexpr int NKS = DQK / 16, KB = DQK * 128, NLK = KB / 8192;
    constexpr int NS = (DQK == 128) ? 4 : 3, SLOTB = KB + 16384;
    const int ql = lane & 31, hh = lane >> 5;
    const int ntiles = G.nctx + (G.t_hi - G.t_lo);
    const LAS float* rpb = (const LAS float*)(ring + ATT_RPB_OFF);
#define ATT_ISSUE(i, SLOTC) do { const int _i = (i); const bool _c = _i < G.nctx; const int _t = _c ? _i : G.t_lo + (_i - G.nctx); \
        const char* _kg = (const char*)(_c ? G.kc : G.kl) + (size_t)_t * KB + tid * 16; const char* _vg = (const char*)(_c ? G.vc : G.vl) + (size_t)_t * 16384 + tid * 16; \
        LAS unsigned char* _sl = ring + (SLOTC) * SLOTB + wave * 1024; \
        _Pragma("unroll") for (int _p = 0; _p < NLK; ++_p) __builtin_amdgcn_global_load_lds((const unsigned*)(_kg + _p * 8192), (LAS unsigned*)(_sl + _p * 8192), 16, 0, 0); \
        _Pragma("unroll") for (int _p = 0; _p < 2; ++_p) __builtin_amdgcn_global_load_lds((const unsigned*)(_vg + _p * 8192), (LAS unsigned*)(_sl + KB + _p * 8192), 16, 0, 0); } while (0)
    asm volatile("s_waitcnt lgkmcnt(0)" ::: "memory"); __builtin_amdgcn_s_barrier(); asm volatile("" ::: "memory");
    bf16x8 qf[NKS];
#pragma unroll
    for (int ks = 0; ks < NKS; ++ks) qf[ks] = *(const bf16x8*)(U.qb + (size_t)(U.qoff + (unsigned)(ql * U.qpitch + 16 * ks + 8 * hh)));
    if (MODE == 2) { const int i = opaque_v(tid); if (i < 15 * 31) ((LAS float*)(ring + ATT_RPB_OFF))[i] = rpb_g[i]; }
    if (VAR != 2) { ATT_ISSUE(0, 0); if (ntiles > 1) ATT_ISSUE(1, 1); if (NS == 4 && ntiles > 2) ATT_ISSUE(2, 2); }
    f32x16 o[4];
#pragma unroll
    for (int db = 0; db < 4; ++db)
#pragma unroll
        for (int r = 0; r < 16; ++r) o[db][r] = 0.f;
    float m = -1e30f, l = 0.f;
    const float sl2 = U.scale * LOG2E;
#define ATT_STEP(i_, SLOTC) do { const int i = (i_); if (i < ntiles) { \
        if (NS == 4) { if (i + 2 < ntiles) asm volatile("s_waitcnt vmcnt(8)" ::: "memory"); else if (i + 1 < ntiles) asm volatile("s_waitcnt vmcnt(4)" ::: "memory"); else asm volatile("s_waitcnt vmcnt(0)" ::: "memory"); } \
        else { if (i + 1 < ntiles) asm volatile("s_waitcnt vmcnt(5)" ::: "memory"); else asm volatile("s_waitcnt vmcnt(0)" ::: "memory"); } \
        asm volatile("s_waitcnt lgkmcnt(0)" ::: "memory"); __builtin_amdgcn_s_barrier(); asm volatile("" ::: "memory"); \
        if (VAR != 2 && i + NS - 1 < ntiles) ATT_ISSUE(i + NS - 1, ((SLOTC) + NS - 1) % NS); \
        const bool isctx = i < G.nctx; const int t64 = isctx ? 0 : G.t_lo + (i - G.nctx); \
        if (VAR != 1 && (isctx || (t64 >= U.w_lo && t64 < U.w_hi))) attn_tile64<DQK, MODE>(ring + (SLOTC) * SLOTB, t64, !isctx, qf, o, m, l, U, rpb, lane, sl2); } } while (0)
    if constexpr (NS == 4) { for (int i0 = 0; i0 < ntiles; i0 += 4) { ATT_STEP(i0, 0); ATT_STEP(i0 + 1, 1); ATT_STEP(i0 + 2, 2); ATT_STEP(i0 + 3, 3); } }
    else { for (int i0 = 0; i0 < ntiles; i0 += 3) { ATT_STEP(i0, 0); ATT_STEP(i0 + 1, 1); ATT_STEP(i0 + 2, 2); } }
#undef ATT_STEP
#undef ATT_ISSUE
    l += __shfl_xor(l, 32);
    if (U.has_sink) l += fast_exp2(U.sink * LOG2E - m);
    const float inv = 1.0f / l;
    bf16_t* op = U.ob + (size_t)(U.ooff + (unsigned)(opaque_v(ql) * DM));
#pragma unroll
    for (int db = 0; db < 4; ++db)
#pragma unroll
        for (int k = 0; k < 2; ++k) {
            const unsigned p0x = pk2(o[db][8 * k] * inv, o[db][8 * k + 1] * inv), p0y = pk2(o[db][8 * k + 2] * inv, o[db][8 * k + 3] * inv);
            const unsigned p1x = pk2(o[db][8 * k + 4] * inv, o[db][8 * k + 5] * inv), p1y = pk2(o[db][8 * k + 6] * inv, o[db][8 * k + 7] * inv);
            const auto sx = __builtin_amdgcn_permlane32_swap(p0x, p1x, false, false);
            const auto sy = __builtin_amdgcn_permlane32_swap(p0y, p1y, false, false);
            u32x4 w; w.x = sx[0]; w.y = sy[0]; w.z = sx[1]; w.w = sy[1];
            *(u32x4*)(op + 32 * db + 16 * k + 8 * hh) = w; }
}

template <int VAR>
__device__ __forceinline__ void phase_attn_even(Frame& F, bf16_t* O) {
 const bf16_t* QA = (const bf16_t*)(F.ws + WS_QA); const bf16_t* QNA = (const bf16_t*)(F.ws + WS_QNA);
    const int wave = F.wave, lane = F.lane, tid = F.tid;
    WgUnit G; WvUnit U; U.sink = 0.f; U.has_sink = 0; U.qpos = 0; U.qcol0 = 0;
    const int vcu = (F.G % 8 == 0) ? ((int)blockIdx.x % 8) * (F.G / 8) + (int)blockIdx.x / 8 : (int)blockIdx.x;
    for (int u = vcu; u < 256; u += F.G) { const int bh = u >> 2, q4 = u & 3, b = bh >> 3, h = bh & 7, t0 = NCTX + b * 1024 + q4 * 256 + 32 * wave;
        U.qb = QA; U.qoff = (unsigned)(t0 * 1536 + h * 192); U.qpitch = 1536; U.scale = 0.07216878364870322f; U.ob = O; U.ooff = (unsigned)(t0 * DM + h * 128);
        G.kc = (const bf16_t*)(F.ws + WS_KM_CAC) + (size_t)bh * (512 * 192); G.vc = (const bf16_t*)(F.ws + WS_VM_CAC) + (size_t)bh * (512 * 128); G.nctx = 8;
        G.kl = (const bf16_t*)(F.ws + WS_KM_LAT) + (size_t)bh * (1024 * 192); G.vl = (const bf16_t*)(F.ws + WS_VM_LAT) + (size_t)bh * (1024 * 128); G.t_lo = 0; G.t_hi = 16; U.w_lo = 0; U.w_hi = 16;
        attn_wg_unit<192, 0, VAR>(F.lds, G, U, nullptr, tid, wave, lane); }
    for (int u = vcu; u < 256; u += F.G) { const int bh = u >> 2, r0 = (u & 3) * 4, b = bh >> 3, h = bh & 7, r = r0 + (wave >> 1), c0 = (wave & 1) * 32, t0 = NCTX + b * 1024 + r * 64 + c0;
        int rs = r - 4; rs = rs < 0 ? 0 : (rs > 8 ? 8 : rs);
        int glo = r0 - 4; glo = glo < 0 ? 0 : (glo > 8 ? 8 : glo); int ghi = r0 - 1; ghi = ghi < 0 ? 0 : (ghi > 8 ? 8 : ghi);
        U.qb = QNA; U.qoff = (unsigned)(t0 * 1024 + h * 128); U.qpitch = 1024; U.scale = 0.08838834764831845f; U.ob = O; U.ooff = (unsigned)(t0 * DM + 1024 + h * 128);
        G.kc = (const bf16_t*)(F.ws + WS_KN_CAC) + (size_t)bh * (512 * 128); G.vc = (const bf16_t*)(F.ws + WS_VN_CAC) + (size_t)bh * (512 * 128); G.nctx = 8;
        G.kl = (const bf16_t*)(F.ws + WS_KN_LAT) + (size_t)bh * (1024 * 128); G.vl = (const bf16_t*)(F.ws + WS_VN_LAT) + (size_t)bh * (1024 * 128); G.t_lo = glo; G.t_hi = ghi + 8; U.w_lo = rs; U.w_hi = rs + 8;
        U.qpos = r; U.qcol0 = c0;
        attn_wg_unit<128, 2, VAR>(F.lds, G, U, F.a->in[IN_RPB] + h * (15 * 31), tid, wave, lane); }
    U.qpos = 0; U.qcol0 = 0; U.w_lo = 0; U.w_hi = 4; G.nctx = 0; G.kc = nullptr; G.vc = nullptr; G.t_lo = 0; G.t_hi = 4;
    for (int u = vcu; u < 256; u += F.G) { const int bh = u & 127, b = bh >> 3, h = bh & 7, t0 = b * 256 + 32 * wave;
        if (u < 128) {
            U.qb = QA; U.qoff = (unsigned)(t0 * 1536 + h * 192); U.qpitch = 1536; U.scale = 0.07216878364870322f; U.ob = O; U.ooff = (unsigned)(t0 * DM + h * 128);
            G.kl = (const bf16_t*)(F.ws + WS_KM_CTX) + (size_t)bh * (256 * 192); G.vl = (const bf16_t*)(F.ws + WS_VM_CTX) + (size_t)bh * (256 * 128);
            attn_wg_unit<192, 0, VAR>(F.lds, G, U, nullptr, tid, wave, lane);
        } else {
            U.qb = QNA; U.qoff = (unsigned)(t0 * 1024 + h * 128); U.qpitch = 1024; U.scale = 0.08838834764831845f; U.ob = O; U.ooff = (unsigned)(t0 * DM + 1024 + h * 128);
            G.kl = (const bf16_t*)(F.ws + WS_KN_CTX) + (size_t)bh * (256 * 128); G.vl = (const bf16_t*)(F.ws + WS_VN_CTX) + (size_t)bh * (256 * 128);
            attn_wg_unit<128, 0, VAR>(F.lds, G, U, nullptr, tid, wave, lane);
        } }
    asm volatile("s_waitcnt vmcnt(0) lgkmcnt(0)" ::: "memory"); __syncthreads();
}
__device__ __forceinline__ void phase_attn_odd(Frame& F) {
    bf16_t* O = (bf16_t*)(F.ws + WS_O); const bf16_t* QA = (const bf16_t*)(F.ws + WS_QA);
    const int wave = F.wave, lane = F.lane, tid = F.tid;
    WgUnit G; WvUnit U; U.has_sink = 1; U.qcol0 = 0; U.qpitch = 2048; U.scale = 0.08838834764831845f;
    const int vcu = (F.G % 8 == 0) ? ((int)blockIdx.x % 8) * (F.G / 8) + (int)blockIdx.x / 8 : (int)blockIdx.x;
    const float* sink = F.a->in[IN_SINK];
    for (int u = vcu; u < 512; u += F.G) { const int bk = u >> 4, q64 = u & 15, b = bk >> 2, kvh = bk & 3, g = wave >> 1, hq = kvh * 4 + g, qs = q64 * 64 + (wave & 1) * 32, t0 = NCTX + b * 1024 + qs;
        U.qb = QA; U.qoff = (unsigned)(t0 * 2048 + hq * 128); U.ob = O; U.ooff = (unsigned)(t0 * DM + hq * 128); U.qpos = qs; U.sink = sink[hq];
        G.kc = (const bf16_t*)(F.ws + WS_KG_CAC) + (size_t)bk * (512 * 128); G.vc = (const bf16_t*)(F.ws + WS_VG_CAC) + (size_t)bk * (512 * 128); G.nctx = 8;
        G.kl = (const bf16_t*)(F.ws + WS_KG_LAT) + (size_t)bk * (1024 * 128); G.vl = (const bf16_t*)(F.ws + WS_VG_LAT) + (size_t)bk * (1024 * 128);
        G.t_lo = q64 - 2 < 0 ? 0 : q64 - 2; G.t_hi = (q64 + 2 > 15 ? 15 : q64 + 2) + 1; U.w_lo = G.t_lo; U.w_hi = G.t_hi;
        attn_wg_unit<128, 1>(F.lds, G, U, nullptr, tid, wave, lane); }
    G.nctx = 0; G.kc = nullptr; G.vc = nullptr; G.t_lo = 0; G.t_hi = 4; U.w_lo = 0; U.w_hi = 4;
    for (int u = vcu; u < 256; u += F.G) { const int bk = u >> 2, q64 = u & 3, b = bk >> 2, kvh = bk & 3, g = wave >> 1, hq = kvh * 4 + g, qs = q64 * 64 + (wave & 1) * 32, t0 = b * 256 + qs;
        U.qb = QA; U.qoff = (unsigned)(t0 * 2048 + hq * 128); U.ob = O; U.ooff = (unsigned)(t0 * DM + hq * 128); U.qpos = 0; U.sink = sink[hq];
        G.kl = (const bf16_t*)(F.ws + WS_KG_CTX) + (size_t)bk * (256 * 128); G.vl = (const bf16_t*)(F.ws + WS_VG_CTX) + (size_t)bk * (256 * 128);
        attn_wg_unit<128, 0>(F.lds, G, U, nullptr, tid, wave, lane); }
    asm volatile("s_waitcnt vmcnt(0) lgkmcnt(0)" ::: "memory"); __syncthreads();
}

constexpr int N_PHASES = 36;
__global__ void __launch_bounds__(512, 2) fwd_kernel(Args args) {
    extern __shared__ __attribute__((aligned(16))) unsigned char lds_raw[];
    Frame F;
    F.lds = (LAS unsigned char*)lds_raw;
    F.tid = threadIdx.x; F.lane = F.tid & 63; F.wave = __builtin_amdgcn_readfirstlane(F.tid >> 6);
    F.G = gridDim.x; F.gw = blockIdx.x * 8 + F.wave; F.NGW = F.G * 8;
    F.a = &args; F.out = args.out; F.ws = args.ws;
    volatile LAS unsigned* MISC = (volatile LAS unsigned*)(F.lds + LDSCTL_OFF);
    for (int u = F.tid; u < (LDS_BYTES - LDSCTL_OFF) / 4; u += 512) ((LAS unsigned*)(F.lds + LDSCTL_OFF))[u] = 0u;
    __syncthreads();
    unsigned* ctl = (unsigned*)(F.ws + WS_CTL);
    const int lo = args.ph_lo, hi = args.ph_hi;
    const bool multi = (hi - lo) > 1;
    XcdBarrier bar; bar.bar = ctl + CW_BAR; bar.x = 0; bar.st = nullptr;
    if (multi) bar = xcd_barrier_post(ctl + CW_BAR, MISC + 8);
#define IN(k) (lo <= (k) && (k) < hi)
    int ph = 0;
#define PHASE(...) do { if (IN(ph)) { __VA_ARGS__ } if (IN(ph) && IN(ph + 1)) xcd_barrier(bar); ++ph; } while (0)
    const float* mods = (const float*)(F.ws + WS_MODS);
    bf16_t* H = (bf16_t*)(F.ws + WS_H); bf16_t* ACT = (bf16_t*)(F.ws + WS_ACT); float* P = (float*)(F.ws + WS_P); bf16_t* OB = (bf16_t*)(F.ws + WS_O);
    LAS unsigned char* ring = F.lds;
    const int cid = (int)blockIdx.x;
#define GEMM2(EPI_T, EDEF, A_, B_, M_, N_, K_, SLAB) \
    PHASE( pg8::Gemm g{(A_), (B_), (M_), (N_), (K_)}; typedef pg8::SplitOrder<(M_), (N_), (K_), true> SO; SO S; S.init(cid); EDEF; pg8::gemm_phase<EPI_T, SO, true, true>(ring, g, S, E, (SLAB)); ); \
    PHASE( typedef pg8::SplitOrder<(M_), (N_), (K_), true> SO; EDEF; pg8::gemm_fixup<EPI_T, SO>(E, (SLAB)); )
#define GEMM1(EPI_T, EDEF, A_, B_, M_, N_, K_) \
    PHASE( pg8::Gemm g{(A_), (B_), (M_), (N_), (K_)}; typedef pg8::SplitOrder<(M_), (N_), (K_), false> SO; SO S; S.init(cid); EDEF; pg8::gemm_phase<EPI_T, SO, true, true>(ring, g, S, E, nullptr); )
#define W_FI(layer, f) ((const bf16_t*)(F.ws + WS_WFI) + (size_t)((layer) * 2 + (f)) * NFF2 * DM)
#define W_FO(layer, f) ((const bf16_t*)(F.ws + WS_WFO) + (size_t)((layer) * 2 + (f)) * DM * DFF)
#define E_SWIGLU EpiSwiGLU E{ACT}
#define E_RESID(RT, layer, gidx, coef) RT E{F.a->in[IN_XP], F.a->in[IN_XS], (bf16_t*)(F.ws + WS_XB), F.out, mods + (size_t)(layer) * 9 * NMOD + (size_t)(gidx) * DM, (coef)}
#define FFN(layer, f, RT) \
    GEMM2(EpiSwiGLU, E_SWIGLU, H, W_FI(layer, f), NTOK, NFF2, DM, P); \
    GEMM2(RT, E_RESID(RT, layer, (f) ? 8 : 2, 0.5f), ACT, W_FO(layer, f), NTOK, DM, DFF, P)

    PHASE( phase_prologue(F); );
    PHASE( phase_norm(F, true, 0, 0); );
    FFN(0, 0, ResidIn);
    PHASE( phase_norm(F, false, 0, 1); );
    GEMM1(EpiBf16, EpiBf16 E{(bf16_t*)P COMMA IN_EVEN_P}, H, (const bf16_t*)(F.ws + WS_WEI), NTOK, IN_EVEN_P, DM);
    PHASE( phase_post1_even(F); );
    PHASE( { pg8::Gemm g{(const bf16_t*)(F.ws + WS_CQN), (const bf16_t*)(F.ws + WS_WQU), NTOK, 1536, 512}; typedef pg8::SplitOrder<NTOK, 1536, 512, false> SO; SO S; S.init(cid);
             EpiBf16 E{(bf16_t*)(F.ws + WS_QM), 1536}; pg8::gemm_phase<EpiBf16, SO, true, true>(ring, g, S, E, nullptr); }
           { pg8::Gemm g{(const bf16_t*)(F.ws + WS_CKVA), (const bf16_t*)(F.ws + WS_WKU), 16384, 2048, 512}; typedef pg8::SplitOrder<16384, 2048, 512, false> SO; SO S; S.init(cid);
             EpiBf16 E{(bf16_t*)(F.ws + WS_ACT), 2048}; pg8::gemm_phase<EpiBf16, SO, true, true>(ring, g, S, E, nullptr); } );
    PHASE( phase_post2_even(F); );
    PHASE( phase_attn_even<0>(F, (bf16_t*)(F.ws + WS_O)); );
    GEMM2(ResidMid, E_RESID(ResidMid, 0, 5, 1.0f), OB, (const bf16_t*)(F.ws + WS_WEO), NTOK, DM, DM, P);
    PHASE( phase_norm(F, false, 0, 2); );
    FFN(0, 1, ResidMid);
    PHASE( phase_norm(F, false, 1, 0); );
    FFN(1, 0, ResidMid);
    PHASE( phase_norm(F, false, 1, 1); );
    GEMM2(EpiBf16, EpiBf16 E{(bf16_t*)P COMMA IN_ODD}, H, (const bf16_t*)(F.ws + WS_WOI), NTOK, IN_ODD, DM, (float*)(F.ws + WS_ACT));
    PHASE( phase_post_odd(F); );
    PHASE( phase_attn_odd(F); );
    GEMM2(ResidMid, E_RESID(ResidMid, 1, 5, 1.0f), OB, (const bf16_t*)(F.ws + WS_WOO), NTOK, DM, DM, P);
    PHASE( phase_norm(F, false, 1, 2); );
    FFN(1, 1, ResidOut);
#undef IN
}

extern "C" void kernel_launch(void* const* d_in, const int* in_sizes, int n_in, void* d_out, int out_size, void* d_ws, size_t ws_size, hipStream_t stream) {
    static int grid = 0;
    if (grid == 0) {
        if (n_in != 28 || (size_t)out_size != O_END || ws_size < WS_END) { fprintf(stderr, "kernel_launch: unexpected shapes (n_in %d, out %d, ws %zu; need ws >= %zu); nothing launched\n", n_in, out_size, ws_size, (size_t)WS_END); grid = -1; return; }
        int dev = 0, cus = 0, per_cu = 0;
        if (hipGetDevice(&dev) != hipSuccess || hipDeviceGetAttribute(&cus, hipDeviceAttributeMultiprocessorCount, dev) != hipSuccess) { grid = -1; return; }
        if (hipFuncSetAttribute((const void*)fwd_kernel, hipFuncAttributeMaxDynamicSharedMemorySize, LDS_BYTES) != hipSuccess) { fprintf(stderr, "kernel_launch: hipFuncSetAttribute failed\n"); grid = -1; return; }
        if (hipOccupancyMaxActiveBlocksPerMultiprocessor(&per_cu, (const void*)fwd_kernel, 512, LDS_BYTES) != hipSuccess || per_cu < 1) { fprintf(stderr, "kernel_launch: occupancy query says %d blocks per CU\n", per_cu); }
        (void)hipGetLastError();
        if (cus < pg8::GRID) { fprintf(stderr, "kernel_launch: %d CUs < %d workgroups: not resident; nothing launched\n", cus, pg8::GRID); grid = -1; return; }
        grid = pg8::GRID;
    }
    if (grid < 0) return;
    if (hipMemsetAsync((char*)d_ws + WS_CTL, 0, CTL_ZERO_BYTES, stream) != hipSuccess) return;
    Args a{};
    for (int i = 0; i < 28; ++i) a.in[i] = (const float*)d_in[i];
    a.out = (float*)d_out; a.ws = (unsigned char*)d_ws;
#if MK_ONE_LAUNCH
    a.ph_lo = 0; a.ph_hi = N_PHASES;
    hipLaunchKernelGGL(fwd_kernel, dim3(grid), dim3(512), LDS_BYTES, stream, a);
#else
    for (int p = 0; p < N_PHASES; ++p) { a.ph_lo = p; a.ph_hi = p + 1; hipLaunchKernelGGL(fwd_kernel, dim3(grid), dim3(512), LDS_BYTES, stream, a); }
#endif
}
```

```cpp
#include <hip/hip_runtime.h>
#include <cstdio>
#include <cstdint>

#ifndef MK_ONE_LAUNCH
#define MK_ONE_LAUNCH 1
#endif

#define COMMA ,
#define GAS __attribute__((address_space(1)))
#define LAS __attribute__((address_space(3)))
typedef unsigned short bf16_t;
typedef short bf16x8 __attribute__((ext_vector_type(8)));
typedef float f32x4 __attribute__((ext_vector_type(4)));
typedef float f32x16 __attribute__((ext_vector_type(16)));
typedef unsigned u32x4 __attribute__((ext_vector_type(4)));
typedef unsigned u32x2 __attribute__((ext_vector_type(2)));

namespace pg8 {
constexpr int BM = 256, BK = 64, HALF = 128, HTB = HALF * BK * 2, STAGE_BYTES = 8 * HTB, NXCD = 8, WGM = 8;
__host__ __device__ __forceinline__ int lds_byte(int r, int c) { const int st = (r >> 4) * 2 + (c >> 5), rr = r & 15, cc = c & 31, ob = rr * 64 + cc * 2; return st * 1024 + (ob ^ (((ob >> 9) & 1) << 5)); }
__host__ __device__ __forceinline__ void stage_rc(int b, int& R, int& C) { const int st = b / 1024, sb = b % 1024, swz = sb ^ (((sb >> 9) & 1) << 5); R = (st >> 1) * 16 + swz / 64; C = (st & 1) * 32 + (swz % 64) / 2; }
__host__ __device__ __forceinline__ int perm32(int rho) { const int n = rho >> 4, i = rho & 15; return 8 * (i >> 2) + 4 * n + (i & 3); }
struct Unit { int pm, pn, kt0, nkt, part; };
struct Gemm { const bf16_t* A; const bf16_t* Bt; int M, N, K; };
constexpr int GRID = 256;
template <int M, int N, int K, bool SPLIT>
struct SplitOrder {
    static constexpr int nM = M / BM, nN = N / BM, nwg = nM * nN, G = GRID, nt = K / BK, nfull = (nwg / G) * G, rem = nwg - nfull, NR = nfull / G;
    static constexpr int S0 = (SPLIT && rem > 0 && G % rem == 0) ? G / rem : 1;
    static constexpr int S = ((S0 == 2 || S0 == 4) && nt % (2 * S0) == 0) ? S0 : 1;
    int c;
    __host__ __device__ void init(int c_) { c = c_; }
    __host__ __device__ static Unit unit_of(int L, int kt0, int nkt, int part) {
        int wgid = L; { constexpr int q = nwg / NXCD, r = nwg % NXCD; const int xcd = wgid % NXCD, off = wgid / NXCD; wgid = (xcd < r ? xcd * (q + 1) : r * (q + 1) + (xcd - r) * q) + off; }
        constexpr int nig = WGM * nN; const int gid = wgid / nig, fm = gid * WGM, gsz = (nM - fm) < WGM ? (nM - fm) : WGM;
        Unit u; u.pm = fm + ((wgid % nig) % gsz); u.pn = (wgid % nig) / gsz; u.kt0 = kt0; u.nkt = nkt; u.part = part; return u;
    }
    __host__ __device__ bool next(int i, Unit& u) const {
        int j = i;
        if (S > 1 && NR > 0 && (c & 4)) j = (i == 0) ? NR : i - 1;
        int L = j * G + c, kt0 = 0, nkt = nt, part = -1; bool ok = (S > 1) ? (i <= NR) : (L < nwg);
        if (S > 1 && j >= NR) { constexpr int R1 = rem > 0 ? rem : 1; L = nfull + (c % R1); nkt = nt / S; kt0 = (c / R1) * (nt / S); part = c; }
        if (!ok) return false;
        u = unit_of(L, kt0, nkt, part); return true;
    }
};
typedef float f32x2_t __attribute__((ext_vector_type(2)));
typedef __bf16 bf16x2_t __attribute__((ext_vector_type(2)));
__device__ __forceinline__ unsigned cvt_pk_bf16(float lo, float hi) { const f32x2_t v = {lo, hi}; return __builtin_bit_cast(unsigned, __builtin_convertvector(v, bf16x2_t)); }

template <class Epi, class Sched, bool ALIGN_EPI = false, bool SP2 = false>
__device__ __forceinline__ void gemm_phase(LAS unsigned char* lds, const Gemm g, const Sched& S, const Epi& E, float* slab) {
    const int tid = threadIdx.x, wid = __builtin_amdgcn_readfirstlane(tid >> 6), lane = tid & 63, wr = wid >> 2, wc = wid & 3, fr = lane & 15, fq = lane >> 4;
    const int K = g.K;
    unsigned voffA[2], voffB[2];
#pragma unroll
    for (int i = 0; i < 2; ++i) { int R, C; stage_rc(tid * 16 + i * 8192, R, C); const int Rb = Epi::PERM ? ((R & ~31) + perm32(R & 31)) : R;
        voffA[i] = (unsigned)(R * K + C) * 2u; voffB[i] = (unsigned)(Rb * K + C) * 2u; }
    const size_t kstep = (size_t)(BK * 2);
    const size_t hstep = (size_t)HALF * K * 2;
    const size_t tstep = 2 * hstep;
    const unsigned ldsw = (unsigned)wid * 1024u;
    const int aoff = lds_byte(wr * 64 + fr, fq * 8), boff = lds_byte(wc * 32 + fr, fq * 8);
#define PG8_SA(b, h) (((b) * 2 + (h)) * HTB)
#define PG8_SB(b, h) ((4 + (b) * 2 + (h)) * HTB)
#define PG8_STAGE(bufoff, gbase, voff) do { _Pragma("unroll") for (int _i = 0; _i < 2; ++_i) \
        __builtin_amdgcn_global_load_lds((const unsigned*)((const char*)(gbase) + (voff)[_i]), (LAS unsigned*)(lds + (bufoff) + ldsw + _i * 8192), 16, 0, 0); } while (0)
#define PG8_LDA(dst, b, h) do { _Pragma("unroll") for (int m = 0; m < 4; ++m) _Pragma("unroll") for (int k = 0; k < 2; ++k) dst[m][k] = *(const LAS bf16x8*)(lds + PG8_SA(b, h) + aoff + m * 2048 + k * 1024); } while (0)
#define PG8_LDB(dst, b, h) do { _Pragma("unroll") for (int n = 0; n < 2; ++n) _Pragma("unroll") for (int k = 0; k < 2; ++k) dst[n][k] = *(const LAS bf16x8*)(lds + PG8_SB(b, h) + boff + n * 2048 + k * 1024); } while (0)
#define PG8_MMA(ai, bj, At, Bt) do { __builtin_amdgcn_s_setprio(1); _Pragma("unroll") for (int m = 0; m < 4; ++m) _Pragma("unroll") for (int n = 0; n < 2; ++n) _Pragma("unroll") for (int k = 0; k < 2; ++k) \
        acc[ai][bj][m][n] = __builtin_amdgcn_mfma_f32_16x16x32_bf16(Bt[n][k], At[m][k], acc[ai][bj][m][n], 0, 0, 0); __builtin_amdgcn_s_setprio(0); } while (0)
#define PG8_WAIT_V(n) asm volatile("s_waitcnt vmcnt(" #n ")" ::: "memory")
#define PG8_WAIT_L(n) asm volatile("s_waitcnt lgkmcnt(" #n ")" ::: "memory")
#define PG8_BAR __builtin_amdgcn_s_barrier()
#define PG8_SCHED __builtin_amdgcn_sched_barrier(0)
    Unit cur, nxt; int ui = 0;
    if (!S.next(0, cur)) return;
    f32x4 acc[2][2][4][2];
#pragma unroll
    for (int a = 0; a < 2; ++a)
#pragma unroll
        for (int b = 0; b < 2; ++b)
#pragma unroll
            for (int m = 0; m < 4; ++m)
#pragma unroll
                for (int n = 0; n < 2; ++n) acc[a][b][m][n] = (f32x4){0.f, 0.f, 0.f, 0.f};
    bf16x8 At[4][2], B0[2][2], B1[2][2];
    const char* cA = (const char*)g.A + (size_t)cur.pm * tstep + (size_t)cur.kt0 * kstep; const char* cB = (const char*)g.Bt + (size_t)cur.pn * tstep + (size_t)cur.kt0 * kstep;
    if constexpr (SP2) {
        PG8_STAGE(PG8_SB(0, 0), cB, voffB); PG8_STAGE(PG8_SB(0, 1), cB + hstep, voffB); PG8_STAGE(PG8_SA(0, 0), cA, voffA); PG8_STAGE(PG8_SA(0, 1), cA + hstep, voffA);
        if (wr == 1) PG8_BAR;
        PG8_WAIT_V(2); PG8_BAR;
        PG8_STAGE(PG8_SB(1, 0), cB + kstep, voffB); PG8_STAGE(PG8_SA(1, 0), cA + kstep, voffA); PG8_STAGE(PG8_SB(1, 1), cB + hstep + kstep, voffB);
        PG8_WAIT_V(6); PG8_BAR;
    } else {
        PG8_STAGE(PG8_SB(0, 0), cB, voffB); PG8_STAGE(PG8_SA(0, 0), cA, voffA); PG8_STAGE(PG8_SB(0, 1), cB + hstep, voffB); PG8_STAGE(PG8_SA(0, 1), cA + hstep, voffA);
        if (wr == 1) PG8_BAR;
        PG8_WAIT_V(4); PG8_BAR;
        PG8_STAGE(PG8_SB(1, 0), cB + kstep, voffB); PG8_STAGE(PG8_SA(1, 0), cA + kstep, voffA); PG8_STAGE(PG8_SB(1, 1), cB + hstep + kstep, voffB);
        PG8_WAIT_V(6); PG8_BAR;
    }
    for (;;) {
        const bool has_next = S.next(ui + 1, nxt);
        const char* nA = has_next ? (const char*)g.A + (size_t)nxt.pm * tstep + (size_t)nxt.kt0 * kstep : cA; const char* nB = has_next ? (const char*)g.Bt + (size_t)nxt.pn * tstep + (size_t)nxt.kt0 * kstep : cB;
        const int nt = cur.nkt;
        for (int t = 0; t < nt; t += 2) {
            const bool last = (t == nt - 2);
            const char* a1 = cA + (size_t)(t + 1) * kstep;
            const char* a2 = last ? nA : cA + (size_t)(t + 2) * kstep; const char* b2 = last ? nB : cB + (size_t)(t + 2) * kstep;
            const char* a3 = a2 + kstep; const char* b3 = b2 + kstep;
            if constexpr (SP2) {
            PG8_LDB(B0, 0, 0); PG8_LDB(B1, 0, 1); PG8_SCHED; PG8_LDA(At, 0, 0); PG8_STAGE(PG8_SA(1, 1), a1 + hstep, voffA);
            PG8_WAIT_V(8); PG8_WAIT_L(0); PG8_BAR; PG8_MMA(0, 0, At, B0); PG8_MMA(0, 1, At, B1); PG8_BAR; PG8_SCHED;
            PG8_LDA(At, 0, 1); PG8_STAGE(PG8_SB(0, 0), b2, voffB); PG8_STAGE(PG8_SB(0, 1), b2 + hstep, voffB); PG8_STAGE(PG8_SA(0, 0), a2, voffA);
            PG8_WAIT_V(8); PG8_WAIT_L(0); PG8_BAR; PG8_MMA(1, 0, At, B0); PG8_MMA(1, 1, At, B1); PG8_BAR; PG8_SCHED;
            PG8_LDB(B0, 1, 0); PG8_LDB(B1, 1, 1); PG8_SCHED; PG8_LDA(At, 1, 0); PG8_STAGE(PG8_SA(0, 1), a2 + hstep, voffA);
            PG8_WAIT_V(8); PG8_WAIT_L(0); PG8_BAR; PG8_MMA(0, 0, At, B0); PG8_MMA(0, 1, At, B1); PG8_BAR; PG8_SCHED;
            PG8_LDA(At, 1, 1); PG8_STAGE(PG8_SB(1, 0), b3, voffB); PG8_STAGE(PG8_SB(1, 1), b3 + hstep, voffB); PG8_STAGE(PG8_SA(1, 0), a3, voffA);
            PG8_WAIT_V(8); PG8_WAIT_L(0); PG8_BAR; PG8_MMA(1, 0, At, B0); PG8_MMA(1, 1, At, B1); PG8_BAR; PG8_SCHED;
            } else {
            PG8_LDB(B0, 0, 0); PG8_SCHED; PG8_LDA(At, 0, 0); PG8_STAGE(PG8_SA(1, 1), a1 + hstep, voffA);
            PG8_WAIT_L(8); PG8_BAR; PG8_WAIT_L(0); PG8_MMA(0, 0, At, B0); PG8_BAR; PG8_SCHED;
            PG8_LDB(B1, 0, 1); PG8_STAGE(PG8_SB(0, 0), b2, voffB);
            PG8_BAR; PG8_WAIT_L(0); PG8_MMA(0, 1, At, B1); PG8_BAR;
            PG8_LDA(At, 0, 1); PG8_STAGE(PG8_SA(0, 0), a2, voffA);
            PG8_BAR; PG8_WAIT_L(0); PG8_MMA(1, 0, At, B0); PG8_BAR; PG8_SCHED;
            PG8_STAGE(PG8_SB(0, 1), b2 + hstep, voffB);
            PG8_WAIT_V(6); PG8_BAR; PG8_MMA(1, 1, At, B1); PG8_BAR;
            PG8_LDB(B0, 1, 0); PG8_SCHED; PG8_LDA(At, 1, 0); PG8_STAGE(PG8_SA(0, 1), a2 + hstep, voffA);
            PG8_WAIT_L(8); PG8_BAR; PG8_WAIT_L(0); PG8_MMA(0, 0, At, B0); PG8_BAR; PG8_SCHED;
            PG8_LDB(B1, 1, 1); PG8_STAGE(PG8_SB(1, 0), b3, voffB);
            PG8_BAR; PG8_WAIT_L(0); PG8_MMA(0, 1, At, B1); PG8_BAR;
            PG8_LDA(At, 1, 1); PG8_STAGE(PG8_SA(1, 0), a3, voffA);
            PG8_BAR; PG8_WAIT_L(0); PG8_MMA(1, 0, At, B0); PG8_BAR; PG8_SCHED;
            PG8_STAGE(PG8_SB(1, 1), b3 + hstep, voffB);
            PG8_WAIT_V(6); PG8_BAR; PG8_MMA(1, 1, At, B1); PG8_BAR;
            }
        }
        if constexpr (ALIGN_EPI) { if (wr == 0) PG8_BAR; }
        if (cur.part < 0) {
            const auto cx = E.begin(cur, wr, wc, fr, fq);
            auto pf = E.pre(cx, 0, 0);
#pragma unroll
            for (int ai = 0; ai < 2; ++ai)
#pragma unroll
                for (int m = 0; m < 4; ++m) { const f32x4 v[2][2] = {{acc[ai][0][m][0], acc[ai][0][m][1]}, {acc[ai][1][m][0], acc[ai][1][m][1]}};
                    const auto pc = pf; { const int gn = ai * 4 + m + 1; if (gn < 8) pf = E.pre(cx, gn >> 2, gn & 3); }
                    E.rows(cx, pc, v, cur, ai, m, wr, wc, fr, fq); }
        } else {
            bf16_t* sp = (bf16_t*)slab + (size_t)cur.part * 65536 + (size_t)tid * 8;
#pragma unroll
            for (int ai = 0; ai < 2; ++ai)
#pragma unroll
                for (int bj = 0; bj < 2; ++bj)
#pragma unroll
                    for (int m = 0; m < 4; ++m) { const f32x4 a = acc[ai][bj][m][0], b = acc[ai][bj][m][1];
                        u32x4 w; w.x = cvt_pk_bf16(a[0], a[1]); w.y = cvt_pk_bf16(a[2], a[3]); w.z = cvt_pk_bf16(b[0], b[1]); w.w = cvt_pk_bf16(b[2], b[3]);
                        *(u32x4*)(sp + (size_t)(((ai * 2 + bj) * 4 + m) * 4096)) = w; }
        }
        if (!has_next) break;
#pragma unroll
        for (int a = 0; a < 2; ++a)
#pragma unroll
            for (int b = 0; b < 2; ++b)
#pragma unroll
                for (int m = 0; m < 4; ++m)
#pragma unroll
                    for (int n = 0; n < 2; ++n) acc[a][b][m][n] = (f32x4){0.f, 0.f, 0.f, 0.f};
        cur = nxt; cA = nA; cB = nB; ++ui;
        if constexpr (ALIGN_EPI) { if (wr == 1) PG8_BAR; }
    }
    PG8_WAIT_V(0);
    if constexpr (!ALIGN_EPI) { if (wr == 0) PG8_BAR; }
    PG8_BAR;
#undef PG8_SA
#undef PG8_SB
#undef PG8_STAGE
#undef PG8_LDA
#undef PG8_LDB
#undef PG8_MMA
#undef PG8_WAIT_V
#undef PG8_WAIT_L
#undef PG8_BAR
#undef PG8_SCHED
}
template <class Epi, class Sched>
__device__ __forceinline__ void gemm_fixup(const Epi& E, const float* slab) {
    if constexpr (Sched::S > 1) {
    constexpr int NG = 8 / Sched::S;
    const int tid = threadIdx.x, wid = __builtin_amdgcn_readfirstlane(tid >> 6), lane = tid & 63, wr = wid >> 2, wc = wid & 3, fr = lane & 15, fq = lane >> 4;
    for (int b = blockIdx.x; b < Sched::rem * Sched::S; b += Sched::G) {
        const int r = b % Sched::rem, q = b / Sched::rem;
        const Unit u = Sched::unit_of(Sched::nfull + r, 0, Sched::nt, -1);
        f32x4 v[NG][2][2];
#pragma unroll
        for (int gi = 0; gi < NG; ++gi)
#pragma unroll
            for (int bj = 0; bj < 2; ++bj)
#pragma unroll
                for (int n = 0; n < 2; ++n) v[gi][bj][n] = (f32x4){0.f, 0.f, 0.f, 0.f};
#pragma unroll
        for (int gi = 0; gi < NG; ++gi) { const int g = q * NG + gi, ai = g >> 2, m = g & 3;
#pragma unroll
            for (int p = 0; p < Sched::S; ++p) {
                const bf16_t* sp = (const bf16_t*)slab + (size_t)(r + p * Sched::rem) * 65536 + (size_t)tid * 8;
#pragma unroll
                for (int bj = 0; bj < 2; ++bj) { const u32x4 w = *(const u32x4*)(sp + (size_t)(((ai * 2 + bj) * 4 + m) * 4096));
                    v[gi][bj][0] += (f32x4){__builtin_bit_cast(float, w.x << 16), __builtin_bit_cast(float, w.x & 0xffff0000u), __builtin_bit_cast(float, w.y << 16), __builtin_bit_cast(float, w.y & 0xffff0000u)};
                    v[gi][bj][1] += (f32x4){__builtin_bit_cast(float, w.z << 16), __builtin_bit_cast(float, w.z & 0xffff0000u), __builtin_bit_cast(float, w.w << 16), __builtin_bit_cast(float, w.w & 0xffff0000u)}; } } }
        const auto cx = E.begin(u, wr, wc, fr, fq);
        auto pf = E.pre(cx, (q * NG) >> 2, (q * NG) & 3);
#pragma unroll
        for (int gi = 0; gi < NG; ++gi) { const int g = q * NG + gi; const auto pc = pf; if (gi + 1 < NG) pf = E.pre(cx, (g + 1) >> 2, (g + 1) & 3);
            E.rows(cx, pc, v[gi], u, g >> 2, g & 3, wr, wc, fr, fq); }
    }
    }
}
}

constexpr int DM = 2048, NTOK = 12288, NCTX = 4096, DFF = 5632, NFF2 = 11264;
constexpr int IN_EVEN = 4160, IN_EVEN_P = 4096, IN_ODD = 3072;
constexpr int NMOD = 18432;
constexpr float EPS = 1e-6f;
constexpr float LOG2E = 1.4426950408889634f;

constexpr size_t O_X = 0, O_CKV = 25165824, O_KROPE = 27262976, O_NAK = 27525120, O_NAV = 31719424, O_GK = 35913728, O_GV = 38010880, O_END = 40108032;

constexpr size_t MiB = 1u << 20;
constexpr size_t WS_CTL = 0;
constexpr size_t WS_MODS = 2 * MiB;
constexpr size_t CTL_ZERO_BYTES = 4 * MiB;
constexpr size_t WS_WFI = 4 * MiB;
constexpr size_t WS_WFO = WS_WFI + 176 * MiB;
constexpr size_t WS_WEI = WS_WFO + 88 * MiB;
constexpr size_t WS_WQU = WS_WEI + 17 * MiB;
constexpr size_t WS_WKU = WS_WQU + 2 * MiB;
constexpr size_t WS_WEO = WS_WKU + 2 * MiB;
constexpr size_t WS_WOI = WS_WEO + 8 * MiB;
constexpr size_t WS_WOO = WS_WOI + 12 * MiB;
constexpr size_t WS_H = WS_WOO + 8 * MiB;
constexpr size_t WS_ACT = WS_H + 48 * MiB;
constexpr size_t WS_P = WS_ACT + 132 * MiB;
constexpr size_t WS_XB = WS_P + 128 * MiB;
constexpr size_t WS_QM = WS_P + 204 * MiB;
constexpr size_t WS_CQN = WS_QM + 72 * MiB;
constexpr size_t WS_CKVA = WS_CQN + 12 * MiB;
constexpr size_t WS_QA = WS_CKVA + 16 * MiB;
constexpr size_t WS_QNA = WS_QA + 48 * MiB;
constexpr size_t WS_KM_CTX = WS_QNA + 24 * MiB;
constexpr size_t WS_KM_LAT = WS_KM_CTX + 12 * MiB;
constexpr size_t WS_KM_CAC = WS_KM_LAT + 24 * MiB;
constexpr size_t WS_VM_CTX = WS_KM_CAC + 12 * MiB;
constexpr size_t WS_VM_LAT = WS_VM_CTX + 8 * MiB;
constexpr size_t WS_VM_CAC = WS_VM_LAT + 16 * MiB;
constexpr size_t WS_KN_CTX = WS_VM_CAC + 8 * MiB;
constexpr size_t WS_KN_LAT = WS_KN_CTX + 8 * MiB;
constexpr size_t WS_KN_CAC = WS_KN_LAT + 16 * MiB;
constexpr size_t WS_VN_CTX = WS_KN_CAC + 8 * MiB;
constexpr size_t WS_VN_LAT = WS_VN_CTX + 8 * MiB;
constexpr size_t WS_VN_CAC = WS_VN_LAT + 16 * MiB;
constexpr size_t WS_KG_CTX = WS_VN_CAC + 8 * MiB;
constexpr size_t WS_KG_LAT = WS_KG_CTX + 4 * MiB;
constexpr size_t WS_KG_CAC = WS_KG_LAT + 8 * MiB;
constexpr size_t WS_VG_CTX = WS_KG_CAC + 4 * MiB;
constexpr size_t WS_VG_LAT = WS_VG_CTX + 4 * MiB;
constexpr size_t WS_VG_CAC = WS_VG_LAT + 8 * MiB;
constexpr size_t WS_O = WS_VG_CAC + 4 * MiB;
constexpr size_t WS_KROPE = WS_O + 48 * MiB;
constexpr size_t WS_END = WS_KROPE + 4 * MiB;
constexpr int CW_BAR = 4096;

constexpr int RING_BYTES = 131072;
constexpr int LDSCTL_OFF = RING_BYTES;
constexpr int LDS_BYTES = 147456;

__device__ __forceinline__ unsigned f2bf(float f) { unsigned u = __builtin_bit_cast(unsigned, f); return (u + 0x7fffu + ((u >> 16) & 1u)) >> 16; }
__device__ __forceinline__ unsigned pk2(float lo, float hi) { return pg8::cvt_pk_bf16(lo, hi); }
__device__ __forceinline__ float wave_sum(float v) {
#pragma unroll
    for (int o = 1; o < 64; o <<= 1) v += __shfl_xor(v, o);
    return v;
}
__device__ __forceinline__ float fast_exp2(float x) { return __builtin_amdgcn_exp2f(x); }
__device__ __forceinline__ float fast_rcp(float x) { return __builtin_amdgcn_rcpf(x); }
__device__ __forceinline__ float silu_f(float g) { return g * fast_rcp(1.0f + fast_exp2(-g * LOG2E)); }
__device__ __forceinline__ float sin_rev(float rev) { return __builtin_amdgcn_sinf(rev); }
__device__ __forceinline__ float cos_rev(float rev) { return __builtin_amdgcn_cosf(rev); }

#define XB_TMO      128
#define XB_XCNT(j)  (256  + 64 * (j))
#define XB_XSUB(j)  (1280 + 64 * (j))
#define XB_XGEN(j)  (2304 + 64 * (j))
#define XB_TOP      3328
#define XB_TOPGEN   3392
#define XCD_BAR_WORDS 3456
#define XB_SPIN_CAP (1u << 18)
__device__ __forceinline__ unsigned xb_ld(unsigned* p)              { return __hip_atomic_load(p, __ATOMIC_RELAXED, __HIP_MEMORY_SCOPE_AGENT); }
__device__ __forceinline__ unsigned xb_add(unsigned* p, unsigned v) { return __hip_atomic_fetch_add(p, v, __ATOMIC_RELAXED, __HIP_MEMORY_SCOPE_AGENT); }
__device__ __forceinline__ unsigned xb_xcc_id() { return (unsigned)__builtin_amdgcn_s_getreg((3 << 11) | 20) & 0xFu; }
#define XB_SPIN(cond, bar) do { unsigned _sp = 0; while (cond) { __builtin_amdgcn_s_sleep(1); \
    if ((++_sp & 255u) == 0u) { if (xb_ld(&(bar)[XB_TMO])) break; if (_sp > XB_SPIN_CAP) { atomicAdd(&(bar)[XB_TMO], 1u); break; } } } } while (0)
struct XcdBarrier { unsigned* bar; unsigned x; volatile LAS unsigned* st; };
__device__ __forceinline__ XcdBarrier xcd_barrier_post(unsigned* bar, volatile LAS unsigned* st) {
    XcdBarrier b; b.bar = bar; b.x = xb_xcc_id(); b.st = st;
    if (threadIdx.x == 0) (void)xb_add(&bar[XB_XCNT(b.x)], 1u);
    return b;
}
__device__ __forceinline__ void xcd_barrier_complete(unsigned* bar, unsigned x, unsigned& nloc, unsigned& nx) {
    const unsigned G = gridDim.x * gridDim.y * gridDim.z;
    unsigned sum, cnt, mine, sp = 0u;
    for (;;) {
        sum = 0u; cnt = 0u; mine = 0u;
#pragma unroll
        for (unsigned j = 0; j < 16; ++j) { const unsigned c = xb_ld(&bar[XB_XCNT(j)]); sum += c; cnt += (c > 0u) ? 1u : 0u; mine = (j == x) ? c : mine; }
        if (sum == G) break;
        __builtin_amdgcn_s_sleep(1);
        if ((++sp & 255u) == 0u) { if (xb_ld(&bar[XB_TMO])) break; if (sp > XB_SPIN_CAP) { atomicAdd(&bar[XB_TMO], 1u); break; } }
    }
    nloc = mine > 0u ? mine : 1u; nx = cnt > 0u ? cnt : 1u;
}
__device__ __forceinline__ void xcd_barrier(const XcdBarrier& b) {
    asm volatile("s_waitcnt vmcnt(0)" ::: "memory");
    __syncthreads();
    if (threadIdx.x == 0) {
        unsigned* bar = b.bar;
        __builtin_amdgcn_s_waitcnt(0);
        unsigned nloc = b.st[0], nx = b.st[1];
        if (nloc == 0u) { xcd_barrier_complete(bar, b.x, nloc, nx); b.st[0] = nloc; b.st[1] = nx; }
        const unsigned old = xb_add(&bar[XB_XSUB(b.x)], 1u);
        const unsigned gen = old / nloc;
        if (old + 1u == (gen + 1u) * nloc) {
            __builtin_amdgcn_fence(__ATOMIC_RELEASE, "agent");
            asm volatile("s_waitcnt vmcnt(0)" ::: "memory");
            const unsigned og = xb_add(&bar[XB_TOP], 1u);
            const unsigned tg = og / nx;
            if (og + 1u == (tg + 1u) * nx) xb_add(&bar[XB_TOPGEN], 1u);
            else XB_SPIN(xb_ld(&bar[XB_TOPGEN]) == tg, bar);
            __builtin_amdgcn_fence(__ATOMIC_ACQUIRE, "agent");
            xb_add(&bar[XB_XGEN(b.x)], 1u);
            asm volatile("s_waitcnt vmcnt(0)" ::: "memory");
        } else {
            XB_SPIN(xb_ld(&bar[XB_XGEN(b.x)]) == gen, bar);
            __builtin_amdgcn_fence(__ATOMIC_ACQUIRE, "agent");
            asm volatile("s_waitcnt vmcnt(0)" ::: "memory");
        }
    }
    __syncthreads();
}

struct Args { const float* in[28]; float* out; unsigned char* ws; int ph_lo, ph_hi; };
struct Frame {
    LAS unsigned char* lds;
    int tid, lane, wave, G, gw, NGW;
    const Args* a; float* out; unsigned char* ws;
};
#define IN_XP 0
#define IN_XS 1
#define IN_C_CKV 2
#define IN_C_KROPE 3
#define IN_C_NAK 4
#define IN_C_NAV 5
#define IN_C_GK 6
#define IN_C_GV 7
#define IN_C 8
#define IN_CCTX 9
#define IN_ADAW 10
#define IN_ADAB 11
#define IN_NORMG 12
#define IN_FFI 13
#define IN_FFO 14
#define IN_EWI 15
#define IN_EWO 16
#define IN_QNORM 17
#define IN_WQUP 18
#define IN_KVNORM 19
#define IN_WKVUP 20
#define IN_MLAQK 21
#define IN_NAQK 22
#define IN_RPB 23
#define IN_OWI 24
#define IN_OWO 25
#define IN_GQK 26
#define IN_SINK 27

__device__ __forceinline__ int opaque_v(int x) { asm volatile("" : "+v"(x)); return x; }
__device__ __forceinline__ int tok_mb(int t) { return t < NCTX ? 0 : 1 + ((t - NCTX) >> 10); }

__device__ __forceinline__ size_t k_chunk_off(int DQK, int key, int c8) { return (size_t)(key >> 5) * (DQK * 32) + (size_t)(c8 >> 1) * 512 + (((c8 & 1) * 32 + (key & 31)) << 3); }
__device__ __forceinline__ void vt_tile_write_h(const bf16_t* src0, size_t pitch, bf16_t* dst, int lane) {
    unsigned v[8][8];
#pragma unroll
    for (int it = 0; it < 8; ++it) {
        const int d = (it & 1) * 64 + lane, s = (it >> 1) & 1, hh = it >> 2;
#pragma unroll
        for (int j = 0; j < 8; ++j) { const int key = 16 * s + 8 * (j >> 2) + 4 * hh + (j & 3); v[it][j] = src0[(size_t)key * pitch + d]; }
    }
#pragma unroll
    for (int it = 0; it < 8; ++it) {
        const int d = (it & 1) * 64 + lane, s = (it >> 1) & 1, hh = it >> 2;
        u32x4 w; w.x = v[it][0] | (v[it][1] << 16); w.y = v[it][2] | (v[it][3] << 16); w.z = v[it][4] | (v[it][5] << 16); w.w = v[it][6] | (v[it][7] << 16);
        *(u32x4*)(dst + (size_t)(((s * 4 + (d >> 5)) * 64 + hh * 32 + (d & 31)) << 3)) = w;
    }
}
__device__ __forceinline__ void vt_tile_write(const float* src0, size_t pitch, bf16_t* dst, int lane) {
#pragma unroll
    for (int it = 0; it < 8; ++it) {
        const int d = (it & 1) * 64 + lane, s = (it >> 1) & 1, hh = it >> 2;
        float v[8];
#pragma unroll
        for (int j = 0; j < 8; ++j) { const int key = 16 * s + 8 * (j >> 2) + 4 * hh + (j & 3); v[j] = src0[(size_t)key * pitch + d]; }
        u32x4 w; w.x = pk2(v[0], v[1]); w.y = pk2(v[2], v[3]); w.z = pk2(v[4], v[5]); w.w = pk2(v[6], v[7]);
        *(u32x4*)(dst + (size_t)(((s * 4 + (d >> 5)) * 64 + hh * 32 + (d & 31)) << 3)) = w;
    }
}

__device__ __forceinline__ void p0_transpose_item(const float* W, int K, int N, bf16_t* WT, int mode, LAS float* scr, int item, int lane) {
    const int nblk = N / 32, kb = item / nblk, nb = item % nblk, k0 = 64 * kb, n0 = 32 * nb;
#pragma unroll 8
    for (int i = 0; i < 32; ++i) { const int kk = 2 * i + (lane >> 5); scr[kk * 33 + (lane & 31)] = __builtin_nontemporal_load(W + (size_t)(k0 + kk) * N + n0 + (lane & 31)); }
    asm volatile("s_waitcnt lgkmcnt(0)" ::: "memory");
    int d0 = n0;
    if (mode == 1) { const int j0 = n0 < DFF ? n0 : n0 - DFF; d0 = 256 * (j0 >> 7) + (j0 & 127) + (n0 < DFF ? 0 : 128); }
    if (mode == 2) d0 = n0 < 1024 ? n0 : (n0 < 1088 ? 4096 + (n0 - 1024) : n0 - 64);
    const int c = lane & 7;
#pragma unroll
    for (int j = 0; j < 4; ++j) { const int n = (lane >> 3) + 8 * j; const LAS float* s = scr + (8 * c) * 33 + n;
        u32x4 o; o.x = pk2(s[0 * 33], s[1 * 33]); o.y = pk2(s[2 * 33], s[3 * 33]); o.z = pk2(s[4 * 33], s[5 * 33]); o.w = pk2(s[6 * 33], s[7 * 33]);
        *(u32x4*)(WT + (size_t)(d0 + n) * K + k0 + 8 * c) = o; }
    asm volatile("s_waitcnt lgkmcnt(0)" ::: "memory");
}

__device__ __forceinline__ const float* p0_mods_wptr(Frame& F, int item) {
    const int layer = item / 1152, rem = item % 1152, slab = rem >> 4, ks = rem & 15;
    return F.a->in[IN_ADAW] + (size_t)layer * DM * NMOD + (size_t)(ks * 128 + F.wave * 16) * NMOD + slab * 256 + 4 * F.lane;
}
__device__ __forceinline__ void phase_mods(Frame& F) {
    LAS float* stab = (LAS float*)(F.lds);
    LAS float* part = (LAS float*)(F.lds + 8192);
    const float* c = F.a->in[IN_C]; const float* cctx = F.a->in[IN_CCTX];
    for (int item = blockIdx.x; item < 2304; item += F.G) {
        const int layer = item / 1152, rem = item % 1152, slab = rem >> 4, ks = rem & 15, n0 = slab * 256, k0 = ks * 128;
        f32x4 w[16];
        { const float* W = p0_mods_wptr(F, item);
#pragma unroll
          for (int kk = 0; kk < 16; ++kk) w[kk] = __builtin_nontemporal_load((const f32x4*)(W + (size_t)kk * NMOD)); }
        for (int i = F.tid; i < 9 * 128; i += 512) { const int b = i >> 7, k = i & 127; const float v = (b == 0) ? cctx[k0 + k] : c[(size_t)(b - 1) * DM + k0 + k]; stab[i] = silu_f(v); }
        __syncthreads();
        f32x4 acc[9];
#pragma unroll
        for (int b = 0; b < 9; ++b) acc[b] = (f32x4){0.f, 0.f, 0.f, 0.f};
#pragma unroll
        for (int kk = 0; kk < 16; ++kk) {
#pragma unroll
            for (int b = 0; b < 9; ++b) { const float sv = stab[b * 128 + F.wave * 16 + kk]; acc[b] += w[kk] * sv; }
        }
#pragma unroll
        for (int b = 0; b < 9; ++b) *(LAS f32x4*)(part + (F.wave * 9 + b) * 256 + 4 * F.lane) = acc[b];
        __syncthreads();
        float* mods = (float*)(F.ws + WS_MODS) + (size_t)layer * 9 * NMOD;
        const float* bias = F.a->in[IN_ADAB] + (size_t)layer * NMOD;
        for (int i = F.tid; i < 9 * 256; i += 512) { const int b = i >> 8, col = i & 255; float sm = 0.f;
#pragma unroll
            for (int ww = 0; ww < 8; ++ww) sm += part[(ww * 9 + b) * 256 + col];
            if (ks == 0) sm += bias[n0 + col];
            atomicAdd(mods + (size_t)b * NMOD + n0 + col, sm); }
        __syncthreads();
    }
}

__device__ __forceinline__ void p0_cacheK_item(const float* src, int H, bf16_t* dstbase, int item, int lane) {
    const int t32 = item & 15, bh = item >> 4, b = bh / H, h = bh % H;
    bf16_t* dst = dstbase + (size_t)bh * (512 * 128);
#pragma unroll
    for (int it = 0; it < 8; ++it) { const int idx = it * 64 + lane, kl = idx >> 4, c8 = idx & 15, key = t32 * 32 + kl;
        const float* s = src + ((size_t)(b * 512 + key) * H + h) * 128 + c8 * 8;
        const f32x4 a = *(const f32x4*)s, bb = *(const f32x4*)(s + 4);
        u32x4 w; w.x = pk2(a[0], a[1]); w.y = pk2(a[2], a[3]); w.z = pk2(bb[0], bb[1]); w.w = pk2(bb[2], bb[3]);
        *(u32x4*)(dst + k_chunk_off(128, key, c8)) = w; }
}
__device__ __forceinline__ void p0_cacheV_item(const float* src, int H, bf16_t* dstbase, int item, int lane) {
    const int t32 = item & 15, bh = item >> 4, b = bh / H, h = bh % H;
    vt_tile_write(src + ((size_t)(b * 512 + t32 * 32) * H + h) * 128, (size_t)H * 128, dstbase + (size_t)bh * (512 * 128) + (size_t)t32 * 4096, lane);
}

__device__ __forceinline__ void phase_prologue(Frame& F) {
    phase_mods(F);
    LAS float* scr = (LAS float*)(F.lds + F.wave * 16384);
    constexpr int I_FI = 32 * 352, I_FO = 88 * 64, I_EI = 32 * 130, I_QU = 8 * 48, I_KU = 8 * 64, I_EO = 32 * 64, I_OI = 32 * 96, I_OO = 32 * 64;
    constexpr int I_PAD = 0, I_CKV = 1024, I_NK = 1024, I_NV = 1024, I_GK = 512, I_GV = 512;
    constexpr int NITEMS = 4 * I_FI + 4 * I_FO + I_EI + I_QU + I_KU + I_EO + I_OI + I_OO + I_PAD + I_CKV + I_NK + I_NV + I_GK + I_GV;
    unsigned char* ws = F.ws;
    for (int it = F.gw; it < NITEMS; it += F.NGW) {
        int r = it;
        if (r < 4 * I_FI) { const int m = r / I_FI; p0_transpose_item(F.a->in[IN_FFI] + (size_t)m * DM * NFF2, DM, NFF2, (bf16_t*)(ws + WS_WFI) + (size_t)m * NFF2 * DM, 1, scr, r % I_FI, F.lane); continue; } r -= 4 * I_FI;
        if (r < 4 * I_FO) { const int m = r / I_FO; p0_transpose_item(F.a->in[IN_FFO] + (size_t)m * DFF * DM, DFF, DM, (bf16_t*)(ws + WS_WFO) + (size_t)m * DM * DFF, 0, scr, r % I_FO, F.lane); continue; } r -= 4 * I_FO;
        if (r < I_EI) { p0_transpose_item(F.a->in[IN_EWI], DM, IN_EVEN, (bf16_t*)(ws + WS_WEI), 2, scr, r, F.lane); continue; } r -= I_EI;
        if (r < I_QU) { p0_transpose_item(F.a->in[IN_WQUP], 512, 1536, (bf16_t*)(ws + WS_WQU), 0, scr, r, F.lane); continue; } r -= I_QU;
        if (r < I_KU) { p0_transpose_item(F.a->in[IN_WKVUP], 512, 2048, (bf16_t*)(ws + WS_WKU), 0, scr, r, F.lane); continue; } r -= I_KU;
        if (r < I_EO) { p0_transpose_item(F.a->in[IN_EWO], DM, DM, (bf16_t*)(ws + WS_WEO), 0, scr, r, F.lane); continue; } r -= I_EO;
        if (r < I_OI) { p0_transpose_item(F.a->in[IN_OWI], DM, IN_ODD, (bf16_t*)(ws + WS_WOI), 0, scr, r, F.lane); continue; } r -= I_OI;
        if (r < I_OO) { p0_transpose_item(F.a->in[IN_OWO], DM, DM, (bf16_t*)(ws + WS_WOO), 0, scr, r, F.lane); continue; } r -= I_OO;
        if (r < I_PAD) { u32x4* p = (u32x4*)((bf16_t*)(ws + WS_WEI) + (size_t)(IN_EVEN + r) * DM); const u32x4 z = {0u, 0u, 0u, 0u};
#pragma unroll
            for (int j = 0; j < 4; ++j) p[j * 64 + F.lane] = z; continue; } r -= I_PAD;
        if (r < I_CKV) {
#pragma unroll
            for (int j = 0; j < 4; ++j) { const int row = 4 * r + j; const float* s = F.a->in[IN_C_CKV] + (size_t)row * 512 + 8 * F.lane;
                const f32x4 a = *(const f32x4*)s, b = *(const f32x4*)(s + 4);
                u32x4 w; w.x = pk2(a[0], a[1]); w.y = pk2(a[2], a[3]); w.z = pk2(b[0], b[1]); w.w = pk2(b[2], b[3]);
                *(u32x4*)((bf16_t*)(ws + WS_CKVA) + (size_t)(NTOK + row) * 512 + 8 * F.lane) = w; }
            continue; } r -= I_CKV;
        if (r < I_NK) { p0_cacheK_item(F.a->in[IN_C_NAK], 8, (bf16_t*)(ws + WS_KN_CAC), r, F.lane); continue; } r -= I_NK;
        if (r < I_NV) { p0_cacheV_item(F.a->in[IN_C_NAV], 8, (bf16_t*)(ws + WS_VN_CAC), r, F.lane); continue; } r -= I_NV;
        if (r < I_GK) { p0_cacheK_item(F.a->in[IN_C_GK], 4, (bf16_t*)(ws + WS_KG_CAC), r, F.lane); continue; } r -= I_GK;
        p0_cacheV_item(F.a->in[IN_C_GV], 4, (bf16_t*)(ws + WS_VG_CAC), r, F.lane);
    }
}

__device__ __forceinline__ void load8(const float* p, float (&v)[8]) { const f32x4 a = *(const f32x4*)p, b = *(const f32x4*)(p + 4); v[0] = a[0]; v[1] = a[1]; v[2] = a[2]; v[3] = a[3]; v[4] = b[0]; v[5] = b[1]; v[6] = b[2]; v[7] = b[3]; }
__device__ __forceinline__ void unpack8h(const u32x4 w, float (&v)[8]) {
    v[0] = __builtin_bit_cast(float, w.x << 16); v[1] = __builtin_bit_cast(float, w.x & 0xffff0000u); v[2] = __builtin_bit_cast(float, w.y << 16); v[3] = __builtin_bit_cast(float, w.y & 0xffff0000u);
    v[4] = __builtin_bit_cast(float, w.z << 16); v[5] = __builtin_bit_cast(float, w.z & 0xffff0000u); v[6] = __builtin_bit_cast(float, w.w << 16); v[7] = __builtin_bit_cast(float, w.w & 0xffff0000u); }
__device__ __forceinline__ void load8h(const bf16_t* p, float (&v)[8]) { unpack8h(*(const u32x4*)p, v); }

__device__ __forceinline__ const float* x_in_row(Frame& F, int t) { return t < NCTX ? F.a->in[IN_XP] + (size_t)t * DM : F.a->in[IN_XS] + (size_t)(t - NCTX) * DM; }
__device__ __forceinline__ void phase_norm(Frame& F, bool from_input, int layer, int sub) {
    const float* g = F.a->in[IN_NORMG] + (size_t)(layer * 3 + sub) * DM;
    bf16_t* H = (bf16_t*)(F.ws + WS_H);
    const bf16_t* XB = (const bf16_t*)(F.ws + WS_XB);
    const int lane = opaque_v(F.lane);
    float gg[4][8];
#pragma unroll
    for (int j = 0; j < 4; ++j) load8(g + 512 * j + 8 * lane, gg[j]);
    f32x4 RF[8]; u32x4 RH[4];
#define NORM_LOAD(t_) do { if (from_input) { const float* xr_ = x_in_row(F, (t_)); _Pragma("unroll") for (int j = 0; j < 4; ++j) { RF[2 * j] = *(const f32x4*)(xr_ + 512 * j + 8 * lane); RF[2 * j + 1] = *(const f32x4*)(xr_ + 512 * j + 8 * lane + 4); } } \
        else { const bf16_t* xr_ = XB + (size_t)(t_) * DM; _Pragma("unroll") for (int j = 0; j < 4; ++j) RH[j] = *(const u32x4*)(xr_ + 512 * j + 8 * lane); } } while (0)
    NORM_LOAD(F.gw);
    for (int t = F.gw; t < NTOK; t += F.NGW) {
        const float* md = (const float*)(F.ws + WS_MODS) + ((size_t)layer * 9 + tok_mb(t)) * NMOD + (size_t)(3 * sub) * DM;
        float v[4][8]; float ss = 0.f;
        if (from_input) {
#pragma unroll
            for (int j = 0; j < 4; ++j) { v[j][0] = RF[2 * j][0]; v[j][1] = RF[2 * j][1]; v[j][2] = RF[2 * j][2]; v[j][3] = RF[2 * j][3]; v[j][4] = RF[2 * j + 1][0]; v[j][5] = RF[2 * j + 1][1]; v[j][6] = RF[2 * j + 1][2]; v[j][7] = RF[2 * j + 1][3]; }
        } else {
#pragma unroll
            for (int j = 0; j < 4; ++j) unpack8h(RH[j], v[j]);
        }
        float sh[4][8], sc[4][8];
#pragma unroll
        for (int j = 0; j < 4; ++j) { load8(md + 512 * j + 8 * lane, sh[j]); load8(md + DM + 512 * j + 8 * lane, sc[j]); }
        { const int tn = t + F.NGW < NTOK ? t + F.NGW : t; NORM_LOAD(tn); }
#pragma unroll
        for (int j = 0; j < 4; ++j) ss += ((v[j][0] * v[j][0] + v[j][1] * v[j][1]) + (v[j][2] * v[j][2] + v[j][3] * v[j][3])) + ((v[j][4] * v[j][4] + v[j][5] * v[j][5]) + (v[j][6] * v[j][6] + v[j][7] * v[j][7]));
        const float rstd = __builtin_amdgcn_rsqf(wave_sum(ss) * (1.0f / DM) + EPS);
#pragma unroll
        for (int j = 0; j < 4; ++j) { const int c = 512 * j + 8 * lane;
            float y[8];
#pragma unroll
            for (int e = 0; e < 8; ++e) y[e] = (v[j][e] * rstd * gg[j][e]) * (sc[j][e] + 1.0f) + sh[j][e];
            u32x4 w; w.x = pk2(y[0], y[1]); w.y = pk2(y[2], y[3]); w.z = pk2(y[4], y[5]); w.w = pk2(y[6], y[7]);
            *(u32x4*)(H + (size_t)t * DM + c) = w; }
    }
#undef NORM_LOAD
}

struct EpiSwiGLU {
    static constexpr bool PERM = true;
    bf16_t* O;
    struct Ctx { int row0, col0; };
    __device__ __forceinline__ Ctx begin(const pg8::Unit& u, int wr, int wc, int fr, int fq) const { return Ctx{u.pm * 256 + wr * 64 + fr, u.pn * 128 + wc * 32 + 8 * fq}; }
    struct Pre {};
    __device__ __forceinline__ Pre pre(const Ctx&, int, int) const { return Pre{}; }
    __device__ __forceinline__ void rows(const Ctx& c, const Pre&, const f32x4 (&v)[2][2], const pg8::Unit&, int ai, int m, int, int, int, int) const {
        float r[8];
#pragma unroll
        for (int n = 0; n < 2; ++n)
#pragma unroll
            for (int j = 0; j < 4; ++j) r[4 * n + j] = silu_f(v[0][n][j]) * v[1][n][j];
        u32x4 w; w.x = pk2(r[0], r[1]); w.y = pk2(r[2], r[3]); w.z = pk2(r[4], r[5]); w.w = pk2(r[6], r[7]);
        *(u32x4*)(O + (size_t)(c.row0 + ai * 128 + m * 16) * DFF + c.col0) = w;
    }
};
template <bool INF, bool OUTF>
struct EpiResid {
    static constexpr bool PERM = true;
    const float* xp; const float* xs; bf16_t* xb; float* out; const float* gate_base; float coef;
    struct Ctx { const float* xin; f32x4 gv[2][2]; int row0, col0; };
    __device__ __forceinline__ Ctx begin(const pg8::Unit& u, int wr, int wc, int fr, int fq) const {
        Ctx c; const int rowt = u.pm * 256; c.row0 = rowt + wr * 64 + fr; c.col0 = u.pn * 256 + wc * 32 + 8 * fq;
        const float* gt = gate_base + (size_t)tok_mb(rowt) * NMOD;
        c.xin = rowt < NCTX ? xp : xs - (size_t)NCTX * DM;
#pragma unroll
        for (int bj = 0; bj < 2; ++bj)
#pragma unroll
            for (int n = 0; n < 2; ++n) c.gv[bj][n] = *(const f32x4*)(gt + c.col0 + bj * 128 + n * 4) * coef;
        return c;
    }
    struct Pre { f32x4 f[INF ? 4 : 1]; u32x4 w[INF ? 1 : 2]; };
    __device__ __forceinline__ Pre pre(const Ctx& c, int ai, int m) const {
        const size_t off = (size_t)(c.row0 + ai * 128 + m * 16) * DM + c.col0; Pre p;
#pragma unroll
        for (int bj = 0; bj < 2; ++bj) {
            if constexpr (INF) { p.f[2 * bj] = *(const f32x4*)(c.xin + off + bj * 128); p.f[2 * bj + 1] = *(const f32x4*)(c.xin + off + bj * 128 + 4); }
            else p.w[bj] = *(const u32x4*)(xb + off + bj * 128);
        }
        return p;
    }
    __device__ __forceinline__ void rows(const Ctx& c, const Pre& p, const f32x4 (&v)[2][2], const pg8::Unit&, int ai, int m, int, int, int, int) const {
        const size_t off = (size_t)(c.row0 + ai * 128 + m * 16) * DM + c.col0;
        f32x4 x[2][2];
#pragma unroll
        for (int bj = 0; bj < 2; ++bj) {
            if constexpr (INF) { x[bj][0] = p.f[2 * bj]; x[bj][1] = p.f[2 * bj + 1]; }
            else { const u32x4 w = p.w[bj];
                x[bj][0] = (f32x4){__builtin_bit_cast(float, w.x << 16), __builtin_bit_cast(float, w.x & 0xffff0000u), __builtin_bit_cast(float, w.y << 16), __builtin_bit_cast(float, w.y & 0xffff0000u)};
                x[bj][1] = (f32x4){__builtin_bit_cast(float, w.z << 16), __builtin_bit_cast(float, w.z & 0xffff0000u), __builtin_bit_cast(float, w.w << 16), __builtin_bit_cast(float, w.w & 0xffff0000u)}; }
        }
#pragma unroll
        for (int bj = 0; bj < 2; ++bj) { const f32x4 r0 = x[bj][0] + c.gv[bj][0] * v[bj][0], r1 = x[bj][1] + c.gv[bj][1] * v[bj][1];
            if constexpr (OUTF) { *(f32x4*)(out + off + bj * 128) = r0; *(f32x4*)(out + off + bj * 128 + 4) = r1; }
            else { u32x4 w; w.x = pk2(r0[0], r0[1]); w.y = pk2(r0[2], r0[3]); w.z = pk2(r1[0], r1[1]); w.w = pk2(r1[2], r1[3]); *(u32x4*)(xb + off + bj * 128) = w; }
        }
        asm volatile("" ::: "memory");
    }
};
typedef EpiResid<true, false> ResidIn; typedef EpiResid<false, false> ResidMid; typedef EpiResid<false, true> ResidOut;
struct EpiBf16 {
    static constexpr bool PERM = true;
    bf16_t* C; int ldc;
    struct Ctx { int row0, col0; };
    __device__ __forceinline__ Ctx begin(const pg8::Unit& u, int wr, int wc, int fr, int fq) const { return Ctx{u.pm * 256 + wr * 64 + fr, u.pn * 256 + wc * 32 + 8 * fq}; }
    struct Pre {};
    __device__ __forceinline__ Pre pre(const Ctx&, int, int) const { return Pre{}; }
    __device__ __forceinline__ void rows(const Ctx& c, const Pre&, const f32x4 (&v)[2][2], const pg8::Unit&, int ai, int m, int, int, int, int) const {
        bf16_t* rowp = C + (size_t)(c.row0 + ai * 128 + m * 16) * ldc + c.col0;
#pragma unroll
        for (int bj = 0; bj < 2; ++bj) { u32x4 w; w.x = pk2(v[bj][0][0], v[bj][0][1]); w.y = pk2(v[bj][0][2], v[bj][0][3]); w.z = pk2(v[bj][1][0], v[bj][1][1]); w.w = pk2(v[bj][1][2], v[bj][1][3]);
            *(u32x4*)(rowp + bj * 128) = w; }
    }
};
struct EpiF32 {
    static constexpr bool PERM = false;
    float* C; int ldc;
    struct Ctx { int row0, col0; };
    __device__ __forceinline__ Ctx begin(const pg8::Unit& u, int wr, int wc, int fr, int fq) const { return Ctx{u.pm * 256 + wr * 64 + fr, u.pn * 256 + wc * 32 + 4 * fq}; }
    struct Pre {};
    __device__ __forceinline__ Pre pre(const Ctx&, int, int) const { return Pre{}; }
    __device__ __forceinline__ void rows(const Ctx& c, const Pre&, const f32x4 (&v)[2][2], const pg8::Unit&, int ai, int m, int, int, int, int) const {
        float* rowp = C + (size_t)(c.row0 + ai * 128 + m * 16) * ldc + c.col0;
#pragma unroll
        for (int bj = 0; bj < 2; ++bj)
#pragma unroll
            for (int n = 0; n < 2; ++n) *(f32x4*)(rowp + bj * 128 + n * 16) = v[bj][n];
    }
};

__device__ __forceinline__ u32x4 pack8(const float (&v)[8]) { u32x4 w; w.x = pk2(v[0], v[1]); w.y = pk2(v[2], v[3]); w.z = pk2(v[4], v[5]); w.w = pk2(v[6], v[7]); return w; }
__device__ __forceinline__ void store8f(float* p, const float (&v)[8]) { *(f32x4*)p = (f32x4){v[0], v[1], v[2], v[3]}; *(f32x4*)(p + 4) = (f32x4){v[4], v[5], v[6], v[7]}; }
template <int W> __device__ __forceinline__ float group_sum(float v) {
#pragma unroll
    for (int o = 1; o < W; o <<= 1) v += __shfl_xor(v, o);
    return v;
}

__device__ __forceinline__ void phase_post1_even(Frame& F) {
    const bf16_t* P = (const bf16_t*)(F.ws + WS_P);
    const float* qn_g = F.a->in[IN_QNORM]; const float* kvn_g = F.a->in[IN_KVNORM]; const float* naq_g = F.a->in[IN_NAQK]; const float* nak_g = F.a->in[IN_NAQK] + 128;
    bf16_t* CQN = (bf16_t*)(F.ws + WS_CQN); bf16_t* CKVA = (bf16_t*)(F.ws + WS_CKVA); bf16_t* QNA = (bf16_t*)(F.ws + WS_QNA);
    constexpr int NVT_CTX = 16 * 8 * 8, NVT_LAT = 8 * 8 * 32;
    {
        const int lane = F.lane, lr = lane & 15, lq = lane >> 4, w = F.wave, t0 = (int)blockIdx.x * 48;
        const bf16_t* ap = (const bf16_t*)(F.ws + WS_H) + (size_t)(t0 + lr) * DM + 256 * w + 8 * lq;
        const bf16_t* bp = (const bf16_t*)(F.ws + WS_WEI) + (size_t)(4096 + lr) * DM + 256 * w + 8 * lq;
        f32x4 acc[3][4];
#pragma unroll
        for (int mb = 0; mb < 3; ++mb)
#pragma unroll
            for (int j = 0; j < 4; ++j) acc[mb][j] = (f32x4){0.f, 0.f, 0.f, 0.f};
#pragma unroll
        for (int kk = 0; kk < 8; ++kk) {
            bf16x8 bf[4];
#pragma unroll
            for (int j = 0; j < 4; ++j) bf[j] = *(const bf16x8*)(bp + (size_t)j * 16 * DM + kk * 32);
#pragma unroll
            for (int mb = 0; mb < 3; ++mb) { const bf16x8 af = *(const bf16x8*)(ap + (size_t)mb * 16 * DM + kk * 32);
#pragma unroll
                for (int j = 0; j < 4; ++j) acc[mb][j] = __builtin_amdgcn_mfma_f32_16x16x32_bf16(af, bf[j], acc[mb][j], 0, 0, 0); }
        }
        LAS float* red = (LAS float*)F.lds;
#pragma unroll
        for (int mb = 0; mb < 3; ++mb)
#pragma unroll
            for (int j = 0; j < 4; ++j)
#pragma unroll
                for (int r = 0; r < 4; ++r) red[(w * 48 + 16 * mb + 4 * lq + r) * 64 + 16 * j + lr] = acc[mb][j][r];
        __syncthreads();
        float* kr = (float*)(F.ws + WS_KROPE);
#pragma unroll
        for (int i = 0; i < 6; ++i) { const int o = F.tid + 512 * i; float sum = 0.f;
#pragma unroll
            for (int p = 0; p < 8; ++p) sum += red[p * 3072 + o];
            const int t = t0 + (o >> 6);
            kr[(size_t)t0 * 64 + o] = sum; if (t < NCTX) F.out[O_KROPE + (size_t)t0 * 64 + o] = sum; }
        __syncthreads();
    }
    {
        const int lane = F.lane, head = lane >> 3, d0 = (lane & 7) * 16;
        float gq[8], gkv[8], gqa[8], gqc[8], gka[8], gkc[8];
        load8(qn_g + 8 * lane, gq); load8(kvn_g + 8 * lane, gkv); load8(naq_g + d0, gqa); load8(naq_g + d0 + 8, gqc); load8(nak_g + d0, gka); load8(nak_g + d0 + 8, gkc);
#define P1_LOAD(R, t_) do { const bf16_t* pr_ = P + (size_t)(t_) * IN_EVEN_P; R[0] = *(const u32x4*)(pr_ + 8 * lane); R[1] = *(const u32x4*)(pr_ + 512 + 8 * lane); \
            _Pragma("unroll") for (int w_ = 0; w_ < 3; ++w_) { R[2 + 2 * w_] = *(const u32x4*)(pr_ + 1024 + 1024 * w_ + 16 * lane); R[3 + 2 * w_] = *(const u32x4*)(pr_ + 1024 + 1024 * w_ + 16 * lane + 8); } } while (0)
        u32x4 R[8];
        P1_LOAD(R, F.gw);
        for (int t = F.gw; t < NTOK; t += F.NGW) {
            u32x4 C[8];
#pragma unroll
            for (int i = 0; i < 8; ++i) C[i] = R[i];
            { const int tn = t + F.NGW < NTOK ? t + F.NGW : t; P1_LOAD(R, tn); }
            const bool ctx = t < NCTX;
            float v[8];
            unpack8h(C[0], v); float ss = 0.f;
#pragma unroll
            for (int i = 0; i < 8; ++i) ss += v[i] * v[i];
            float rstd = __builtin_amdgcn_rsqf(wave_sum(ss) * (1.0f / 512) + EPS);
#pragma unroll
            for (int i = 0; i < 8; ++i) v[i] = v[i] * rstd * gq[i];
            *(u32x4*)(CQN + (size_t)t * 512 + 8 * lane) = pack8(v);
            unpack8h(C[1], v); ss = 0.f;
#pragma unroll
            for (int i = 0; i < 8; ++i) ss += v[i] * v[i];
            rstd = __builtin_amdgcn_rsqf(wave_sum(ss) * (1.0f / 512) + EPS);
#pragma unroll
            for (int i = 0; i < 8; ++i) v[i] = v[i] * rstd * gkv[i];
            if (ctx) store8f(F.out + O_CKV + (size_t)t * 512 + 8 * lane, v);
            *(u32x4*)(CKVA + (size_t)t * 512 + 8 * lane) = pack8(v);
            int b, s; if (ctx) { b = t >> 8; s = t & 255; } else { b = (t - NCTX) >> 10; s = (t - NCTX) & 1023; }
#pragma unroll
            for (int which = 0; which < 2; ++which) {
                float a[8], c[8]; unpack8h(C[2 + 2 * which], a); unpack8h(C[3 + 2 * which], c);
                float q = 0.f;
#pragma unroll
                for (int i = 0; i < 8; ++i) q += a[i] * a[i] + c[i] * c[i];
                const float r2 = __builtin_amdgcn_rsqf(group_sum<8>(q) * (1.0f / 128) + EPS);
#pragma unroll
                for (int i = 0; i < 8; ++i) { a[i] = a[i] * r2 * (which ? gka[i] : gqa[i]); c[i] = c[i] * r2 * (which ? gkc[i] : gqc[i]); }
                if (which == 0) { bf16_t* qd = QNA + (size_t)t * 1024 + head * 128 + d0; *(u32x4*)qd = pack8(a); *(u32x4*)(qd + 8) = pack8(c); }
                else {
                    if (ctx) { float* od = F.out + O_NAK + (size_t)t * 1024 + head * 128 + d0; store8f(od, a); store8f(od + 8, c); }
                    bf16_t* kb = ctx ? (bf16_t*)(F.ws + WS_KN_CTX) + (size_t)(b * 8 + head) * (256 * 128) : (bf16_t*)(F.ws + WS_KN_LAT) + (size_t)(b * 8 + head) * (1024 * 128);
                    *(u32x4*)(kb + k_chunk_off(128, s, d0 >> 3)) = pack8(a); *(u32x4*)(kb + k_chunk_off(128, s, (d0 >> 3) + 1)) = pack8(c);
                }
            }
            if (ctx) { float a[8], c[8]; unpack8h(C[6], a); unpack8h(C[7], c); float* od = F.out + O_NAV + (size_t)t * 1024 + 16 * lane; store8f(od, a); store8f(od + 8, c); }
        }
#undef P1_LOAD
    }
    for (int r = F.gw; r < NVT_CTX + NVT_LAT; r += F.NGW) {
        if (r < NVT_CTX) { const int t32 = r & 7, bh = r >> 3, b = bh >> 3, h = bh & 7;
            vt_tile_write_h(P + (size_t)(b * 256 + t32 * 32) * IN_EVEN_P + 3072 + h * 128, IN_EVEN_P, (bf16_t*)(F.ws + WS_VN_CTX) + (size_t)bh * (256 * 128) + (size_t)t32 * 4096, F.lane);
        } else { const int r2 = r - NVT_CTX, t32 = r2 & 31, bh = r2 >> 5, b = bh >> 3, h = bh & 7;
            vt_tile_write_h(P + (size_t)(NCTX + b * 1024 + t32 * 32) * IN_EVEN_P + 3072 + h * 128, IN_EVEN_P, (bf16_t*)(F.ws + WS_VN_LAT) + (size_t)bh * (1024 * 128) + (size_t)t32 * 4096, F.lane);
        }
    }
}

__device__ __forceinline__ void rope8(float (&v)[8], const float (&vp)[8], bool is_x1, float pos, int f0, float inv_nf) {
#pragma unroll
    for (int i = 0; i < 8; ++i) {
        const float invf = fast_exp2(-(float)(f0 + i) * inv_nf * 13.287712379549449f);
        const float rev = pos * invf * 0.15915494309189535f;
        const float cs = cos_rev(rev), sn = sin_rev(rev);
        v[i] = is_x1 ? (v[i] * cs - vp[i] * sn) : (vp[i] * sn + v[i] * cs);
    }
}

__device__ __forceinline__ void phase_post2_even(Frame& F) {
    const bf16_t* P = (const bf16_t*)(F.ws + WS_P); const bf16_t* QM = (const bf16_t*)(F.ws + WS_QM); const bf16_t* KVM = (const bf16_t*)(F.ws + WS_ACT);
    const float* gq = F.a->in[IN_MLAQK]; const float* gk = F.a->in[IN_MLAQK] + 192;
    bf16_t* QA = (bf16_t*)(F.ws + WS_QA);
    constexpr int NROW = 16384, NVT_CTX = 1024, NVT_LAT = 2048, NVT_CAC = 1024;
    const int lane = F.lane, hsub = lane >> 5, c = lane & 31; const bool act = c < 24;
    for (int it = F.gw; it < NTOK + NROW + NVT_CTX + NVT_LAT + NVT_CAC; it += F.NGW) {
        if (it < NTOK) {
            const int t = it; const bool lat = t >= NCTX; const int s = (t - NCTX) & 1023; const float row = (float)(s >> 6), col = (float)(s & 63);
            const int cc = act ? c : 23, cpq = cc >= 16 ? (cc ^ 2) : cc;
            float g[8], gp[8]; load8(gq + 8 * cc, g); load8(gq + 8 * cpq, gp);
            float v[4][8], vp[4][8];
#pragma unroll
            for (int pass = 0; pass < 4; ++pass) { const bf16_t* src = QM + (size_t)t * 1536 + (2 * pass + hsub) * 192; load8h(src + 8 * cc, v[pass]); load8h(src + 8 * cpq, vp[pass]); }
#pragma unroll
            for (int pass = 0; pass < 4; ++pass) {
                const int head = 2 * pass + hsub;
                float q = 0.f;
#pragma unroll
                for (int i = 0; i < 8; ++i) { v[pass][i] = act ? v[pass][i] : 0.f; q += v[pass][i] * v[pass][i]; }
                const float rstd = __builtin_amdgcn_rsqf(group_sum<32>(q) * (1.0f / 192) + EPS);
#pragma unroll
                for (int i = 0; i < 8; ++i) { v[pass][i] = v[pass][i] * rstd * g[i]; vp[pass][i] = vp[pass][i] * rstd * gp[i]; }
                if (lat && c >= 16 && act) rope8(v[pass], vp[pass], (c & 2) == 0, c < 20 ? row : col, (c & 1) * 8, 1.0f / 16);
                if (act) *(u32x4*)(QA + (size_t)t * 1536 + head * 192 + 8 * c) = pack8(v[pass]);
            }
        } else if (it < NTOK + NROW) {
            const int r = it - NTOK; const bool istok = r < NTOK; const bool lat = istok && r >= NCTX;
            int bsel, s; bf16_t* kb0; int nkeys;
            if (!istok) { bsel = (r - NTOK) >> 9; s = (r - NTOK) & 511; kb0 = (bf16_t*)(F.ws + WS_KM_CAC); nkeys = 512; }
            else if (lat) { bsel = (r - NCTX) >> 10; s = (r - NCTX) & 1023; kb0 = (bf16_t*)(F.ws + WS_KM_LAT); nkeys = 1024; }
            else { bsel = r >> 8; s = r & 255; kb0 = (bf16_t*)(F.ws + WS_KM_CTX); nkeys = 256; }
            const float* krp_f = istok ? (const float*)(F.ws + WS_KROPE) + (size_t)r * 64 : F.a->in[IN_C_KROPE] + (size_t)(r - NTOK) * 64;
            const float row = (float)(s >> 6), col = (float)(s & 63);
            const int cc = act ? c : 23, cpq = cc >= 16 ? (cc ^ 2) : cc, cn = c < 16 ? c : 15, cr = cc >= 16 ? cc - 16 : 0, crp = cc >= 16 ? cpq - 16 : 0;
            float g[8], gp[8], kr[8], krp[8]; load8(gk + 8 * cc, g); load8(gk + 8 * cpq, gp); load8(krp_f + 8 * cr, kr); load8(krp_f + 8 * crp, krp);
            float v[4][8];
#pragma unroll
            for (int pass = 0; pass < 4; ++pass) load8h(KVM + (size_t)r * 2048 + (2 * pass + hsub) * 256 + 8 * cn, v[pass]);
#pragma unroll
            for (int pass = 0; pass < 4; ++pass) {
                const int head = 2 * pass + hsub;
                float vp[8]; float q = 0.f;
#pragma unroll
                for (int i = 0; i < 8; ++i) { v[pass][i] = c < 16 ? v[pass][i] : (act ? kr[i] : 0.f); q += v[pass][i] * v[pass][i]; }
                const float rstd = __builtin_amdgcn_rsqf(group_sum<32>(q) * (1.0f / 192) + EPS);
#pragma unroll
                for (int i = 0; i < 8; ++i) { v[pass][i] = v[pass][i] * rstd * g[i]; vp[i] = krp[i] * rstd * gp[i]; }
                if (lat && c >= 16 && act) rope8(v[pass], vp, (c & 2) == 0, c < 20 ? row : col, (c & 1) * 8, 1.0f / 16);
                if (act) *(u32x4*)(kb0 + (size_t)(bsel * 8 + head) * ((size_t)nkeys * 192) + k_chunk_off(192, s, c)) = pack8(v[pass]);
            }
        } else {
            int r = it - NTOK - NROW;
            if (r < NVT_CTX) { const int t32 = r & 7, bh = r >> 3, b = bh >> 3, h = bh & 7;
                vt_tile_write_h(KVM + (size_t)(b * 256 + t32 * 32) * 2048 + h * 256 + 128, 2048, (bf16_t*)(F.ws + WS_VM_CTX) + (size_t)bh * (256 * 128) + (size_t)t32 * 4096, lane);
            } else if (r < NVT_CTX + NVT_LAT) { r -= NVT_CTX; const int t32 = r & 31, bh = r >> 5, b = bh >> 3, h = bh & 7;
                vt_tile_write_h(KVM + (size_t)(NCTX + b * 1024 + t32 * 32) * 2048 + h * 256 + 128, 2048, (bf16_t*)(F.ws + WS_VM_LAT) + (size_t)bh * (1024 * 128) + (size_t)t32 * 4096, lane);
            } else { r -= NVT_CTX + NVT_LAT; const int t32 = r & 15, bh = r >> 4, b = bh >> 3, h = bh & 7;
                vt_tile_write_h(KVM + (size_t)(NTOK + b * 512 + t32 * 32) * 2048 + h * 256 + 128, 2048, (bf16_t*)(F.ws + WS_VM_CAC) + (size_t)bh * (512 * 128) + (size_t)t32 * 4096, lane);
            }
        }
    }
}

__device__ __forceinline__ void phase_post_odd(Frame& F) {
    const bf16_t* P = (const bf16_t*)(F.ws + WS_P); const float* gq = F.a->in[IN_GQK]; const float* gk = F.a->in[IN_GQK] + 128;
    bf16_t* QA = (bf16_t*)(F.ws + WS_QA);
    constexpr int NVT_CTX = 16 * 4 * 8, NVT_LAT = 8 * 4 * 32;
    const int lane = F.lane, hsub = lane >> 4, c = lane & 15;
    for (int it = F.gw; it < NTOK + NVT_CTX + NVT_LAT; it += F.NGW) {
        if (it < NTOK) {
            const int t = it; const bool ctx = t < NCTX, lat = !ctx; const bf16_t* pr = P + (size_t)t * IN_ODD;
            int b, s; if (ctx) { b = t >> 8; s = t & 255; } else { b = (t - NCTX) >> 10; s = (t - NCTX) & 1023; }
            const float row = (float)(s >> 6), col = (float)(s & 63);
            const int cp = c ^ 4;
            float gqv[8], gqp[8], gkv[8], gkp[8]; load8(gq + 8 * c, gqv); load8(gq + 8 * cp, gqp); load8(gk + 8 * c, gkv); load8(gk + 8 * cp, gkp);
            float v[5][8], vp[5][8];
#pragma unroll
            for (int pass = 0; pass < 5; ++pass) { const bf16_t* src = pr + (pass == 4 ? 2048 + hsub * 128 : (4 * pass + hsub) * 128); load8h(src + 8 * c, v[pass]); load8h(src + 8 * cp, vp[pass]); }
#pragma unroll
            for (int pass = 0; pass < 5; ++pass) {
                const bool isk = pass == 4; const int head = isk ? hsub : 4 * pass + hsub;
                float q = 0.f;
#pragma unroll
                for (int i = 0; i < 8; ++i) q += v[pass][i] * v[pass][i];
                const float rstd = __builtin_amdgcn_rsqf(group_sum<16>(q) * (1.0f / 128) + EPS);
#pragma unroll
                for (int i = 0; i < 8; ++i) { v[pass][i] = v[pass][i] * rstd * (isk ? gkv[i] : gqv[i]); vp[pass][i] = vp[pass][i] * rstd * (isk ? gkp[i] : gqp[i]); }
                if (isk && ctx) store8f(F.out + O_GK + (size_t)t * 512 + head * 128 + 8 * c, v[pass]);
                if (lat) rope8(v[pass], vp[pass], (c & 4) == 0, c < 8 ? row : col, (c & 3) * 8, 1.0f / 32);
                if (!isk) *(u32x4*)(QA + (size_t)t * 2048 + head * 128 + 8 * c) = pack8(v[pass]);
                else { bf16_t* kb = ctx ? (bf16_t*)(F.ws + WS_KG_CTX) + (size_t)(b * 4 + head) * (256 * 128) : (bf16_t*)(F.ws + WS_KG_LAT) + (size_t)(b * 4 + head) * (1024 * 128);
                    *(u32x4*)(kb + k_chunk_off(128, s, c)) = pack8(v[pass]); }
            }
            { float vv[8]; load8h(pr + 2560 + 8 * lane, vv); if (ctx) store8f(F.out + O_GV + (size_t)t * 512 + 8 * lane, vv); }
        } else {
            int r = it - NTOK;
            if (r < NVT_CTX) { const int t32 = r & 7, bh = r >> 3, b = bh >> 2, h = bh & 3;
                vt_tile_write_h(P + (size_t)(b * 256 + t32 * 32) * IN_ODD + 2560 + h * 128, IN_ODD, (bf16_t*)(F.ws + WS_VG_CTX) + (size_t)bh * (256 * 128) + (size_t)t32 * 4096, lane);
            } else { r -= NVT_CTX; const int t32 = r & 31, bh = r >> 5, b = bh >> 2, h = bh & 3;
                vt_tile_write_h(P + (size_t)(NCTX + b * 1024 + t32 * 32) * IN_ODD + 2560 + h * 128, IN_ODD, (bf16_t*)(F.ws + WS_VG_LAT) + (size_t)bh * (1024 * 128) + (size_t)t32 * 4096, lane);
            }
        }
    }
}

struct WgUnit {
    const bf16_t* kc; const bf16_t* vc; int nctx;
    const bf16_t* kl; const bf16_t* vl; int t_lo, t_hi;
};
struct WvUnit {
    const bf16_t* qb; unsigned qoff; int qpitch; bf16_t* ob; unsigned ooff;
    int qpos;
    int qcol0;
    int w_lo, w_hi;
    float sink; int has_sink; float scale;
};
constexpr int ATT_RPB_OFF = RING_BYTES + 512;
constexpr float ATT_THR = 8.0f;
template <int MODE>
__device__ __forceinline__ float attn_mask(float v, int tile32, int r, int hh, int ql, bool masked, const WvUnit& U, const LAS float* rpb) {
    const int kk = (r & 3) + 8 * (r >> 2) + 4 * hh;
    if (MODE == 1) { const int df = U.qpos + ql - (tile32 * 32 + kk); if (masked && (df > 128 || df < -128)) v = -1e30f; }
    if (MODE == 2 && masked) { const int krow = tile32 >> 1, kcol = (tile32 & 1) * 32 + kk, qc = U.qcol0 + ql;
        int ws = qc - 8; ws = ws < 0 ? 0 : (ws > 48 ? 48 : ws);
        const bool valid = (kcol >= ws) && (kcol < ws + 16);
        int co = kcol - qc; co = co < -15 ? -15 : (co > 15 ? 15 : co);
        const float bias = rpb[(krow - U.qpos + 7) * 31 + co + 15];
        v = valid ? v + bias * LOG2E : -1e30f; }
    return v;
}
template <int OFF> __device__ __forceinline__ bf16x8 lds_rd(unsigned addr) { bf16x8 r; asm volatile("ds_read_b128 %0, %1 offset:%2" : "=v"(r) : "v"(addr), "i"(OFF)); return r; }
template <int BASE, int H1> __device__ __forceinline__ void lds_rd8(unsigned addr, bf16x8 (&a)[8]) {
    a[0] = lds_rd<BASE>(addr); a[1] = lds_rd<BASE + 1024>(addr); a[2] = lds_rd<BASE + 2048>(addr); a[3] = lds_rd<BASE + 3072>(addr);
    a[4] = lds_rd<BASE + H1>(addr); a[5] = lds_rd<BASE + H1 + 1024>(addr); a[6] = lds_rd<BASE + H1 + 2048>(addr); a[7] = lds_rd<BASE + H1 + 3072>(addr);
}
#define LDS_WAIT8(n, a) asm volatile("s_waitcnt lgkmcnt(" #n ")" : "+v"(a[0]), "+v"(a[1]), "+v"(a[2]), "+v"(a[3]), "+v"(a[4]), "+v"(a[5]), "+v"(a[6]), "+v"(a[7]))
#define QK_MMA8(a, kb) do { _Pragma("unroll") for (int _j = 0; _j < 4; ++_j) { s0 = __builtin_amdgcn_mfma_f32_32x32x16_bf16(a[_j], qf[(kb) * 4 + _j], s0, 0, 0, 0); s1 = __builtin_amdgcn_mfma_f32_32x32x16_bf16(a[4 + _j], qf[(kb) * 4 + _j], s1, 0, 0, 0); } } while (0)
__device__ __forceinline__ void na_mask16(f32x16& sx, int tile32, int hh, int ql, bool masked, const WvUnit& U, const LAS float* rpb) {
    const int krow = tile32 >> 1, kc0 = (tile32 & 1) * 32 + 4 * hh, qc = U.qcol0 + ql;
    int ws = qc - 8; ws = ws < 0 ? 0 : (ws > 48 ? 48 : ws);
    int ro = krow - U.qpos + 7; ro = ro < 0 ? 0 : (ro > 14 ? 14 : ro);
    const LAS float* rrow = rpb + ro * 31 + 15;
    float bias[16];
#pragma unroll
    for (int r = 0; r < 16; ++r) { int co = kc0 + (r & 3) + 8 * (r >> 2) - qc; co = co < -15 ? -15 : (co > 15 ? 15 : co); bias[r] = rrow[co]; }
#pragma unroll
    for (int r = 0; r < 16; ++r) { const int kcol = kc0 + (r & 3) + 8 * (r >> 2); const float mv = ((unsigned)(kcol - ws) < 16u) ? sx[r] + bias[r] * LOG2E : -1e30f; sx[r] = masked ? mv : sx[r]; }
}
template <int DQK, int MODE>
__device__ __forceinline__ void attn_tile64(const LAS unsigned char* sl, int t64, bool masked, const bf16x8 (&qf)[DQK / 16], f32x16 (&o)[4], float& m, float& l, const WvUnit& U, const LAS float* rpb, int lane, float sl2) {
    constexpr int NKS = DQK / 16, KB = DQK * 128;
    const int ql = lane & 31, hh = lane >> 5;
    const unsigned addr = (unsigned)(unsigned long)sl + (unsigned)lane * 16u;
    f32x16 s0, s1;
#pragma unroll
    for (int r = 0; r < 16; ++r) { s0[r] = 0.f; s1[r] = 0.f; }
    bf16x8 pb[4];
#define ATT_SMA(sx, T32) do { float mt = -1e30f; \
    if (MODE == 1) { if (masked) {   \
            _Pragma("unroll") for (int r = 0; r < 16; ++r) sx[r] = attn_mask<MODE>(sx[r] * sl2, (T32), r, hh, ql, true, U, rpb); } } \
    if (MODE == 2) { _Pragma("unroll") for (int r = 0; r < 16; ++r) sx[r] *= sl2; na_mask16(sx, (T32), hh, ql, masked, U, rpb); } \
    _Pragma("unroll") for (int r = 0; r < 16; ++r) mt = fmaxf(mt, sx[r]); \
    if (MODE == 0 || (MODE == 1 && !masked)) mt *= sl2;     \
    mt = fmaxf(mt, __shfl_xor(mt, 32)); \
    if (!__all(mt - m <= ATT_THR)) { const float mn = fmaxf(m, mt), alpha = fast_exp2(m - mn); m = mn; l *= alpha; \
        _Pragma("unroll") for (int db = 0; db < 4; ++db) _Pragma("unroll") for (int r = 0; r < 16; ++r) o[db][r] *= alpha; } } while (0)
#define ATT_SMB(sx, PBI) do { float ps = 0.f; const float esc = (MODE == 0 || (MODE == 1 && !masked)) ? sl2 : 1.0f; \
    _Pragma("unroll") for (int r = 0; r < 16; ++r) { sx[r] = fast_exp2(fmaf(sx[r], esc, -m)); ps += sx[r]; } \
    l += ps; \
    _Pragma("unroll") for (int s2 = 0; s2 < 2; ++s2) { \
        u32x4 w; w.x = pk2(sx[8 * s2 + 0], sx[8 * s2 + 1]); w.y = pk2(sx[8 * s2 + 2], sx[8 * s2 + 3]); w.z = pk2(sx[8 * s2 + 4], sx[8 * s2 + 5]); w.w = pk2(sx[8 * s2 + 6], sx[8 * s2 + 7]); pb[(PBI) + s2] = __builtin_bit_cast(bf16x8, w); } } while (0)
#define MFMA32(a_, b_, c_) __builtin_amdgcn_mfma_f32_32x32x16_bf16(a_, b_, c_, 0, 0, 0)
    if constexpr (NKS == 8) {
        bf16x8 ka[8], kb_[8];
        lds_rd8<0, 4096>(addr, ka); lds_rd8<KB / 2, 4096>(addr, kb_);
        LDS_WAIT8(8, ka);
#pragma unroll
        for (int j = 0; j < 8; ++j) s0 = MFMA32(ka[j], qf[j], s0);
        if (MODE != 2) { lds_rd8<KB, 4096>(addr, ka); LDS_WAIT8(8, kb_); } else LDS_WAIT8(0, kb_);
#pragma unroll
        for (int j = 0; j < 4; ++j) s1 = MFMA32(kb_[j], qf[j], s1);
        ATT_SMA(s0, 2 * t64);
        if (MODE == 2) lds_rd8<KB, 4096>(addr, ka);
#pragma unroll
        for (int j = 4; j < 8; ++j) s1 = MFMA32(kb_[j], qf[j], s1);
        ATT_SMB(s0, 0);
        lds_rd8<KB + 8192, 4096>(addr, kb_);
        LDS_WAIT8(8, ka);
#pragma unroll
        for (int db = 0; db < 4; ++db) o[db] = MFMA32(ka[db], pb[0], o[db]);
        ATT_SMA(s1, 2 * t64 + 1);
#pragma unroll
        for (int db = 0; db < 4; ++db) o[db] = MFMA32(ka[4 + db], pb[1], o[db]);
        ATT_SMB(s1, 2);
        LDS_WAIT8(0, kb_);
#pragma unroll
        for (int s2 = 0; s2 < 2; ++s2)
#pragma unroll
            for (int db = 0; db < 4; ++db) o[db] = MFMA32(kb_[s2 * 4 + db], pb[2 + s2], o[db]);
    } else {
        bf16x8 ka[4], kb_[4];
#define RDK4(a, h, b) do { a[0] = lds_rd<(h) * (KB / 2) + (b) * 4096>(addr); a[1] = lds_rd<(h) * (KB / 2) + (b) * 4096 + 1024>(addr); a[2] = lds_rd<(h) * (KB / 2) + (b) * 4096 + 2048>(addr); a[3] = lds_rd<(h) * (KB / 2) + (b) * 4096 + 3072>(addr); } while (0)
#define RDV4(a, q) do { a[0] = lds_rd<KB + (q) * 4096>(addr); a[1] = lds_rd<KB + (q) * 4096 + 1024>(addr); a[2] = lds_rd<KB + (q) * 4096 + 2048>(addr); a[3] = lds_rd<KB + (q) * 4096 + 3072>(addr); } while (0)
#define WAIT4(n, a) asm volatile("s_waitcnt lgkmcnt(" #n ")" : "+v"(a[0]), "+v"(a[1]), "+v"(a[2]), "+v"(a[3]))
#define QK4(a, sx, b) do { _Pragma("unroll") for (int j = 0; j < 4; ++j) sx = MFMA32(a[j], qf[4 * (b) + j], sx); } while (0)
#define PV4(a, q) do { _Pragma("unroll") for (int db = 0; db < 4; ++db) o[db] = MFMA32(a[db], pb[q], o[db]); } while (0)
        RDK4(ka, 0, 0); RDK4(kb_, 0, 1);
        WAIT4(4, ka); QK4(ka, s0, 0); RDK4(ka, 0, 2);
        WAIT4(4, kb_); QK4(kb_, s0, 1); RDK4(kb_, 1, 0);
        WAIT4(4, ka); QK4(ka, s0, 2); RDK4(ka, 1, 1);
        WAIT4(4, kb_); QK4(kb_, s1, 0); RDK4(kb_, 1, 2);
        ATT_SMA(s0, 2 * t64);
        WAIT4(4, ka); QK4(ka, s1, 1); RDV4(ka, 0);
        ATT_SMB(s0, 0);
        WAIT4(4, kb_); QK4(kb_, s1, 2); RDV4(kb_, 1);
        WAIT4(4, ka); PV4(ka, 0); RDV4(ka, 2);
        ATT_SMA(s1, 2 * t64 + 1);
        WAIT4(4, kb_); PV4(kb_, 1); RDV4(kb_, 3);
        ATT_SMB(s1, 2);
        WAIT4(4, ka); PV4(ka, 2);
        WAIT4(0, kb_); PV4(kb_, 3);
#undef RDK4
#undef RDV4
#undef WAIT4
#undef QK4
#undef PV4
    }
#undef ATT_SMA
#undef ATT_SMB
#undef MFMA32
}
template <int DQK, int MODE, int VAR = 0>
__device__ __forceinline__ void attn_wg_unit(LAS unsigned char* ring, const WgUnit& G, const WvUnit& U, const float* rpb_g, int tid, int wave, int lane) {
    constexpr int NKS = DQK / 16, KB = DQK * 128, NLK = KB / 8192;
    constexpr int NS = (DQK == 128) ? 4 : 3, SLOTB = KB + 16384;
    const int ql = lane & 31, hh = lane >> 5;
    const int ntiles = G.nctx + (G.t_hi - G.t_lo);
    const LAS float* rpb = (const LAS float*)(ring + ATT_RPB_OFF);
#define ATT_ISSUE(i, SLOTC) do { const int _i = (i); const bool _c = _i < G.nctx; const int _t = _c ? _i : G.t_lo + (_i - G.nctx); \
        const char* _kg = (const char*)(_c ? G.kc : G.kl) + (size_t)_t * KB + tid * 16; const char* _vg = (const char*)(_c ? G.vc : G.vl) + (size_t)_t * 16384 + tid * 16; \
        LAS unsigned char* _sl = ring + (SLOTC) * SLOTB + wave * 1024; \
        _Pragma("unroll") for (int _p = 0; _p < NLK; ++_p) __builtin_amdgcn_global_load_lds((const unsigned*)(_kg + _p * 8192), (LAS unsigned*)(_sl + _p * 8192), 16, 0, 0); \
        _Pragma("unroll") for (int _p = 0; _p < 2; ++_p) __builtin_amdgcn_global_load_lds((const unsigned*)(_vg + _p * 8192), (LAS unsigned*)(_sl + KB + _p * 8192), 16, 0, 0); } while (0)
    asm volatile("s_waitcnt lgkmcnt(0)" ::: "memory"); __builtin_amdgcn_s_barrier(); asm volatile("" ::: "memory");
    bf16x8 qf[NKS];
#pragma unroll
    for (int ks = 0; ks < NKS; ++ks) qf[ks] = *(const bf16x8*)(U.qb + (size_t)(U.qoff + (unsigned)(ql * U.qpitch + 16 * ks + 8 * hh)));
    if (MODE == 2) { const int i = opaque_v(tid); if (i < 15 * 31) ((LAS float*)(ring + ATT_RPB_OFF))[i] = rpb_g[i]; }
    if (VAR != 2) { ATT_ISSUE(0, 0); if (ntiles > 1) ATT_ISSUE(1, 1); if (NS == 4 && ntiles > 2) ATT_ISSUE(2, 2); }
    f32x16 o[4];
#pragma unroll
    for (int db = 0; db < 4; ++db)
#pragma unroll
        for (int r = 0; r < 16; ++r) o[db][r] = 0.f;
    float m = -1e30f, l = 0.f;
    const float sl2 = U.scale * LOG2E;
#define ATT_STEP(i_, SLOTC) do { const int i = (i_); if (i < ntiles) { \
        if (NS == 4) { if (i + 2 < ntiles) asm volatile("s_waitcnt vmcnt(8)" ::: "memory"); else if (i + 1 < ntiles) asm volatile("s_waitcnt vmcnt(4)" ::: "memory"); else asm volatile("s_waitcnt vmcnt(0)" ::: "memory"); } \
        else { if (i + 1 < ntiles) asm volatile("s_waitcnt vmcnt(5)" ::: "memory"); else asm volatile("s_waitcnt vmcnt(0)" ::: "memory"); } \
        asm volatile("s_waitcnt lgkmcnt(0)" ::: "memory"); __builtin_amdgcn_s_barrier(); asm volatile("" ::: "memory"); \
        if (VAR != 2 && i + NS - 1 < ntiles) ATT_ISSUE(i + NS - 1, ((SLOTC) + NS - 1) % NS); \
        const bool isctx = i < G.nctx; const int t64 = isctx ? 0 : G.t_lo + (i - G.nctx); \
        if (VAR != 1 && (isctx || (t64 >= U.w_lo && t64 < U.w_hi))) attn_tile64<DQK, MODE>(ring + (SLOTC) * SLOTB, t64, !isctx, qf, o, m, l, U, rpb, lane, sl2); } } while (0)
    if constexpr (NS == 4) { for (int i0 = 0; i0 < ntiles; i0 += 4) { ATT_STEP(i0, 0); ATT_STEP(i0 + 1, 1); ATT_STEP(i0 + 2, 2); ATT_STEP(i0 + 3, 3); } }
    else { for (int i0 = 0; i0 < ntiles; i0 += 3) { ATT_STEP(i0, 0); ATT_STEP(i0 + 1, 1); ATT_STEP(i0 + 2, 2); } }
#undef ATT_STEP
#undef ATT_ISSUE
    l += __shfl_xor(l, 32);
    if (U.has_sink) l += fast_exp2(U.sink * LOG2E - m);
    const float inv = 1.0f / l;
    bf16_t* op = U.ob + (size_t)(U.ooff + (unsigned)(opaque_v(ql) * DM));
#pragma unroll
    for (int db = 0; db < 4; ++db)
#pragma unroll
        for (int k = 0; k < 2; ++k) {
            const unsigned p0x = pk2(o[db][8 * k] * inv, o[db][8 * k + 1] * inv), p0y = pk2(o[db][8 * k + 2] * inv, o[db][8 * k + 3] * inv);
            const unsigned p1x = pk2(o[db][8 * k + 4] * inv, o[db][8 * k + 5] * inv), p1y = pk2(o[db][8 * k + 6] * inv, o[db][8 * k + 7] * inv);
            const auto sx = __builtin_amdgcn_permlane32_swap(p0x, p1x, false, false);
            const auto sy = __builtin_amdgcn_permlane32_swap(p0y, p1y, false, false);
            u32x4 w; w.x = sx[0]; w.y = sy[0]; w.z = sx[1]; w.w = sy[1];
            *(u32x4*)(op + 32 * db + 16 * k + 8 * hh) = w; }
}

template <int VAR>
__device__ __forceinline__ void phase_attn_even(Frame& F, bf16_t* O) {
 const bf16_t* QA = (const bf16_t*)(F.ws + WS_QA); const bf16_t* QNA = (const bf16_t*)(F.ws + WS_QNA);
    const int wave = F.wave, lane = F.lane, tid = F.tid;
    WgUnit G; WvUnit U; U.sink = 0.f; U.has_sink = 0; U.qpos = 0; U.qcol0 = 0;
    const int vcu = (F.G % 8 == 0) ? ((int)blockIdx.x % 8) * (F.G / 8) + (int)blockIdx.x / 8 : (int)blockIdx.x;
    for (int u = vcu; u < 256; u += F.G) { const int bh = u >> 2, q4 = u & 3, b = bh >> 3, h = bh & 7, t0 = NCTX + b * 1024 + q4 * 256 + 32 * wave;
        U.qb = QA; U.qoff = (unsigned)(t0 * 1536 + h * 192); U.qpitch = 1536; U.scale = 0.07216878364870322f; U.ob = O; U.ooff = (unsigned)(t0 * DM + h * 128);
        G.kc = (const bf16_t*)(F.ws + WS_KM_CAC) + (size_t)bh * (512 * 192); G.vc = (const bf16_t*)(F.ws + WS_VM_CAC) + (size_t)bh * (512 * 128); G.nctx = 8;
        G.kl = (const bf16_t*)(F.ws + WS_KM_LAT) + (size_t)bh * (1024 * 192); G.vl = (const bf16_t*)(F.ws + WS_VM_LAT) + (size_t)bh * (1024 * 128); G.t_lo = 0; G.t_hi = 16; U.w_lo = 0; U.w_hi = 16;
        attn_wg_unit<192, 0, VAR>(F.lds, G, U, nullptr, tid, wave, lane); }
    for (int u = vcu; u < 256; u += F.G) { const int bh = u >> 2, r0 = (u & 3) * 4, b = bh >> 3, h = bh & 7, r = r0 + (wave >> 1), c0 = (wave & 1) * 32, t0 = NCTX + b * 1024 + r * 64 + c0;
        int rs = r - 4; rs = rs < 0 ? 0 : (rs > 8 ? 8 : rs);
        int glo = r0 - 4; glo = glo < 0 ? 0 : (glo > 8 ? 8 : glo); int ghi = r0 - 1; ghi = ghi < 0 ? 0 : (ghi > 8 ? 8 : ghi);
        U.qb = QNA; U.qoff = (unsigned)(t0 * 1024 + h * 128); U.qpitch = 1024; U.scale = 0.08838834764831845f; U.ob = O; U.ooff = (unsigned)(t0 * DM + 1024 + h * 128);
        G.kc = (const bf16_t*)(F.ws + WS_KN_CAC) + (size_t)bh * (512 * 128); G.vc = (const bf16_t*)(F.ws + WS_VN_CAC) + (size_t)bh * (512 * 128); G.nctx = 8;
        G.kl = (const bf16_t*)(F.ws + WS_KN_LAT) + (size_t)bh * (1024 * 128); G.vl = (const bf16_t*)(F.ws + WS_VN_LAT) + (size_t)bh * (1024 * 128); G.t_lo = glo; G.t_hi = ghi + 8; U.w_lo = rs; U.w_hi = rs + 8;
        U.qpos = r; U.qcol0 = c0;
        attn_wg_unit<128, 2, VAR>(F.lds, G, U, F.a->in[IN_RPB] + h * (15 * 31), tid, wave, lane); }
    U.qpos = 0; U.qcol0 = 0; U.w_lo = 0; U.w_hi = 4; G.nctx = 0; G.kc = nullptr; G.vc = nullptr; G.t_lo = 0; G.t_hi = 4;
    for (int u = vcu; u < 256; u += F.G) { const int bh = u & 127, b = bh >> 3, h = bh & 7, t0 = b * 256 + 32 * wave;
        if (u < 128) {
            U.qb = QA; U.qoff = (unsigned)(t0 * 1536 + h * 192); U.qpitch = 1536; U.scale = 0.07216878364870322f; U.ob = O; U.ooff = (unsigned)(t0 * DM + h * 128);
            G.kl = (const bf16_t*)(F.ws + WS_KM_CTX) + (size_t)bh * (256 * 192); G.vl = (const bf16_t*)(F.ws + WS_VM_CTX) + (size_t)bh * (256 * 128);
            attn_wg_unit<192, 0, VAR>(F.lds, G, U, nullptr, tid, wave, lane);
        } else {
            U.qb = QNA; U.qoff = (unsigned)(t0 * 1024 + h * 128); U.qpitch = 1024; U.scale = 0.08838834764831845f; U.ob = O; U.ooff = (unsigned)(t0 * DM + 1024 + h * 128);
            G.kl = (const bf16_t*)(F.ws + WS_KN_CTX) + (size_t)bh * (256 * 128); G.vl = (const bf16_t*)(F.ws + WS_VN_CTX) + (size_t)bh * (256 * 128);
            attn_wg_unit<128, 0, VAR>(F.lds, G, U, nullptr, tid, wave, lane);
        } }
    asm volatile("s_waitcnt vmcnt(0) lgkmcnt(0)" ::: "memory"); __syncthreads();
}
__device__ __forceinline__ void phase_attn_odd(Frame& F) {
    bf16_t* O = (bf16_t*)(F.ws + WS_O); const bf16_t* QA = (const bf16_t*)(F.ws + WS_QA);
    const int wave = F.wave, lane = F.lane, tid = F.tid;
    WgUnit G; WvUnit U; U.has_sink = 1; U.qcol0 = 0; U.qpitch = 2048; U.scale = 0.08838834764831845f;
    const int vcu = (F.G % 8 == 0) ? ((int)blockIdx.x % 8) * (F.G / 8) + (int)blockIdx.x / 8 : (int)blockIdx.x;
    const float* sink = F.a->in[IN_SINK];
    for (int u = vcu; u < 512; u += F.G) { const int bk = u >> 4, q64 = u & 15, b = bk >> 2, kvh = bk & 3, g = wave >> 1, hq = kvh * 4 + g, qs = q64 * 64 + (wave & 1) * 32, t0 = NCTX + b * 1024 + qs;
        U.qb = QA; U.qoff = (unsigned)(t0 * 2048 + hq * 128); U.ob = O; U.ooff = (unsigned)(t0 * DM + hq * 128); U.qpos = qs; U.sink = sink[hq];
        G.kc = (const bf16_t*)(F.ws + WS_KG_CAC) + (size_t)bk * (512 * 128); G.vc = (const bf16_t*)(F.ws + WS_VG_CAC) + (size_t)bk * (512 * 128); G.nctx = 8;
        G.kl = (const bf16_t*)(F.ws + WS_KG_LAT) + (size_t)bk * (1024 * 128); G.vl = (const bf16_t*)(F.ws + WS_VG_LAT) + (size_t)bk * (1024 * 128);
        G.t_lo = q64 - 2 < 0 ? 0 : q64 - 2; G.t_hi = (q64 + 2 > 15 ? 15 : q64 + 2) + 1; U.w_lo = G.t_lo; U.w_hi = G.t_hi;
        attn_wg_unit<128, 1>(F.lds, G, U, nullptr, tid, wave, lane); }
    G.nctx = 0; G.kc = nullptr; G.vc = nullptr; G.t_lo = 0; G.t_hi = 4; U.w_lo = 0; U.w_hi = 4;
    for (int u = vcu; u < 256; u += F.G) { const int bk = u >> 2, q64 = u & 3, b = bk >> 2, kvh = bk & 3, g = wave >> 1, hq = kvh * 4 + g, qs = q64 * 64 + (wave & 1) * 32, t0 = b * 256 + qs;
        U.qb = QA; U.qoff = (unsigned)(t0 * 2048 + hq * 128); U.ob = O; U.ooff = (unsigned)(t0 * DM + hq * 128); U.qpos = 0; U.sink = sink[hq];
        G.kl = (const bf16_t*)(F.ws + WS_KG_CTX) + (size_t)bk * (256 * 128); G.vl = (const bf16_t*)(F.ws + WS_VG_CTX) + (size_t)bk * (256 * 128);
        attn_wg_unit<128, 0>(F.lds, G, U, nullptr, tid, wave, lane); }
    asm volatile("s_waitcnt vmcnt(0) lgkmcnt(0)" ::: "memory"); __syncthreads();
}

constexpr int N_PHASES = 36;
__global__ void __launch_bounds__(512, 2) fwd_kernel(Args args) {
    extern __shared__ __attribute__((aligned(16))) unsigned char lds_raw[];
    Frame F;
    F.lds = (LAS unsigned char*)lds_raw;
    F.tid = threadIdx.x; F.lane = F.tid & 63; F.wave = __builtin_amdgcn_readfirstlane(F.tid >> 6);
    F.G = gridDim.x; F.gw = blockIdx.x * 8 + F.wave; F.NGW = F.G * 8;
    F.a = &args; F.out = args.out; F.ws = args.ws;
    volatile LAS unsigned* MISC = (volatile LAS unsigned*)(F.lds + LDSCTL_OFF);
    for (int u = F.tid; u < (LDS_BYTES - LDSCTL_OFF) / 4; u += 512) ((LAS unsigned*)(F.lds + LDSCTL_OFF))[u] = 0u;
    __syncthreads();
    unsigned* ctl = (unsigned*)(F.ws + WS_CTL);
    const int lo = args.ph_lo, hi = args.ph_hi;
    const bool multi = (hi - lo) > 1;
    XcdBarrier bar; bar.bar = ctl + CW_BAR; bar.x = 0; bar.st = nullptr;
    if (multi) bar = xcd_barrier_post(ctl + CW_BAR, MISC + 8);
#define IN(k) (lo <= (k) && (k) < hi)
    int ph = 0;
#define PHASE(...) do { if (IN(ph)) { __VA_ARGS__ } if (IN(ph) && IN(ph + 1)) xcd_barrier(bar); ++ph; } while (0)
    const float* mods = (const float*)(F.ws + WS_MODS);
    bf16_t* H = (bf16_t*)(F.ws + WS_H); bf16_t* ACT = (bf16_t*)(F.ws + WS_ACT); float* P = (float*)(F.ws + WS_P); bf16_t* OB = (bf16_t*)(F.ws + WS_O);
    LAS unsigned char* ring = F.lds;
    const int cid = (int)blockIdx.x;
#define GEMM2(EPI_T, EDEF, A_, B_, M_, N_, K_, SLAB) \
    PHASE( pg8::Gemm g{(A_), (B_), (M_), (N_), (K_)}; typedef pg8::SplitOrder<(M_), (N_), (K_), true> SO; SO S; S.init(cid); EDEF; pg8::gemm_phase<EPI_T, SO, true, true>(ring, g, S, E, (SLAB)); ); \
    PHASE( typedef pg8::SplitOrder<(M_), (N_), (K_), true> SO; EDEF; pg8::gemm_fixup<EPI_T, SO>(E, (SLAB)); )
#define GEMM1(EPI_T, EDEF, A_, B_, M_, N_, K_) \
    PHASE( pg8::Gemm g{(A_), (B_), (M_), (N_), (K_)}; typedef pg8::SplitOrder<(M_), (N_), (K_), false> SO; SO S; S.init(cid); EDEF; pg8::gemm_phase<EPI_T, SO, true, true>(ring, g, S, E, nullptr); )
#define W_FI(layer, f) ((const bf16_t*)(F.ws + WS_WFI) + (size_t)((layer) * 2 + (f)) * NFF2 * DM)
#define W_FO(layer, f) ((const bf16_t*)(F.ws + WS_WFO) + (size_t)((layer) * 2 + (f)) * DM * DFF)
#define E_SWIGLU EpiSwiGLU E{ACT}
#define E_RESID(RT, layer, gidx, coef) RT E{F.a->in[IN_XP], F.a->in[IN_XS], (bf16_t*)(F.ws + WS_XB), F.out, mods + (size_t)(layer) * 9 * NMOD + (size_t)(gidx) * DM, (coef)}
#define FFN(layer, f, RT) \
    GEMM2(EpiSwiGLU, E_SWIGLU, H, W_FI(layer, f), NTOK, NFF2, DM, P); \
    GEMM2(RT, E_RESID(RT, layer, (f) ? 8 : 2, 0.5f), ACT, W_FO(layer, f), NTOK, DM, DFF, P)

    PHASE( phase_prologue(F); );
    PHASE( phase_norm(F, true, 0, 0); );
    FFN(0, 0, ResidIn);
    PHASE( phase_norm(F, false, 0, 1); );
    GEMM1(EpiBf16, EpiBf16 E{(bf16_t*)P COMMA IN_EVEN_P}, H, (const bf16_t*)(F.ws + WS_WEI), NTOK, IN_EVEN_P, DM);
    PHASE( phase_post1_even(F); );
    PHASE( { pg8::Gemm g{(const bf16_t*)(F.ws + WS_CQN), (const bf16_t*)(F.ws + WS_WQU), NTOK, 1536, 512}; typedef pg8::SplitOrder<NTOK, 1536, 512, false> SO; SO S; S.init(cid);
             EpiBf16 E{(bf16_t*)(F.ws + WS_QM), 1536}; pg8::gemm_phase<EpiBf16, SO, true, true>(ring, g, S, E, nullptr); }
           { pg8::Gemm g{(const bf16_t*)(F.ws + WS_CKVA), (const bf16_t*)(F.ws + WS_WKU), 16384, 2048, 512}; typedef pg8::SplitOrder<16384, 2048, 512, false> SO; SO S; S.init(cid);
             EpiBf16 E{(bf16_t*)(F.ws + WS_ACT), 2048}; pg8::gemm_phase<EpiBf16, SO, true, true>(ring, g, S, E, nullptr); } );
    PHASE( phase_post2_even(F); );
    PHASE( phase_attn_even<0>(F, (bf16_t*)(F.ws + WS_O)); );
    GEMM2(ResidMid, E_RESID(ResidMid, 0, 5, 1.0f), OB, (const bf16_t*)(F.ws + WS_WEO), NTOK, DM, DM, P);
    PHASE( phase_norm(F, false, 0, 2); );
    FFN(0, 1, ResidMid);
    PHASE( phase_norm(F, false, 1, 0); );
    FFN(1, 0, ResidMid);
    PHASE( phase_norm(F, false, 1, 1); );
    GEMM2(EpiBf16, EpiBf16 E{(bf16_t*)P COMMA IN_ODD}, H, (const bf16_t*)(F.ws + WS_WOI), NTOK, IN_ODD, DM, (float*)(F.ws + WS_ACT));
    PHASE( phase_post_odd(F); );
    PHASE( phase_attn_odd(F); );
    GEMM2(ResidMid, E_RESID(ResidMid, 1, 5, 1.0f), OB, (const bf16_t*)(F.ws + WS_WOO), NTOK, DM, DM, P);
    PHASE( phase_norm(F, false, 1, 2); );
    FFN(1, 1, ResidOut);
#undef IN
}

extern "C" void kernel_launch(void* const* d_in, const int* in_sizes, int n_in, void* d_out, int out_size, void* d_ws, size_t ws_size, hipStream_t stream) {
    static int grid = 0;
    if (grid == 0) {
        if (n_in != 28 || (size_t)out_size != O_END || ws_size < WS_END) { fprintf(stderr, "kernel_launch: unexpected shapes (n_in %d, out %d, ws %zu; need ws >= %zu); nothing launched\n", n_in, out_size, ws_size, (size_t)WS_END); grid = -1; return; }
        int dev = 0, cus = 0, per_cu = 0;
        if (hipGetDevice(&dev) != hipSuccess || hipDeviceGetAttribute(&cus, hipDeviceAttributeMultiprocessorCount, dev) != hipSuccess) { grid = -1; return; }
        if (hipFuncSetAttribute((const void*)fwd_kernel, hipFuncAttributeMaxDynamicSharedMemorySize, LDS_BYTES) != hipSuccess) { fprintf(stderr, "kernel_launch: hipFuncSetAttribute failed\n"); grid = -1; return; }
        if (hipOccupancyMaxActiveBlocksPerMultiprocessor(&per_cu, (const void*)fwd_kernel, 512, LDS_BYTES) != hipSuccess || per_cu < 1) { fprintf(stderr, "kernel_launch: occupancy query says %d blocks per CU\n", per_cu); }
        (void)hipGetLastError();
        if (cus < pg8::GRID) { fprintf(stderr, "kernel_launch: %d CUs < %d workgroups: not resident; nothing launched\n", cus, pg8::GRID); grid = -1; return; }
        grid = pg8::GRID;
    }
    if (grid < 0) return;
    if (hipMemsetAsync((char*)d_ws + WS_CTL, 0, CTL_ZERO_BYTES, stream) != hipSuccess) return;
    Args a{};
    for (int i = 0; i < 28; ++i) a.in[i] = (const float*)d_in[i];
    a.out = (float*)d_out; a.ws = (unsigned char*)d_ws;
#if MK_ONE_LAUNCH
    a.ph_lo = 0; a.ph_hi = N_PHASES;
    hipLaunchKernelGGL(fwd_kernel, dim3(grid), dim3(512), LDS_BYTES, stream, a);
#else
    for (int p = 0; p < N_PHASES; ++p) { a.ph_lo = p; a.ph_hi = p + 1; hipLaunchKernelGGL(fwd_kernel, dim3(grid), dim3(512), LDS_BYTES, stream, a); }
#endif
}
```
